# Optimizing an MI355X kernel written in HIP

```python
import jax
import jax.numpy as jnp
from jax import lax
import numpy as np


D_MODEL = 1024
BATCH = 8
SEQ = 4096
DEPTH = 2

HEAD_DIM = 64
HEADS_PER_MIXER = 4
N_MIXERS = 4
N_HEADS = N_MIXERS * HEADS_PER_MIXER
MIX_WIDTH = N_HEADS * HEAD_DIM
QKV_WIDTH = 3 * HEADS_PER_MIXER * HEAD_DIM
Q_BLOCK = 128
IDX_HEADS = 8
IDX_DIM = 64
DSA_TOPK = 256
DILATED_PAIRS = ((128, 1), (512, 4), (2048, 16))
MOBA_BLOCK = 256
MOBA_TOPK = 3
N_ALIBI_MIXERS = 3
N_ALIBI_HEADS = N_ALIBI_MIXERS * HEADS_PER_MIXER
ALIBI_MAX_EXP = 8.0
N_IN = N_MIXERS * QKV_WIDTH + IDX_HEADS * IDX_DIM + IDX_DIM + IDX_HEADS
D_FF = 2816
N_EXPERTS = 8
TOP_K_EXPERTS = 2
D_FF_EXPERT = 3584
EXPERT_BLOCK = 128
NORM_EPS = 1e-6
ADA_INIT_SCALE = 0.5

kernel_name = "hybrid_sb_dsa_dilated_moba_moe_block"


def _rmsnorm(x, g):
    xf = x.astype(jnp.float32)
    y = xf * lax.rsqrt(jnp.mean(xf * xf, axis=-1, keepdims=True) + NORM_EPS)
    return (y * g.astype(jnp.float32)).astype(x.dtype)


def _alibi_slopes(mixer_pos):
    idx = jnp.arange(HEADS_PER_MIXER, dtype=jnp.float32) * N_ALIBI_MIXERS + (mixer_pos + 1)
    return jnp.exp2(-ALIBI_MAX_EXP * idx / N_ALIBI_HEADS)


def _split_heads(p):
    b, l, _ = p.shape
    p = p.reshape(b, l, 3, HEADS_PER_MIXER, HEAD_DIM)
    return p[:, :, 0].transpose(0, 2, 1, 3), p[:, :, 1].transpose(0, 2, 1, 3), p[:, :, 2].transpose(0, 2, 1, 3)


def _qblock(a, i, axis):
    return lax.dynamic_slice_in_dim(a, i * Q_BLOCK, Q_BLOCK, axis=axis)


def _merge_blocks(out):
    nq, b, h, q, d = out.shape
    return out.transpose(1, 2, 0, 3, 4).reshape(b, h, nq * q, d)


def _stick_breaking_attention(q, k, v):
    b, h, l, dh = q.shape
    scale = dh ** -0.5
    kpos = jnp.arange(l)

    def block(i):
        qs = _qblock(q, i, 2)
        qpos = i * Q_BLOCK + jnp.arange(Q_BLOCK)
        z = jnp.einsum('bhqd,bhkd->bhqk', qs, k).astype(jnp.float32) * scale
        past = kpos[None, :] < qpos[:, None]
        log_1m = jnp.where(past, jax.nn.log_sigmoid(-z), 0.0)
        after = lax.cumsum(log_1m, axis=3, reverse=True) - log_1m
        a = jnp.where(past, jnp.exp(jax.nn.log_sigmoid(z) + after), 0.0)
        return jnp.einsum('bhqk,bhkd->bhqd', a.astype(v.dtype), v)

    return _merge_blocks(lax.map(block, jnp.arange(l // Q_BLOCK)))


def _dsa_attention(q, k, v, q_idx, k_idx, w_idx, slopes):
    b, h, l, dh = q.shape
    n_sel = min(DSA_TOPK, l // 4)
    scale = dh ** -0.5
    kpos = jnp.arange(l)

    def block(i):
        qs = _qblock(q, i, 2)
        qi = _qblock(q_idx, i, 1)
        wi = _qblock(w_idx, i, 1).astype(jnp.float32) * IDX_HEADS ** -0.5
        qpos = i * Q_BLOCK + jnp.arange(Q_BLOCK)
        rel = jax.nn.relu(jnp.einsum('bqhd,bkd->bqhk', qi, k_idx).astype(jnp.float32) * IDX_DIM ** -0.5)
        score = jnp.einsum('bqh,bqhk->bqk', wi, rel)
        score = jnp.where(kpos[None, None, :] <= qpos[None, :, None], score, -jnp.inf)
        sel_score, sel_idx = lax.top_k(score, n_sel)
        kg = jax.vmap(lambda kk, ii: kk[:, ii])(k, sel_idx)
        vg = jax.vmap(lambda vv, ii: vv[:, ii])(v, sel_idx)
        dist = (qpos[None, :, None] - sel_idx).astype(jnp.float32)
        s = jnp.einsum('bhqd,bhqsd->bhqs', qs, kg).astype(jnp.float32) * scale
        s = s - slopes[None, :, None, None] * dist[:, None]
        s = jnp.where(jnp.isfinite(sel_score)[:, None], s, -jnp.inf)
        p = jax.nn.softmax(s, axis=-1)
        return jnp.einsum('bhqs,bhqsd->bhqd', p.astype(v.dtype), vg)

    return _merge_blocks(lax.map(block, jnp.arange(l // Q_BLOCK)))


def _dilated_attention(q, k, v, slopes):
    b, h, l, dh = q.shape
    scale = dh ** -0.5

    def block(i):
        qs = _qblock(q, i, 2)
        qpos = i * Q_BLOCK + jnp.arange(Q_BLOCK)
        outs, lses = [], []
        for window, dilation in DILATED_PAIRS:
            dist = jnp.arange(window // dilation + 1) * dilation
            kpos = qpos[:, None] - dist[None, :]
            kidx = jnp.maximum(kpos, 0)
            kg = k[:, :, kidx]
            vg = v[:, :, kidx]
            s = jnp.einsum('bhqd,bhqnd->bhqn', qs, kg).astype(jnp.float32) * scale
            s = s - slopes[:, None, None] * dist.astype(jnp.float32)
            s = jnp.where(kpos >= 0, s, -jnp.inf)
            m = jnp.max(s, axis=-1, keepdims=True)
            e = jnp.exp(s - m)
            den = jnp.sum(e, axis=-1, keepdims=True)
            outs.append(jnp.einsum('bhqn,bhqnd->bhqd', e, vg.astype(jnp.float32)) / den)
            lses.append(m + jnp.log(den))
        wts = jax.nn.softmax(jnp.stack(lses), axis=0)
        return jnp.sum(wts * jnp.stack(outs), axis=0).astype(v.dtype)

    return _merge_blocks(lax.map(block, jnp.arange(l // Q_BLOCK)))


def _moba_attention(q, k, v, slopes):
    b, h, l, dh = q.shape
    scale = dh ** -0.5
    nb = -(-l // MOBA_BLOCK)
    pad = nb * MOBA_BLOCK - l
    kb = jnp.pad(k, ((0, 0), (0, 0), (0, pad), (0, 0))).reshape(b, h, nb, MOBA_BLOCK, dh)
    vb = jnp.pad(v, ((0, 0), (0, 0), (0, pad), (0, 0))).reshape(b, h, nb, MOBA_BLOCK, dh)
    blk_len = jnp.clip(l - jnp.arange(nb) * MOBA_BLOCK, 1, MOBA_BLOCK).astype(jnp.float32)
    k_mean = kb.astype(jnp.float32).sum(axis=3) / blk_len[:, None]
    n_slots = min(MOBA_TOPK, nb - 1)
    offs = jnp.arange(MOBA_BLOCK)
    gather = jax.vmap(jax.vmap(lambda t, ii: t[ii]))

    def block(i):
        qs = _qblock(q, i, 2)
        qpos = i * Q_BLOCK + jnp.arange(Q_BLOCK)
        own = (i * Q_BLOCK) // MOBA_BLOCK
        k_own = lax.dynamic_index_in_dim(kb, own, axis=2, keepdims=False)
        v_own = lax.dynamic_index_in_dim(vb, own, axis=2, keepdims=False)
        own_pos = own * MOBA_BLOCK + offs
        s_own = jnp.einsum('bhqd,bhxd->bhqx', qs, k_own).astype(jnp.float32) * scale
        s_own = s_own - slopes[:, None, None] * (qpos[:, None] - own_pos[None, :]).astype(jnp.float32)
        s_own = jnp.where(own_pos[None, :] <= qpos[:, None], s_own, -jnp.inf)
        scores = [s_own]
        sel = []
        if n_slots > 0:
            g = jnp.einsum('bhqd,bhnd->bhqn', qs.astype(jnp.float32), k_mean)
            g = jnp.where(jnp.arange(nb) < own, g, -jnp.inf)
            g_val, g_idx = lax.top_k(g, n_slots)
            for j in range(n_slots):
                bj = g_idx[..., j]
                sel.append(bj)
                kg = gather(kb, bj)
                pos = bj[..., None] * MOBA_BLOCK + offs
                s = jnp.einsum('bhqd,bhqxd->bhqx', qs, kg).astype(jnp.float32) * scale
                s = s - slopes[:, None, None] * (qpos[:, None] - pos).astype(jnp.float32)
                s = jnp.where(jnp.isfinite(g_val[..., j:j + 1]), s, -jnp.inf)
                scores.append(s)
        p = jax.nn.softmax(jnp.concatenate(scores, axis=-1), axis=-1).astype(v.dtype)
        out = jnp.einsum('bhqx,bhxd->bhqd', p[..., :MOBA_BLOCK], v_own)
        for j, bj in enumerate(sel):
            vg = gather(vb, bj)
            out = out + jnp.einsum('bhqx,bhqxd->bhqd', p[..., (j + 1) * MOBA_BLOCK:(j + 2) * MOBA_BLOCK], vg)
        return out

    return _merge_blocks(lax.map(block, jnp.arange(l // Q_BLOCK)))


def _token_mixer(h, w_in, g_heads, w_out):
    b, l, _ = h.shape
    p = h @ w_in
    cuts = [int(c) for c in np.cumsum([QKV_WIDTH] * N_MIXERS + [IDX_HEADS * IDX_DIM, IDX_DIM])]
    pa, pb, pc, pd, pqi, pki, pwi = jnp.split(p, cuts, axis=-1)
    o_a = _stick_breaking_attention(*_split_heads(pa))
    o_b = _dsa_attention(*_split_heads(pb), pqi.reshape(b, l, IDX_HEADS, IDX_DIM), pki, pwi, _alibi_slopes(0))
    o_c = _dilated_attention(*_split_heads(pc), _alibi_slopes(1))
    o_d = _moba_attention(*_split_heads(pd), _alibi_slopes(2))
    o = jnp.concatenate([o_a, o_b, o_c, o_d], axis=1)
    o = _rmsnorm(o, g_heads[None, :, None, :])
    o = o.transpose(0, 2, 1, 3).reshape(b, l, MIX_WIDTH)
    return o @ w_out


def _swiglu(h, wg, wu, wd):
    return (jax.nn.silu(h @ wg) * (h @ wu)) @ wd


def _moe_ffn(h, w_router, w_gate, w_up, w_down):
    t, d = h.shape
    logits = h.astype(jnp.float32) @ w_router.astype(jnp.float32)
    top_val, top_idx = lax.top_k(logits, TOP_K_EXPERTS)
    gate = jax.nn.softmax(top_val, axis=-1)
    n_assign = t * TOP_K_EXPERTS
    flat_e = top_idx.reshape(-1).astype(jnp.int32)
    flat_tok = jnp.arange(n_assign, dtype=jnp.int32) // TOP_K_EXPERTS
    flat_g = gate.reshape(-1)
    order = jnp.argsort(flat_e)
    e_s, tok_s, g_s = flat_e[order], flat_tok[order], flat_g[order]
    counts = jnp.bincount(flat_e, length=N_EXPERTS).astype(jnp.int32)
    padded = (counts + EXPERT_BLOCK - 1) // EXPERT_BLOCK * EXPERT_BLOCK
    pad_end = jnp.cumsum(padded)
    pad_start = pad_end - padded
    start = jnp.cumsum(counts) - counts
    dest = pad_start[e_s] + jnp.arange(n_assign, dtype=jnp.int32) - start[e_s]
    n_slots = -(-n_assign // EXPERT_BLOCK) * EXPERT_BLOCK + N_EXPERTS * EXPERT_BLOCK
    n_blocks = n_slots // EXPERT_BLOCK
    slot_tok = jnp.zeros((n_slots,), jnp.int32).at[dest].set(tok_s)
    block_e = jnp.minimum(jnp.searchsorted(pad_end, jnp.arange(n_blocks, dtype=jnp.int32) * EXPERT_BLOCK, side='right'), N_EXPERTS - 1)
    xs = h[slot_tok].reshape(n_blocks, EXPERT_BLOCK, d)

    def expert_block(args):
        xb, e = args
        return _swiglu(xb, w_gate[e], w_up[e], w_down[e])

    ys = lax.map(expert_block, (xs, block_e)).reshape(n_slots, d)
    y_assign = ys[dest] * g_s[:, None].astype(h.dtype)
    return jnp.zeros_like(h).at[tok_s].add(y_assign)


def setup_inputs(seed: int = 0) -> dict:
    key = jax.random.key(seed)
    ks = jax.random.split(key, 17)
    n_dense = (DEPTH + 1) // 2
    n_moe = DEPTH // 2
    f32 = jnp.float32

    def nrm(k, shape, fan_in):
        return jax.random.normal(k, shape, f32) * fan_in ** -0.5

    def gain(k, shape):
        return 1.0 + 0.02 * jax.random.normal(k, shape, f32)

    return {
        'x': jax.random.normal(ks[0], (BATCH, SEQ, D_MODEL), f32),
        'c': jax.random.normal(ks[1], (BATCH, D_MODEL), f32),
        'w_ada': nrm(ks[2], (DEPTH, D_MODEL, 6 * D_MODEL), D_MODEL) * ADA_INIT_SCALE,
        'b_ada': 0.02 * jax.random.normal(ks[3], (DEPTH, 6 * D_MODEL), f32),
        'g_mix': gain(ks[4], (DEPTH, D_MODEL)),
        'w_in': nrm(ks[5], (DEPTH, D_MODEL, N_IN), D_MODEL),
        'g_heads': gain(ks[6], (DEPTH, N_HEADS, HEAD_DIM)),
        'w_out': nrm(ks[7], (DEPTH, MIX_WIDTH, D_MODEL), MIX_WIDTH),
        'g_ffn': gain(ks[8], (DEPTH, D_MODEL)),
        'w_ff_gate': nrm(ks[9], (n_dense, D_MODEL, D_FF), D_MODEL),
        'w_ff_up': nrm(ks[10], (n_dense, D_MODEL, D_FF), D_MODEL),
        'w_ff_down': nrm(ks[11], (n_dense, D_FF, D_MODEL), D_FF),
        'w_router': nrm(ks[12], (n_moe, D_MODEL, N_EXPERTS), D_MODEL),
        'w_exp_gate': nrm(ks[13], (n_moe, N_EXPERTS, D_MODEL, D_FF_EXPERT), D_MODEL),
        'w_exp_up': nrm(ks[14], (n_moe, N_EXPERTS, D_MODEL, D_FF_EXPERT), D_MODEL),
        'w_exp_down': nrm(ks[15], (n_moe, N_EXPERTS, D_FF_EXPERT, D_MODEL), D_FF_EXPERT),
        'g_final': gain(ks[16], (D_MODEL,)),
    }


def reference(x, c, w_ada, b_ada, g_mix, w_in, g_heads, w_out, g_ffn, w_ff_gate, w_ff_up, w_ff_down, w_router, w_exp_gate, w_exp_up, w_exp_down, g_final):
    b, l, d = x.shape
    cond = jax.nn.silu(c)
    for layer in range(DEPTH):
        mod = (cond @ w_ada[layer] + b_ada[layer])[:, None, :]
        shift_m, scale_m, gate_m, shift_f, scale_f, gate_f = jnp.split(mod, 6, axis=-1)
        hm = _rmsnorm(x, g_mix[layer]) * (1 + scale_m) + shift_m
        x = x + gate_m * _token_mixer(hm, w_in[layer], g_heads[layer], w_out[layer])
        hf = _rmsnorm(x, g_ffn[layer]) * (1 + scale_f) + shift_f
        i = layer // 2
        if layer % 2 == 0:
            y = _swiglu(hf, w_ff_gate[i], w_ff_up[i], w_ff_down[i])
        else:
            y = _moe_ffn(hf.reshape(b * l, d), w_router[i], w_exp_gate[i], w_exp_up[i], w_exp_down[i]).reshape(b, l, d)
        x = x + gate_f * y
    return _rmsnorm(x, g_final)
```

```cpp
#include <hip/hip_runtime.h>
#include <cstdio>
#include <cstdint>

#define LAS __attribute__((address_space(3)))
#define GAS __attribute__((address_space(1)))
typedef unsigned short bf16;
typedef short bf16x8 __attribute__((ext_vector_type(8)));
typedef float f32x4 __attribute__((ext_vector_type(4)));
typedef float f32x16 __attribute__((ext_vector_type(16)));
typedef unsigned u32x4 __attribute__((ext_vector_type(4)));
typedef unsigned u32x2 __attribute__((ext_vector_type(2)));

constexpr int NB = 8, SEQ = 4096, T = NB * SEQ, DM = 1024, NLAYER = 2;
constexpr int PW = 3840;
constexpr int NIN = 3656;
constexpr int COL_QI = 3072, COL_KI = 3584, COL_WI = 3648;
constexpr int DFF = 2816, DFE = 3584, NEXP = 8;
constexpr float EPS = 1e-6f;
constexpr int XS_TILES = 264;

constexpr size_t MiB = 1u << 20;
constexpr size_t WS_CTL = 0, CTL_BYTES = 1 * MiB;
constexpr size_t WS_MOD = 1 * MiB;
constexpr size_t WS_KMEAN = 1 * MiB + 512 * 1024;
constexpr size_t WS_MOBASEL = 1 * MiB + 768 * 1024;
constexpr size_t WS_TOK = 2 * MiB;
constexpr size_t WS_WIN = 4 * MiB;
constexpr size_t WS_WOUT = 19 * MiB;
constexpr size_t WS_WFU = 23 * MiB;
constexpr size_t WS_WFD = 34 * MiB;
constexpr size_t WS_ACT = 40 * MiB;
constexpr size_t WS_P = 104 * MiB;
constexpr size_t WS_HID = 104 * MiB;
constexpr size_t WS_XS = 216 * MiB;
constexpr size_t WS_MASK = 344 * MiB;
constexpr size_t WS_WEU = 360 * MiB;
constexpr size_t WS_WED = 472 * MiB;
constexpr size_t WS_END = 528 * MiB;
constexpr int CW_ECNT = 64;
constexpr int CW_BAR = 4096;

__device__ __forceinline__ float bf2f(unsigned v) { return __uint_as_float(v << 16); }
__device__ __forceinline__ unsigned f2bf(float f) { unsigned u = __float_as_uint(f); return (u + 0x7fffu + ((u >> 16) & 1u)) >> 16; }
__device__ __forceinline__ unsigned pk2(float lo, float hi) { return f2bf(lo) | (f2bf(hi) << 16); }
__device__ __forceinline__ unsigned cvt_pk_bf16(float lo, float hi) { unsigned r; asm volatile("v_cvt_pk_bf16_f32 %0, %1, %2" : "=v"(r) : "v"(lo), "v"(hi)); return r; }
__device__ __forceinline__ float wave_sum(float v) {
#pragma unroll
    for (int o = 1; o < 64; o <<= 1) v += __shfl_xor(v, o);
    return v;
}
__device__ __forceinline__ void ld8(const bf16* p, float* f) {
    const u32x4 u = *(const u32x4*)p;
    f[0] = __uint_as_float(u.x << 16); f[1] = __uint_as_float(u.x & 0xffff0000u);
    f[2] = __uint_as_float(u.y << 16); f[3] = __uint_as_float(u.y & 0xffff0000u);
    f[4] = __uint_as_float(u.z << 16); f[5] = __uint_as_float(u.z & 0xffff0000u);
    f[6] = __uint_as_float(u.w << 16); f[7] = __uint_as_float(u.w & 0xffff0000u);
}
__device__ __forceinline__ float alibi_slope(int mixer_pos, int h) { return exp2f(-8.0f * (float)(3 * h + mixer_pos + 1) / 12.0f); }
__device__ __forceinline__ float silu_f(float x) { return x * __builtin_amdgcn_rcpf(1.0f + __expf(-x)); }
namespace pg8 {
#define PG8_LAS __attribute__((address_space(3)))
typedef unsigned short bf16_t;
typedef short bf16x8 __attribute__((ext_vector_type(8)));
typedef float f32x4 __attribute__((ext_vector_type(4)));
typedef unsigned u32x4 __attribute__((ext_vector_type(4)));
constexpr int BM = 256, BK = 64, HALF = 128, HTB = HALF * BK * 2  , STAGE_BYTES = 8 * HTB, NXCD = 8, WGM = 8;

__host__ __device__ __forceinline__ int lds_byte(int r, int c) { const int st = (r >> 4) * 2 + (c >> 5), rr = r & 15, cc = c & 31, ob = rr * 64 + cc * 2; return st * 1024 + (ob ^ (((ob >> 9) & 1) << 5)); }
__host__ __device__ __forceinline__ void stage_rc(int b, int& R, int& C) { const int st = b / 1024, sb = b % 1024, swz = sb ^ (((sb >> 9) & 1) << 5); R = (st >> 1) * 16 + swz / 64; C = (st & 1) * 32 + (swz % 64) / 2; }
__host__ __device__ __forceinline__ int perm32(int rho) { const int n = rho >> 4, i = rho & 15; return 8 * (i >> 2) + 4 * n + (i & 3); }

struct Unit { int pm, pn; };
struct Gemm { const bf16_t* A; const bf16_t* Bt; int M, N, K; };

struct StaticOrder {
    int nM, nN, nwg, G, c;
    __host__ __device__ void init(int M, int N, int G_, int c_) { nM = M / BM; nN = N / BM; nwg = nM * nN; G = G_; c = c_; }
    __host__ __device__ bool next(int i, Unit& u) const {
        const long L = (long)i * G + c; if (L >= nwg) return false;
        int wgid = (int)L; { const int q = nwg / NXCD, r = nwg % NXCD, xcd = wgid % NXCD, off = wgid / NXCD; wgid = (xcd < r ? xcd * (q + 1) : r * (q + 1) + (xcd - r) * q) + off; }
        const int nig = WGM * nN, gid = wgid / nig, fm = gid * WGM, gsz = (nM - fm) < WGM ? (nM - fm) : WGM;
        u.pm = fm + ((wgid % nig) % gsz); u.pn = (wgid % nig) / gsz; return true;
    }
    __device__ __forceinline__ void a_ready(const Unit&) const {}
    __device__ __forceinline__ void done(const Unit&) const {}
    __device__ __forceinline__ const char* a_base(const Gemm& g, const Unit& u, size_t tstep) const { return (const char*)g.A + (size_t)u.pm * tstep; }
    __device__ __forceinline__ const char* b_base(const Gemm& g, const Unit& u, size_t tstep) const { return (const char*)g.Bt + (size_t)u.pn * tstep; }
};


struct EpiBf16 {
    static constexpr bool PERM = true, AFTER_DRAIN = false;
    bf16_t* O; int ldc; int row_shift;
    __device__ __forceinline__ void operator()(const f32x4 (&acc)[2][2][4][2], const Unit& u, int wr, int wc, int fr, int fq) const {
        const int row0 = u.pm * BM + row_shift + wr * 64 + fr, col0 = u.pn * BM + wc * 32 + 8 * fq;
#pragma unroll
        for (int ai = 0; ai < 2; ++ai)
#pragma unroll
            for (int m = 0; m < 4; ++m) { bf16_t* rowp = O + (size_t)(row0 + ai * HALF + m * 16) * ldc + col0;
#pragma unroll
                for (int bj = 0; bj < 2; ++bj) { const f32x4 v0 = acc[ai][bj][m][0], v1 = acc[ai][bj][m][1];
                    u32x4 w; w.x = cvt_pk_bf16(v0[0], v0[1]); w.y = cvt_pk_bf16(v0[2], v0[3]); w.z = cvt_pk_bf16(v1[0], v1[1]); w.w = cvt_pk_bf16(v1[2], v1[3]);
                    *(u32x4*)(rowp + bj * HALF) = w; } }
    }
};
struct EpiSwiGLU {
    static constexpr bool PERM = true, AFTER_DRAIN = false;
    bf16_t* H; int ldh; int row_shift;
    __device__ __forceinline__ void operator()(const f32x4 (&acc)[2][2][4][2], const Unit& u, int wr, int wc, int fr, int fq) const {
        const int row0 = u.pm * BM + row_shift + wr * 64 + fr, col0 = u.pn * HALF + wc * 32 + 8 * fq;
#pragma unroll
        for (int ai = 0; ai < 2; ++ai)
#pragma unroll
            for (int m = 0; m < 4; ++m) { bf16_t* rowp = H + (size_t)(row0 + ai * HALF + m * 16) * ldh + col0;
                const f32x4 g0 = acc[ai][0][m][0], g1 = acc[ai][0][m][1], u0 = acc[ai][1][m][0], u1 = acc[ai][1][m][1];
                float h[8];
#pragma unroll
                for (int i = 0; i < 4; ++i) { h[i] = silu_f(g0[i]) * u0[i]; h[4 + i] = silu_f(g1[i]) * u1[i]; }
                u32x4 w; w.x = cvt_pk_bf16(h[0], h[1]); w.y = cvt_pk_bf16(h[2], h[3]); w.z = cvt_pk_bf16(h[4], h[5]); w.w = cvt_pk_bf16(h[6], h[7]);
                *(u32x4*)rowp = w; }
    }
};
struct EpiRes {
    static constexpr bool PERM = false, AFTER_DRAIN = false;
    const float* xin; float* xout; const float* gate;
    __device__ __forceinline__ void operator()(const f32x4 (&acc)[2][2][4][2], const Unit& u, int wr, int wc, int fr, int fq) const {
        const int row0 = u.pm * BM + wr * 64 + fr, col0 = u.pn * BM + wc * 32 + 4 * fq;
        const float* gb = gate + (size_t)((u.pm * BM) / SEQ) * 6144;
        f32x4 gv[2][2];
#pragma unroll
        for (int bj = 0; bj < 2; ++bj)
#pragma unroll
            for (int n = 0; n < 2; ++n) gv[bj][n] = *(const f32x4*)(gb + col0 + bj * HALF + n * 16);
#pragma unroll
        for (int ai = 0; ai < 2; ++ai)
#pragma unroll
            for (int m = 0; m < 4; ++m) { const size_t off = (size_t)(row0 + ai * HALF + m * 16) * DM + col0;
#pragma unroll
                for (int bj = 0; bj < 2; ++bj)
#pragma unroll
                    for (int n = 0; n < 2; ++n) { const f32x4 x = *(const f32x4*)(xin + off + bj * HALF + n * 16);
                        *(f32x4*)(xout + off + bj * HALF + n * 16) = x + gv[bj][n] * acc[ai][bj][m][n]; } }
    }
};
struct MoeOrder {
    int t0, nrt, nN, G, c, a_rel; int ts1, ts2, ts3, ts4, ts5, ts6, ts7; size_t estride;
    __device__ __forceinline__ bool next(int i, Unit& u) const {
        const int L = i * G + c; if (nrt <= 0 || L >= nrt * nN) return false;
        u.pm = t0 + L % nrt; u.pn = L / nrt; return true;
    }
    __device__ __forceinline__ void a_ready(const Unit&) const {}
    __device__ __forceinline__ void done(const Unit&) const {}
    __device__ __forceinline__ const char* a_base(const Gemm& g, const Unit& u, size_t tstep) const { return (const char*)g.A + (size_t)(u.pm - (a_rel ? t0 : 0)) * tstep; }
    __device__ __forceinline__ const char* b_base(const Gemm& g, const Unit& u, size_t tstep) const {
        const int p = u.pm; const int e = (p >= ts1) + (p >= ts2) + (p >= ts3) + (p >= ts4) + (p >= ts5) + (p >= ts6) + (p >= ts7);
        return (const char*)g.Bt + (size_t)e * estride + (size_t)u.pn * tstep;
    }
};
template <class Epi, class Sched, bool ALIGN_EPI = false, bool SP2 = false>
__device__ __forceinline__ void gemm_phase(PG8_LAS unsigned char* lds, const Gemm g, const Sched& S, const Epi& E) {
    const int tid = threadIdx.x, wid = __builtin_amdgcn_readfirstlane(tid >> 6), lane = tid & 63, wr = wid >> 2, wc = wid & 3, fr = lane & 15, fq = lane >> 4;
    const int K = g.K, nt = K / BK;
    unsigned voffA[2], voffB[2];
#pragma unroll
    for (int i = 0; i < 2; ++i) { int R, C; stage_rc(tid * 16 + i * 8192, R, C); const int Rb = Epi::PERM ? ((R & ~31) + perm32(R & 31)) : R;
        voffA[i] = (unsigned)(R * K + C) * 2u; voffB[i] = (unsigned)(Rb * K + C) * 2u; }
    const size_t kstep = (size_t)(BK * 2);
    const size_t hstep = (size_t)HALF * K * 2;
    const size_t tstep = 2 * hstep;
    const unsigned ldsw = (unsigned)wid * 1024u;
    const int aoff = lds_byte(wr * 64 + fr, fq * 8), boff = lds_byte(wc * 32 + fr, fq * 8);
#define PG8_SA(b, h) (((b) * 2 + (h)) * HTB)
#define PG8_SB(b, h) ((4 + (b) * 2 + (h)) * HTB)
#define PG8_STAGE(bufoff, gbase, voff) do { _Pragma("unroll") for (int _i = 0; _i < 2; ++_i) \
        __builtin_amdgcn_global_load_lds((const unsigned*)((const char*)(gbase) + (voff)[_i]), (PG8_LAS unsigned*)(lds + (bufoff) + ldsw + _i * 8192), 16, 0, 0); } while (0)
#define PG8_LDA(dst, b, h) do { _Pragma("unroll") for (int m = 0; m < 4; ++m) _Pragma("unroll") for (int k = 0; k < 2; ++k) dst[m][k] = *(const PG8_LAS bf16x8*)(lds + PG8_SA(b, h) + aoff + m * 2048 + k * 1024); } while (0)
#define PG8_LDB(dst, b, h) do { _Pragma("unroll") for (int n = 0; n < 2; ++n) _Pragma("unroll") for (int k = 0; k < 2; ++k) dst[n][k] = *(const PG8_LAS bf16x8*)(lds + PG8_SB(b, h) + boff + n * 2048 + k * 1024); } while (0)
#define PG8_MMA(ai, bj, At, Bt) do { __builtin_amdgcn_s_setprio(1); _Pragma("unroll") for (int m = 0; m < 4; ++m) _Pragma("unroll") for (int n = 0; n < 2; ++n) _Pragma("unroll") for (int k = 0; k < 2; ++k) \
        acc[ai][bj][m][n] = __builtin_amdgcn_mfma_f32_16x16x32_bf16(Bt[n][k], At[m][k], acc[ai][bj][m][n], 0, 0, 0); __builtin_amdgcn_s_setprio(0); } while (0)
#define PG8_WAIT_V(n) asm volatile("s_waitcnt vmcnt(" #n ")" ::: "memory")
#define PG8_WAIT_L(n) asm volatile("s_waitcnt lgkmcnt(" #n ")" ::: "memory")
#define PG8_BAR __builtin_amdgcn_s_barrier()
#define PG8_SCHED __builtin_amdgcn_sched_barrier(0)
    Unit cur, nxt; int ui = 0;
    if (!S.next(0, cur)) return;
    f32x4 acc[2][2][4][2];
#pragma unroll
    for (int a = 0; a < 2; ++a)
#pragma unroll
        for (int b = 0; b < 2; ++b)
#pragma unroll
            for (int m = 0; m < 4; ++m)
#pragma unroll
                for (int n = 0; n < 2; ++n) acc[a][b][m][n] = (f32x4){0.f, 0.f, 0.f, 0.f};
    bf16x8 At[4][2], B0[2][2], B1[2][2];
    const char* cA = S.a_base(g, cur, tstep); const char* cB = S.b_base(g, cur, tstep);
    S.a_ready(cur);
    if constexpr (SP2) {
        PG8_STAGE(PG8_SB(0, 0), cB, voffB); PG8_STAGE(PG8_SB(0, 1), cB + hstep, voffB); PG8_STAGE(PG8_SA(0, 0), cA, voffA); PG8_STAGE(PG8_SA(0, 1), cA + hstep, voffA);
        if (wr == 1) PG8_BAR;
        PG8_WAIT_V(2); PG8_BAR;
        PG8_STAGE(PG8_SB(1, 0), cB + kstep, voffB); PG8_STAGE(PG8_SA(1, 0), cA + kstep, voffA); PG8_STAGE(PG8_SB(1, 1), cB + hstep + kstep, voffB);
        PG8_WAIT_V(6); PG8_BAR;
    } else {
        PG8_STAGE(PG8_SB(0, 0), cB, voffB); PG8_STAGE(PG8_SA(0, 0), cA, voffA); PG8_STAGE(PG8_SB(0, 1), cB + hstep, voffB); PG8_STAGE(PG8_SA(0, 1), cA + hstep, voffA);
        if (wr == 1) PG8_BAR;
        PG8_WAIT_V(4); PG8_BAR;
        PG8_STAGE(PG8_SB(1, 0), cB + kstep, voffB); PG8_STAGE(PG8_SA(1, 0), cA + kstep, voffA); PG8_STAGE(PG8_SB(1, 1), cB + hstep + kstep, voffB);
        PG8_WAIT_V(6); PG8_BAR;
    }
    for (;;) {
        const bool has_next = S.next(ui + 1, nxt);
        const char* nA = has_next ? S.a_base(g, nxt, tstep) : cA; const char* nB = has_next ? S.b_base(g, nxt, tstep) : cB;
        for (int t = 0; t < nt; t += 2) {
            const bool last = (t == nt - 2);
            const char* a1 = cA + (size_t)(t + 1) * kstep;
            const char* a2 = last ? nA : cA + (size_t)(t + 2) * kstep; const char* b2 = last ? nB : cB + (size_t)(t + 2) * kstep;
            const char* a3 = a2 + kstep; const char* b3 = b2 + kstep;
            if (last && has_next) S.a_ready(nxt);
            if constexpr (SP2) {
            PG8_LDB(B0, 0, 0); PG8_LDB(B1, 0, 1); PG8_SCHED; PG8_LDA(At, 0, 0); PG8_STAGE(PG8_SA(1, 1), a1 + hstep, voffA);
            PG8_WAIT_V(8); PG8_WAIT_L(0); PG8_BAR; PG8_MMA(0, 0, At, B0); PG8_MMA(0, 1, At, B1); PG8_BAR; PG8_SCHED;
            PG8_LDA(At, 0, 1); PG8_STAGE(PG8_SB(0, 0), b2, voffB); PG8_STAGE(PG8_SB(0, 1), b2 + hstep, voffB); PG8_STAGE(PG8_SA(0, 0), a2, voffA);
            PG8_WAIT_V(8); PG8_WAIT_L(0); PG8_BAR; PG8_MMA(1, 0, At, B0); PG8_MMA(1, 1, At, B1); PG8_BAR; PG8_SCHED;
            PG8_LDB(B0, 1, 0); PG8_LDB(B1, 1, 1); PG8_SCHED; PG8_LDA(At, 1, 0); PG8_STAGE(PG8_SA(0, 1), a2 + hstep, voffA);
            PG8_WAIT_V(8); PG8_WAIT_L(0); PG8_BAR; PG8_MMA(0, 0, At, B0); PG8_MMA(0, 1, At, B1); PG8_BAR; PG8_SCHED;
            PG8_LDA(At, 1, 1); PG8_STAGE(PG8_SB(1, 0), b3, voffB); PG8_STAGE(PG8_SB(1, 1), b3 + hstep, voffB); PG8_STAGE(PG8_SA(1, 0), a3, voffA);
            PG8_WAIT_V(8); PG8_WAIT_L(0); PG8_BAR; PG8_MMA(1, 0, At, B0); PG8_MMA(1, 1, At, B1); PG8_BAR; PG8_SCHED;
            } else {
            PG8_LDB(B0, 0, 0); PG8_SCHED; PG8_LDA(At, 0, 0); PG8_STAGE(PG8_SA(1, 1), a1 + hstep, voffA);
            PG8_WAIT_L(8); PG8_BAR; PG8_WAIT_L(0); PG8_MMA(0, 0, At, B0); PG8_BAR; PG8_SCHED;
            PG8_LDB(B1, 0, 1); PG8_STAGE(PG8_SB(0, 0), b2, voffB);
            PG8_BAR; PG8_WAIT_L(0); PG8_MMA(0, 1, At, B1); PG8_BAR;
            PG8_LDA(At, 0, 1); PG8_STAGE(PG8_SA(0, 0), a2, voffA);
            PG8_BAR; PG8_WAIT_L(0); PG8_MMA(1, 0, At, B0); PG8_BAR; PG8_SCHED;
            PG8_STAGE(PG8_SB(0, 1), b2 + hstep, voffB);
            PG8_WAIT_V(6); PG8_BAR; PG8_MMA(1, 1, At, B1); PG8_BAR;
            PG8_LDB(B0, 1, 0); PG8_SCHED; PG8_LDA(At, 1, 0); PG8_STAGE(PG8_SA(0, 1), a2 + hstep, voffA);
            PG8_WAIT_L(8); PG8_BAR; PG8_WAIT_L(0); PG8_MMA(0, 0, At, B0); PG8_BAR; PG8_SCHED;
            PG8_LDB(B1, 1, 1); PG8_STAGE(PG8_SB(1, 0), b3, voffB);
            PG8_BAR; PG8_WAIT_L(0); PG8_MMA(0, 1, At, B1); PG8_BAR;
            PG8_LDA(At, 1, 1); PG8_STAGE(PG8_SA(1, 0), a3, voffA);
            PG8_BAR; PG8_WAIT_L(0); PG8_MMA(1, 0, At, B0); PG8_BAR; PG8_SCHED;
            PG8_STAGE(PG8_SB(1, 1), b3 + hstep, voffB);
            PG8_WAIT_V(6); PG8_BAR; PG8_MMA(1, 1, At, B1); PG8_BAR;
            }
        }
        if constexpr (ALIGN_EPI) { if (wr == 0) PG8_BAR; }
        if constexpr (!Epi::AFTER_DRAIN) { E(acc, cur, wr, wc, fr, fq); S.done(cur); }
        if (!has_next) break;
#pragma unroll
        for (int a = 0; a < 2; ++a)
#pragma unroll
            for (int b = 0; b < 2; ++b)
#pragma unroll
                for (int m = 0; m < 4; ++m)
#pragma unroll
                    for (int n = 0; n < 2; ++n) acc[a][b][m][n] = (f32x4){0.f, 0.f, 0.f, 0.f};
        cur = nxt; cA = nA; cB = nB; ++ui;
        if constexpr (ALIGN_EPI) { if (wr == 1) PG8_BAR; }
    }
    PG8_WAIT_V(0);
    if constexpr (!ALIGN_EPI) { if (wr == 0) PG8_BAR; }
    PG8_BAR;
    if constexpr (Epi::AFTER_DRAIN) { E.fused(acc, cur, wr, wc, fr, fq, lds, wid, lane); S.done(cur); }
#undef PG8_SA
#undef PG8_SB
#undef PG8_STAGE
#undef PG8_LDA
#undef PG8_LDB
#undef PG8_MMA
#undef PG8_WAIT_V
#undef PG8_WAIT_L
#undef PG8_BAR
#undef PG8_SCHED
}
}

#define LDS_WAIT() asm volatile("s_waitcnt lgkmcnt(0)" ::: "memory")
#define VM_WAIT() asm volatile("s_waitcnt vmcnt(0)" ::: "memory")

__device__ __forceinline__ void transpose_item(const float* W, int ldw, int scol0, int ncol_valid, float scale, bf16* WT, int K, int drow0, int k0, LAS float* scr, int lane) {
    const int n = lane & 31; const bool ok = (scol0 + n) < ncol_valid;
#pragma unroll 8
    for (int i = 0; i < 32; ++i) { const int kk = 2 * i + (lane >> 5);
        float v = 0.f; if (ok) v = W[(size_t)(k0 + kk) * ldw + scol0 + n] * scale;
        scr[kk * 33 + n] = v; }
    LDS_WAIT(); asm volatile("" ::: "memory");
    const int c = lane & 7;
#pragma unroll
    for (int j = 0; j < 4; ++j) { const int nn = (lane >> 3) + 8 * j; const LAS float* s = scr + (8 * c) * 33 + nn;
        u32x4 o; o.x = pk2(s[0 * 33], s[1 * 33]); o.y = pk2(s[2 * 33], s[3 * 33]); o.z = pk2(s[4 * 33], s[5 * 33]); o.w = pk2(s[6 * 33], s[7 * 33]);
        *(u32x4*)(WT + (size_t)(drow0 + nn) * K + k0 + 8 * c) = o; }
    LDS_WAIT(); asm volatile("" ::: "memory");
}
struct PrepArgs { const float *w_in, *w_out, *wfg, *wfu, *wfd, *weg, *weu, *wed; unsigned char* ws; };
constexpr int PI_WIN = 2 * 16 * 120, PI_WOUT = 2 * 16 * 32, PI_FU = 16 * 176, PI_FD = 44 * 32, PI_EU = 8 * 16 * 224, PI_ED = 8 * 56 * 32;
constexpr int PREP_ITEMS = PI_WIN + PI_WOUT + PI_FU + PI_FD + PI_EU + PI_ED;
__device__ __forceinline__ void prep_item(const PrepArgs& a, int it, LAS float* scr, int lane) {
    int r = it;
    if (r < PI_WIN) { const int l = r / 1920; r %= 1920; const int kb = r / 120, nb = r % 120, n0 = nb * 32;
        float sc = 1.f; if ((n0 < 3072 && (n0 % 768) < 256) || (n0 >= COL_QI && n0 < COL_KI)) sc = 0.125f; else if (n0 == COL_WI) sc = 0.35355339059327373f;
        transpose_item(a.w_in + (size_t)l * DM * NIN, NIN, n0, NIN, sc, (bf16*)(a.ws + WS_WIN) + (size_t)l * PW * DM, DM, n0, kb * 64, scr, lane); return; }
    r -= PI_WIN;
    if (r < PI_WOUT) { const int l = r / 512; r %= 512; const int kb = r / 32, nb = r % 32;
        transpose_item(a.w_out + (size_t)l * DM * DM, DM, nb * 32, DM, 1.f, (bf16*)(a.ws + WS_WOUT) + (size_t)l * DM * DM, DM, nb * 32, kb * 64, scr, lane); return; }
    r -= PI_WOUT;
    if (r < PI_FU) { const int kb = r / 176, nb = r % 176, r0 = nb * 32, blk = r0 >> 8, w = r0 & 255;
        transpose_item(w < 128 ? a.wfg : a.wfu, DFF, blk * 128 + (w & 127), DFF, 1.f, (bf16*)(a.ws + WS_WFU), DM, r0, kb * 64, scr, lane); return; }
    r -= PI_FU;
    if (r < PI_FD) { const int kb = r / 32, nb = r % 32;
        transpose_item(a.wfd, DM, nb * 32, DM, 1.f, (bf16*)(a.ws + WS_WFD), DFF, nb * 32, kb * 64, scr, lane); return; }
    r -= PI_FD;
    if (r < PI_EU) { const int e = r / 3584; r %= 3584; const int kb = r / 224, nb = r % 224, r0 = nb * 32, blk = r0 >> 8, w = r0 & 255;
        transpose_item((w < 128 ? a.weg : a.weu) + (size_t)e * DM * DFE, DFE, blk * 128 + (w & 127), DFE, 1.f, (bf16*)(a.ws + WS_WEU) + (size_t)e * 7168 * DM, DM, r0, kb * 64, scr, lane); return; }
    r -= PI_EU;
    { const int e = r / 1792; r %= 1792; const int kb = r / 32, nb = r % 32;
        transpose_item(a.wed + (size_t)e * DFE * DM, DM, nb * 32, DM, 1.f, (bf16*)(a.ws + WS_WED) + (size_t)e * DM * DFE, DFE, nb * 32, kb * 64, scr, lane); }
}
__global__ void __launch_bounds__(256) k_prep(PrepArgs a) {
    __shared__ float scr_all[4 * 64 * 33];
    const int lane = threadIdx.x & 63, wave = threadIdx.x >> 6;
    LAS float* scr = (LAS float*)scr_all + wave * 64 * 33;
    const int gw = blockIdx.x * 4 + wave, ngw = gridDim.x * 4;
    for (int it = gw; it < PREP_ITEMS; it += ngw) prep_item(a, it, scr, lane);
}
__global__ void __launch_bounds__(256) k_mod(const float* c, const float* w_ada, const float* b_ada, float* mod) {
    __shared__ float sc[8 * 1024]; __shared__ float part[4][8][64];
    for (int i = threadIdx.x; i < 8 * 1024; i += 256) { const float v = c[i]; sc[i] = v / (1.0f + __expf(-v)); }
    __syncthreads();
    const int l = blockIdx.x / 96, j0 = (blockIdx.x % 96) * 64, jj = threadIdx.x & 63, kq = threadIdx.x >> 6;
    float acc[8];
#pragma unroll
    for (int b = 0; b < 8; ++b) acc[b] = 0.f;
    const float* w = w_ada + (size_t)l * DM * 6144 + j0 + jj;
    for (int k = kq * 256; k < kq * 256 + 256; ++k) { const float wv = w[(size_t)k * 6144];
#pragma unroll
        for (int b = 0; b < 8; ++b) acc[b] += sc[b * 1024 + k] * wv; }
#pragma unroll
    for (int b = 0; b < 8; ++b) part[kq][b][jj] = acc[b];
    __syncthreads();
    for (int i = threadIdx.x; i < 8 * 64; i += 256) { const int b = i >> 6, j = i & 63;
        mod[(size_t)l * 8 * 6144 + (size_t)b * 6144 + j0 + j] = part[0][b][j] + part[1][b][j] + part[2][b][j] + part[3][b][j] + b_ada[l * 6144 + j0 + j]; }
}

struct MoeTiles { int p0, p1, p2, p3, p4, p5, p6, p7; };
__device__ __forceinline__ MoeTiles moe_tiles(const unsigned* ecnt) {
    MoeTiles m; m.p0 = (int)(ecnt[0] + 255u) >> 8; m.p1 = (int)(ecnt[1] + 255u) >> 8; m.p2 = (int)(ecnt[2] + 255u) >> 8; m.p3 = (int)(ecnt[3] + 255u) >> 8;
    m.p4 = (int)(ecnt[4] + 255u) >> 8; m.p5 = (int)(ecnt[5] + 255u) >> 8; m.p6 = (int)(ecnt[6] + 255u) >> 8; m.p7 = (int)(ecnt[7] + 255u) >> 8; return m;
}
__device__ __forceinline__ int moe_tile_start(const MoeTiles& m, int e) {
    int s = 0; s += (e > 0) ? m.p0 : 0; s += (e > 1) ? m.p1 : 0; s += (e > 2) ? m.p2 : 0; s += (e > 3) ? m.p3 : 0; s += (e > 4) ? m.p4 : 0; s += (e > 5) ? m.p5 : 0; s += (e > 6) ? m.p6 : 0; return s;
}
struct NormArgs {
    const float* xin; const float* g; const float* shift; const float* scale;
    bf16* act;
    const float* w_router; int* tok; unsigned* ecnt;
    const bf16* ys; const float* gate; float* out;
};
template <int MODE> __global__ void __launch_bounds__(512) k_norm(NormArgs a) {
    __shared__ unsigned lcnt[8]; __shared__ unsigned lbase[8]; __shared__ int linfo[128][6];
    const int tid = threadIdx.x, lane = tid & 63, wave = tid >> 6;
    if (MODE == 1) { if (tid < 8) lcnt[tid] = 0u; __syncthreads(); }
    MoeTiles mt; if (MODE == 2) mt = moe_tiles(a.ecnt);
    for (int blk = blockIdx.x; blk < T / 128; blk += gridDim.x) {
        for (int i = 0; i < 16; ++i) {
            const int lr = wave + 8 * i, row = blk * 128 + lr, b = row / SEQ;
            const f32x4* xr = (const f32x4*)(a.xin + (size_t)row * DM) + lane;
            f32x4 v[4];
#pragma unroll
            for (int j = 0; j < 4; ++j) v[j] = xr[64 * j];
            if (MODE == 2) {
                const int* ti = a.tok + (size_t)row * 8; const int e0 = ti[0], e1 = ti[1], p0 = ti[2], p1 = ti[3]; const float g0 = __int_as_float(ti[4]), g1 = __int_as_float(ti[5]);
                const size_t s0 = (size_t)moe_tile_start(mt, e0) * 256 + p0, s1 = (size_t)moe_tile_start(mt, e1) * 256 + p1;
                const u32x2* y0 = (const u32x2*)(a.ys + s0 * DM) + lane; const u32x2* y1 = (const u32x2*)(a.ys + s1 * DM) + lane;
                const f32x4* gt = (const f32x4*)(a.gate + (size_t)b * 6144) + lane;
#pragma unroll
                for (int j = 0; j < 4; ++j) { const u32x2 a0 = y0[64 * j], a1 = y1[64 * j]; const f32x4 gv = gt[64 * j];
                    f32x4 y; y.x = g0 * bf2f(a0.x & 0xffffu) + g1 * bf2f(a1.x & 0xffffu); y.y = g0 * bf2f(a0.x >> 16) + g1 * bf2f(a1.x >> 16);
                    y.z = g0 * bf2f(a0.y & 0xffffu) + g1 * bf2f(a1.y & 0xffffu); y.w = g0 * bf2f(a0.y >> 16) + g1 * bf2f(a1.y >> 16);
                    v[j] = v[j] + gv * y; }
            }
            float ss = 0.f;
#pragma unroll
            for (int j = 0; j < 4; ++j) ss += (v[j].x * v[j].x + v[j].y * v[j].y) + (v[j].z * v[j].z + v[j].w * v[j].w);
            const float rstd = rsqrtf(wave_sum(ss) * (1.0f / DM) + EPS);
            const f32x4* gp = (const f32x4*)a.g + lane;
            if (MODE == 2) {
                f32x4* o = (f32x4*)(a.out + (size_t)row * DM) + lane;
#pragma unroll
                for (int j = 0; j < 4; ++j) o[64 * j] = v[j] * rstd * gp[64 * j];
            } else {
                const f32x4* sh = (const f32x4*)(a.shift + (size_t)b * 6144) + lane; const f32x4* sc = (const f32x4*)(a.scale + (size_t)b * 6144) + lane;
                u32x2* o = (u32x2*)(a.act + (size_t)row * DM) + lane;
#pragma unroll
                for (int j = 0; j < 4; ++j) { v[j] = v[j] * rstd * gp[64 * j] * (sc[64 * j] + 1.0f) + sh[64 * j];
                    u32x2 w; w.x = pk2(v[j].x, v[j].y); w.y = pk2(v[j].z, v[j].w); o[64 * j] = w; }
                if (MODE == 1) {
                    float lg[8];
#pragma unroll
                    for (int e = 0; e < 8; ++e) lg[e] = 0.f;
#pragma unroll
                    for (int j = 0; j < 4; ++j) { const float hv[4] = {v[j].x, v[j].y, v[j].z, v[j].w};
#pragma unroll
                        for (int q = 0; q < 4; ++q) { const f32x4* wr = (const f32x4*)(a.w_router + (size_t)(256 * j + 4 * lane + q) * 8); const f32x4 w0 = wr[0], w1 = wr[1];
                            lg[0] += hv[q] * w0.x; lg[1] += hv[q] * w0.y; lg[2] += hv[q] * w0.z; lg[3] += hv[q] * w0.w; lg[4] += hv[q] * w1.x; lg[5] += hv[q] * w1.y; lg[6] += hv[q] * w1.z; lg[7] += hv[q] * w1.w; } }
#pragma unroll
                    for (int e = 0; e < 8; ++e) lg[e] = wave_sum(lg[e]);
                    int e0 = 0; float v0 = lg[0];
#pragma unroll
                    for (int e = 1; e < 8; ++e) if (lg[e] > v0) { v0 = lg[e]; e0 = e; }
                    int e1 = -1; float v1 = -INFINITY;
#pragma unroll
                    for (int e = 0; e < 8; ++e) if (e != e0 && lg[e] > v1) { v1 = lg[e]; e1 = e; }
                    const float g0 = 1.0f / (1.0f + __expf(v1 - v0)), g1 = 1.0f - g0;
                    if (lane == 0) { const unsigned q0 = atomicAdd(&lcnt[e0], 1u), q1 = atomicAdd(&lcnt[e1], 1u);
                        linfo[lr][0] = e0; linfo[lr][1] = e1; linfo[lr][2] = (int)q0; linfo[lr][3] = (int)q1; linfo[lr][4] = __float_as_int(g0); linfo[lr][5] = __float_as_int(g1); }
                }
            }
        }
        if (MODE == 1) {
            __syncthreads();
            if (tid < 8) { lbase[tid] = atomicAdd(&a.ecnt[tid], lcnt[tid]); }
            __syncthreads();
            if (tid < 128) { int* ti = a.tok + (size_t)(blk * 128 + tid) * 8; const int e0 = linfo[tid][0], e1 = linfo[tid][1];
                ti[0] = e0; ti[1] = e1; ti[2] = linfo[tid][2] + (int)lbase[e0]; ti[3] = linfo[tid][3] + (int)lbase[e1]; ti[4] = linfo[tid][4]; ti[5] = linfo[tid][5]; ti[6] = 0; ti[7] = 0; }
            __syncthreads();
            if (tid < 8) lcnt[tid] = 0u;
            __syncthreads();
        }
    }
}
__global__ void __launch_bounds__(512) k_gather(const bf16* act, const int* tok, const unsigned* ecnt, bf16* xs) {
    const int lane = threadIdx.x & 63, gw = blockIdx.x * 8 + (threadIdx.x >> 6), ngw = gridDim.x * 8;
    const MoeTiles mt = moe_tiles(ecnt);
    for (int t = gw; t < T; t += ngw) {
        const int* ti = tok + (size_t)t * 8; const int e0 = ti[0], e1 = ti[1], p0 = ti[2], p1 = ti[3];
        const size_t s0 = (size_t)moe_tile_start(mt, e0) * 256 + p0, s1 = (size_t)moe_tile_start(mt, e1) * 256 + p1;
        const u32x4* src = (const u32x4*)(act + (size_t)t * DM) + lane; const u32x4 a0 = src[0], a1 = src[64];
        u32x4* d0 = (u32x4*)(xs + s0 * DM) + lane; u32x4* d1 = (u32x4*)(xs + s1 * DM) + lane;
        d0[0] = a0; d0[64] = a1; d1[0] = a0; d1[64] = a1;
    }
    for (int i = gw; i < 8 * 256; i += ngw) { const int e = i >> 8, r = i & 255; const int cnt = (int)ecnt[e]; const int padded = ((cnt + 255) >> 8) << 8;
        if (cnt + r < padded) { u32x4* d = (u32x4*)(xs + ((size_t)moe_tile_start(mt, e) * 256 + cnt + r) * DM) + lane; const u32x4 z = {0u, 0u, 0u, 0u}; d[0] = z; d[64] = z; } }
}

__device__ __forceinline__ void ld_row64(const bf16* p, float (&f)[64]) {
#pragma unroll
    for (int i = 0; i < 8; ++i) ld8(p + 8 * i, &f[8 * i]);
}
__device__ __forceinline__ float dot64(const float (&a)[64], const float (&b)[64]) {
    float s0 = 0.f, s1 = 0.f, s2 = 0.f, s3 = 0.f;
#pragma unroll
    for (int i = 0; i < 64; i += 4) { s0 += a[i] * b[i]; s1 += a[i + 1] * b[i + 1]; s2 += a[i + 2] * b[i + 2]; s3 += a[i + 3] * b[i + 3]; }
    return (s0 + s1) + (s2 + s3);
}
__device__ __forceinline__ void head_norm_store(float (&o)[64], const float* gh, bf16* dst) {
    float ss = 0.f;
#pragma unroll
    for (int i = 0; i < 64; ++i) ss += o[i] * o[i];
    const float r = rsqrtf(ss * (1.0f / 64.0f) + EPS);
#pragma unroll
    for (int i = 0; i < 8; ++i) { u32x4 w; const float* q = &o[8 * i]; const float* g = gh + 8 * i;
        w.x = pk2(q[0] * r * g[0], q[1] * r * g[1]); w.y = pk2(q[2] * r * g[2], q[3] * r * g[3]); w.z = pk2(q[4] * r * g[4], q[5] * r * g[5]); w.w = pk2(q[6] * r * g[6], q[7] * r * g[7]);
        *(u32x4*)(dst + 8 * i) = w; }
}
#define OSM_STEP(s, vrow) do { if ((s) > m) { const float a_ = __expf(m - (s)); l *= a_; _Pragma("unroll") for (int d_ = 0; d_ < 64; ++d_) o[d_] *= a_; m = (s); } \
    const float p_ = __expf((s) - m); l += p_; float vv_[64]; ld_row64((vrow), vv_); _Pragma("unroll") for (int d_ = 0; d_ < 64; ++d_) o[d_] += p_ * vv_[d_]; } while (0)

__global__ void __launch_bounds__(256) k_sb_naive(const bf16* P, const float* gh, bf16* act) {
    const int idx = blockIdx.x * 256 + threadIdx.x; const int t = idx & (SEQ - 1), h = (idx >> 12) & 3, b = idx >> 14;
    const bf16* Pb = P + (size_t)b * SEQ * PW;
    float q[64], o[64], kk[64];
    ld_row64(Pb + (size_t)t * PW + h * 64, q);
#pragma unroll
    for (int i = 0; i < 64; ++i) o[i] = 0.f;
    float carry = 1.0f;
    for (int s = t - 1; s >= 0; --s) {
        ld_row64(Pb + (size_t)s * PW + 256 + h * 64, kk);
        float z = dot64(q, kk); z = fminf(fmaxf(z, -80.f), 80.f);
        const float e = __expf(z), om = 1.0f / (1.0f + e), beta = e * om, aw = beta * carry;
        ld_row64(Pb + (size_t)s * PW + 512 + h * 64, kk);
#pragma unroll
        for (int i = 0; i < 64; ++i) o[i] += aw * kk[i];
        carry *= om;
        if (carry < 1e-30f) break;
    }
    head_norm_store(o, gh + h * 64, act + (size_t)(b * SEQ + t) * DM + h * 64);
}
__global__ void __launch_bounds__(256) k_dil_naive(const bf16* P, const float* gh, bf16* act) {
    const int idx = blockIdx.x * 256 + threadIdx.x; const int t = idx & (SEQ - 1), h = (idx >> 12) & 3, b = idx >> 14;
    const bf16* Pb = P + (size_t)b * SEQ * PW + 1536;
    const float slope = alibi_slope(1, h);
    float q[64], o[64], kk[64];
    ld_row64(Pb + (size_t)t * PW + h * 64, q);
#pragma unroll
    for (int i = 0; i < 64; ++i) o[i] = 0.f;
    float m = -INFINITY, l = 0.f;
    for (int br = 0; br < 3; ++br) { const int dil = br == 0 ? 1 : (br == 1 ? 4 : 16);
        for (int j = 0; j <= 128; ++j) { const int dist = j * dil, kp = t - dist; if (kp < 0) break;
            ld_row64(Pb + (size_t)kp * PW + 256 + h * 64, kk);
            const float s = dot64(q, kk) - slope * (float)dist;
            OSM_STEP(s, Pb + (size_t)kp * PW + 512 + h * 64); } }
    const float rl = 1.0f / l;
#pragma unroll
    for (int i = 0; i < 64; ++i) o[i] *= rl;
    head_norm_store(o, gh + (8 + h) * 64, act + (size_t)(b * SEQ + t) * DM + (8 + h) * 64);
}
template <int MODE> __global__ void __launch_bounds__(256) k_masked_naive(const bf16* P, const unsigned long long* mask, const unsigned short* msel, const float* gh, bf16* act) {
    const int idx = blockIdx.x * 256 + threadIdx.x; const int t = idx & (SEQ - 1), h = (idx >> 12) & 3, b = idx >> 14;
    const int cb = MODE == 0 ? 768 : 2304, hb = MODE == 0 ? 4 : 12;
    const bf16* Pb = P + (size_t)b * SEQ * PW + cb;
    const float slope = alibi_slope(MODE == 0 ? 0 : 2, h);
    float q[64], o[64], kk[64];
    ld_row64(Pb + (size_t)t * PW + h * 64, q);
#pragma unroll
    for (int i = 0; i < 64; ++i) o[i] = 0.f;
    float m = -INFINITY, l = 0.f;
    if (MODE == 0) {
        const unsigned long long* mr = mask + (size_t)(b * SEQ + t) * 64;
        for (int w = 0; w <= (t >> 6); ++w) { unsigned long long bits = mr[w];
            while (bits) { const int j = __builtin_ctzll(bits); bits &= bits - 1; const int kp = w * 64 + j;
                ld_row64(Pb + (size_t)kp * PW + 256 + h * 64, kk);
                const float s = dot64(q, kk) - slope * (float)(t - kp);
                OSM_STEP(s, Pb + (size_t)kp * PW + 512 + h * 64); } }
    } else {
        const int own = t >> 8; const unsigned sel = msel[(size_t)(b * SEQ + t) * 4 + h];
        for (int blk = 0; blk <= own; ++blk) { if (blk < own && !((sel >> blk) & 1u)) continue;
            const int kend = blk == own ? t : blk * 256 + 255;
            for (int kp = blk * 256; kp <= kend; ++kp) {
                ld_row64(Pb + (size_t)kp * PW + 256 + h * 64, kk);
                const float s = dot64(q, kk) - slope * (float)(t - kp);
                OSM_STEP(s, Pb + (size_t)kp * PW + 512 + h * 64); } }
    }
    const float rl = 1.0f / l;
#pragma unroll
    for (int i = 0; i < 64; ++i) o[i] *= rl;
    head_norm_store(o, gh + (hb + h) * 64, act + (size_t)(b * SEQ + t) * DM + (hb + h) * 64);
}
__global__ void __launch_bounds__(256) k_kmean(const bf16* P, float* kmean) {
    const int b = blockIdx.x >> 4, blk = blockIdx.x & 15, c = threadIdx.x;
    const bf16* p = P + ((size_t)b * SEQ + blk * 256) * PW + 2304 + 256 + c;
    float s = 0.f;
    for (int r = 0; r < 256; ++r) s += bf2f(p[(size_t)r * PW]);
    kmean[(size_t)blockIdx.x * 256 + c] = s * (1.0f / 256.0f);
}
__global__ void __launch_bounds__(256) k_moba_sel(const bf16* P, const float* kmean, unsigned short* msel) {
    const int idx = blockIdx.x * 256 + threadIdx.x; const int t = idx & (SEQ - 1), h = (idx >> 12) & 3, b = idx >> 14;
    const int own = t >> 8; unsigned sel = 0u;
    if (own <= 3) sel = (1u << own) - 1u;
    else {
        float q[64]; ld_row64(P + ((size_t)b * SEQ + t) * PW + 2304 + h * 64, q);
        float g[16];
#pragma unroll
        for (int blk = 0; blk < 16; ++blk) { float s = -INFINITY;
            if (blk < own) { const float* km = kmean + ((size_t)b * 16 + blk) * 256 + h * 64; s = 0.f;
#pragma unroll
                for (int d = 0; d < 64; ++d) s += q[d] * km[d]; }
            g[blk] = s; }
#pragma unroll
        for (int r = 0; r < 3; ++r) { int bi = 0; float bv = -INFINITY;
#pragma unroll
            for (int blk = 0; blk < 16; ++blk) { const bool free_ = !((sel >> blk) & 1u); if (free_ && g[blk] > bv) { bv = g[blk]; bi = blk; } }
            sel |= 1u << bi; }
    }
    msel[(size_t)(b * SEQ + t) * 4 + h] = (unsigned short)sel;
}

constexpr int DSA_LDS = 8 * 4096 * 4;
__device__ __forceinline__ void dsa_select_unit(const bf16* P, unsigned long long* mask, int unit, LAS unsigned* sc) {
    const int tid = threadIdx.x, lane = tid & 63, wid = tid >> 6, r32 = lane & 31, hi = lane >> 5;
    const int b = unit >> 9, t0 = (unit & 511) * 8;
    const bf16* Pb = P + (size_t)b * SEQ * PW;
    const int hrow = (r32 & 3) + 4 * ((r32 >> 3) & 1), qrow = 2 * ((r32 >> 2) & 1) + ((r32 >> 4) & 1);
    bf16x8 af[2][4];
#pragma unroll
    for (int qg = 0; qg < 2; ++qg)
#pragma unroll
        for (int s = 0; s < 4; ++s) af[qg][s] = *(const bf16x8*)(Pb + (size_t)(t0 + 4 * qg + qrow) * PW + COL_QI + hrow * 64 + 16 * s + 8 * hi);
    float wv[2][2][8];
#pragma unroll
    for (int qg = 0; qg < 2; ++qg)
#pragma unroll
        for (int qq = 0; qq < 2; ++qq) ld8(Pb + (size_t)(t0 + 4 * qg + 2 * hi + qq) * PW + COL_WI, wv[qg][qq]);
    const int ntile = (t0 + 8 + 31) >> 5;
    for (int kt = wid; kt < ntile; kt += 8) {
        const int key = kt * 32 + r32;
        bf16x8 bfr[4];
#pragma unroll
        for (int s = 0; s < 4; ++s) bfr[s] = *(const bf16x8*)(Pb + (size_t)key * PW + COL_KI + 16 * s + 8 * hi);
#pragma unroll
        for (int qg = 0; qg < 2; ++qg) {
            f32x16 acc = {0.f, 0.f, 0.f, 0.f, 0.f, 0.f, 0.f, 0.f, 0.f, 0.f, 0.f, 0.f, 0.f, 0.f, 0.f, 0.f};
#pragma unroll
            for (int s = 0; s < 4; ++s) acc = __builtin_amdgcn_mfma_f32_32x32x16_bf16(af[qg][s], bfr[s], acc, 0, 0, 0);
#pragma unroll
            for (int qq = 0; qq < 2; ++qq) { float s = 0.f;
#pragma unroll
                for (int h = 0; h < 8; ++h) s += wv[qg][qq][h] * fmaxf(acc[8 * qq + h], 0.f);
                const int ql = 4 * qg + 2 * hi + qq;
                const unsigned u = __float_as_uint(s); const unsigned sk = (u & 0x80000000u) ? ~u : (u | 0x80000000u);
                sc[ql * 4096 + key] = (key <= t0 + ql) ? sk : 0u; }
        }
    }
    __syncthreads();
    {
        const int t = t0 + wid, nvalid = t + 1, nk = ntile * 32;
        unsigned long long myword = 0ull;
        if (nvalid <= 256) {
            const int lo = lane * 64; myword = (nvalid >= lo + 64) ? ~0ull : (nvalid > lo ? ((1ull << (nvalid - lo)) - 1ull) : 0ull);
        } else {
            unsigned K[64];
#pragma unroll
            for (int r = 0; r < 64; ++r) K[r] = (r * 64 + lane < nk) ? sc[wid * 4096 + r * 64 + lane] : 0u;
            unsigned prefix = 0u;
            for (int bit = 31; bit >= 0; --bit) { const unsigned trial = prefix | (1u << bit); int cnt = 0;
#pragma unroll
                for (int r = 0; r < 64; ++r) cnt += __builtin_popcountll(__ballot(K[r] >= trial));
                if (cnt >= 256) prefix = trial; }
            int cgt = 0;
#pragma unroll
            for (int r = 0; r < 64; ++r) cgt += __builtin_popcountll(__ballot(K[r] > prefix));
            int need = 256 - cgt;
            const unsigned long long below = (1ull << lane) - 1ull;
#pragma unroll
            for (int r = 0; r < 64; ++r) {
                const unsigned long long gt = __ballot(K[r] > prefix), eq = __ballot(K[r] == prefix);
                const int c = __builtin_popcountll(eq); unsigned long long take;
                if (c <= need) { take = eq; need -= c; }
                else { const bool mine = ((eq >> lane) & 1ull) && (__builtin_popcountll(eq & below) < need); take = __ballot(mine); need = 0; }
                const unsigned long long word = gt | take;
                if (lane == r) myword = word;
            }
        }
        mask[(size_t)(b * SEQ + t) * 64 + lane] = myword;
    }
    __syncthreads();
}
__global__ void __launch_bounds__(512, 2) k_dsa_select(const bf16* P, unsigned long long* mask) {
    extern __shared__ __attribute__((aligned(16))) unsigned char lds[];
    for (int unit = blockIdx.x; unit < NB * 512; unit += gridDim.x) dsa_select_unit(P, mask, unit, (LAS unsigned*)lds);
}

constexpr int GEMM_LDS = 131072;
struct GemmArgs { const bf16* A; const bf16* Bt; void* out; const float* xin; const float* gate; const unsigned* ecnt; int M, N, K, ld, row_shift, chunk; };
template <int KIND> __global__ void __launch_bounds__(512, 2) k_gemm(GemmArgs a) {
    extern __shared__ __attribute__((aligned(16))) unsigned char lds[];
    pg8::Gemm g{a.A, a.Bt, a.M, a.N, a.K};
    if constexpr (KIND <= 2) {
        pg8::StaticOrder S; S.init(a.M, a.N, (int)gridDim.x, (int)blockIdx.x);
        if constexpr (KIND == 0) { pg8::EpiBf16 E{(bf16*)a.out, a.ld, 0}; pg8::gemm_phase<pg8::EpiBf16, pg8::StaticOrder, true, true>((LAS unsigned char*)lds, g, S, E); }
        if constexpr (KIND == 1) { pg8::EpiSwiGLU E{(bf16*)a.out, a.ld, 0}; pg8::gemm_phase<pg8::EpiSwiGLU, pg8::StaticOrder, true, true>((LAS unsigned char*)lds, g, S, E); }
        if constexpr (KIND == 2) { pg8::EpiRes E{a.xin, (float*)a.out, a.gate}; pg8::gemm_phase<pg8::EpiRes, pg8::StaticOrder, true, true>((LAS unsigned char*)lds, g, S, E); }
    } else {
        const MoeTiles mt = moe_tiles(a.ecnt);
        const int ntot = moe_tile_start(mt, 7) + mt.p7;
        pg8::MoeOrder S; S.t0 = a.chunk * 64; S.nrt = min(64, ntot - S.t0); S.G = (int)gridDim.x; S.c = (int)blockIdx.x;
        S.ts1 = moe_tile_start(mt, 1); S.ts2 = moe_tile_start(mt, 2); S.ts3 = moe_tile_start(mt, 3); S.ts4 = moe_tile_start(mt, 4); S.ts5 = moe_tile_start(mt, 5); S.ts6 = moe_tile_start(mt, 6); S.ts7 = moe_tile_start(mt, 7);
        if constexpr (KIND == 3) { S.nN = 28; S.a_rel = 0; S.estride = (size_t)7168 * DM * 2;
            pg8::EpiSwiGLU E{(bf16*)a.out, DFE, -S.t0 * 256}; pg8::gemm_phase<pg8::EpiSwiGLU, pg8::MoeOrder, true, true>((LAS unsigned char*)lds, g, S, E); }
        if constexpr (KIND == 4) { S.nN = 4; S.a_rel = 1; S.estride = (size_t)DM * DFE * 2;
            pg8::EpiBf16 E{(bf16*)a.out, DM, 0}; pg8::gemm_phase<pg8::EpiBf16, pg8::MoeOrder, true, true>((LAS unsigned char*)lds, g, S, E); }
    }
}

extern "C" void kernel_launch(void* const* d_in, const int* in_sizes, int n_in, void* d_out, int out_size, void* d_ws, size_t ws_size, hipStream_t stream) {
    static int ready = 0;
    if (ready == 0) {
        if (n_in != 17 || out_size != T * DM || ws_size < WS_END) { fprintf(stderr, "kernel_launch: unexpected problem (n_in %d out %d ws %zu)\n", n_in, out_size, ws_size); ready = -1; return; }
        hipFuncSetAttribute((const void*)k_gemm<0>, hipFuncAttributeMaxDynamicSharedMemorySize, GEMM_LDS);
        hipFuncSetAttribute((const void*)k_gemm<1>, hipFuncAttributeMaxDynamicSharedMemorySize, GEMM_LDS);
        hipFuncSetAttribute((const void*)k_gemm<2>, hipFuncAttributeMaxDynamicSharedMemorySize, GEMM_LDS);
        hipFuncSetAttribute((const void*)k_gemm<3>, hipFuncAttributeMaxDynamicSharedMemorySize, GEMM_LDS);
        hipFuncSetAttribute((const void*)k_gemm<4>, hipFuncAttributeMaxDynamicSharedMemorySize, GEMM_LDS);
        hipFuncSetAttribute((const void*)k_dsa_select, hipFuncAttributeMaxDynamicSharedMemorySize, DSA_LDS);
        ready = 1;
    }
    if (ready < 0) return;
    const float* x = (const float*)d_in[0]; const float* c = (const float*)d_in[1]; const float* w_ada = (const float*)d_in[2]; const float* b_ada = (const float*)d_in[3];
    const float* g_mix = (const float*)d_in[4]; const float* w_in = (const float*)d_in[5]; const float* g_heads = (const float*)d_in[6]; const float* w_out = (const float*)d_in[7];
    const float* g_ffn = (const float*)d_in[8]; const float* wfg = (const float*)d_in[9]; const float* wfu = (const float*)d_in[10]; const float* wfd = (const float*)d_in[11];
    const float* w_router = (const float*)d_in[12]; const float* weg = (const float*)d_in[13]; const float* weu = (const float*)d_in[14]; const float* wed = (const float*)d_in[15];
    const float* g_final = (const float*)d_in[16];
    unsigned char* ws = (unsigned char*)d_ws; float* out = (float*)d_out;
    unsigned* ctl = (unsigned*)(ws + WS_CTL); float* mod = (float*)(ws + WS_MOD); float* kmean = (float*)(ws + WS_KMEAN); unsigned short* msel = (unsigned short*)(ws + WS_MOBASEL);
    int* tok = (int*)(ws + WS_TOK); bf16* act = (bf16*)(ws + WS_ACT); bf16* P = (bf16*)(ws + WS_P); bf16* hid = (bf16*)(ws + WS_HID); bf16* xs = (bf16*)(ws + WS_XS);
    unsigned long long* mask = (unsigned long long*)(ws + WS_MASK); unsigned* ecnt = ctl + CW_ECNT;
    hipMemsetAsync(ws + WS_CTL, 0, CTL_BYTES, stream);
    PrepArgs pa{w_in, w_out, wfg, wfu, wfd, weg, weu, wed, ws};
    hipLaunchKernelGGL(k_prep, dim3(2048), dim3(256), 0, stream, pa);
    hipLaunchKernelGGL(k_mod, dim3(192), dim3(256), 0, stream, c, w_ada, b_ada, mod);
    const int G = 256;
    for (int l = 0; l < NLAYER; ++l) {
        const float* ml = mod + (size_t)l * 8 * 6144; const float* xin = (l == 0) ? x : out; const float* gh = g_heads + l * 1024;
        { NormArgs na{}; na.xin = xin; na.g = g_mix + l * DM; na.shift = ml; na.scale = ml + 1024; na.act = act; hipLaunchKernelGGL(k_norm<0>, dim3(256), dim3(512), 0, stream, na); }
        { GemmArgs ga{}; ga.A = act; ga.Bt = (const bf16*)(ws + WS_WIN) + (size_t)l * PW * DM; ga.M = T; ga.N = PW; ga.K = DM; ga.out = P; ga.ld = PW;
          hipLaunchKernelGGL(k_gemm<0>, dim3(G), dim3(512), GEMM_LDS, stream, ga); }
        hipLaunchKernelGGL(k_sb_naive, dim3(T * 4 / 256), dim3(256), 0, stream, P, gh, act);
        hipLaunchKernelGGL(k_dsa_select, dim3(1024), dim3(512), DSA_LDS, stream, P, mask);
        hipLaunchKernelGGL(k_dil_naive, dim3(T * 4 / 256), dim3(256), 0, stream, P, gh, act);
        hipLaunchKernelGGL(k_kmean, dim3(128), dim3(256), 0, stream, P, kmean);
        hipLaunchKernelGGL(k_moba_sel, dim3(T * 4 / 256), dim3(256), 0, stream, P, kmean, msel);
        hipLaunchKernelGGL(k_masked_naive<0>, dim3(T * 4 / 256), dim3(256), 0, stream, P, mask, msel, gh, act);
        hipLaunchKernelGGL(k_masked_naive<1>, dim3(T * 4 / 256), dim3(256), 0, stream, P, mask, msel, gh, act);
        { GemmArgs ga{}; ga.A = act; ga.Bt = (const bf16*)(ws + WS_WOUT) + (size_t)l * DM * DM; ga.M = T; ga.N = DM; ga.K = DM; ga.out = out; ga.xin = xin; ga.gate = ml + 2048;
          hipLaunchKernelGGL(k_gemm<2>, dim3(G), dim3(512), GEMM_LDS, stream, ga); }
        if (l == 0) {
            { NormArgs na{}; na.xin = out; na.g = g_ffn; na.shift = ml + 3072; na.scale = ml + 4096; na.act = act; hipLaunchKernelGGL(k_norm<0>, dim3(256), dim3(512), 0, stream, na); }
            { GemmArgs ga{}; ga.A = act; ga.Bt = (const bf16*)(ws + WS_WFU); ga.M = T; ga.N = 2 * DFF; ga.K = DM; ga.out = hid; ga.ld = DFF;
              hipLaunchKernelGGL(k_gemm<1>, dim3(G), dim3(512), GEMM_LDS, stream, ga); }
            { GemmArgs ga{}; ga.A = hid; ga.Bt = (const bf16*)(ws + WS_WFD); ga.M = T; ga.N = DM; ga.K = DFF; ga.out = out; ga.xin = out; ga.gate = ml + 5120;
              hipLaunchKernelGGL(k_gemm<2>, dim3(G), dim3(512), GEMM_LDS, stream, ga); }
        } else {
            { NormArgs na{}; na.xin = out; na.g = g_ffn + DM; na.shift = ml + 3072; na.scale = ml + 4096; na.act = act; na.w_router = w_router; na.tok = tok; na.ecnt = ecnt;
              hipLaunchKernelGGL(k_norm<1>, dim3(256), dim3(512), 0, stream, na); }
            hipLaunchKernelGGL(k_gather, dim3(512), dim3(512), 0, stream, act, tok, ecnt, xs);
            for (int ch = 0; ch < 5; ++ch) {
                { GemmArgs ga{}; ga.A = xs; ga.Bt = (const bf16*)(ws + WS_WEU); ga.M = 0; ga.N = 0; ga.K = DM; ga.out = hid; ga.ecnt = ecnt; ga.chunk = ch;
                  hipLaunchKernelGGL(k_gemm<3>, dim3(G), dim3(512), GEMM_LDS, stream, ga); }
                { GemmArgs ga{}; ga.A = hid; ga.Bt = (const bf16*)(ws + WS_WED); ga.M = 0; ga.N = 0; ga.K = DFE; ga.out = xs; ga.ecnt = ecnt; ga.chunk = ch;
                  hipLaunchKernelGGL(k_gemm<4>, dim3(G), dim3(512), GEMM_LDS, stream, ga); }
            }
            { NormArgs na{}; na.xin = out; na.g = g_final; na.tok = tok; na.ecnt = ecnt; na.ys = xs; na.gate = ml + 5120; na.out = out; hipLaunchKernelGGL(k_norm<2>, dim3(256), dim3(512), 0, stream, na); }
        }
    }
}
```

```cpp
#include <hip/hip_runtime.h>
#include <cstdio>
#include <cstdint>

#define LAS __attribute__((address_space(3)))
#define GAS __attribute__((address_space(1)))
typedef unsigned short bf16;
typedef short bf16x8 __attribute__((ext_vector_type(8)));
typedef float f32x4 __attribute__((ext_vector_type(4)));
typedef float f32x16 __attribute__((ext_vector_type(16)));
typedef unsigned u32x4 __attribute__((ext_vector_type(4)));
typedef unsigned u32x2 __attribute__((ext_vector_type(2)));

constexpr int NB = 8, SEQ = 4096, T = NB * SEQ, DM = 1024, NLAYER = 2;
constexpr int PW = 3840;
constexpr int NIN = 3656;
constexpr int COL_QI = 3072, COL_KI = 3584, COL_WI = 3648;
constexpr int DFF = 2816, DFE = 3584, NEXP = 8;
constexpr float EPS = 1e-6f;
constexpr int XS_TILES = 264;

constexpr size_t MiB = 1u << 20;
constexpr size_t WS_CTL = 0, CTL_BYTES = 1 * MiB;
constexpr size_t WS_MOD = 1 * MiB;
constexpr size_t WS_GV = 1 * MiB + 400 * 1024;
constexpr size_t WS_KMEAN = 1 * MiB + 512 * 1024;
constexpr size_t WS_MOBASEL = 1 * MiB + 768 * 1024;
constexpr size_t WS_TOK = 2 * MiB;
constexpr size_t WS_WIN = 4 * MiB;
constexpr size_t WS_WOUT = 19 * MiB;
constexpr size_t WS_WFU = 23 * MiB;
constexpr size_t WS_WFD = 34 * MiB;
constexpr size_t WS_ACT = 40 * MiB;
constexpr size_t WS_P = 104 * MiB;
constexpr size_t WS_HID = 104 * MiB;
constexpr size_t WS_XS = 216 * MiB;
constexpr size_t WS_MASK = 344 * MiB;
constexpr size_t WS_WEU = 360 * MiB;
constexpr size_t WS_WED = 472 * MiB;
constexpr size_t WS_END = 528 * MiB;
constexpr int CW_ECNT = 64;
constexpr int CW_BAR = 4096;

__device__ __forceinline__ float bf2f(unsigned v) { return __uint_as_float(v << 16); }
__device__ __forceinline__ unsigned f2bf(float f) { unsigned u = __float_as_uint(f); return (u + 0x7fffu + ((u >> 16) & 1u)) >> 16; }
__device__ __forceinline__ unsigned pk2(float lo, float hi) { return f2bf(lo) | (f2bf(hi) << 16); }
__device__ __forceinline__ unsigned cvt_pk_bf16(float lo, float hi) { unsigned r; asm volatile("v_cvt_pk_bf16_f32 %0, %1, %2" : "=v"(r) : "v"(lo), "v"(hi)); return r; }
__device__ __forceinline__ float wave_sum(float v) {
#pragma unroll
    for (int o = 1; o < 64; o <<= 1) v += __shfl_xor(v, o);
    return v;
}
__device__ __forceinline__ void ld8(const bf16* p, float* f) {
    const u32x4 u = *(const u32x4*)p;
    f[0] = __uint_as_float(u.x << 16); f[1] = __uint_as_float(u.x & 0xffff0000u);
    f[2] = __uint_as_float(u.y << 16); f[3] = __uint_as_float(u.y & 0xffff0000u);
    f[4] = __uint_as_float(u.z << 16); f[5] = __uint_as_float(u.z & 0xffff0000u);
    f[6] = __uint_as_float(u.w << 16); f[7] = __uint_as_float(u.w & 0xffff0000u);
}
__device__ __forceinline__ float alibi_slope(int mixer_pos, int h) { return exp2f(-8.0f * (float)(3 * h + mixer_pos + 1) / 12.0f); }
__device__ __forceinline__ float silu_f(float x) { return x * __builtin_amdgcn_rcpf(1.0f + __expf(-x)); }
__device__ __forceinline__ int otid() { int t = threadIdx.x; asm volatile("" : "+v"(t)); return t; }
#define XB_TMO      128
#define XB_XCNT(j)  (256  + 64 * (j))
#define XB_XSUB(j)  (1280 + 64 * (j))
#define XB_XGEN(j)  (2304 + 64 * (j))
#define XB_TOP      3328
#define XB_TOPGEN   3392
#define XCD_BAR_WORDS 3456
#define XB_SPIN_CAP (1u << 18)

__device__ __forceinline__ unsigned xb_ld(unsigned* p)              { return __hip_atomic_load(p, __ATOMIC_RELAXED, __HIP_MEMORY_SCOPE_AGENT); }
__device__ __forceinline__ unsigned xb_add(unsigned* p, unsigned v) { return __hip_atomic_fetch_add(p, v, __ATOMIC_RELAXED, __HIP_MEMORY_SCOPE_AGENT); }
__device__ __forceinline__ unsigned xb_xcc_id() { return (unsigned)__builtin_amdgcn_s_getreg((3 << 11) | 20) & 0xFu; }
#define XB_SPIN(cond, bar) do { unsigned _sp = 0; while (cond) { __builtin_amdgcn_s_sleep(1); \
    if ((++_sp & 255u) == 0u) { if (xb_ld(&(bar)[XB_TMO])) break; if (_sp > XB_SPIN_CAP) { atomicAdd(&(bar)[XB_TMO], 1u); break; } } } } while (0)

struct XcdBarrier {
    unsigned* bar; unsigned x;
    volatile LAS unsigned* st;
};

__device__ __forceinline__ XcdBarrier xcd_barrier_post(unsigned* bar, volatile LAS unsigned* st) {
    XcdBarrier b; b.bar = bar; b.x = xb_xcc_id(); b.st = st;
    if (threadIdx.x == 0) (void)xb_add(&bar[XB_XCNT(b.x)], 1u);
    return b;
}
__device__ __forceinline__ void xcd_barrier_complete(unsigned* bar, unsigned x, unsigned& nloc, unsigned& nx) {
    const unsigned G = gridDim.x * gridDim.y * gridDim.z;
    unsigned sum, cnt, mine, sp = 0u;
    for (;;) {
        asm volatile("" : "+s"(bar), "+s"(x));
        sum = 0u; cnt = 0u; mine = 0u;
#pragma unroll
        for (unsigned j = 0; j < 16; ++j) { const unsigned c = xb_ld(&bar[XB_XCNT(j)]); sum += c; cnt += (c > 0u) ? 1u : 0u; mine = (j == x) ? c : mine; }
        if (sum == G) break;
        __builtin_amdgcn_s_sleep(1);
        if ((++sp & 255u) == 0u) { if (xb_ld(&bar[XB_TMO])) break; if (sp > XB_SPIN_CAP) { atomicAdd(&bar[XB_TMO], 1u); break; } }
    }
    nloc = mine > 0u ? mine : 1u; nx = cnt > 0u ? cnt : 1u;
}

__device__ __forceinline__ void xcd_barrier(const XcdBarrier& b) {
    asm volatile("s_waitcnt vmcnt(0)" ::: "memory");
    __syncthreads();
    if (threadIdx.x == 0) {
        unsigned* bar = b.bar; unsigned bx = b.x; asm volatile("" : "+s"(bx));
        __builtin_amdgcn_s_waitcnt(0);
        unsigned nloc = b.st[0], nx = b.st[1];
        if (nloc == 0u) { xcd_barrier_complete(bar, bx, nloc, nx); b.st[0] = nloc; b.st[1] = nx; }
        const unsigned old = xb_add(&bar[XB_XSUB(bx)], 1u);
        const unsigned gen = old / nloc;
        if (old + 1u == (gen + 1u) * nloc) {
            __builtin_amdgcn_fence(__ATOMIC_RELEASE, "agent");
            asm volatile("s_waitcnt vmcnt(0)" ::: "memory");
            const unsigned og = xb_add(&bar[XB_TOP], 1u);
            const unsigned tg = og / nx;
            if (og + 1u == (tg + 1u) * nx) xb_add(&bar[XB_TOPGEN], 1u);
            else XB_SPIN(xb_ld(&bar[XB_TOPGEN]) == tg, bar);
            __builtin_amdgcn_fence(__ATOMIC_ACQUIRE, "agent");
            xb_add(&bar[XB_XGEN(bx)], 1u);
            asm volatile("s_waitcnt vmcnt(0)" ::: "memory");
        } else {
            XB_SPIN(xb_ld(&bar[XB_XGEN(bx)]) == gen, bar);
            __builtin_amdgcn_fence(__ATOMIC_ACQUIRE, "agent");
            asm volatile("s_waitcnt vmcnt(0)" ::: "memory");
        }
    }
    __syncthreads();
}
namespace pg8 {
#define PG8_LAS __attribute__((address_space(3)))
typedef unsigned short bf16_t;
typedef short bf16x8 __attribute__((ext_vector_type(8)));
typedef float f32x4 __attribute__((ext_vector_type(4)));
typedef unsigned u32x4 __attribute__((ext_vector_type(4)));
constexpr int BM = 256, BK = 64, HALF = 128, HTB = HALF * BK * 2  , STAGE_BYTES = 8 * HTB, NXCD = 8, WGM = 8;

__host__ __device__ __forceinline__ int lds_byte(int r, int c) { const int st = (r >> 4) * 2 + (c >> 5), rr = r & 15, cc = c & 31, ob = rr * 64 + cc * 2; return st * 1024 + (ob ^ (((ob >> 9) & 1) << 5)); }
__host__ __device__ __forceinline__ void stage_rc(int b, int& R, int& C) { const int st = b / 1024, sb = b % 1024, swz = sb ^ (((sb >> 9) & 1) << 5); R = (st >> 1) * 16 + swz / 64; C = (st & 1) * 32 + (swz % 64) / 2; }
__host__ __device__ __forceinline__ int perm32(int rho) { const int n = rho >> 4, i = rho & 15; return 8 * (i >> 2) + 4 * n + (i & 3); }

struct Unit { int pm, pn; };
struct Gemm { const bf16_t* A; const bf16_t* Bt; int M, N, K; };

struct StaticOrder {
    int nM, nN, nwg, G, c;
    __host__ __device__ void init(int M, int N, int G_, int c_) { nM = M / BM; nN = N / BM; nwg = nM * nN; G = G_; c = c_; }
    __host__ __device__ bool next(int i, Unit& u) const {
        const long L = (long)i * G + c; if (L >= nwg) return false;
        int wgid = (int)L; { const int q = nwg / NXCD, r = nwg % NXCD, xcd = wgid % NXCD, off = wgid / NXCD; wgid = (xcd < r ? xcd * (q + 1) : r * (q + 1) + (xcd - r) * q) + off; }
        const int nig = WGM * nN, gid = wgid / nig, fm = gid * WGM, gsz = (nM - fm) < WGM ? (nM - fm) : WGM;
        u.pm = fm + ((wgid % nig) % gsz); u.pn = (wgid % nig) / gsz; return true;
    }
    __device__ __forceinline__ void a_ready(const Unit&) const {}
    __device__ __forceinline__ void done(const Unit&) const {}
    __device__ __forceinline__ const char* a_base(const Gemm& g, const Unit& u, size_t tstep) const { return (const char*)g.A + (size_t)u.pm * tstep; }
    __device__ __forceinline__ const char* b_base(const Gemm& g, const Unit& u, size_t tstep) const { return (const char*)g.Bt + (size_t)u.pn * tstep; }
};


struct EpiBf16 {
    static constexpr bool PERM = true, AFTER_DRAIN = false;
    bf16_t* O; int ldc; int row_shift;
    __device__ __forceinline__ void operator()(const f32x4 (&acc)[2][2][4][2], const Unit& u, int wr, int wc, int fr, int fq) const {
        const int row0 = u.pm * BM + row_shift + wr * 64 + fr, col0 = u.pn * BM + wc * 32 + 8 * fq;
#pragma unroll
        for (int ai = 0; ai < 2; ++ai)
#pragma unroll
            for (int m = 0; m < 4; ++m) { bf16_t* rowp = O + (size_t)(row0 + ai * HALF + m * 16) * ldc + col0;
#pragma unroll
                for (int bj = 0; bj < 2; ++bj) { const f32x4 v0 = acc[ai][bj][m][0], v1 = acc[ai][bj][m][1];
                    u32x4 w; w.x = cvt_pk_bf16(v0[0], v0[1]); w.y = cvt_pk_bf16(v0[2], v0[3]); w.z = cvt_pk_bf16(v1[0], v1[1]); w.w = cvt_pk_bf16(v1[2], v1[3]);
                    *(u32x4*)(rowp + bj * HALF) = w; } }
    }
};
struct EpiSwiGLU {
    static constexpr bool PERM = true, AFTER_DRAIN = false;
    bf16_t* H; int ldh; int row_shift;
    __device__ __forceinline__ void operator()(const f32x4 (&acc)[2][2][4][2], const Unit& u, int wr, int wc, int fr, int fq) const {
        const int row0 = u.pm * BM + row_shift + wr * 64 + fr, col0 = u.pn * HALF + wc * 32 + 8 * fq;
#pragma unroll
        for (int ai = 0; ai < 2; ++ai)
#pragma unroll
            for (int m = 0; m < 4; ++m) { bf16_t* rowp = H + (size_t)(row0 + ai * HALF + m * 16) * ldh + col0;
                const f32x4 g0 = acc[ai][0][m][0], g1 = acc[ai][0][m][1], u0 = acc[ai][1][m][0], u1 = acc[ai][1][m][1];
                float h[8];
#pragma unroll
                for (int i = 0; i < 4; ++i) { h[i] = silu_f(g0[i]) * u0[i]; h[4 + i] = silu_f(g1[i]) * u1[i]; }
                u32x4 w; w.x = cvt_pk_bf16(h[0], h[1]); w.y = cvt_pk_bf16(h[2], h[3]); w.z = cvt_pk_bf16(h[4], h[5]); w.w = cvt_pk_bf16(h[6], h[7]);
                *(u32x4*)rowp = w; }
    }
};
struct EpiRes {
    static constexpr bool PERM = false, AFTER_DRAIN = false;
    const float* xin; float* xout; const float* gate;
    __device__ __forceinline__ void operator()(const f32x4 (&acc)[2][2][4][2], const Unit& u, int wr, int wc, int fr, int fq) const {
        const int row0 = u.pm * BM + wr * 64 + fr, col0 = u.pn * BM + wc * 32 + 4 * fq;
        const float* gb = gate + (size_t)((u.pm * BM) / SEQ) * 6144;
        f32x4 gv[2][2];
#pragma unroll
        for (int bj = 0; bj < 2; ++bj)
#pragma unroll
            for (int n = 0; n < 2; ++n) gv[bj][n] = *(const f32x4*)(gb + col0 + bj * HALF + n * 16);
#pragma unroll
        for (int ai = 0; ai < 2; ++ai)
#pragma unroll
            for (int m = 0; m < 4; ++m) { const size_t off = (size_t)(row0 + ai * HALF + m * 16) * DM + col0;
#pragma unroll
                for (int bj = 0; bj < 2; ++bj)
#pragma unroll
                    for (int n = 0; n < 2; ++n) { const f32x4 x = *(const f32x4*)(xin + off + bj * HALF + n * 16);
                        *(f32x4*)(xout + off + bj * HALF + n * 16) = x + gv[bj][n] * acc[ai][bj][m][n]; } }
    }
};
struct MoeOrder {
    int t0, nrt, nN, G, c, a_rel; int ts1, ts2, ts3, ts4, ts5, ts6, ts7; size_t estride;
    __device__ __forceinline__ bool next(int i, Unit& u) const {
        const int L = i * G + c; if (nrt <= 0 || L >= nrt * nN) return false;
        u.pm = t0 + L % nrt; u.pn = L / nrt; return true;
    }
    __device__ __forceinline__ void a_ready(const Unit&) const {}
    __device__ __forceinline__ void done(const Unit&) const {}
    __device__ __forceinline__ const char* a_base(const Gemm& g, const Unit& u, size_t tstep) const { return (const char*)g.A + (size_t)(u.pm - (a_rel ? t0 : 0)) * tstep; }
    __device__ __forceinline__ const char* b_base(const Gemm& g, const Unit& u, size_t tstep) const {
        const int p = u.pm; const int e = (p >= ts1) + (p >= ts2) + (p >= ts3) + (p >= ts4) + (p >= ts5) + (p >= ts6) + (p >= ts7);
        return (const char*)g.Bt + (size_t)e * estride + (size_t)u.pn * tstep;
    }
};
template <class Epi, class Sched, bool ALIGN_EPI = false, bool SP2 = false>
__device__ __forceinline__ void gemm_phase(PG8_LAS unsigned char* lds, const Gemm g, const Sched& S, const Epi& E) {
    int tid_ = threadIdx.x; asm volatile("" : "+v"(tid_));
    const int tid = tid_, wid = __builtin_amdgcn_readfirstlane(tid >> 6), lane = tid & 63, wr = wid >> 2, wc = wid & 3, fr = lane & 15, fq = lane >> 4;
    const int K = g.K, nt = K / BK;
    unsigned voffA[2], voffB[2];
#pragma unroll
    for (int i = 0; i < 2; ++i) { int R, C; stage_rc(tid * 16 + i * 8192, R, C); const int Rb = Epi::PERM ? ((R & ~31) + perm32(R & 31)) : R;
        voffA[i] = (unsigned)(R * K + C) * 2u; voffB[i] = (unsigned)(Rb * K + C) * 2u; }
    const size_t kstep = (size_t)(BK * 2);
    const size_t hstep = (size_t)HALF * K * 2;
    const size_t tstep = 2 * hstep;
    const unsigned ldsw = (unsigned)wid * 1024u;
    const int aoff = lds_byte(wr * 64 + fr, fq * 8), boff = lds_byte(wc * 32 + fr, fq * 8);
#define PG8_SA(b, h) (((b) * 2 + (h)) * HTB)
#define PG8_SB(b, h) ((4 + (b) * 2 + (h)) * HTB)
#define PG8_STAGE(bufoff, gbase, voff) do { _Pragma("unroll") for (int _i = 0; _i < 2; ++_i) \
        __builtin_amdgcn_global_load_lds((const unsigned*)((const char*)(gbase) + (voff)[_i]), (PG8_LAS unsigned*)(lds + (bufoff) + ldsw + _i * 8192), 16, 0, 0); } while (0)
#define PG8_LDA(dst, b, h) do { _Pragma("unroll") for (int m = 0; m < 4; ++m) _Pragma("unroll") for (int k = 0; k < 2; ++k) dst[m][k] = *(const PG8_LAS bf16x8*)(lds + PG8_SA(b, h) + aoff + m * 2048 + k * 1024); } while (0)
#define PG8_LDB(dst, b, h) do { _Pragma("unroll") for (int n = 0; n < 2; ++n) _Pragma("unroll") for (int k = 0; k < 2; ++k) dst[n][k] = *(const PG8_LAS bf16x8*)(lds + PG8_SB(b, h) + boff + n * 2048 + k * 1024); } while (0)
#define PG8_MMA(ai, bj, At, Bt) do { __builtin_amdgcn_s_setprio(1); _Pragma("unroll") for (int m = 0; m < 4; ++m) _Pragma("unroll") for (int n = 0; n < 2; ++n) _Pragma("unroll") for (int k = 0; k < 2; ++k) \
        acc[ai][bj][m][n] = __builtin_amdgcn_mfma_f32_16x16x32_bf16(Bt[n][k], At[m][k], acc[ai][bj][m][n], 0, 0, 0); __builtin_amdgcn_s_setprio(0); } while (0)
#define PG8_WAIT_V(n) asm volatile("s_waitcnt vmcnt(" #n ")" ::: "memory")
#define PG8_WAIT_L(n) asm volatile("s_waitcnt lgkmcnt(" #n ")" ::: "memory")
#define PG8_BAR __builtin_amdgcn_s_barrier()
#define PG8_SCHED __builtin_amdgcn_sched_barrier(0)
    Unit cur, nxt; int ui = 0;
    if (!S.next(0, cur)) return;
    f32x4 acc[2][2][4][2];
#pragma unroll
    for (int a = 0; a < 2; ++a)
#pragma unroll
        for (int b = 0; b < 2; ++b)
#pragma unroll
            for (int m = 0; m < 4; ++m)
#pragma unroll
                for (int n = 0; n < 2; ++n) acc[a][b][m][n] = (f32x4){0.f, 0.f, 0.f, 0.f};
    bf16x8 At[4][2], B0[2][2], B1[2][2];
    const char* cA = S.a_base(g, cur, tstep); const char* cB = S.b_base(g, cur, tstep);
    S.a_ready(cur);
    if constexpr (SP2) {
        PG8_STAGE(PG8_SB(0, 0), cB, voffB); PG8_STAGE(PG8_SB(0, 1), cB + hstep, voffB); PG8_STAGE(PG8_SA(0, 0), cA, voffA); PG8_STAGE(PG8_SA(0, 1), cA + hstep, voffA);
        if (wr == 1) PG8_BAR;
        PG8_WAIT_V(2); PG8_BAR;
        PG8_STAGE(PG8_SB(1, 0), cB + kstep, voffB); PG8_STAGE(PG8_SA(1, 0), cA + kstep, voffA); PG8_STAGE(PG8_SB(1, 1), cB + hstep + kstep, voffB);
        PG8_WAIT_V(6); PG8_BAR;
    } else {
        PG8_STAGE(PG8_SB(0, 0), cB, voffB); PG8_STAGE(PG8_SA(0, 0), cA, voffA); PG8_STAGE(PG8_SB(0, 1), cB + hstep, voffB); PG8_STAGE(PG8_SA(0, 1), cA + hstep, voffA);
        if (wr == 1) PG8_BAR;
        PG8_WAIT_V(4); PG8_BAR;
        PG8_STAGE(PG8_SB(1, 0), cB + kstep, voffB); PG8_STAGE(PG8_SA(1, 0), cA + kstep, voffA); PG8_STAGE(PG8_SB(1, 1), cB + hstep + kstep, voffB);
        PG8_WAIT_V(6); PG8_BAR;
    }
    for (;;) {
        const bool has_next = S.next(ui + 1, nxt);
        const char* nA = has_next ? S.a_base(g, nxt, tstep) : cA; const char* nB = has_next ? S.b_base(g, nxt, tstep) : cB;
        for (int t = 0; t < nt; t += 2) {
            const bool last = (t == nt - 2);
            const char* a1 = cA + (size_t)(t + 1) * kstep;
            const char* a2 = last ? nA : cA + (size_t)(t + 2) * kstep; const char* b2 = last ? nB : cB + (size_t)(t + 2) * kstep;
            const char* a3 = a2 + kstep; const char* b3 = b2 + kstep;
            if (last && has_next) S.a_ready(nxt);
            if constexpr (SP2) {
            PG8_LDB(B0, 0, 0); PG8_LDB(B1, 0, 1); PG8_SCHED; PG8_LDA(At, 0, 0); PG8_STAGE(PG8_SA(1, 1), a1 + hstep, voffA);
            PG8_WAIT_V(8); PG8_WAIT_L(0); PG8_BAR; PG8_MMA(0, 0, At, B0); PG8_MMA(0, 1, At, B1); PG8_BAR; PG8_SCHED;
            PG8_LDA(At, 0, 1); PG8_STAGE(PG8_SB(0, 0), b2, voffB); PG8_STAGE(PG8_SB(0, 1), b2 + hstep, voffB); PG8_STAGE(PG8_SA(0, 0), a2, voffA);
            PG8_WAIT_V(8); PG8_WAIT_L(0); PG8_BAR; PG8_MMA(1, 0, At, B0); PG8_MMA(1, 1, At, B1); PG8_BAR; PG8_SCHED;
            PG8_LDB(B0, 1, 0); PG8_LDB(B1, 1, 1); PG8_SCHED; PG8_LDA(At, 1, 0); PG8_STAGE(PG8_SA(0, 1), a2 + hstep, voffA);
            PG8_WAIT_V(8); PG8_WAIT_L(0); PG8_BAR; PG8_MMA(0, 0, At, B0); PG8_MMA(0, 1, At, B1); PG8_BAR; PG8_SCHED;
            PG8_LDA(At, 1, 1); PG8_STAGE(PG8_SB(1, 0), b3, voffB); PG8_STAGE(PG8_SB(1, 1), b3 + hstep, voffB); PG8_STAGE(PG8_SA(1, 0), a3, voffA);
            PG8_WAIT_V(8); PG8_WAIT_L(0); PG8_BAR; PG8_MMA(1, 0, At, B0); PG8_MMA(1, 1, At, B1); PG8_BAR; PG8_SCHED;
            } else {
            PG8_LDB(B0, 0, 0); PG8_SCHED; PG8_LDA(At, 0, 0); PG8_STAGE(PG8_SA(1, 1), a1 + hstep, voffA);
            PG8_WAIT_L(8); PG8_BAR; PG8_WAIT_L(0); PG8_MMA(0, 0, At, B0); PG8_BAR; PG8_SCHED;
            PG8_LDB(B1, 0, 1); PG8_STAGE(PG8_SB(0, 0), b2, voffB);
            PG8_BAR; PG8_WAIT_L(0); PG8_MMA(0, 1, At, B1); PG8_BAR;
            PG8_LDA(At, 0, 1); PG8_STAGE(PG8_SA(0, 0), a2, voffA);
            PG8_BAR; PG8_WAIT_L(0); PG8_MMA(1, 0, At, B0); PG8_BAR; PG8_SCHED;
            PG8_STAGE(PG8_SB(0, 1), b2 + hstep, voffB);
            PG8_WAIT_V(6); PG8_BAR; PG8_MMA(1, 1, At, B1); PG8_BAR;
            PG8_LDB(B0, 1, 0); PG8_SCHED; PG8_LDA(At, 1, 0); PG8_STAGE(PG8_SA(0, 1), a2 + hstep, voffA);
            PG8_WAIT_L(8); PG8_BAR; PG8_WAIT_L(0); PG8_MMA(0, 0, At, B0); PG8_BAR; PG8_SCHED;
            PG8_LDB(B1, 1, 1); PG8_STAGE(PG8_SB(1, 0), b3, voffB);
            PG8_BAR; PG8_WAIT_L(0); PG8_MMA(0, 1, At, B1); PG8_BAR;
            PG8_LDA(At, 1, 1); PG8_STAGE(PG8_SA(1, 0), a3, voffA);
            PG8_BAR; PG8_WAIT_L(0); PG8_MMA(1, 0, At, B0); PG8_BAR; PG8_SCHED;
            PG8_STAGE(PG8_SB(1, 1), b3 + hstep, voffB);
            PG8_WAIT_V(6); PG8_BAR; PG8_MMA(1, 1, At, B1); PG8_BAR;
            }
        }
        if constexpr (ALIGN_EPI) { if (wr == 0) PG8_BAR; }
        if constexpr (!Epi::AFTER_DRAIN) { E(acc, cur, wr, wc, fr, fq); S.done(cur); }
        if (!has_next) break;
#pragma unroll
        for (int a = 0; a < 2; ++a)
#pragma unroll
            for (int b = 0; b < 2; ++b)
#pragma unroll
                for (int m = 0; m < 4; ++m)
#pragma unroll
                    for (int n = 0; n < 2; ++n) acc[a][b][m][n] = (f32x4){0.f, 0.f, 0.f, 0.f};
        cur = nxt; cA = nA; cB = nB; ++ui;
        if constexpr (ALIGN_EPI) { if (wr == 1) PG8_BAR; }
    }
    PG8_WAIT_V(0);
    if constexpr (!ALIGN_EPI) { if (wr == 0) PG8_BAR; }
    PG8_BAR;
    if constexpr (Epi::AFTER_DRAIN) { E.fused(acc, cur, wr, wc, fr, fq, lds, wid, lane); S.done(cur); }
#undef PG8_SA
#undef PG8_SB
#undef PG8_STAGE
#undef PG8_LDA
#undef PG8_LDB
#undef PG8_MMA
#undef PG8_WAIT_V
#undef PG8_WAIT_L
#undef PG8_BAR
#undef PG8_SCHED
}
}

#define LDS_WAIT() asm volatile("s_waitcnt lgkmcnt(0)" ::: "memory")
#define VM_WAIT() asm volatile("s_waitcnt vmcnt(0)" ::: "memory")

__device__ __forceinline__ void transpose_item(const float* W, int ldw, int scol0, int ncol_valid, float scale, bf16* WT, int K, int drow0, int k0, LAS float* scr, int lane) {
    const int n = lane & 31; const bool ok = (scol0 + n) < ncol_valid;
#pragma unroll 8
    for (int i = 0; i < 32; ++i) { const int kk = 2 * i + (lane >> 5);
        float v = 0.f; if (ok) v = W[(size_t)(k0 + kk) * ldw + scol0 + n] * scale;
        scr[kk * 33 + n] = v; }
    LDS_WAIT(); asm volatile("" ::: "memory");
    const int c = lane & 7;
#pragma unroll
    for (int j = 0; j < 4; ++j) { const int nn = (lane >> 3) + 8 * j; const LAS float* s = scr + (8 * c) * 33 + nn;
        u32x4 o; o.x = pk2(s[0 * 33], s[1 * 33]); o.y = pk2(s[2 * 33], s[3 * 33]); o.z = pk2(s[4 * 33], s[5 * 33]); o.w = pk2(s[6 * 33], s[7 * 33]);
        *(u32x4*)(WT + (size_t)(drow0 + nn) * K + k0 + 8 * c) = o; }
    LDS_WAIT(); asm volatile("" ::: "memory");
}
struct PrepArgs { const float *w_in, *w_out, *wfg, *wfu, *wfd, *weg, *weu, *wed; unsigned char* ws; };
constexpr int PI_WIN = 2 * 16 * 120, PI_WOUT = 2 * 16 * 32, PI_FU = 16 * 176, PI_FD = 44 * 32, PI_EU = 8 * 16 * 224, PI_ED = 8 * 56 * 32;
constexpr int PREP_ITEMS = PI_WIN + PI_WOUT + PI_FU + PI_FD + PI_EU + PI_ED;
__device__ __forceinline__ void prep_item(const PrepArgs& a, int it, LAS float* scr, int lane) {
    int r = it;
    if (r < PI_WIN) { const int l = r / 1920; r %= 1920; const int kb = r / 120, nb = r % 120, n0 = nb * 32;
        float sc = 1.f; if ((n0 < 3072 && (n0 % 768) < 256) || (n0 >= COL_QI && n0 < COL_KI)) sc = 0.125f; else if (n0 == COL_WI) sc = 0.35355339059327373f;
        transpose_item(a.w_in + (size_t)l * DM * NIN, NIN, n0, NIN, sc, (bf16*)(a.ws + WS_WIN) + (size_t)l * PW * DM, DM, n0, kb * 64, scr, lane); return; }
    r -= PI_WIN;
    if (r < PI_WOUT) { const int l = r / 512; r %= 512; const int kb = r / 32, nb = r % 32;
        transpose_item(a.w_out + (size_t)l * DM * DM, DM, nb * 32, DM, 1.f, (bf16*)(a.ws + WS_WOUT) + (size_t)l * DM * DM, DM, nb * 32, kb * 64, scr, lane); return; }
    r -= PI_WOUT;
    if (r < PI_FU) { const int kb = r / 176, nb = r % 176, r0 = nb * 32, blk = r0 >> 8, w = r0 & 255;
        transpose_item(w < 128 ? a.wfg : a.wfu, DFF, blk * 128 + (w & 127), DFF, 1.f, (bf16*)(a.ws + WS_WFU), DM, r0, kb * 64, scr, lane); return; }
    r -= PI_FU;
    if (r < PI_FD) { const int kb = r / 32, nb = r % 32;
        transpose_item(a.wfd, DM, nb * 32, DM, 1.f, (bf16*)(a.ws + WS_WFD), DFF, nb * 32, kb * 64, scr, lane); return; }
    r -= PI_FD;
    if (r < PI_EU) { const int e = r / 3584; r %= 3584; const int kb = r / 224, nb = r % 224, r0 = nb * 32, blk = r0 >> 8, w = r0 & 255;
        transpose_item((w < 128 ? a.weg : a.weu) + (size_t)e * DM * DFE, DFE, blk * 128 + (w & 127), DFE, 1.f, (bf16*)(a.ws + WS_WEU) + (size_t)e * 7168 * DM, DM, r0, kb * 64, scr, lane); return; }
    r -= PI_EU;
    { const int e = r / 1792; r %= 1792; const int kb = r / 32, nb = r % 32;
        transpose_item(a.wed + (size_t)e * DFE * DM, DM, nb * 32, DM, 1.f, (bf16*)(a.ws + WS_WED) + (size_t)e * DM * DFE, DFE, nb * 32, kb * 64, scr, lane); }
}
__device__ __forceinline__ void ph_prep(const PrepArgs& a, LAS unsigned char* lds, int bid, int nblk) {
    const int lane = otid() & 63, wave = otid() >> 6;
    LAS float* scr = (LAS float*)lds + wave * 64 * 33;
    const int gw = bid * 8 + wave, ngw = nblk * 8;
    for (int it = gw; it < PREP_ITEMS; it += ngw) prep_item(a, it, scr, lane);
}
__device__ __forceinline__ void ph_mod(const float* c, const float* w_ada, const float* b_ada, float* mod, LAS unsigned char* lds, int bid, int nblk) {
    LAS float* sc = (LAS float*)lds; LAS float* part = (LAS float*)(lds + 32768);
    const int tid = otid();
    if (bid >= 192) return;
    for (int i = tid; i < 8 * 1024; i += 512) { const float v = c[i]; sc[i] = v / (1.0f + __expf(-v)); }
    __syncthreads();
    for (int item = bid; item < 192; item += nblk) {
        const int l = item / 96, j0 = (item % 96) * 64, jj = tid & 63, kq = tid >> 6;
        float acc[8];
#pragma unroll
        for (int b = 0; b < 8; ++b) acc[b] = 0.f;
        const float* w = w_ada + (size_t)l * DM * 6144 + j0 + jj;
        for (int k = kq * 128; k < kq * 128 + 128; ++k) { const float wv = w[(size_t)k * 6144];
#pragma unroll
            for (int b = 0; b < 8; ++b) acc[b] += sc[b * 1024 + k] * wv; }
#pragma unroll
        for (int b = 0; b < 8; ++b) part[(kq * 8 + b) * 64 + jj] = acc[b];
        __syncthreads();
        { const int b = tid >> 6, j = tid & 63; float sum = 0.f;
#pragma unroll
          for (int q = 0; q < 8; ++q) sum += part[(q * 8 + b) * 64 + j];
          mod[(size_t)l * 8 * 6144 + (size_t)b * 6144 + j0 + j] = sum + b_ada[l * 6144 + j0 + j]; }
        __syncthreads();
    }
}

struct MoeTiles { int p0, p1, p2, p3, p4, p5, p6, p7; };
__device__ __forceinline__ MoeTiles moe_tiles(const unsigned* ecnt) {
#define ECNT_LD(i) ((int)((__hip_atomic_load(ecnt + (i), __ATOMIC_RELAXED, __HIP_MEMORY_SCOPE_AGENT) + 255u) >> 8))
    MoeTiles m; m.p0 = ECNT_LD(0); m.p1 = ECNT_LD(1); m.p2 = ECNT_LD(2); m.p3 = ECNT_LD(3); m.p4 = ECNT_LD(4); m.p5 = ECNT_LD(5); m.p6 = ECNT_LD(6); m.p7 = ECNT_LD(7); return m;
#undef ECNT_LD
}
__device__ __forceinline__ int moe_tile_start(const MoeTiles& m, int e) {
    int s = 0; s += (e > 0) ? m.p0 : 0; s += (e > 1) ? m.p1 : 0; s += (e > 2) ? m.p2 : 0; s += (e > 3) ? m.p3 : 0; s += (e > 4) ? m.p4 : 0; s += (e > 5) ? m.p5 : 0; s += (e > 6) ? m.p6 : 0; return s;
}
struct NormArgs {
    const float* xin; const float* g; const float* shift; const float* scale;
    bf16* act;
    const float* w_router; int* tok; unsigned* ecnt;
    const bf16* ys; const float* gate; float* out;
};
template <int MODE> __device__ __forceinline__ void ph_norm(const NormArgs& a, LAS unsigned char* lds, int bid, int nblk) {
    LAS unsigned* lcnt = (LAS unsigned*)lds; LAS unsigned* lbase = lcnt + 8; typedef int info6[6]; LAS info6* linfo = (LAS info6*)(lds + 64);
    const int tid = otid(), lane = tid & 63, wave = tid >> 6;
    if (MODE == 1) { if (tid < 8) lcnt[tid] = 0u; __syncthreads(); }
    MoeTiles mt; if (MODE == 2) mt = moe_tiles(a.ecnt);
    for (int blk = bid; blk < T / 128; blk += nblk) {
        for (int i = 0; i < 16; ++i) {
            const int lr = wave + 8 * i, row = blk * 128 + lr, b = row / SEQ;
            const f32x4* xr = (const f32x4*)(a.xin + (size_t)row * DM) + lane;
            f32x4 v[4];
#pragma unroll
            for (int j = 0; j < 4; ++j) v[j] = xr[64 * j];
            if (MODE == 2) {
                const int* ti = a.tok + (size_t)row * 8; const int e0 = ti[0], e1 = ti[1], p0 = ti[2], p1 = ti[3]; const float g0 = __int_as_float(ti[4]), g1 = __int_as_float(ti[5]);
                const size_t s0 = (size_t)moe_tile_start(mt, e0) * 256 + p0, s1 = (size_t)moe_tile_start(mt, e1) * 256 + p1;
                const u32x2* y0 = (const u32x2*)(a.ys + s0 * DM) + lane; const u32x2* y1 = (const u32x2*)(a.ys + s1 * DM) + lane;
                const f32x4* gt = (const f32x4*)(a.gate + (size_t)b * 6144) + lane;
#pragma unroll
                for (int j = 0; j < 4; ++j) { const u32x2 a0 = y0[64 * j], a1 = y1[64 * j]; const f32x4 gv = gt[64 * j];
                    f32x4 y; y.x = g0 * bf2f(a0.x & 0xffffu) + g1 * bf2f(a1.x & 0xffffu); y.y = g0 * bf2f(a0.x >> 16) + g1 * bf2f(a1.x >> 16);
                    y.z = g0 * bf2f(a0.y & 0xffffu) + g1 * bf2f(a1.y & 0xffffu); y.w = g0 * bf2f(a0.y >> 16) + g1 * bf2f(a1.y >> 16);
                    v[j] = v[j] + gv * y; }
            }
            float ss = 0.f;
#pragma unroll
            for (int j = 0; j < 4; ++j) ss += (v[j].x * v[j].x + v[j].y * v[j].y) + (v[j].z * v[j].z + v[j].w * v[j].w);
            const float rstd = rsqrtf(wave_sum(ss) * (1.0f / DM) + EPS);
            const f32x4* gp = (const f32x4*)a.g + lane;
            if (MODE == 2) {
                f32x4* o = (f32x4*)(a.out + (size_t)row * DM) + lane;
#pragma unroll
                for (int j = 0; j < 4; ++j) o[64 * j] = v[j] * rstd * gp[64 * j];
            } else {
                const f32x4* sh = (const f32x4*)(a.shift + (size_t)b * 6144) + lane; const f32x4* sc = (const f32x4*)(a.scale + (size_t)b * 6144) + lane;
                u32x2* o = (u32x2*)(a.act + (size_t)row * DM) + lane;
#pragma unroll
                for (int j = 0; j < 4; ++j) { v[j] = v[j] * rstd * gp[64 * j] * (sc[64 * j] + 1.0f) + sh[64 * j];
                    u32x2 w; w.x = pk2(v[j].x, v[j].y); w.y = pk2(v[j].z, v[j].w); o[64 * j] = w; }
                if (MODE == 1) {
                    float lg[8];
#pragma unroll
                    for (int e = 0; e < 8; ++e) lg[e] = 0.f;
#pragma unroll
                    for (int j = 0; j < 4; ++j) { const float hv[4] = {v[j].x, v[j].y, v[j].z, v[j].w};
#pragma unroll
                        for (int q = 0; q < 4; ++q) { const f32x4* wr = (const f32x4*)(a.w_router + (size_t)(256 * j + 4 * lane + q) * 8); const f32x4 w0 = wr[0], w1 = wr[1];
                            lg[0] += hv[q] * w0.x; lg[1] += hv[q] * w0.y; lg[2] += hv[q] * w0.z; lg[3] += hv[q] * w0.w; lg[4] += hv[q] * w1.x; lg[5] += hv[q] * w1.y; lg[6] += hv[q] * w1.z; lg[7] += hv[q] * w1.w; } }
#pragma unroll
                    for (int e = 0; e < 8; ++e) lg[e] = wave_sum(lg[e]);
                    int e0 = 0; float v0 = lg[0];
#pragma unroll
                    for (int e = 1; e < 8; ++e) if (lg[e] > v0) { v0 = lg[e]; e0 = e; }
                    int e1 = -1; float v1 = -INFINITY;
#pragma unroll
                    for (int e = 0; e < 8; ++e) if (e != e0 && lg[e] > v1) { v1 = lg[e]; e1 = e; }
                    const float g0 = 1.0f / (1.0f + __expf(v1 - v0)), g1 = 1.0f - g0;
                    if (lane == 0) { const unsigned q0 = __hip_atomic_fetch_add(&lcnt[e0], 1u, __ATOMIC_RELAXED, __HIP_MEMORY_SCOPE_WORKGROUP), q1 = __hip_atomic_fetch_add(&lcnt[e1], 1u, __ATOMIC_RELAXED, __HIP_MEMORY_SCOPE_WORKGROUP);
                        linfo[lr][0] = e0; linfo[lr][1] = e1; linfo[lr][2] = (int)q0; linfo[lr][3] = (int)q1; linfo[lr][4] = __float_as_int(g0); linfo[lr][5] = __float_as_int(g1); }
                }
            }
        }
        if (MODE == 1) {
            __syncthreads();
            if (tid < 8) { lbase[tid] = atomicAdd(&a.ecnt[tid], lcnt[tid]); }
            __syncthreads();
            if (tid < 128) { int* ti = a.tok + (size_t)(blk * 128 + tid) * 8; const int e0 = linfo[tid][0], e1 = linfo[tid][1];
                ti[0] = e0; ti[1] = e1; ti[2] = linfo[tid][2] + (int)lbase[e0]; ti[3] = linfo[tid][3] + (int)lbase[e1]; ti[4] = linfo[tid][4]; ti[5] = linfo[tid][5]; ti[6] = 0; ti[7] = 0; }
            __syncthreads();
            if (tid < 8) lcnt[tid] = 0u;
            __syncthreads();
        }
    }
}
__device__ __forceinline__ void ph_gather(const bf16* act, const int* tok, const unsigned* ecnt, bf16* xs, int bid, int nblk) {
    const int lane = otid() & 63, gw = bid * 8 + (otid() >> 6), ngw = nblk * 8;
    const MoeTiles mt = moe_tiles(ecnt);
    for (int t = gw; t < T; t += ngw) {
        const int* ti = tok + (size_t)t * 8; const int e0 = ti[0], e1 = ti[1], p0 = ti[2], p1 = ti[3];
        const size_t s0 = (size_t)moe_tile_start(mt, e0) * 256 + p0, s1 = (size_t)moe_tile_start(mt, e1) * 256 + p1;
        const u32x4* src = (const u32x4*)(act + (size_t)t * DM) + lane; const u32x4 a0 = src[0], a1 = src[64];
        u32x4* d0 = (u32x4*)(xs + s0 * DM) + lane; u32x4* d1 = (u32x4*)(xs + s1 * DM) + lane;
        d0[0] = a0; d0[64] = a1; d1[0] = a0; d1[64] = a1;
    }
    for (int i = gw; i < 8 * 256; i += ngw) { const int e = i >> 8, r = i & 255; const int cnt = (int)__hip_atomic_load(ecnt + e, __ATOMIC_RELAXED, __HIP_MEMORY_SCOPE_AGENT); const int padded = ((cnt + 255) >> 8) << 8;
        if (cnt + r < padded) { u32x4* d = (u32x4*)(xs + ((size_t)moe_tile_start(mt, e) * 256 + cnt + r) * DM) + lane; const u32x4 z = {0u, 0u, 0u, 0u}; d[0] = z; d[64] = z; } }
}

__device__ __forceinline__ void ld16(const bf16* p, float (&f)[16]) { ld8(p, &f[0]); ld8(p + 8, &f[8]); }
__device__ __forceinline__ float dot16x4(const float (&q)[16], const bf16* p) {
    float f[16]; ld16(p, f); float s0 = 0.f, s1 = 0.f;
#pragma unroll
    for (int i = 0; i < 16; i += 2) { s0 += q[i] * f[i]; s1 += q[i + 1] * f[i + 1]; }
    float s = s0 + s1; s += __shfl_xor(s, 1); s += __shfl_xor(s, 2); return s;
}
__device__ __forceinline__ void axpy16(float (&o)[16], float w, const bf16* p) {
    float f[16]; ld16(p, f);
#pragma unroll
    for (int i = 0; i < 16; ++i) o[i] += w * f[i];
}
__device__ __forceinline__ void head_norm_store16(float (&o)[16], const float* gh, bf16* dst) {
    float ss = 0.f;
#pragma unroll
    for (int i = 0; i < 16; ++i) ss += o[i] * o[i];
    ss += __shfl_xor(ss, 1); ss += __shfl_xor(ss, 2);
    const float r = rsqrtf(ss * (1.0f / 64.0f) + EPS);
#pragma unroll
    for (int i = 0; i < 2; ++i) { u32x4 w; const float* q = &o[8 * i]; const float* g = gh + 8 * i;
        w.x = pk2(q[0] * r * g[0], q[1] * r * g[1]); w.y = pk2(q[2] * r * g[2], q[3] * r * g[3]); w.z = pk2(q[4] * r * g[4], q[5] * r * g[5]); w.w = pk2(q[6] * r * g[6], q[7] * r * g[7]);
        *(u32x4*)(dst + 8 * i) = w; }
}
#define OSM_STEP(s, vrow) do { if ((s) > m) { const float a_ = __expf(m - (s)); l *= a_; _Pragma("unroll") for (int d_ = 0; d_ < 16; ++d_) o[d_] *= a_; m = (s); } \
    const float p_ = __expf((s) - m); l += p_; axpy16(o, p_, (vrow)); } while (0)
#define NAIVE_IDX() const int part = gidx & 3, idx = gidx >> 2; const int t = idx & (SEQ - 1), h = (idx >> 12) & 3, b = idx >> 14; const int po = 16 * part

__device__ __forceinline__ void sb_naive_one(const bf16* P, const float* gh, bf16* act, int gidx) {
    NAIVE_IDX();
    const bf16* Pb = P + (size_t)b * SEQ * PW + po;
    float q[16], o[16];
    ld16(Pb + (size_t)t * PW + h * 64, q);
#pragma unroll
    for (int i = 0; i < 16; ++i) o[i] = 0.f;
    float carry = 1.0f;
    for (int s = t - 1; s >= 0; --s) {
        float z = dot16x4(q, Pb + (size_t)s * PW + 256 + h * 64); z = fminf(fmaxf(z, -80.f), 80.f);
        const float e = __expf(z), om = 1.0f / (1.0f + e), beta = e * om, aw = beta * carry;
        axpy16(o, aw, Pb + (size_t)s * PW + 512 + h * 64);
        carry *= om;
        if (carry < 1e-30f) break;
    }
    head_norm_store16(o, gh + h * 64 + po, act + (size_t)(b * SEQ + t) * DM + h * 64 + po);
}
__device__ __forceinline__ void dil_naive_one(const bf16* P, const float* gh, bf16* act, int gidx) {
    NAIVE_IDX();
    const bf16* Pb = P + (size_t)b * SEQ * PW + 1536 + po;
    const float slope = alibi_slope(1, h);
    float q[16], o[16];
    ld16(Pb + (size_t)t * PW + h * 64, q);
#pragma unroll
    for (int i = 0; i < 16; ++i) o[i] = 0.f;
    float m = -INFINITY, l = 0.f;
    for (int br = 0; br < 3; ++br) { const int dil = br == 0 ? 1 : (br == 1 ? 4 : 16);
        for (int j = 0; j <= 128; ++j) { const int dist = j * dil, kp = t - dist; if (kp < 0) break;
            const float s = dot16x4(q, Pb + (size_t)kp * PW + 256 + h * 64) - slope * (float)dist;
            OSM_STEP(s, Pb + (size_t)kp * PW + 512 + h * 64); } }
    const float rl = 1.0f / l;
#pragma unroll
    for (int i = 0; i < 16; ++i) o[i] *= rl;
    head_norm_store16(o, gh + (8 + h) * 64 + po, act + (size_t)(b * SEQ + t) * DM + (8 + h) * 64 + po);
}
__device__ __forceinline__ unsigned moba_sel_one(const float (&q)[16], const float* kmean, int b, int t, int h, int po) {
    const int own = t >> 8; unsigned sel = 0u;
    if (own <= 3) sel = (1u << own) - 1u;
    else {
        float g[16];
#pragma unroll
        for (int blk = 0; blk < 16; ++blk) { float s = -INFINITY;
            if (blk < own) { const float* km = kmean + ((size_t)b * 16 + blk) * 256 + h * 64 + po; s = 0.f;
#pragma unroll
                for (int d = 0; d < 16; ++d) s += q[d] * km[d];
                s += __shfl_xor(s, 1); s += __shfl_xor(s, 2); }
            g[blk] = s; }
#pragma unroll
        for (int r = 0; r < 3; ++r) { int bi = 0; float bv = -INFINITY;
#pragma unroll
            for (int blk = 0; blk < 16; ++blk) { const bool free_ = !((sel >> blk) & 1u); if (free_ && g[blk] > bv) { bv = g[blk]; bi = blk; } }
            sel |= 1u << bi; }
    }
    return sel;
}
template <int MODE> __device__ __forceinline__ void masked_naive_one(const bf16* P, const unsigned long long* mask, const float* kmean, const float* gh, bf16* act, int gidx) {
    NAIVE_IDX();
    const int cb = MODE == 0 ? 768 : 2304, hb = MODE == 0 ? 4 : 12;
    const bf16* Pb = P + (size_t)b * SEQ * PW + cb + po;
    const float slope = alibi_slope(MODE == 0 ? 0 : 2, h);
    float q[16], o[16];
    ld16(Pb + (size_t)t * PW + h * 64, q);
#pragma unroll
    for (int i = 0; i < 16; ++i) o[i] = 0.f;
    float m = -INFINITY, l = 0.f;
    if (MODE == 0) {
        const unsigned long long* mr = mask + (size_t)(b * SEQ + t) * 64;
        for (int w = 0; w <= (t >> 6); ++w) { unsigned long long bits = mr[w];
            while (bits) { const int j = __builtin_ctzll(bits); bits &= bits - 1; const int kp = w * 64 + j;
                const float s = dot16x4(q, Pb + (size_t)kp * PW + 256 + h * 64) - slope * (float)(t - kp);
                OSM_STEP(s, Pb + (size_t)kp * PW + 512 + h * 64); } }
    } else {
        const int own = t >> 8; const unsigned sel = moba_sel_one(q, kmean, b, t, h, po);
        for (int blk = 0; blk <= own; ++blk) { if (blk < own && !((sel >> blk) & 1u)) continue;
            const int kend = blk == own ? t : blk * 256 + 255;
            for (int kp = blk * 256; kp <= kend; ++kp) {
                const float s = dot16x4(q, Pb + (size_t)kp * PW + 256 + h * 64) - slope * (float)(t - kp);
                OSM_STEP(s, Pb + (size_t)kp * PW + 512 + h * 64); } }
    }
    const float rl = 1.0f / l;
#pragma unroll
    for (int i = 0; i < 16; ++i) o[i] *= rl;
    head_norm_store16(o, gh + (hb + h) * 64 + po, act + (size_t)(b * SEQ + t) * DM + (hb + h) * 64 + po);
}
__device__ __forceinline__ void kmean_unit(const bf16* P, float* kmean, int unit, LAS unsigned char* lds) {
    const int b = unit >> 4, blk = unit & 15, c = otid() & 255, hf = otid() >> 8;
    const bf16* p = P + ((size_t)b * SEQ + blk * 256 + hf * 128) * PW + 2304 + 256 + c;
    float s = 0.f;
    for (int r = 0; r < 128; ++r) s += bf2f(p[(size_t)r * PW]);
    LAS float* part = (LAS float*)lds;
    part[hf * 256 + c] = s;
    __syncthreads();
    if (hf == 0) kmean[(size_t)unit * 256 + c] = (part[c] + part[256 + c]) * (1.0f / 256.0f);
    __syncthreads();
}
constexpr int DSA_LDS = 8 * 4096 * 4;
__device__ __forceinline__ void dsa_select_unit(const bf16* P, unsigned long long* mask, int unit, LAS unsigned* sc) {
    const int tid = otid(), lane = tid & 63, wid = tid >> 6, r32 = lane & 31, hi = lane >> 5;
    const int b = unit >> 9, t0 = (unit & 511) * 8;
    const bf16* Pb = P + (size_t)b * SEQ * PW;
    const int hrow = (r32 & 3) + 4 * ((r32 >> 3) & 1), qrow = 2 * ((r32 >> 2) & 1) + ((r32 >> 4) & 1);
    bf16x8 af[2][4];
#pragma unroll
    for (int qg = 0; qg < 2; ++qg)
#pragma unroll
        for (int s = 0; s < 4; ++s) af[qg][s] = *(const bf16x8*)(Pb + (size_t)(t0 + 4 * qg + qrow) * PW + COL_QI + hrow * 64 + 16 * s + 8 * hi);
    float wv[2][2][8];
#pragma unroll
    for (int qg = 0; qg < 2; ++qg)
#pragma unroll
        for (int qq = 0; qq < 2; ++qq) ld8(Pb + (size_t)(t0 + 4 * qg + 2 * hi + qq) * PW + COL_WI, wv[qg][qq]);
    const int ntile = (t0 + 8 + 31) >> 5;
    for (int kt = wid; kt < ntile; kt += 8) {
        const int key = kt * 32 + r32;
        bf16x8 bfr[4];
#pragma unroll
        for (int s = 0; s < 4; ++s) bfr[s] = *(const bf16x8*)(Pb + (size_t)key * PW + COL_KI + 16 * s + 8 * hi);
#pragma unroll
        for (int qg = 0; qg < 2; ++qg) {
            f32x16 acc = {0.f, 0.f, 0.f, 0.f, 0.f, 0.f, 0.f, 0.f, 0.f, 0.f, 0.f, 0.f, 0.f, 0.f, 0.f, 0.f};
#pragma unroll
            for (int s = 0; s < 4; ++s) acc = __builtin_amdgcn_mfma_f32_32x32x16_bf16(af[qg][s], bfr[s], acc, 0, 0, 0);
#pragma unroll
            for (int qq = 0; qq < 2; ++qq) { float s = 0.f;
#pragma unroll
                for (int h = 0; h < 8; ++h) s += wv[qg][qq][h] * fmaxf(acc[8 * qq + h], 0.f);
                const int ql = 4 * qg + 2 * hi + qq;
                const unsigned u = __float_as_uint(s); const unsigned sk = (u & 0x80000000u) ? ~u : (u | 0x80000000u);
                sc[ql * 4096 + key] = (key <= t0 + ql) ? sk : 0u; }
        }
    }
    __syncthreads();
    {
        const int t = t0 + wid, nvalid = t + 1, nk = ntile * 32;
        unsigned long long myword = 0ull;
        if (nvalid <= 256) {
            const int lo = lane * 64; myword = (nvalid >= lo + 64) ? ~0ull : (nvalid > lo ? ((1ull << (nvalid - lo)) - 1ull) : 0ull);
        } else {
            unsigned K[64];
#pragma unroll
            for (int r = 0; r < 64; ++r) K[r] = (r * 64 + lane < nk) ? sc[wid * 4096 + r * 64 + lane] : 0u;
            unsigned prefix = 0u;
            for (int bit = 31; bit >= 0; --bit) { const unsigned trial = prefix | (1u << bit); int cnt = 0;
#pragma unroll
                for (int r = 0; r < 64; ++r) cnt += __builtin_popcountll(__ballot(K[r] >= trial));
                if (cnt >= 256) prefix = trial; }
            int cgt = 0;
#pragma unroll
            for (int r = 0; r < 64; ++r) cgt += __builtin_popcountll(__ballot(K[r] > prefix));
            int need = 256 - cgt;
            const unsigned long long below = (1ull << lane) - 1ull;
#pragma unroll
            for (int r = 0; r < 64; ++r) {
                const unsigned long long gt = __ballot(K[r] > prefix), eq = __ballot(K[r] == prefix);
                const int c = __builtin_popcountll(eq); unsigned long long take;
                if (c <= need) { take = eq; need -= c; }
                else { const bool mine = ((eq >> lane) & 1ull) && (__builtin_popcountll(eq & below) < need); take = __ballot(mine); need = 0; }
                const unsigned long long word = gt | take;
                if (lane == r) myword = word;
            }
        }
        mask[(size_t)(b * SEQ + t) * 64 + lane] = myword;
    }
    __syncthreads();
}

#ifndef MK_SPLIT
#define MK_SPLIT 0
#endif
constexpr int MISC_OFF = 131072, LDS_BYTES = 131072 + 1024;
constexpr int N_PHASES = 27;
struct MegaArgs { const float* in[17]; float* out; unsigned char* ws; int ph_lo, ph_hi; };

__global__ void __launch_bounds__(512, 2) mega_fwd(MegaArgs a) {
    extern __shared__ __attribute__((aligned(16))) unsigned char lds_raw[];
    LAS unsigned char* lds = (LAS unsigned char*)lds_raw;
    volatile LAS unsigned* MISC = (volatile LAS unsigned*)(lds + MISC_OFF);
    const int tid = threadIdx.x, bid = blockIdx.x, nblk = gridDim.x;
    for (int u = tid; u < (LDS_BYTES - MISC_OFF) / 4; u += 512) MISC[u] = 0u;
    __syncthreads();
    if (tid < 17) { const unsigned long long p = (unsigned long long)a.in[tid]; MISC[64 + 2 * tid] = (unsigned)p; MISC[65 + 2 * tid] = (unsigned)(p >> 32); }
    __syncthreads();
#define INP(i) ((const float*)(((unsigned long long)(unsigned)__builtin_amdgcn_readfirstlane((int)MISC[65 + 2 * (i)]) << 32) | (unsigned long long)(unsigned)__builtin_amdgcn_readfirstlane((int)MISC[64 + 2 * (i)])))
    unsigned char* ws = a.ws;
    unsigned* ctl = (unsigned*)(ws + WS_CTL);
    XcdBarrier bar; bar.bar = ctl + CW_BAR; bar.x = 0; bar.st = nullptr;
    if (!MK_SPLIT) bar = xcd_barrier_post(ctl + CW_BAR, MISC + 8);
    const int lo = a.ph_lo, hi = a.ph_hi;
#define RUN(k) (lo <= (k) && (k) < hi)
#define SEAM(k) do { if (RUN(k) && RUN((k) + 1)) { if (!MK_SPLIT) xcd_barrier(bar); } } while (0)
    float* out = a.out;
    float* mod = (float*)(ws + WS_MOD); float* kmean = (float*)(ws + WS_KMEAN); const float* gv = (const float*)(ws + WS_GV);
    int* tok = (int*)(ws + WS_TOK); bf16* act = (bf16*)(ws + WS_ACT); bf16* P = (bf16*)(ws + WS_P); bf16* hid = (bf16*)(ws + WS_HID); bf16* xs = (bf16*)(ws + WS_XS);
    unsigned long long* mask = (unsigned long long*)(ws + WS_MASK); unsigned* ecnt = ctl + CW_ECNT;

    if (RUN(0)) {
        PrepArgs pa{INP(5), INP(7), INP(9), INP(10), INP(11), INP(13), INP(14), INP(15), ws};
        ph_prep(pa, lds, bid, nblk);
        __syncthreads();
        ph_mod(INP(1), INP(2), INP(3), mod, lds, bid, nblk);
        { float* gvw = (float*)(ws + WS_GV); const float* s4 = INP(4); const float* s6 = INP(6); const float* s8 = INP(8); const float* s16 = INP(16);
          for (int i = bid * 512 + otid(); i < 7168; i += nblk * 512) gvw[i] = i < 2048 ? s4[i] : (i < 4096 ? s6[i - 2048] : (i < 6144 ? s8[i - 4096] : s16[i - 6144])); }
    }
    SEAM(0);
    for (int l = 0; l < NLAYER; ++l) {
        const int pb = 1 + 8 * l;
        const float* ml = mod + (size_t)l * 8 * 6144; const float* xin = (l == 0) ? INP(0) : out; const float* gh = gv + 2048 + l * 1024;
        if (RUN(pb)) { NormArgs na{}; na.xin = xin; na.g = gv + l * DM; na.shift = ml; na.scale = ml + 1024; na.act = act; ph_norm<0>(na, lds, bid, nblk); }
        SEAM(pb);
        if (RUN(pb + 1)) { pg8::Gemm g{act, (const bf16*)(ws + WS_WIN) + (size_t)l * PW * DM, T, PW, DM}; pg8::StaticOrder S; S.init(T, PW, nblk, bid);
            pg8::EpiBf16 E{P, PW, 0}; pg8::gemm_phase<pg8::EpiBf16, pg8::StaticOrder, true, true>(lds, g, S, E); }
        SEAM(pb + 1);
        if (RUN(pb + 2)) {
#ifndef NO_DSA
            for (int unit = bid; unit < NB * 512; unit += nblk) dsa_select_unit(P, mask, unit, (LAS unsigned*)lds);
#endif
            for (int unit = bid; unit < NB * 16; unit += nblk) kmean_unit(P, kmean, unit, lds);
#ifndef NO_NAIVE
            for (int gi = bid * 512 + otid(); gi < T * 16; gi += nblk * 512) sb_naive_one(P, gh, act, gi);
            for (int gi = bid * 512 + otid(); gi < T * 16; gi += nblk * 512) dil_naive_one(P, gh, act, gi);
#endif
        }
        SEAM(pb + 2);
        if (RUN(pb + 3)) {
#ifndef NO_NAIVE
            for (int gi = bid * 512 + otid(); gi < T * 16; gi += nblk * 512) masked_naive_one<0>(P, mask, kmean, gh, act, gi);
            for (int gi = bid * 512 + otid(); gi < T * 16; gi += nblk * 512) masked_naive_one<1>(P, mask, kmean, gh, act, gi);
#endif
        }
        SEAM(pb + 3);
        if (RUN(pb + 4)) { pg8::Gemm g{act, (const bf16*)(ws + WS_WOUT) + (size_t)l * DM * DM, T, DM, DM}; pg8::StaticOrder S; S.init(T, DM, nblk, bid);
            pg8::EpiRes E{xin, out, ml + 2048}; pg8::gemm_phase<pg8::EpiRes, pg8::StaticOrder, true, true>(lds, g, S, E); }
        SEAM(pb + 4);
        if (l == 0) {
            if (RUN(6)) { NormArgs na{}; na.xin = out; na.g = gv + 4096; na.shift = ml + 3072; na.scale = ml + 4096; na.act = act; ph_norm<0>(na, lds, bid, nblk); }
            SEAM(6);
#ifndef NO_FF
            if (RUN(7)) { pg8::Gemm g{act, (const bf16*)(ws + WS_WFU), T, 2 * DFF, DM}; pg8::StaticOrder S; S.init(T, 2 * DFF, nblk, bid);
                pg8::EpiSwiGLU E{hid, DFF, 0}; pg8::gemm_phase<pg8::EpiSwiGLU, pg8::StaticOrder, true, true>(lds, g, S, E); }
            SEAM(7);
            if (RUN(8)) { pg8::Gemm g{hid, (const bf16*)(ws + WS_WFD), T, DM, DFF}; pg8::StaticOrder S; S.init(T, DM, nblk, bid);
                pg8::EpiRes E{out, out, ml + 5120}; pg8::gemm_phase<pg8::EpiRes, pg8::StaticOrder, true, true>(lds, g, S, E); }
            SEAM(8);
#endif
        } else {
            if (RUN(14)) { NormArgs na{}; na.xin = out; na.g = gv + 4096 + DM; na.shift = ml + 3072; na.scale = ml + 4096; na.act = act; na.w_router = INP(12); na.tok = tok; na.ecnt = ecnt;
                ph_norm<1>(na, lds, bid, nblk); }
            SEAM(14);
            if (RUN(15)) ph_gather(act, tok, ecnt, xs, bid, nblk);
            SEAM(15);
#ifndef NO_MOE
            for (int ch = 0; ch < 5; ++ch) {
                if (RUN(16 + 2 * ch) || RUN(17 + 2 * ch)) {
                    const MoeTiles mt = moe_tiles(ecnt);
                    const int ntot = moe_tile_start(mt, 7) + mt.p7;
                    pg8::MoeOrder S; S.t0 = ch * 64; S.nrt = min(64, ntot - S.t0); S.G = nblk; S.c = bid;
                    S.ts1 = moe_tile_start(mt, 1); S.ts2 = moe_tile_start(mt, 2); S.ts3 = moe_tile_start(mt, 3); S.ts4 = moe_tile_start(mt, 4); S.ts5 = moe_tile_start(mt, 5); S.ts6 = moe_tile_start(mt, 6); S.ts7 = moe_tile_start(mt, 7);
                    if (RUN(16 + 2 * ch)) { S.nN = 28; S.a_rel = 0; S.estride = (size_t)7168 * DM * 2;
                        pg8::Gemm g{xs, (const bf16*)(ws + WS_WEU), 0, 0, DM};
                        pg8::EpiSwiGLU E{hid, DFE, -S.t0 * 256}; pg8::gemm_phase<pg8::EpiSwiGLU, pg8::MoeOrder, true, true>(lds, g, S, E); }
                    SEAM(16 + 2 * ch);
                    if (RUN(17 + 2 * ch)) { S.nN = 4; S.a_rel = 1; S.estride = (size_t)DM * DFE * 2;
                        pg8::Gemm g{hid, (const bf16*)(ws + WS_WED), 0, 0, DFE};
                        pg8::EpiBf16 E{xs, DM, 0}; pg8::gemm_phase<pg8::EpiBf16, pg8::MoeOrder, true, true>(lds, g, S, E); }
                    SEAM(17 + 2 * ch);
                }
            }
#endif
            if (RUN(26)) { NormArgs na{}; na.xin = out; na.g = gv + 6144; na.tok = tok; na.ecnt = ecnt; na.ys = xs; na.gate = ml + 5120; na.out = out; ph_norm<2>(na, lds, bid, nblk); }
        }
    }
#undef RUN
#undef SEAM
}

extern "C" void kernel_launch(void* const* d_in, const int* in_sizes, int n_in, void* d_out, int out_size, void* d_ws, size_t ws_size, hipStream_t stream) {
    static int grid = 0;
    if (grid == 0) {
        if (n_in != 17 || out_size != T * DM || ws_size < WS_END) { fprintf(stderr, "kernel_launch: unexpected problem (n_in %d out %d ws %zu)\n", n_in, out_size, ws_size); grid = -1; return; }
        int dev = 0, cus = 0, per_cu = 0;
        if (hipGetDevice(&dev) != hipSuccess || hipDeviceGetAttribute(&cus, hipDeviceAttributeMultiprocessorCount, dev) != hipSuccess) { grid = -1; return; }
        if (hipFuncSetAttribute((const void*)mega_fwd, hipFuncAttributeMaxDynamicSharedMemorySize, LDS_BYTES) != hipSuccess) { fprintf(stderr, "kernel_launch: hipFuncSetAttribute failed\n"); grid = -1; return; }
        if (hipOccupancyMaxActiveBlocksPerMultiprocessor(&per_cu, (const void*)mega_fwd, 512, LDS_BYTES) != hipSuccess || per_cu < 1) fprintf(stderr, "kernel_launch: occupancy query says %d\n", per_cu);
        (void)hipGetLastError();
        grid = cus;
    }
    if (grid < 0) return;
    if (hipMemsetAsync((unsigned char*)d_ws + WS_CTL, 0, CTL_BYTES, stream) != hipSuccess) return;
    MegaArgs a{};
    for (int i = 0; i < 17; ++i) a.in[i] = (const float*)d_in[i];
    a.out = (float*)d_out; a.ws = (unsigned char*)d_ws;
#if MK_SPLIT
    for (int p = 0; p < N_PHASES; ++p) { a.ph_lo = p; a.ph_hi = p + 1; hipLaunchKernelGGL(mega_fwd, dim3(grid), dim3(512), LDS_BYTES, stream, a); }
#else
    a.ph_lo = 0; a.ph_hi = N_PHASES;
    hipLaunchKernelGGL(mega_fwd, dim3(grid), dim3(512), LDS_BYTES, stream, a);
#endif
}
```

```cpp
#include <hip/hip_runtime.h>
#include <cstdio>
#include <cstdint>

#define LAS __attribute__((address_space(3)))
#define GAS __attribute__((address_space(1)))
typedef unsigned short bf16;
typedef short bf16x8 __attribute__((ext_vector_type(8)));
typedef float f32x4 __attribute__((ext_vector_type(4)));
typedef float f32x16 __attribute__((ext_vector_type(16)));
typedef unsigned u32x4 __attribute__((ext_vector_type(4)));
typedef unsigned u32x2 __attribute__((ext_vector_type(2)));

constexpr int NB = 8, SEQ = 4096, T = NB * SEQ, DM = 1024, NLAYER = 2;
constexpr int PW = 3840;
constexpr int NIN = 3656;
constexpr int COL_QI = 3072, COL_KI = 3584, COL_WI = 3648;
constexpr int DFF = 2816, DFE = 3584, NEXP = 8;
constexpr float EPS = 1e-6f;
constexpr int XS_TILES = 264;

constexpr size_t MiB = 1u << 20;
constexpr size_t WS_CTL = 0, CTL_BYTES = 1 * MiB;
constexpr size_t WS_MOD = 1 * MiB;
constexpr size_t WS_GV = 1 * MiB + 400 * 1024;
constexpr size_t WS_KMEAN = 1 * MiB + 512 * 1024;
constexpr size_t WS_MOBASEL = 1 * MiB + 768 * 1024;
constexpr size_t WS_TOK = 2 * MiB;
constexpr size_t WS_WIN = 4 * MiB;
constexpr size_t WS_WOUT = 19 * MiB;
constexpr size_t WS_WFU = 23 * MiB;
constexpr size_t WS_WFD = 34 * MiB;
constexpr size_t WS_ACT = 40 * MiB;
constexpr size_t WS_P = 104 * MiB;
constexpr size_t WS_HID = 104 * MiB;
constexpr size_t WS_XS = 216 * MiB;
constexpr size_t WS_MASK = 344 * MiB;
constexpr size_t WS_WEU = 360 * MiB;
constexpr size_t WS_WED = 472 * MiB;
constexpr size_t WS_END = 528 * MiB;
constexpr int CW_ECNT = 64;
constexpr int CW_BAR = 4096;

__device__ __forceinline__ float bf2f(unsigned v) { return __uint_as_float(v << 16); }
__device__ __forceinline__ unsigned f2bf(float f) { unsigned u = __float_as_uint(f); return (u + 0x7fffu + ((u >> 16) & 1u)) >> 16; }
__device__ __forceinline__ unsigned pk2(float lo, float hi) { return f2bf(lo) | (f2bf(hi) << 16); }
__device__ __forceinline__ unsigned cvt_pk_bf16(float lo, float hi) { unsigned r; asm volatile("v_cvt_pk_bf16_f32 %0, %1, %2" : "=v"(r) : "v"(lo), "v"(hi)); return r; }
__device__ __forceinline__ float wave_sum(float v) {
#pragma unroll
    for (int o = 1; o < 64; o <<= 1) v += __shfl_xor(v, o);
    return v;
}
__device__ __forceinline__ void ld8(const bf16* p, float* f) {
    const u32x4 u = *(const u32x4*)p;
    f[0] = __uint_as_float(u.x << 16); f[1] = __uint_as_float(u.x & 0xffff0000u);
    f[2] = __uint_as_float(u.y << 16); f[3] = __uint_as_float(u.y & 0xffff0000u);
    f[4] = __uint_as_float(u.z << 16); f[5] = __uint_as_float(u.z & 0xffff0000u);
    f[6] = __uint_as_float(u.w << 16); f[7] = __uint_as_float(u.w & 0xffff0000u);
}
__device__ __forceinline__ float alibi_slope(int mixer_pos, int h) { return exp2f(-8.0f * (float)(3 * h + mixer_pos + 1) / 12.0f); }
__device__ __forceinline__ float silu_f(float x) { return x * __builtin_amdgcn_rcpf(1.0f + __expf(-x)); }
__device__ __forceinline__ int otid() { int t = threadIdx.x; asm volatile("" : "+v"(t)); return t; }
#define XB_TMO      128
#define XB_XCNT(j)  (256  + 64 * (j))
#define XB_XSUB(j)  (1280 + 64 * (j))
#define XB_XGEN(j)  (2304 + 64 * (j))
#define XB_TOP      3328
#define XB_TOPGEN   3392
#define XCD_BAR_WORDS 3456
#define XB_SPIN_CAP (1u << 18)

__device__ __forceinline__ unsigned xb_ld(unsigned* p)              { return __hip_atomic_load(p, __ATOMIC_RELAXED, __HIP_MEMORY_SCOPE_AGENT); }
__device__ __forceinline__ unsigned xb_add(unsigned* p, unsigned v) { return __hip_atomic_fetch_add(p, v, __ATOMIC_RELAXED, __HIP_MEMORY_SCOPE_AGENT); }
__device__ __forceinline__ unsigned xb_xcc_id() { return (unsigned)__builtin_amdgcn_s_getreg((3 << 11) | 20) & 0xFu; }
#define XB_SPIN(cond, bar) do { unsigned _sp = 0; while (cond) { __builtin_amdgcn_s_sleep(1); \
    if ((++_sp & 255u) == 0u) { if (xb_ld(&(bar)[XB_TMO])) break; if (_sp > XB_SPIN_CAP) { atomicAdd(&(bar)[XB_TMO], 1u); break; } } } } while (0)

struct XcdBarrier {
    unsigned* bar; unsigned x;
    volatile LAS unsigned* st;
};

__device__ __forceinline__ XcdBarrier xcd_barrier_post(unsigned* bar, volatile LAS unsigned* st) {
    XcdBarrier b; b.bar = bar; b.x = xb_xcc_id(); b.st = st;
    if (threadIdx.x == 0) (void)xb_add(&bar[XB_XCNT(b.x)], 1u);
    return b;
}
__device__ __forceinline__ void xcd_barrier_complete(unsigned* bar, unsigned x, unsigned& nloc, unsigned& nx) {
    const unsigned G = gridDim.x * gridDim.y * gridDim.z;
    unsigned sum, cnt, mine, sp = 0u;
    for (;;) {
        asm volatile("" : "+s"(bar), "+s"(x));
        sum = 0u; cnt = 0u; mine = 0u;
#pragma unroll
        for (unsigned j = 0; j < 16; ++j) { const unsigned c = xb_ld(&bar[XB_XCNT(j)]); sum += c; cnt += (c > 0u) ? 1u : 0u; mine = (j == x) ? c : mine; }
        if (sum == G) break;
        __builtin_amdgcn_s_sleep(1);
        if ((++sp & 255u) == 0u) { if (xb_ld(&bar[XB_TMO])) break; if (sp > XB_SPIN_CAP) { atomicAdd(&bar[XB_TMO], 1u); break; } }
    }
    nloc = mine > 0u ? mine : 1u; nx = cnt > 0u ? cnt : 1u;
}

__device__ __forceinline__ void xcd_barrier(const XcdBarrier& b) {
    asm volatile("s_waitcnt vmcnt(0)" ::: "memory");
    __syncthreads();
    if (threadIdx.x == 0) {
        unsigned* bar = b.bar; unsigned bx = b.x; asm volatile("" : "+s"(bx));
        __builtin_amdgcn_s_waitcnt(0);
        unsigned nloc = b.st[0], nx = b.st[1];
        if (nloc == 0u) { xcd_barrier_complete(bar, bx, nloc, nx); b.st[0] = nloc; b.st[1] = nx; }
        const unsigned old = xb_add(&bar[XB_XSUB(bx)], 1u);
        const unsigned gen = old / nloc;
        if (old + 1u == (gen + 1u) * nloc) {
            __builtin_amdgcn_fence(__ATOMIC_RELEASE, "agent");
            asm volatile("s_waitcnt vmcnt(0)" ::: "memory");
            const unsigned og = xb_add(&bar[XB_TOP], 1u);
            const unsigned tg = og / nx;
            if (og + 1u == (tg + 1u) * nx) xb_add(&bar[XB_TOPGEN], 1u);
            else XB_SPIN(xb_ld(&bar[XB_TOPGEN]) == tg, bar);
            __builtin_amdgcn_fence(__ATOMIC_ACQUIRE, "agent");
            xb_add(&bar[XB_XGEN(bx)], 1u);
            asm volatile("s_waitcnt vmcnt(0)" ::: "memory");
        } else {
            XB_SPIN(xb_ld(&bar[XB_XGEN(bx)]) == gen, bar);
            __builtin_amdgcn_fence(__ATOMIC_ACQUIRE, "agent");
            asm volatile("s_waitcnt vmcnt(0)" ::: "memory");
        }
    }
    __syncthreads();
}
namespace pg8 {
#define PG8_LAS __attribute__((address_space(3)))
typedef unsigned short bf16_t;
typedef short bf16x8 __attribute__((ext_vector_type(8)));
typedef float f32x4 __attribute__((ext_vector_type(4)));
typedef unsigned u32x4 __attribute__((ext_vector_type(4)));
constexpr int BM = 256, BK = 64, HALF = 128, HTB = HALF * BK * 2  , STAGE_BYTES = 8 * HTB, NXCD = 8, WGM = 8;

__host__ __device__ __forceinline__ int lds_byte(int r, int c) { const int st = (r >> 4) * 2 + (c >> 5), rr = r & 15, cc = c & 31, ob = rr * 64 + cc * 2; return st * 1024 + (ob ^ (((ob >> 9) & 1) << 5)); }
__host__ __device__ __forceinline__ void stage_rc(int b, int& R, int& C) { const int st = b / 1024, sb = b % 1024, swz = sb ^ (((sb >> 9) & 1) << 5); R = (st >> 1) * 16 + swz / 64; C = (st & 1) * 32 + (swz % 64) / 2; }
__host__ __device__ __forceinline__ int perm32(int rho) { const int n = rho >> 4, i = rho & 15; return 8 * (i >> 2) + 4 * n + (i & 3); }

struct Unit { int pm, pn; };
struct Gemm { const bf16_t* A; const bf16_t* Bt; int M, N, K; };

struct StaticOrder {
    int nM, nN, nwg, G, c;
    __host__ __device__ void init(int M, int N, int G_, int c_) { nM = M / BM; nN = N / BM; nwg = nM * nN; G = G_; c = c_; }
    __host__ __device__ bool next(int i, Unit& u) const {
        const long L = (long)i * G + c; if (L >= nwg) return false;
        int wgid = (int)L; { const int q = nwg / NXCD, r = nwg % NXCD, xcd = wgid % NXCD, off = wgid / NXCD; wgid = (xcd < r ? xcd * (q + 1) : r * (q + 1) + (xcd - r) * q) + off; }
        const int nig = WGM * nN, gid = wgid / nig, fm = gid * WGM, gsz = (nM - fm) < WGM ? (nM - fm) : WGM;
        u.pm = fm + ((wgid % nig) % gsz); u.pn = (wgid % nig) / gsz; return true;
    }
    __device__ __forceinline__ void a_ready(const Unit&) const {}
    __device__ __forceinline__ void done(const Unit&) const {}
    __device__ __forceinline__ const char* a_base(const Gemm& g, const Unit& u, size_t tstep) const { return (const char*)g.A + (size_t)u.pm * tstep; }
    __device__ __forceinline__ const char* b_base(const Gemm& g, const Unit& u, size_t tstep) const { return (const char*)g.Bt + (size_t)u.pn * tstep; }
};


struct EpiBf16 {
    static constexpr bool PERM = true, AFTER_DRAIN = false;
    bf16_t* O; int ldc; int row_shift;
    __device__ __forceinline__ void operator()(const f32x4 (&acc)[2][2][4][2], const Unit& u, int wr, int wc, int fr, int fq) const {
        const int row0 = u.pm * BM + row_shift + wr * 64 + fr, col0 = u.pn * BM + wc * 32 + 8 * fq;
#pragma unroll
        for (int ai = 0; ai < 2; ++ai)
#pragma unroll
            for (int m = 0; m < 4; ++m) { bf16_t* rowp = O + (size_t)(row0 + ai * HALF + m * 16) * ldc + col0;
#pragma unroll
                for (int bj = 0; bj < 2; ++bj) { const f32x4 v0 = acc[ai][bj][m][0], v1 = acc[ai][bj][m][1];
                    u32x4 w; w.x = cvt_pk_bf16(v0[0], v0[1]); w.y = cvt_pk_bf16(v0[2], v0[3]); w.z = cvt_pk_bf16(v1[0], v1[1]); w.w = cvt_pk_bf16(v1[2], v1[3]);
                    *(u32x4*)(rowp + bj * HALF) = w; } }
    }
};
struct EpiSwiGLU {
    static constexpr bool PERM = true, AFTER_DRAIN = false;
    bf16_t* H; int ldh; int row_shift;
    __device__ __forceinline__ void operator()(const f32x4 (&acc)[2][2][4][2], const Unit& u, int wr, int wc, int fr, int fq) const {
        const int row0 = u.pm * BM + row_shift + wr * 64 + fr, col0 = u.pn * HALF + wc * 32 + 8 * fq;
#pragma unroll
        for (int ai = 0; ai < 2; ++ai)
#pragma unroll
            for (int m = 0; m < 4; ++m) { bf16_t* rowp = H + (size_t)(row0 + ai * HALF + m * 16) * ldh + col0;
                const f32x4 g0 = acc[ai][0][m][0], g1 = acc[ai][0][m][1], u0 = acc[ai][1][m][0], u1 = acc[ai][1][m][1];
                float h[8];
#pragma unroll
                for (int i = 0; i < 4; ++i) { h[i] = silu_f(g0[i]) * u0[i]; h[4 + i] = silu_f(g1[i]) * u1[i]; }
                u32x4 w; w.x = cvt_pk_bf16(h[0], h[1]); w.y = cvt_pk_bf16(h[2], h[3]); w.z = cvt_pk_bf16(h[4], h[5]); w.w = cvt_pk_bf16(h[6], h[7]);
                *(u32x4*)rowp = w; }
    }
};
struct EpiRes {
    static constexpr bool PERM = false, AFTER_DRAIN = false;
    const float* xin; float* xout; const float* gate;
    __device__ __forceinline__ void operator()(const f32x4 (&acc)[2][2][4][2], const Unit& u, int wr, int wc, int fr, int fq) const {
        const int row0 = u.pm * BM + wr * 64 + fr, col0 = u.pn * BM + wc * 32 + 4 * fq;
        const float* gb = gate + (size_t)((u.pm * BM) / SEQ) * 6144;
        f32x4 gv[2][2];
#pragma unroll
        for (int bj = 0; bj < 2; ++bj)
#pragma unroll
            for (int n = 0; n < 2; ++n) gv[bj][n] = *(const f32x4*)(gb + col0 + bj * HALF + n * 16);
#pragma unroll
        for (int ai = 0; ai < 2; ++ai)
#pragma unroll
            for (int m = 0; m < 4; ++m) { const size_t off = (size_t)(row0 + ai * HALF + m * 16) * DM + col0;
#pragma unroll
                for (int bj = 0; bj < 2; ++bj)
#pragma unroll
                    for (int n = 0; n < 2; ++n) { const f32x4 x = *(const f32x4*)(xin + off + bj * HALF + n * 16);
                        *(f32x4*)(xout + off + bj * HALF + n * 16) = x + gv[bj][n] * acc[ai][bj][m][n]; } }
    }
};
struct MoeOrder {
    int t0, nrt, nN, G, c, a_rel; int ts1, ts2, ts3, ts4, ts5, ts6, ts7; size_t estride;
    __device__ __forceinline__ bool next(int i, Unit& u) const {
        const int L = i * G + c; if (nrt <= 0 || L >= nrt * nN) return false;
        u.pm = t0 + L % nrt; u.pn = L / nrt; return true;
    }
    __device__ __forceinline__ void a_ready(const Unit&) const {}
    __device__ __forceinline__ void done(const Unit&) const {}
    __device__ __forceinline__ const char* a_base(const Gemm& g, const Unit& u, size_t tstep) const { return (const char*)g.A + (size_t)(u.pm - (a_rel ? t0 : 0)) * tstep; }
    __device__ __forceinline__ const char* b_base(const Gemm& g, const Unit& u, size_t tstep) const {
        const int p = u.pm; const int e = (p >= ts1) + (p >= ts2) + (p >= ts3) + (p >= ts4) + (p >= ts5) + (p >= ts6) + (p >= ts7);
        return (const char*)g.Bt + (size_t)e * estride + (size_t)u.pn * tstep;
    }
};
template <class Epi, class Sched, bool ALIGN_EPI = false, bool SP2 = false>
__device__ __forceinline__ void gemm_phase(PG8_LAS unsigned char* lds, const Gemm g, const Sched& S, const Epi& E) {
    int tid_ = threadIdx.x; asm volatile("" : "+v"(tid_));
    const int tid = tid_, wid = __builtin_amdgcn_readfirstlane(tid >> 6), lane = tid & 63, wr = wid >> 2, wc = wid & 3, fr = lane & 15, fq = lane >> 4;
    const int K = g.K, nt = K / BK;
    unsigned voffA[2], voffB[2];
#pragma unroll
    for (int i = 0; i < 2; ++i) { int R, C; stage_rc(tid * 16 + i * 8192, R, C); const int Rb = Epi::PERM ? ((R & ~31) + perm32(R & 31)) : R;
        voffA[i] = (unsigned)(R * K + C) * 2u; voffB[i] = (unsigned)(Rb * K + C) * 2u; }
    const size_t kstep = (size_t)(BK * 2);
    const size_t hstep = (size_t)HALF * K * 2;
    const size_t tstep = 2 * hstep;
    const unsigned ldsw = (unsigned)wid * 1024u;
    const int aoff = lds_byte(wr * 64 + fr, fq * 8), boff = lds_byte(wc * 32 + fr, fq * 8);
#define PG8_SA(b, h) (((b) * 2 + (h)) * HTB)
#define PG8_SB(b, h) ((4 + (b) * 2 + (h)) * HTB)
#define PG8_STAGE(bufoff, gbase, voff) do { _Pragma("unroll") for (int _i = 0; _i < 2; ++_i) \
        __builtin_amdgcn_global_load_lds((const unsigned*)((const char*)(gbase) + (voff)[_i]), (PG8_LAS unsigned*)(lds + (bufoff) + ldsw + _i * 8192), 16, 0, 0); } while (0)
#define PG8_LDA(dst, b, h) do { _Pragma("unroll") for (int m = 0; m < 4; ++m) _Pragma("unroll") for (int k = 0; k < 2; ++k) dst[m][k] = *(const PG8_LAS bf16x8*)(lds + PG8_SA(b, h) + aoff + m * 2048 + k * 1024); } while (0)
#define PG8_LDB(dst, b, h) do { _Pragma("unroll") for (int n = 0; n < 2; ++n) _Pragma("unroll") for (int k = 0; k < 2; ++k) dst[n][k] = *(const PG8_LAS bf16x8*)(lds + PG8_SB(b, h) + boff + n * 2048 + k * 1024); } while (0)
#define PG8_MMA(ai, bj, At, Bt) do { __builtin_amdgcn_s_setprio(1); _Pragma("unroll") for (int m = 0; m < 4; ++m) _Pragma("unroll") for (int n = 0; n < 2; ++n) _Pragma("unroll") for (int k = 0; k < 2; ++k) \
        acc[ai][bj][m][n] = __builtin_amdgcn_mfma_f32_16x16x32_bf16(Bt[n][k], At[m][k], acc[ai][bj][m][n], 0, 0, 0); __builtin_amdgcn_s_setprio(0); } while (0)
#define PG8_WAIT_V(n) asm volatile("s_waitcnt vmcnt(" #n ")" ::: "memory")
#define PG8_WAIT_L(n) asm volatile("s_waitcnt lgkmcnt(" #n ")" ::: "memory")
#define PG8_BAR __builtin_amdgcn_s_barrier()
#define PG8_SCHED __builtin_amdgcn_sched_barrier(0)
    Unit cur, nxt; int ui = 0;
    if (!S.next(0, cur)) return;
    f32x4 acc[2][2][4][2];
#pragma unroll
    for (int a = 0; a < 2; ++a)
#pragma unroll
        for (int b = 0; b < 2; ++b)
#pragma unroll
            for (int m = 0; m < 4; ++m)
#pragma unroll
                for (int n = 0; n < 2; ++n) acc[a][b][m][n] = (f32x4){0.f, 0.f, 0.f, 0.f};
    bf16x8 At[4][2], B0[2][2], B1[2][2];
    const char* cA = S.a_base(g, cur, tstep); const char* cB = S.b_base(g, cur, tstep);
    S.a_ready(cur);
    if constexpr (SP2) {
        PG8_STAGE(PG8_SB(0, 0), cB, voffB); PG8_STAGE(PG8_SB(0, 1), cB + hstep, voffB); PG8_STAGE(PG8_SA(0, 0), cA, voffA); PG8_STAGE(PG8_SA(0, 1), cA + hstep, voffA);
        if (wr == 1) PG8_BAR;
        PG8_WAIT_V(2); PG8_BAR;
        PG8_STAGE(PG8_SB(1, 0), cB + kstep, voffB); PG8_STAGE(PG8_SA(1, 0), cA + kstep, voffA); PG8_STAGE(PG8_SB(1, 1), cB + hstep + kstep, voffB);
        PG8_WAIT_V(6); PG8_BAR;
    } else {
        PG8_STAGE(PG8_SB(0, 0), cB, voffB); PG8_STAGE(PG8_SA(0, 0), cA, voffA); PG8_STAGE(PG8_SB(0, 1), cB + hstep, voffB); PG8_STAGE(PG8_SA(0, 1), cA + hstep, voffA);
        if (wr == 1) PG8_BAR;
        PG8_WAIT_V(4); PG8_BAR;
        PG8_STAGE(PG8_SB(1, 0), cB + kstep, voffB); PG8_STAGE(PG8_SA(1, 0), cA + kstep, voffA); PG8_STAGE(PG8_SB(1, 1), cB + hstep + kstep, voffB);
        PG8_WAIT_V(6); PG8_BAR;
    }
    for (;;) {
        const bool has_next = S.next(ui + 1, nxt);
        const char* nA = has_next ? S.a_base(g, nxt, tstep) : cA; const char* nB = has_next ? S.b_base(g, nxt, tstep) : cB;
        for (int t = 0; t < nt; t += 2) {
            const bool last = (t == nt - 2);
            const char* a1 = cA + (size_t)(t + 1) * kstep;
            const char* a2 = last ? nA : cA + (size_t)(t + 2) * kstep; const char* b2 = last ? nB : cB + (size_t)(t + 2) * kstep;
            const char* a3 = a2 + kstep; const char* b3 = b2 + kstep;
            if (last && has_next) S.a_ready(nxt);
            if constexpr (SP2) {
            PG8_LDB(B0, 0, 0); PG8_LDB(B1, 0, 1); PG8_SCHED; PG8_LDA(At, 0, 0); PG8_STAGE(PG8_SA(1, 1), a1 + hstep, voffA);
            PG8_WAIT_V(8); PG8_WAIT_L(0); PG8_BAR; PG8_MMA(0, 0, At, B0); PG8_MMA(0, 1, At, B1); PG8_BAR; PG8_SCHED;
            PG8_LDA(At, 0, 1); PG8_STAGE(PG8_SB(0, 0), b2, voffB); PG8_STAGE(PG8_SB(0, 1), b2 + hstep, voffB); PG8_STAGE(PG8_SA(0, 0), a2, voffA);
            PG8_WAIT_V(8); PG8_WAIT_L(0); PG8_BAR; PG8_MMA(1, 0, At, B0); PG8_MMA(1, 1, At, B1); PG8_BAR; PG8_SCHED;
            PG8_LDB(B0, 1, 0); PG8_LDB(B1, 1, 1); PG8_SCHED; PG8_LDA(At, 1, 0); PG8_STAGE(PG8_SA(0, 1), a2 + hstep, voffA);
            PG8_WAIT_V(8); PG8_WAIT_L(0); PG8_BAR; PG8_MMA(0, 0, At, B0); PG8_MMA(0, 1, At, B1); PG8_BAR; PG8_SCHED;
            PG8_LDA(At, 1, 1); PG8_STAGE(PG8_SB(1, 0), b3, voffB); PG8_STAGE(PG8_SB(1, 1), b3 + hstep, voffB); PG8_STAGE(PG8_SA(1, 0), a3, voffA);
            PG8_WAIT_V(8); PG8_WAIT_L(0); PG8_BAR; PG8_MMA(1, 0, At, B0); PG8_MMA(1, 1, At, B1); PG8_BAR; PG8_SCHED;
            } else {
            PG8_LDB(B0, 0, 0); PG8_SCHED; PG8_LDA(At, 0, 0); PG8_STAGE(PG8_SA(1, 1), a1 + hstep, voffA);
            PG8_WAIT_L(8); PG8_BAR; PG8_WAIT_L(0); PG8_MMA(0, 0, At, B0); PG8_BAR; PG8_SCHED;
            PG8_LDB(B1, 0, 1); PG8_STAGE(PG8_SB(0, 0), b2, voffB);
            PG8_BAR; PG8_WAIT_L(0); PG8_MMA(0, 1, At, B1); PG8_BAR;
            PG8_LDA(At, 0, 1); PG8_STAGE(PG8_SA(0, 0), a2, voffA);
            PG8_BAR; PG8_WAIT_L(0); PG8_MMA(1, 0, At, B0); PG8_BAR; PG8_SCHED;
            PG8_STAGE(PG8_SB(0, 1), b2 + hstep, voffB);
            PG8_WAIT_V(6); PG8_BAR; PG8_MMA(1, 1, At, B1); PG8_BAR;
            PG8_LDB(B0, 1, 0); PG8_SCHED; PG8_LDA(At, 1, 0); PG8_STAGE(PG8_SA(0, 1), a2 + hstep, voffA);
            PG8_WAIT_L(8); PG8_BAR; PG8_WAIT_L(0); PG8_MMA(0, 0, At, B0); PG8_BAR; PG8_SCHED;
            PG8_LDB(B1, 1, 1); PG8_STAGE(PG8_SB(1, 0), b3, voffB);
            PG8_BAR; PG8_WAIT_L(0); PG8_MMA(0, 1, At, B1); PG8_BAR;
            PG8_LDA(At, 1, 1); PG8_STAGE(PG8_SA(1, 0), a3, voffA);
            PG8_BAR; PG8_WAIT_L(0); PG8_MMA(1, 0, At, B0); PG8_BAR; PG8_SCHED;
            PG8_STAGE(PG8_SB(1, 1), b3 + hstep, voffB);
            PG8_WAIT_V(6); PG8_BAR; PG8_MMA(1, 1, At, B1); PG8_BAR;
            }
        }
        if constexpr (ALIGN_EPI) { if (wr == 0) PG8_BAR; }
        if constexpr (!Epi::AFTER_DRAIN) { E(acc, cur, wr, wc, fr, fq); S.done(cur); }
        if (!has_next) break;
#pragma unroll
        for (int a = 0; a < 2; ++a)
#pragma unroll
            for (int b = 0; b < 2; ++b)
#pragma unroll
                for (int m = 0; m < 4; ++m)
#pragma unroll
                    for (int n = 0; n < 2; ++n) acc[a][b][m][n] = (f32x4){0.f, 0.f, 0.f, 0.f};
        cur = nxt; cA = nA; cB = nB; ++ui;
        if constexpr (ALIGN_EPI) { if (wr == 1) PG8_BAR; }
    }
    PG8_WAIT_V(0);
    if constexpr (!ALIGN_EPI) { if (wr == 0) PG8_BAR; }
    PG8_BAR;
    if constexpr (Epi::AFTER_DRAIN) { E.fused(acc, cur, wr, wc, fr, fq, lds, wid, lane); S.done(cur); }
#undef PG8_SA
#undef PG8_SB
#undef PG8_STAGE
#undef PG8_LDA
#undef PG8_LDB
#undef PG8_MMA
#undef PG8_WAIT_V
#undef PG8_WAIT_L
#undef PG8_BAR
#undef PG8_SCHED
}
}

#define LDS_WAIT() asm volatile("s_waitcnt lgkmcnt(0)" ::: "memory")
#define VM_WAIT() asm volatile("s_waitcnt vmcnt(0)" ::: "memory")

__device__ __forceinline__ void transpose_item(const float* W, int ldw, int scol0, int ncol_valid, float scale, bf16* WT, int K, int drow0, int k0, LAS float* scr, int lane) {
    const int n = lane & 31; const bool ok = (scol0 + n) < ncol_valid;
#pragma unroll 8
    for (int i = 0; i < 32; ++i) { const int kk = 2 * i + (lane >> 5);
        float v = 0.f; if (ok) v = W[(size_t)(k0 + kk) * ldw + scol0 + n] * scale;
        scr[kk * 33 + n] = v; }
    LDS_WAIT(); asm volatile("" ::: "memory");
    const int c = lane & 7;
#pragma unroll
    for (int j = 0; j < 4; ++j) { const int nn = (lane >> 3) + 8 * j; const LAS float* s = scr + (8 * c) * 33 + nn;
        u32x4 o; o.x = pk2(s[0 * 33], s[1 * 33]); o.y = pk2(s[2 * 33], s[3 * 33]); o.z = pk2(s[4 * 33], s[5 * 33]); o.w = pk2(s[6 * 33], s[7 * 33]);
        *(u32x4*)(WT + (size_t)(drow0 + nn) * K + k0 + 8 * c) = o; }
    LDS_WAIT(); asm volatile("" ::: "memory");
}
struct PrepArgs { const float *w_in, *w_out, *wfg, *wfu, *wfd, *weg, *weu, *wed; unsigned char* ws; };
constexpr int PI_WIN = 2 * 16 * 120, PI_WOUT = 2 * 16 * 32, PI_FU = 16 * 176, PI_FD = 44 * 32, PI_EU = 8 * 16 * 224, PI_ED = 8 * 56 * 32;
constexpr int PREP_ITEMS = PI_WIN + PI_WOUT + PI_FU + PI_FD + PI_EU + PI_ED;
__device__ __forceinline__ void prep_item(const PrepArgs& a, int it, LAS float* scr, int lane) {
    int r = it;
    if (r < PI_WIN) { const int l = r / 1920; r %= 1920; const int kb = r / 120, nb = r % 120, n0 = nb * 32;
        float sc = 1.f; if ((n0 < 3072 && (n0 % 768) < 256) || (n0 >= COL_QI && n0 < COL_KI)) sc = 0.125f; else if (n0 == COL_WI) sc = 0.35355339059327373f;
        transpose_item(a.w_in + (size_t)l * DM * NIN, NIN, n0, NIN, sc, (bf16*)(a.ws + WS_WIN) + (size_t)l * PW * DM, DM, n0, kb * 64, scr, lane); return; }
    r -= PI_WIN;
    if (r < PI_WOUT) { const int l = r / 512; r %= 512; const int kb = r / 32, nb = r % 32;
        transpose_item(a.w_out + (size_t)l * DM * DM, DM, nb * 32, DM, 1.f, (bf16*)(a.ws + WS_WOUT) + (size_t)l * DM * DM, DM, nb * 32, kb * 64, scr, lane); return; }
    r -= PI_WOUT;
    if (r < PI_FU) { const int kb = r / 176, nb = r % 176, r0 = nb * 32, blk = r0 >> 8, w = r0 & 255;
        transpose_item(w < 128 ? a.wfg : a.wfu, DFF, blk * 128 + (w & 127), DFF, 1.f, (bf16*)(a.ws + WS_WFU), DM, r0, kb * 64, scr, lane); return; }
    r -= PI_FU;
    if (r < PI_FD) { const int kb = r / 32, nb = r % 32;
        transpose_item(a.wfd, DM, nb * 32, DM, 1.f, (bf16*)(a.ws + WS_WFD), DFF, nb * 32, kb * 64, scr, lane); return; }
    r -= PI_FD;
    if (r < PI_EU) { const int e = r / 3584; r %= 3584; const int kb = r / 224, nb = r % 224, r0 = nb * 32, blk = r0 >> 8, w = r0 & 255;
        transpose_item((w < 128 ? a.weg : a.weu) + (size_t)e * DM * DFE, DFE, blk * 128 + (w & 127), DFE, 1.f, (bf16*)(a.ws + WS_WEU) + (size_t)e * 7168 * DM, DM, r0, kb * 64, scr, lane); return; }
    r -= PI_EU;
    { const int e = r / 1792; r %= 1792; const int kb = r / 32, nb = r % 32;
        transpose_item(a.wed + (size_t)e * DFE * DM, DM, nb * 32, DM, 1.f, (bf16*)(a.ws + WS_WED) + (size_t)e * DM * DFE, DFE, nb * 32, kb * 64, scr, lane); }
}
__device__ __forceinline__ void ph_prep(const PrepArgs& a, LAS unsigned char* lds, int bid, int nblk) {
    const int lane = otid() & 63, wave = otid() >> 6;
    LAS float* scr = (LAS float*)lds + wave * 64 * 33;
    const int gw = bid * 8 + wave, ngw = nblk * 8;
    for (int it = gw; it < PREP_ITEMS; it += ngw) prep_item(a, it, scr, lane);
}
__device__ __forceinline__ void ph_mod(const float* c, const float* w_ada, const float* b_ada, float* mod, LAS unsigned char* lds, int bid, int nblk) {
    LAS float* sc = (LAS float*)lds; LAS float* part = (LAS float*)(lds + 32768);
    const int tid = otid();
    if (bid >= 192) return;
    for (int i = tid; i < 8 * 1024; i += 512) { const float v = c[i]; sc[i] = v / (1.0f + __expf(-v)); }
    __syncthreads();
    for (int item = bid; item < 192; item += nblk) {
        const int l = item / 96, j0 = (item % 96) * 64, jj = tid & 63, kq = tid >> 6;
        float acc[8];
#pragma unroll
        for (int b = 0; b < 8; ++b) acc[b] = 0.f;
        const float* w = w_ada + (size_t)l * DM * 6144 + j0 + jj;
        for (int k = kq * 128; k < kq * 128 + 128; ++k) { const float wv = w[(size_t)k * 6144];
#pragma unroll
            for (int b = 0; b < 8; ++b) acc[b] += sc[b * 1024 + k] * wv; }
#pragma unroll
        for (int b = 0; b < 8; ++b) part[(kq * 8 + b) * 64 + jj] = acc[b];
        __syncthreads();
        { const int b = tid >> 6, j = tid & 63; float sum = 0.f;
#pragma unroll
          for (int q = 0; q < 8; ++q) sum += part[(q * 8 + b) * 64 + j];
          mod[(size_t)l * 8 * 6144 + (size_t)b * 6144 + j0 + j] = sum + b_ada[l * 6144 + j0 + j]; }
        __syncthreads();
    }
}

struct MoeTiles { int p0, p1, p2, p3, p4, p5, p6, p7; };
__device__ __forceinline__ MoeTiles moe_tiles(const unsigned* ecnt) {
#define ECNT_LD(i) ((int)((__hip_atomic_load(ecnt + (i), __ATOMIC_RELAXED, __HIP_MEMORY_SCOPE_AGENT) + 255u) >> 8))
    MoeTiles m; m.p0 = ECNT_LD(0); m.p1 = ECNT_LD(1); m.p2 = ECNT_LD(2); m.p3 = ECNT_LD(3); m.p4 = ECNT_LD(4); m.p5 = ECNT_LD(5); m.p6 = ECNT_LD(6); m.p7 = ECNT_LD(7); return m;
#undef ECNT_LD
}
__device__ __forceinline__ int moe_tile_start(const MoeTiles& m, int e) {
    int s = 0; s += (e > 0) ? m.p0 : 0; s += (e > 1) ? m.p1 : 0; s += (e > 2) ? m.p2 : 0; s += (e > 3) ? m.p3 : 0; s += (e > 4) ? m.p4 : 0; s += (e > 5) ? m.p5 : 0; s += (e > 6) ? m.p6 : 0; return s;
}
struct NormArgs {
    const float* xin; const float* g; const float* shift; const float* scale;
    bf16* act;
    const float* w_router; int* tok; unsigned* ecnt;
    const bf16* ys; const float* gate; float* out;
};
template <int MODE> __device__ __forceinline__ void ph_norm(const NormArgs& a, LAS unsigned char* lds, int bid, int nblk) {
    LAS unsigned* lcnt = (LAS unsigned*)lds; LAS unsigned* lbase = lcnt + 8; typedef int info6[6]; LAS info6* linfo = (LAS info6*)(lds + 64);
    const int tid = otid(), lane = tid & 63, wave = tid >> 6;
    if (MODE == 1) { if (tid < 8) lcnt[tid] = 0u; __syncthreads(); }
    MoeTiles mt; if (MODE == 2) mt = moe_tiles(a.ecnt);
    for (int blk = bid; blk < T / 128; blk += nblk) {
        for (int i = 0; i < 16; ++i) {
            const int lr = wave + 8 * i, row = blk * 128 + lr, b = row / SEQ;
            const f32x4* xr = (const f32x4*)(a.xin + (size_t)row * DM) + lane;
            f32x4 v[4];
#pragma unroll
            for (int j = 0; j < 4; ++j) v[j] = xr[64 * j];
            if (MODE == 2) {
                const int* ti = a.tok + (size_t)row * 8; const int e0 = ti[0], e1 = ti[1], p0 = ti[2], p1 = ti[3]; const float g0 = __int_as_float(ti[4]), g1 = __int_as_float(ti[5]);
                const size_t s0 = (size_t)moe_tile_start(mt, e0) * 256 + p0, s1 = (size_t)moe_tile_start(mt, e1) * 256 + p1;
                const u32x2* y0 = (const u32x2*)(a.ys + s0 * DM) + lane; const u32x2* y1 = (const u32x2*)(a.ys + s1 * DM) + lane;
                const f32x4* gt = (const f32x4*)(a.gate + (size_t)b * 6144) + lane;
#pragma unroll
                for (int j = 0; j < 4; ++j) { const u32x2 a0 = y0[64 * j], a1 = y1[64 * j]; const f32x4 gv = gt[64 * j];
                    f32x4 y; y.x = g0 * bf2f(a0.x & 0xffffu) + g1 * bf2f(a1.x & 0xffffu); y.y = g0 * bf2f(a0.x >> 16) + g1 * bf2f(a1.x >> 16);
                    y.z = g0 * bf2f(a0.y & 0xffffu) + g1 * bf2f(a1.y & 0xffffu); y.w = g0 * bf2f(a0.y >> 16) + g1 * bf2f(a1.y >> 16);
                    v[j] = v[j] + gv * y; }
            }
            float ss = 0.f;
#pragma unroll
            for (int j = 0; j < 4; ++j) ss += (v[j].x * v[j].x + v[j].y * v[j].y) + (v[j].z * v[j].z + v[j].w * v[j].w);
            const float rstd = rsqrtf(wave_sum(ss) * (1.0f / DM) + EPS);
            const f32x4* gp = (const f32x4*)a.g + lane;
            if (MODE == 2) {
                f32x4* o = (f32x4*)(a.out + (size_t)row * DM) + lane;
#pragma unroll
                for (int j = 0; j < 4; ++j) o[64 * j] = v[j] * rstd * gp[64 * j];
            } else {
                const f32x4* sh = (const f32x4*)(a.shift + (size_t)b * 6144) + lane; const f32x4* sc = (const f32x4*)(a.scale + (size_t)b * 6144) + lane;
                u32x2* o = (u32x2*)(a.act + (size_t)row * DM) + lane;
#pragma unroll
                for (int j = 0; j < 4; ++j) { v[j] = v[j] * rstd * gp[64 * j] * (sc[64 * j] + 1.0f) + sh[64 * j];
                    u32x2 w; w.x = pk2(v[j].x, v[j].y); w.y = pk2(v[j].z, v[j].w); o[64 * j] = w; }
                if (MODE == 1) {
                    float lg[8];
#pragma unroll
                    for (int e = 0; e < 8; ++e) lg[e] = 0.f;
#pragma unroll
                    for (int j = 0; j < 4; ++j) { const float hv[4] = {v[j].x, v[j].y, v[j].z, v[j].w};
#pragma unroll
                        for (int q = 0; q < 4; ++q) { const f32x4* wr = (const f32x4*)(a.w_router + (size_t)(256 * j + 4 * lane + q) * 8); const f32x4 w0 = wr[0], w1 = wr[1];
                            lg[0] += hv[q] * w0.x; lg[1] += hv[q] * w0.y; lg[2] += hv[q] * w0.z; lg[3] += hv[q] * w0.w; lg[4] += hv[q] * w1.x; lg[5] += hv[q] * w1.y; lg[6] += hv[q] * w1.z; lg[7] += hv[q] * w1.w; } }
#pragma unroll
                    for (int e = 0; e < 8; ++e) lg[e] = wave_sum(lg[e]);
                    int e0 = 0; float v0 = lg[0];
#pragma unroll
                    for (int e = 1; e < 8; ++e) if (lg[e] > v0) { v0 = lg[e]; e0 = e; }
                    int e1 = -1; float v1 = -INFINITY;
#pragma unroll
                    for (int e = 0; e < 8; ++e) if (e != e0 && lg[e] > v1) { v1 = lg[e]; e1 = e; }
                    const float g0 = 1.0f / (1.0f + __expf(v1 - v0)), g1 = 1.0f - g0;
                    if (lane == 0) { const unsigned q0 = __hip_atomic_fetch_add(&lcnt[e0], 1u, __ATOMIC_RELAXED, __HIP_MEMORY_SCOPE_WORKGROUP), q1 = __hip_atomic_fetch_add(&lcnt[e1], 1u, __ATOMIC_RELAXED, __HIP_MEMORY_SCOPE_WORKGROUP);
                        linfo[lr][0] = e0; linfo[lr][1] = e1; linfo[lr][2] = (int)q0; linfo[lr][3] = (int)q1; linfo[lr][4] = __float_as_int(g0); linfo[lr][5] = __float_as_int(g1); }
                }
            }
        }
        if (MODE == 1) {
            __syncthreads();
            if (tid < 8) { lbase[tid] = atomicAdd(&a.ecnt[tid], lcnt[tid]); }
            __syncthreads();
            if (tid < 128) { int* ti = a.tok + (size_t)(blk * 128 + tid) * 8; const int e0 = linfo[tid][0], e1 = linfo[tid][1];
                ti[0] = e0; ti[1] = e1; ti[2] = linfo[tid][2] + (int)lbase[e0]; ti[3] = linfo[tid][3] + (int)lbase[e1]; ti[4] = linfo[tid][4]; ti[5] = linfo[tid][5]; ti[6] = 0; ti[7] = 0; }
            __syncthreads();
            if (tid < 8) lcnt[tid] = 0u;
            __syncthreads();
        }
    }
}
__device__ __forceinline__ void ph_gather(const bf16* act, const int* tok, const unsigned* ecnt, bf16* xs, int bid, int nblk) {
    const int lane = otid() & 63, gw = bid * 8 + (otid() >> 6), ngw = nblk * 8;
    const MoeTiles mt = moe_tiles(ecnt);
    for (int t = gw; t < T; t += ngw) {
        const int* ti = tok + (size_t)t * 8; const int e0 = ti[0], e1 = ti[1], p0 = ti[2], p1 = ti[3];
        const size_t s0 = (size_t)moe_tile_start(mt, e0) * 256 + p0, s1 = (size_t)moe_tile_start(mt, e1) * 256 + p1;
        const u32x4* src = (const u32x4*)(act + (size_t)t * DM) + lane; const u32x4 a0 = src[0], a1 = src[64];
        u32x4* d0 = (u32x4*)(xs + s0 * DM) + lane; u32x4* d1 = (u32x4*)(xs + s1 * DM) + lane;
        d0[0] = a0; d0[64] = a1; d1[0] = a0; d1[64] = a1;
    }
    for (int i = gw; i < 8 * 256; i += ngw) { const int e = i >> 8, r = i & 255; const int cnt = (int)__hip_atomic_load(ecnt + e, __ATOMIC_RELAXED, __HIP_MEMORY_SCOPE_AGENT); const int padded = ((cnt + 255) >> 8) << 8;
        if (cnt + r < padded) { u32x4* d = (u32x4*)(xs + ((size_t)moe_tile_start(mt, e) * 256 + cnt + r) * DM) + lane; const u32x4 z = {0u, 0u, 0u, 0u}; d[0] = z; d[64] = z; } }
}

__device__ __forceinline__ void ld16(const bf16* p, float (&f)[16]) { ld8(p, &f[0]); ld8(p + 8, &f[8]); }
__device__ __forceinline__ float dot16x4(const float (&q)[16], const bf16* p) {
    float f[16]; ld16(p, f); float s0 = 0.f, s1 = 0.f;
#pragma unroll
    for (int i = 0; i < 16; i += 2) { s0 += q[i] * f[i]; s1 += q[i + 1] * f[i + 1]; }
    float s = s0 + s1; s += __shfl_xor(s, 1); s += __shfl_xor(s, 2); return s;
}
__device__ __forceinline__ void axpy16(float (&o)[16], float w, const bf16* p) {
    float f[16]; ld16(p, f);
#pragma unroll
    for (int i = 0; i < 16; ++i) o[i] += w * f[i];
}
__device__ __forceinline__ void head_norm_store16(float (&o)[16], const float* gh, bf16* dst) {
    float ss = 0.f;
#pragma unroll
    for (int i = 0; i < 16; ++i) ss += o[i] * o[i];
    ss += __shfl_xor(ss, 1); ss += __shfl_xor(ss, 2);
    const float r = rsqrtf(ss * (1.0f / 64.0f) + EPS);
#pragma unroll
    for (int i = 0; i < 2; ++i) { u32x4 w; const float* q = &o[8 * i]; const float* g = gh + 8 * i;
        w.x = pk2(q[0] * r * g[0], q[1] * r * g[1]); w.y = pk2(q[2] * r * g[2], q[3] * r * g[3]); w.z = pk2(q[4] * r * g[4], q[5] * r * g[5]); w.w = pk2(q[6] * r * g[6], q[7] * r * g[7]);
        *(u32x4*)(dst + 8 * i) = w; }
}
#define OSM_STEP(s, vrow) do { if ((s) > m) { const float a_ = __expf(m - (s)); l *= a_; _Pragma("unroll") for (int d_ = 0; d_ < 16; ++d_) o[d_] *= a_; m = (s); } \
    const float p_ = __expf((s) - m); l += p_; axpy16(o, p_, (vrow)); } while (0)
#define NAIVE_IDX() const int part = gidx & 3, idx = gidx >> 2; const int t = idx & (SEQ - 1), h = (idx >> 12) & 3, b = idx >> 14; const int po = 16 * part

__device__ __forceinline__ void sb_naive_one(const bf16* P, const float* gh, bf16* act, int gidx) {
    NAIVE_IDX();
    const bf16* Pb = P + (size_t)b * SEQ * PW + po;
    float q[16], o[16];
    ld16(Pb + (size_t)t * PW + h * 64, q);
#pragma unroll
    for (int i = 0; i < 16; ++i) o[i] = 0.f;
    float carry = 1.0f;
    for (int s = t - 1; s >= 0; --s) {
        float z = dot16x4(q, Pb + (size_t)s * PW + 256 + h * 64); z = fminf(fmaxf(z, -80.f), 80.f);
        const float e = __expf(z), om = 1.0f / (1.0f + e), beta = e * om, aw = beta * carry;
        axpy16(o, aw, Pb + (size_t)s * PW + 512 + h * 64);
        carry *= om;
        if (carry < 1e-30f) break;
    }
    head_norm_store16(o, gh + h * 64 + po, act + (size_t)(b * SEQ + t) * DM + h * 64 + po);
}
__device__ __forceinline__ void dil_naive_one(const bf16* P, const float* gh, bf16* act, int gidx) {
    NAIVE_IDX();
    const bf16* Pb = P + (size_t)b * SEQ * PW + 1536 + po;
    const float slope = alibi_slope(1, h);
    float q[16], o[16];
    ld16(Pb + (size_t)t * PW + h * 64, q);
#pragma unroll
    for (int i = 0; i < 16; ++i) o[i] = 0.f;
    float m = -INFINITY, l = 0.f;
    for (int br = 0; br < 3; ++br) { const int dil = br == 0 ? 1 : (br == 1 ? 4 : 16);
        for (int j = 0; j <= 128; ++j) { const int dist = j * dil, kp = t - dist; if (kp < 0) break;
            const float s = dot16x4(q, Pb + (size_t)kp * PW + 256 + h * 64) - slope * (float)dist;
            OSM_STEP(s, Pb + (size_t)kp * PW + 512 + h * 64); } }
    const float rl = 1.0f / l;
#pragma unroll
    for (int i = 0; i < 16; ++i) o[i] *= rl;
    head_norm_store16(o, gh + (8 + h) * 64 + po, act + (size_t)(b * SEQ + t) * DM + (8 + h) * 64 + po);
}
__device__ __forceinline__ unsigned moba_sel_one(const float (&q)[16], const float* kmean, int b, int t, int h, int po) {
    const int own = t >> 8; unsigned sel = 0u;
    if (own <= 3) sel = (1u << own) - 1u;
    else {
        float g[16];
#pragma unroll
        for (int blk = 0; blk < 16; ++blk) { float s = -INFINITY;
            if (blk < own) { const float* km = kmean + ((size_t)b * 16 + blk) * 256 + h * 64 + po; s = 0.f;
#pragma unroll
                for (int d = 0; d < 16; ++d) s += q[d] * km[d];
                s += __shfl_xor(s, 1); s += __shfl_xor(s, 2); }
            g[blk] = s; }
#pragma unroll
        for (int r = 0; r < 3; ++r) { int bi = 0; float bv = -INFINITY;
#pragma unroll
            for (int blk = 0; blk < 16; ++blk) { const bool free_ = !((sel >> blk) & 1u); if (free_ && g[blk] > bv) { bv = g[blk]; bi = blk; } }
            sel |= 1u << bi; }
    }
    return sel;
}
template <int MODE> __device__ __forceinline__ void masked_naive_one(const bf16* P, const unsigned long long* mask, const float* kmean, const float* gh, bf16* act, int gidx) {
    NAIVE_IDX();
    const int cb = MODE == 0 ? 768 : 2304, hb = MODE == 0 ? 4 : 12;
    const bf16* Pb = P + (size_t)b * SEQ * PW + cb + po;
    const float slope = alibi_slope(MODE == 0 ? 0 : 2, h);
    float q[16], o[16];
    ld16(Pb + (size_t)t * PW + h * 64, q);
#pragma unroll
    for (int i = 0; i < 16; ++i) o[i] = 0.f;
    float m = -INFINITY, l = 0.f;
    if (MODE == 0) {
        const unsigned long long* mr = mask + (size_t)(b * SEQ + t) * 64;
        for (int w = 0; w <= (t >> 6); ++w) { unsigned long long bits = mr[w];
            while (bits) { const int j = __builtin_ctzll(bits); bits &= bits - 1; const int kp = w * 64 + j;
                const float s = dot16x4(q, Pb + (size_t)kp * PW + 256 + h * 64) - slope * (float)(t - kp);
                OSM_STEP(s, Pb + (size_t)kp * PW + 512 + h * 64); } }
    } else {
        const int own = t >> 8; const unsigned sel = moba_sel_one(q, kmean, b, t, h, po);
        for (int blk = 0; blk <= own; ++blk) { if (blk < own && !((sel >> blk) & 1u)) continue;
            const int kend = blk == own ? t : blk * 256 + 255;
            for (int kp = blk * 256; kp <= kend; ++kp) {
                const float s = dot16x4(q, Pb + (size_t)kp * PW + 256 + h * 64) - slope * (float)(t - kp);
                OSM_STEP(s, Pb + (size_t)kp * PW + 512 + h * 64); } }
    }
    const float rl = 1.0f / l;
#pragma unroll
    for (int i = 0; i < 16; ++i) o[i] *= rl;
    head_norm_store16(o, gh + (hb + h) * 64 + po, act + (size_t)(b * SEQ + t) * DM + (hb + h) * 64 + po);
}
__device__ __forceinline__ void kmean_unit(const bf16* P, float* kmean, int unit, LAS unsigned char* lds) {
    const int b = unit >> 4, blk = unit & 15, c = otid() & 255, hf = otid() >> 8;
    const bf16* p = P + ((size_t)b * SEQ + blk * 256 + hf * 128) * PW + 2304 + 256 + c;
    float s = 0.f;
    for (int r = 0; r < 128; ++r) s += bf2f(p[(size_t)r * PW]);
    LAS float* part = (LAS float*)lds;
    part[hf * 256 + c] = s;
    __syncthreads();
    if (hf == 0) kmean[(size_t)unit * 256 + c] = (part[c] + part[256 + c]) * (1.0f / 256.0f);
    __syncthreads();
}
constexpr int DSA_LDS = 8 * 4096 * 4;
__device__ __forceinline__ void dsa_select_unit(const bf16* P, unsigned long long* mask, int unit, LAS unsigned* sc) {
    const int tid = otid(), lane = tid & 63, wid = tid >> 6, r32 = lane & 31, hi = lane >> 5;
    const int b = unit >> 9, t0 = (unit & 511) * 8;
    const bf16* Pb = P + (size_t)b * SEQ * PW;
    const int hrow = (r32 & 3) + 4 * ((r32 >> 3) & 1), qrow = 2 * ((r32 >> 2) & 1) + ((r32 >> 4) & 1);
    bf16x8 af[2][4];
#pragma unroll
    for (int qg = 0; qg < 2; ++qg)
#pragma unroll
        for (int s = 0; s < 4; ++s) af[qg][s] = *(const bf16x8*)(Pb + (size_t)(t0 + 4 * qg + qrow) * PW + COL_QI + hrow * 64 + 16 * s + 8 * hi);
    float wv[2][2][8];
#pragma unroll
    for (int qg = 0; qg < 2; ++qg)
#pragma unroll
        for (int qq = 0; qq < 2; ++qq) ld8(Pb + (size_t)(t0 + 4 * qg + 2 * hi + qq) * PW + COL_WI, wv[qg][qq]);
    const int ntile = (t0 + 8 + 31) >> 5;
    for (int kt = wid; kt < ntile; kt += 8) {
        const int key = kt * 32 + r32;
        bf16x8 bfr[4];
#pragma unroll
        for (int s = 0; s < 4; ++s) bfr[s] = *(const bf16x8*)(Pb + (size_t)key * PW + COL_KI + 16 * s + 8 * hi);
#pragma unroll
        for (int qg = 0; qg < 2; ++qg) {
            f32x16 acc = {0.f, 0.f, 0.f, 0.f, 0.f, 0.f, 0.f, 0.f, 0.f, 0.f, 0.f, 0.f, 0.f, 0.f, 0.f, 0.f};
#pragma unroll
            for (int s = 0; s < 4; ++s) acc = __builtin_amdgcn_mfma_f32_32x32x16_bf16(af[qg][s], bfr[s], acc, 0, 0, 0);
#pragma unroll
            for (int qq = 0; qq < 2; ++qq) { float s = 0.f;
#pragma unroll
                for (int h = 0; h < 8; ++h) s += wv[qg][qq][h] * fmaxf(acc[8 * qq + h], 0.f);
                const int ql = 4 * qg + 2 * hi + qq;
                const unsigned u = __float_as_uint(s); const unsigned sk = (u & 0x80000000u) ? ~u : (u | 0x80000000u);
                sc[ql * 4096 + key] = (key <= t0 + ql) ? sk : 0u; }
        }
    }
    __syncthreads();
    {
        const int t = t0 + wid, nvalid = t + 1, nk = ntile * 32;
        unsigned long long myword = 0ull;
        if (nvalid <= 256) {
            const int lo = lane * 64; myword = (nvalid >= lo + 64) ? ~0ull : (nvalid > lo ? ((1ull << (nvalid - lo)) - 1ull) : 0ull);
        } else {
            unsigned K[64];
#pragma unroll
            for (int r = 0; r < 64; ++r) K[r] = (r * 64 + lane < nk) ? sc[wid * 4096 + r * 64 + lane] : 0u;
            unsigned prefix = 0u;
            for (int bit = 31; bit >= 0; --bit) { const unsigned trial = prefix | (1u << bit); int cnt = 0;
#pragma unroll
                for (int r = 0; r < 64; ++r) cnt += __builtin_popcountll(__ballot(K[r] >= trial));
                if (cnt >= 256) prefix = trial; }
            int cgt = 0;
#pragma unroll
            for (int r = 0; r < 64; ++r) cgt += __builtin_popcountll(__ballot(K[r] > prefix));
            int need = 256 - cgt;
            const unsigned long long below = (1ull << lane) - 1ull;
#pragma unroll
            for (int r = 0; r < 64; ++r) {
                const unsigned long long gt = __ballot(K[r] > prefix), eq = __ballot(K[r] == prefix);
                const int c = __builtin_popcountll(eq); unsigned long long take;
                if (c <= need) { take = eq; need -= c; }
                else { const bool mine = ((eq >> lane) & 1ull) && (__builtin_popcountll(eq & below) < need); take = __ballot(mine); need = 0; }
                const unsigned long long word = gt | take;
                if (lane == r) myword = word;
            }
        }
        mask[(size_t)(b * SEQ + t) * 64 + lane] = myword;
    }
    __syncthreads();
}

#define MFMA32(a, b, c) __builtin_amdgcn_mfma_f32_32x32x16_bf16(a, b, c, 0, 0, 0)
__device__ __forceinline__ int crow(int r, int hi) { return (r & 3) + 8 * (r >> 2) + 4 * hi; }
constexpr int AT_KROW = 144, AT_VROW = 136;
constexpr int AT_KBUF = 64 * AT_KROW, AT_VBUF = 64 * AT_VROW;
constexpr int AT_KOFF = 0, AT_VOFF = 2 * AT_KBUF, AT_KMOFF = AT_VOFF + 2 * AT_VBUF, AT_MISC = AT_KMOFF + 4096;
typedef short s16x4 __attribute__((ext_vector_type(4)));

__device__ __forceinline__ void at_load(const bf16* Pb, int k0, int kcol, int vcol, int tid, u32x4& kr, u32x4& vr) {
    const bf16* row = Pb + (size_t)(k0 + (tid >> 3)) * PW + (tid & 7) * 8;
    kr = *(const u32x4*)(row + kcol); vr = *(const u32x4*)(row + vcol);
}
__device__ __forceinline__ void at_store(LAS unsigned char* lds, int buf, int tid, const u32x4& kr, const u32x4& vr) {
    const int key = tid >> 3, c = tid & 7;
    *(LAS u32x4*)(lds + AT_KOFF + buf * AT_KBUF + key * AT_KROW + c * 16) = kr;
    LAS unsigned short* vt = (LAS unsigned short*)(lds + AT_VOFF + buf * AT_VBUF + (8 * c) * AT_VROW + key * 2);
    vt[0 * (AT_VROW / 2)] = (unsigned short)(vr.x & 0xffffu); vt[1 * (AT_VROW / 2)] = (unsigned short)(vr.x >> 16);
    vt[2 * (AT_VROW / 2)] = (unsigned short)(vr.y & 0xffffu); vt[3 * (AT_VROW / 2)] = (unsigned short)(vr.y >> 16);
    vt[4 * (AT_VROW / 2)] = (unsigned short)(vr.z & 0xffffu); vt[5 * (AT_VROW / 2)] = (unsigned short)(vr.z >> 16);
    vt[6 * (AT_VROW / 2)] = (unsigned short)(vr.w & 0xffffu); vt[7 * (AT_VROW / 2)] = (unsigned short)(vr.w >> 16);
}
__device__ __forceinline__ f32x16 at_scores(LAS unsigned char* lds, int buf, int a, int r32, int hi, const bf16x8 (&qf)[4]) {
    f32x16 s = {0.f, 0.f, 0.f, 0.f, 0.f, 0.f, 0.f, 0.f, 0.f, 0.f, 0.f, 0.f, 0.f, 0.f, 0.f, 0.f};
    const LAS unsigned char* kp = lds + AT_KOFF + buf * AT_KBUF + (32 * a + r32) * AT_KROW + hi * 16;
#pragma unroll
    for (int sp = 0; sp < 4; ++sp) { const bf16x8 kf = *(const LAS bf16x8*)(kp + sp * 32); s = MFMA32(kf, qf[sp], s); }
    return s;
}
__device__ __forceinline__ void at_pv(LAS unsigned char* lds, int buf, int a, int r32, int hi, const f32x16& p, f32x16 (&o)[2]) {
#pragma unroll
    for (int s = 0; s < 2; ++s) {
        u32x4 w; w.x = cvt_pk_bf16(p[8 * s + 0], p[8 * s + 1]); w.y = cvt_pk_bf16(p[8 * s + 2], p[8 * s + 3]); w.z = cvt_pk_bf16(p[8 * s + 4], p[8 * s + 5]); w.w = cvt_pk_bf16(p[8 * s + 6], p[8 * s + 7]);
        const bf16x8 pf = __builtin_bit_cast(bf16x8, w);
#pragma unroll
        for (int dh = 0; dh < 2; ++dh) {
            const LAS unsigned char* vp = lds + AT_VOFF + buf * AT_VBUF + (32 * dh + r32) * AT_VROW + (32 * a + 16 * s + 4 * hi) * 2;
            const s16x4 v0 = *(const LAS s16x4*)vp, v1 = *(const LAS s16x4*)(vp + 16);
            const bf16x8 vf = {v0[0], v0[1], v0[2], v0[3], v1[0], v1[1], v1[2], v1[3]};
            o[dh] = MFMA32(vf, pf, o[dh]);
        }
    }
}
__device__ __forceinline__ void at_finish(f32x16 (&o)[2], float inv_l, int hi, const float* gh, bf16* dst) {
    float ss = 0.f;
#pragma unroll
    for (int dh = 0; dh < 2; ++dh)
#pragma unroll
        for (int r = 0; r < 16; ++r) { o[dh][r] *= inv_l; ss += o[dh][r] * o[dh][r]; }
    ss += __shfl_xor(ss, 32);
    const float rn = rsqrtf(ss * (1.0f / 64.0f) + EPS);
#pragma unroll
    for (int dh = 0; dh < 2; ++dh)
#pragma unroll
        for (int g = 0; g < 4; ++g) { const int d = 32 * dh + 8 * g + 4 * hi; const f32x4 gv = *(const f32x4*)(gh + d);
            u32x2 w; w.x = cvt_pk_bf16(o[dh][4 * g + 0] * rn * gv.x, o[dh][4 * g + 1] * rn * gv.y); w.y = cvt_pk_bf16(o[dh][4 * g + 2] * rn * gv.z, o[dh][4 * g + 3] * rn * gv.w);
            *(u32x2*)(dst + d) = w; }
}

template <int MODE> __device__ __forceinline__ void attn_masked_unit(const bf16* P, const unsigned long long* mask, const float* kmean, const float* gh16, bf16* act, int b, int h, int qb, LAS unsigned char* lds) {
    const int tid = otid(), lane = tid & 63, wid = tid >> 6, r32 = lane & 31, hi = lane >> 5;
    const int cb = MODE == 0 ? 768 : 2304, hb = MODE == 0 ? 4 : 12;
    const bf16* Pb = P + (size_t)b * SEQ * PW + cb;
    const int kcol = 256 + h * 64, vcol = 512 + h * 64;
    const int q0 = qb * 256, tq = q0 + 32 * wid + r32;
    const float slope = alibi_slope(MODE == 0 ? 0 : 2, h);
    bf16x8 qf[4];
#pragma unroll
    for (int sp = 0; sp < 4; ++sp) qf[sp] = *(const bf16x8*)(Pb + (size_t)tq * PW + h * 64 + 16 * sp + 8 * hi);
    unsigned sel = 0u, wgsel = 0xffffu;
    if (MODE == 1) {
        LAS float* km = (LAS float*)(lds + AT_KMOFF); LAS unsigned* misc = (LAS unsigned*)(lds + AT_MISC);
        for (int i = tid; i < 16 * 64; i += 512) km[i] = kmean[((size_t)b * 16 + (i >> 6)) * 256 + h * 64 + (i & 63)];
        if (tid == 0) misc[0] = 0u;
        __syncthreads();
        if (qb <= 3) sel = (1u << qb) - 1u;
        else {
            u32x4 qraw[8];
#pragma unroll
            for (int c = 0; c < 8; ++c) qraw[c] = *(const u32x4*)(Pb + (size_t)tq * PW + h * 64 + 8 * c);
            float v1 = -INFINITY, v2 = -INFINITY, v3 = -INFINITY; int i1 = 0, i2 = 0, i3 = 0;
            for (int blk = 0; blk < qb; ++blk) {
                const LAS float* kb = km + blk * 64; float g0 = 0.f, g1 = 0.f;
#pragma unroll
                for (int c = 0; c < 8; ++c) { const u32x4 u = qraw[c];
                    g0 += __uint_as_float(u.x << 16) * kb[8 * c + 0]; g1 += __uint_as_float(u.x & 0xffff0000u) * kb[8 * c + 1];
                    g0 += __uint_as_float(u.y << 16) * kb[8 * c + 2]; g1 += __uint_as_float(u.y & 0xffff0000u) * kb[8 * c + 3];
                    g0 += __uint_as_float(u.z << 16) * kb[8 * c + 4]; g1 += __uint_as_float(u.z & 0xffff0000u) * kb[8 * c + 5];
                    g0 += __uint_as_float(u.w << 16) * kb[8 * c + 6]; g1 += __uint_as_float(u.w & 0xffff0000u) * kb[8 * c + 7]; }
                const float g = g0 + g1;
                if (g > v1) { v3 = v2; i3 = i2; v2 = v1; i2 = i1; v1 = g; i1 = blk; }
                else if (g > v2) { v3 = v2; i3 = i2; v2 = g; i2 = blk; }
                else if (g > v3) { v3 = g; i3 = blk; }
            }
            sel = (1u << i1) | (1u << i2) | (1u << i3);
        }
        unsigned ws_ = sel;
#pragma unroll
        for (int o_ = 1; o_ < 64; o_ <<= 1) ws_ |= (unsigned)__shfl_xor((int)ws_, o_);
        if (lane == 0) __hip_atomic_fetch_or(&misc[0], ws_, __ATOMIC_RELAXED, __HIP_MEMORY_SCOPE_WORKGROUP);
        __syncthreads();
        wgsel = misc[0] | (1u << qb);
    }
    const int ntile = 4 * (qb + 1);
    f32x16 o[2];
#pragma unroll
    for (int r = 0; r < 16; ++r) { o[0][r] = 0.f; o[1][r] = 0.f; }
    float m = -INFINITY, l = 0.f;
    const unsigned long long* mrow = mask + (size_t)(b * SEQ + tq) * 64;
    int t = 0;
    if (MODE == 1) { while (t < ntile && !((wgsel >> (t >> 2)) & 1u)) t += 4; }
    u32x4 kr, vr;
    at_load(Pb, t * 64, kcol, vcol, tid, kr, vr);
    unsigned long long mw = (MODE == 0) ? mrow[t] : 0ull;
    at_store(lds, 0, tid, kr, vr);
    __syncthreads();
    int buf = 0;
    while (t < ntile) {
        int tn = t + 1;
        if (MODE == 1) { while (tn < ntile && !((wgsel >> (tn >> 2)) & 1u)) tn += 4; }
        unsigned long long mwn = 0ull;
        if (tn < ntile) { at_load(Pb, tn * 64, kcol, vcol, tid, kr, vr); if (MODE == 0) mwn = mrow[tn]; }
        const int k0 = t * 64;
        const bool wave_has = (k0 <= q0 + 32 * wid + 31) && (MODE == 0 || t >= 4 * qb || __any((sel >> (t >> 2)) & 1u));
        if (wave_has) {
            f32x16 s0 = at_scores(lds, buf, 0, r32, hi, qf), s1 = at_scores(lds, buf, 1, r32, hi, qf);
            const bool blk_ok = (MODE == 0) || (t >= 4 * qb) || ((sel >> (t >> 2)) & 1u);
            const float base = slope * (float)(k0 + 4 * hi - tq);
            float mx = -INFINITY;
#pragma unroll
            for (int r = 0; r < 16; ++r) { const int kk = (r & 3) + 8 * (r >> 2);
                const int kp0 = k0 + kk + 4 * hi, kp1 = kp0 + 32;
                bool v0 = blk_ok && (kp0 <= tq), v1 = blk_ok && (kp1 <= tq);
                if (MODE == 0) { v0 = v0 && ((mw >> (kk + 4 * hi)) & 1ull); v1 = v1 && ((mw >> (32 + kk + 4 * hi)) & 1ull); }
                s0[r] = v0 ? s0[r] + base + slope * (float)kk : -INFINITY;
                s1[r] = v1 ? s1[r] + base + slope * (float)(kk + 32) : -INFINITY;
                mx = fmaxf(mx, fmaxf(s0[r], s1[r])); }
            mx = fmaxf(mx, __shfl_xor(mx, 32));
            const float mn = fmaxf(m, mx), mu = (mn == -INFINITY) ? 0.f : mn;
            const float alpha = __expf(m - mu);
            float ps = 0.f;
#pragma unroll
            for (int r = 0; r < 16; ++r) { s0[r] = __expf(s0[r] - mu); s1[r] = __expf(s1[r] - mu); ps += s0[r] + s1[r]; }
            l = l * alpha + ps; m = mn;
            if (__any(alpha != 1.0f)) {
#pragma unroll
                for (int r = 0; r < 16; ++r) { o[0][r] *= alpha; o[1][r] *= alpha; } }
            at_pv(lds, buf, 0, r32, hi, s0, o);
            at_pv(lds, buf, 1, r32, hi, s1, o);
        }
        if (tn < ntile) at_store(lds, buf ^ 1, tid, kr, vr);
        __syncthreads();
        buf ^= 1; t = tn; mw = mwn;
    }
    l += __shfl_xor(l, 32);
    at_finish(o, 1.0f / l, hi, gh16 + (hb + h) * 64, act + (size_t)(b * SEQ + tq) * DM + (hb + h) * 64);
    __syncthreads();
}

template <int DUMMY> __device__ __forceinline__ void attn_sb_unit(const bf16* P, const float* gh16, bf16* act, int b, int h, int qb, LAS unsigned char* lds) {
    const int tid = otid(), lane = tid & 63, wid = tid >> 6, r32 = lane & 31, hi = lane >> 5;
    const bf16* Pb = P + (size_t)b * SEQ * PW;
    const int kcol = 256 + h * 64, vcol = 512 + h * 64;
    const int q0 = qb * 256, tq = q0 + 32 * wid + r32, qmax = q0 + 32 * wid + 31;
    bf16x8 qf[4];
#pragma unroll
    for (int sp = 0; sp < 4; ++sp) qf[sp] = *(const bf16x8*)(Pb + (size_t)tq * PW + h * 64 + 16 * sp + 8 * hi);
    LAS unsigned* vote = (LAS unsigned*)(lds + AT_MISC);
    if (tid < 3) vote[tid] = 0u;
    f32x16 o[2];
#pragma unroll
    for (int r = 0; r < 16; ++r) { o[0][r] = 0.f; o[1][r] = 0.f; }
    float carry = 1.0f; bool done = false;
    int t = 4 * qb + 3;
    u32x4 kr, vr;
    at_load(Pb, t * 64, kcol, vcol, tid, kr, vr);
    at_store(lds, 0, tid, kr, vr);
    __syncthreads();
    int buf = 0, it = 0;
    while (t >= 0) {
        const int tn = t - 1;
        if (tn >= 0) at_load(Pb, tn * 64, kcol, vcol, tid, kr, vr);
        const int k0 = t * 64;
        if (!done && k0 < qmax) {
#pragma unroll
            for (int ai = 0; ai < 2; ++ai) { const int a = 1 - ai, ks = k0 + 32 * a;
                if (ks < qmax) {
                    f32x16 s = at_scores(lds, buf, a, r32, hi, qf);
                    float G[4];
#pragma unroll
                    for (int g = 0; g < 4; ++g) { float gp = 1.0f;
#pragma unroll
                        for (int i = 0; i < 4; ++i) { const int r = 4 * g + i; const int kp = ks + 8 * g + 4 * hi + i; const bool valid = kp < tq;
                            const float z = fminf(fmaxf(s[r], -80.f), 80.f); const float e = __expf(z); float om = __builtin_amdgcn_rcpf(1.0f + e); float beta = e * om;
                            om = valid ? om : 1.0f; beta = valid ? beta : 0.0f;
                            s[r] = beta; gp *= om; }
                        G[g] = gp; }
                    float Gp[4];
#pragma unroll
                    for (int g = 0; g < 4; ++g) Gp[g] = __shfl_xor(G[g], 32);
                    float SP[4]; SP[3] = 1.0f;
#pragma unroll
                    for (int g = 2; g >= 0; --g) SP[g] = SP[g + 1] * (G[g + 1] * Gp[g + 1]);
                    const float tot = SP[0] * (G[0] * Gp[0]);
#pragma unroll
                    for (int g = 0; g < 4; ++g) { float suf = carry * SP[g] * (hi ? 1.0f : Gp[g]);
#pragma unroll
                        for (int i = 3; i >= 0; --i) { const int r = 4 * g + i; const float beta = s[r]; s[r] = beta * suf; suf *= (1.0f - beta); } }
                    carry *= tot;
                    at_pv(lds, buf, a, r32, hi, s, o);
                }
            }
            done = __all(carry < 1e-30f);
        }
        if (lane == 0 && (done || k0 == 0)) __hip_atomic_fetch_add(&vote[it % 3], 1u, __ATOMIC_RELAXED, __HIP_MEMORY_SCOPE_WORKGROUP);
        if (tid == 0) vote[(it + 1) % 3] = 0u;
        if (tn >= 0) at_store(lds, buf ^ 1, tid, kr, vr);
        __syncthreads();
        const unsigned nd = vote[it % 3];
        buf ^= 1; t = tn; ++it;
        if (nd == 8u) break;
    }
    at_finish(o, 1.0f, hi, gh16 + h * 64, act + (size_t)(b * SEQ + tq) * DM + h * 64);
    __syncthreads();
}

constexpr int DL_VROW = 72, DL_VT = 0, DL_VTW = 64 * DL_VROW, DL_CB = 8 * DL_VTW, DL_CBROW = 65, DL_ML = DL_CB + 256 * DL_CBROW * 4;
template <int BR> __device__ __forceinline__ int dl_kpos(int rho, int j, int q0, int wid) {
    if (BR == 0) return q0 + 32 * wid - 128 + 32 * j + rho;
    if (BR == 1) return q0 + (wid & 3) + 4 * (32 * (wid >> 2) - 128 + 32 * j + rho);
    return q0 + 2 * wid + (rho >> 4) + 16 * (-128 + 16 * j + (rho & 15));
}
template <int BR> __device__ __forceinline__ void dilated_branch(const bf16* Pb, int h, int q0, float slope, LAS unsigned char* lds, int wid, int r32, int hi, const float* ghh, bf16* actb) {
    constexpr int R = BR == 0 ? 1 : (BR == 1 ? 4 : 16), W = 128 * R, NSUB = BR == 2 ? 9 : 5;
    const int qpos = BR == 0 ? q0 + 32 * wid + r32 : (BR == 1 ? q0 + (wid & 3) + 4 * (32 * (wid >> 2) + r32) : q0 + 2 * wid + (r32 >> 4) + 16 * (r32 & 15));
    bf16x8 qf[4];
#pragma unroll
    for (int sp = 0; sp < 4; ++sp) qf[sp] = *(const bf16x8*)(Pb + (size_t)qpos * PW + h * 64 + 16 * sp + 8 * hi);
    LAS unsigned char* vt = lds + DL_VT + wid * DL_VTW;
    f32x16 o[2];
#pragma unroll
    for (int r = 0; r < 16; ++r) { o[0][r] = 0.f; o[1][r] = 0.f; }
    float m = -INFINITY, l = 0.f;
    for (int j = 0; j < NSUB; ++j) {
        const int kp_row = dl_kpos<BR>(r32, j, q0, wid), kc = kp_row < 0 ? 0 : kp_row;
        const bf16* krow = Pb + (size_t)kc * PW;
        bf16x8 kf[4]; u32x4 vv[4];
#pragma unroll
        for (int sp = 0; sp < 4; ++sp) kf[sp] = *(const bf16x8*)(krow + 256 + h * 64 + 16 * sp + 8 * hi);
#pragma unroll
        for (int i = 0; i < 4; ++i) vv[i] = *(const u32x4*)(krow + 512 + h * 64 + 32 * hi + 8 * i);
        f32x16 s = {0.f, 0.f, 0.f, 0.f, 0.f, 0.f, 0.f, 0.f, 0.f, 0.f, 0.f, 0.f, 0.f, 0.f, 0.f, 0.f};
#pragma unroll
        for (int sp = 0; sp < 4; ++sp) s = MFMA32(kf[sp], qf[sp], s);
#pragma unroll
        for (int i = 0; i < 4; ++i) { LAS unsigned short* w = (LAS unsigned short*)(vt + (32 * hi + 8 * i) * DL_VROW + r32 * 2);
            w[0 * (DL_VROW / 2)] = (unsigned short)(vv[i].x & 0xffffu); w[1 * (DL_VROW / 2)] = (unsigned short)(vv[i].x >> 16);
            w[2 * (DL_VROW / 2)] = (unsigned short)(vv[i].y & 0xffffu); w[3 * (DL_VROW / 2)] = (unsigned short)(vv[i].y >> 16);
            w[4 * (DL_VROW / 2)] = (unsigned short)(vv[i].z & 0xffffu); w[5 * (DL_VROW / 2)] = (unsigned short)(vv[i].z >> 16);
            w[6 * (DL_VROW / 2)] = (unsigned short)(vv[i].w & 0xffffu); w[7 * (DL_VROW / 2)] = (unsigned short)(vv[i].w >> 16); }
        float mx = -INFINITY;
#pragma unroll
        for (int r = 0; r < 16; ++r) { const int kp = dl_kpos<BR>(crow(r, hi), j, q0, wid); const int d = qpos - kp;
            const bool valid = (kp >= 0) && (d >= 0) && (d <= W) && ((d & (R - 1)) == 0);
            s[r] = valid ? s[r] - slope * (float)d : -INFINITY; mx = fmaxf(mx, s[r]); }
        mx = fmaxf(mx, __shfl_xor(mx, 32));
        const float mn = fmaxf(m, mx), mu = (mn == -INFINITY) ? 0.f : mn;
        const float alpha = __expf(m - mu);
        float ps = 0.f;
#pragma unroll
        for (int r = 0; r < 16; ++r) { s[r] = __expf(s[r] - mu); ps += s[r]; }
        l = l * alpha + ps; m = mn;
#pragma unroll
        for (int r = 0; r < 16; ++r) { o[0][r] *= alpha; o[1][r] *= alpha; }
        asm volatile("s_waitcnt lgkmcnt(0)" ::: "memory");
#pragma unroll
        for (int sk = 0; sk < 2; ++sk) {
            u32x4 w; w.x = cvt_pk_bf16(s[8 * sk + 0], s[8 * sk + 1]); w.y = cvt_pk_bf16(s[8 * sk + 2], s[8 * sk + 3]); w.z = cvt_pk_bf16(s[8 * sk + 4], s[8 * sk + 5]); w.w = cvt_pk_bf16(s[8 * sk + 6], s[8 * sk + 7]);
            const bf16x8 pf = __builtin_bit_cast(bf16x8, w);
#pragma unroll
            for (int dh = 0; dh < 2; ++dh) { const LAS unsigned char* vp = vt + (32 * dh + r32) * DL_VROW + (16 * sk + 4 * hi) * 2;
                const s16x4 v0 = *(const LAS s16x4*)vp, v1 = *(const LAS s16x4*)(vp + 16);
                const bf16x8 vf = {v0[0], v0[1], v0[2], v0[3], v1[0], v1[1], v1[2], v1[3]};
                o[dh] = MFMA32(vf, pf, o[dh]); } }
        asm volatile("s_waitcnt lgkmcnt(0)" ::: "memory");
    }
    l += __shfl_xor(l, 32);
    const int qi = qpos - q0;
    LAS float* cb = (LAS float*)(lds + DL_CB) + qi * DL_CBROW; LAS float* ml = (LAS float*)(lds + DL_ML);
    if (BR > 0) {
        const float M0 = ml[qi], L0 = ml[256 + qi];
        const float mn = fmaxf(M0, m), a0 = __expf(M0 - mn), a1 = __expf(m - mn);
#pragma unroll
        for (int dh = 0; dh < 2; ++dh)
#pragma unroll
            for (int r = 0; r < 16; ++r) o[dh][r] = o[dh][r] * a1 + cb[32 * dh + crow(r, hi)] * a0;
        l = l * a1 + L0 * a0; m = mn;
    }
    if (BR < 2) {
        __syncthreads();
#pragma unroll
        for (int dh = 0; dh < 2; ++dh)
#pragma unroll
            for (int r = 0; r < 16; ++r) cb[32 * dh + crow(r, hi)] = o[dh][r];
        if (hi == 0) { ml[qi] = m; ml[256 + qi] = l; }
        __syncthreads();
    } else {
        at_finish(o, 1.0f / l, hi, ghh, actb + (size_t)qpos * DM);
    }
}
__device__ __forceinline__ void attn_dilated_unit(const bf16* P, const float* gh16, bf16* act, int b, int h, int qb, LAS unsigned char* lds) {
    const int tid = otid(), lane = tid & 63, wid = tid >> 6, r32 = lane & 31, hi = lane >> 5;
    const bf16* Pb = P + (size_t)b * SEQ * PW + 1536;
    const float slope = alibi_slope(1, h);
    const float* ghh = gh16 + (8 + h) * 64; bf16* actb = act + (size_t)b * SEQ * DM + (8 + h) * 64;
    dilated_branch<0>(Pb, h, qb * 256, slope, lds, wid, r32, hi, ghh, actb);
    dilated_branch<1>(Pb, h, qb * 256, slope, lds, wid, r32, hi, ghh, actb);
    dilated_branch<2>(Pb, h, qb * 256, slope, lds, wid, r32, hi, ghh, actb);
    __syncthreads();
}

#ifndef MK_SPLIT
#define MK_SPLIT 0
#endif
constexpr int MISC_OFF = 131072, LDS_BYTES = 131072 + 1024;
constexpr int N_PHASES = 27;
struct MegaArgs { const float* in[17]; float* out; unsigned char* ws; int ph_lo, ph_hi; };

__global__ void __launch_bounds__(512, 2) mega_fwd(MegaArgs a) {
    extern __shared__ __attribute__((aligned(16))) unsigned char lds_raw[];
    LAS unsigned char* lds = (LAS unsigned char*)lds_raw;
    volatile LAS unsigned* MISC = (volatile LAS unsigned*)(lds + MISC_OFF);
    const int tid = threadIdx.x, bid = blockIdx.x, nblk = gridDim.x;
    for (int u = tid; u < (LDS_BYTES - MISC_OFF) / 4; u += 512) MISC[u] = 0u;
    __syncthreads();
    if (tid < 17) { const unsigned long long p = (unsigned long long)a.in[tid]; MISC[64 + 2 * tid] = (unsigned)p; MISC[65 + 2 * tid] = (unsigned)(p >> 32); }
    __syncthreads();
#define INP(i) ((const float*)(((unsigned long long)(unsigned)__builtin_amdgcn_readfirstlane((int)MISC[65 + 2 * (i)]) << 32) | (unsigned long long)(unsigned)__builtin_amdgcn_readfirstlane((int)MISC[64 + 2 * (i)])))
    unsigned char* ws = a.ws;
    unsigned* ctl = (unsigned*)(ws + WS_CTL);
    XcdBarrier bar; bar.bar = ctl + CW_BAR; bar.x = 0; bar.st = nullptr;
    if (!MK_SPLIT) bar = xcd_barrier_post(ctl + CW_BAR, MISC + 8);
    const int lo = a.ph_lo, hi = a.ph_hi;
#define RUN(k) (lo <= (k) && (k) < hi)
#define SEAM(k) do { if (RUN(k) && RUN((k) + 1)) { if (!MK_SPLIT) xcd_barrier(bar); } } while (0)
    float* out = a.out;
    float* mod = (float*)(ws + WS_MOD); float* kmean = (float*)(ws + WS_KMEAN); const float* gv = (const float*)(ws + WS_GV);
    int* tok = (int*)(ws + WS_TOK); bf16* act = (bf16*)(ws + WS_ACT); bf16* P = (bf16*)(ws + WS_P); bf16* hid = (bf16*)(ws + WS_HID); bf16* xs = (bf16*)(ws + WS_XS);
    unsigned long long* mask = (unsigned long long*)(ws + WS_MASK); unsigned* ecnt = ctl + CW_ECNT;

    if (RUN(0)) {
        PrepArgs pa{INP(5), INP(7), INP(9), INP(10), INP(11), INP(13), INP(14), INP(15), ws};
        ph_prep(pa, lds, bid, nblk);
        __syncthreads();
        ph_mod(INP(1), INP(2), INP(3), mod, lds, bid, nblk);
        { float* gvw = (float*)(ws + WS_GV); const float* s4 = INP(4); const float* s6 = INP(6); const float* s8 = INP(8); const float* s16 = INP(16);
          for (int i = bid * 512 + otid(); i < 7168; i += nblk * 512) gvw[i] = i < 2048 ? s4[i] : (i < 4096 ? s6[i - 2048] : (i < 6144 ? s8[i - 4096] : s16[i - 6144])); }
    }
    SEAM(0);
    for (int l = 0; l < NLAYER; ++l) {
        const int pb = 1 + 8 * l;
        const float* ml = mod + (size_t)l * 8 * 6144; const float* xin = (l == 0) ? INP(0) : out; const float* gh = gv + 2048 + l * 1024;
        if (RUN(pb)) { NormArgs na{}; na.xin = xin; na.g = gv + l * DM; na.shift = ml; na.scale = ml + 1024; na.act = act; ph_norm<0>(na, lds, bid, nblk); }
        SEAM(pb);
        if (RUN(pb + 1)) { pg8::Gemm g{act, (const bf16*)(ws + WS_WIN) + (size_t)l * PW * DM, T, PW, DM}; pg8::StaticOrder S; S.init(T, PW, nblk, bid);
            pg8::EpiBf16 E{P, PW, 0}; pg8::gemm_phase<pg8::EpiBf16, pg8::StaticOrder, true, true>(lds, g, S, E); }
        SEAM(pb + 1);
        if (RUN(pb + 2)) {
            for (int u = bid, r = 0; u < NB * 512; u += nblk, ++r) { const int unit = (r & 1) ? (r * nblk + nblk - 1 - bid) : u; if (unit < NB * 512) dsa_select_unit(P, mask, unit, (LAS unsigned*)lds); }
            for (int unit = bid; unit < NB * 16; unit += nblk) kmean_unit(P, kmean, unit, lds);
#ifndef NO_SB
            for (int u = bid; u < 512; u += nblk) attn_sb_unit<0>(P, gh, act, u & 7, (u >> 3) & 3, u >> 5, lds);
#endif
#ifndef NO_DIL
            for (int u = bid; u < 512; u += nblk) attn_dilated_unit(P, gh, act, u & 7, (u >> 3) & 3, u >> 5, lds);
#endif
        }
        SEAM(pb + 2);
        if (RUN(pb + 3)) {
#ifndef NO_MASKED
            for (int u = bid; u < 512; u += nblk) { const int rnd = u >> 8, w = u & 255, k = w >> 5, rest = w & 31; const int qb = rnd == 0 ? 15 - k : k;
                attn_masked_unit<0>(P, mask, kmean, gh, act, rest >> 2, rest & 3, qb, lds); }
#ifndef NO_MOBA
            for (int u = bid; u < 512; u += nblk) { const int rnd = u >> 8, w = u & 255, k = w >> 5, rest = w & 31; const int qb = rnd == 0 ? 15 - k : k;
                attn_masked_unit<1>(P, mask, kmean, gh, act, rest >> 2, rest & 3, qb, lds); }
#endif
#endif
        }
        SEAM(pb + 3);
        if (RUN(pb + 4)) { pg8::Gemm g{act, (const bf16*)(ws + WS_WOUT) + (size_t)l * DM * DM, T, DM, DM}; pg8::StaticOrder S; S.init(T, DM, nblk, bid);
            pg8::EpiRes E{xin, out, ml + 2048}; pg8::gemm_phase<pg8::EpiRes, pg8::StaticOrder, true, true>(lds, g, S, E); }
        SEAM(pb + 4);
        if (l == 0) {
            if (RUN(6)) { NormArgs na{}; na.xin = out; na.g = gv + 4096; na.shift = ml + 3072; na.scale = ml + 4096; na.act = act; ph_norm<0>(na, lds, bid, nblk); }
            SEAM(6);
#ifndef NO_FF
            if (RUN(7)) { pg8::Gemm g{act, (const bf16*)(ws + WS_WFU), T, 2 * DFF, DM}; pg8::StaticOrder S; S.init(T, 2 * DFF, nblk, bid);
                pg8::EpiSwiGLU E{hid, DFF, 0}; pg8::gemm_phase<pg8::EpiSwiGLU, pg8::StaticOrder, true, true>(lds, g, S, E); }
            SEAM(7);
            if (RUN(8)) { pg8::Gemm g{hid, (const bf16*)(ws + WS_WFD), T, DM, DFF}; pg8::StaticOrder S; S.init(T, DM, nblk, bid);
                pg8::EpiRes E{out, out, ml + 5120}; pg8::gemm_phase<pg8::EpiRes, pg8::StaticOrder, true, true>(lds, g, S, E); }
            SEAM(8);
#endif
        } else {
            if (RUN(14)) { NormArgs na{}; na.xin = out; na.g = gv + 4096 + DM; na.shift = ml + 3072; na.scale = ml + 4096; na.act = act; na.w_router = INP(12); na.tok = tok; na.ecnt = ecnt;
                ph_norm<1>(na, lds, bid, nblk); }
            SEAM(14);
            if (RUN(15)) ph_gather(act, tok, ecnt, xs, bid, nblk);
            SEAM(15);
#ifndef NO_MOE
            for (int ch = 0; ch < 5; ++ch) {
                if (RUN(16 + 2 * ch) || RUN(17 + 2 * ch)) {
                    const MoeTiles mt = moe_tiles(ecnt);
                    const int ntot = moe_tile_start(mt, 7) + mt.p7;
                    pg8::MoeOrder S; S.t0 = ch * 64; S.nrt = min(64, ntot - S.t0); S.G = nblk; S.c = bid;
                    S.ts1 = moe_tile_start(mt, 1); S.ts2 = moe_tile_start(mt, 2); S.ts3 = moe_tile_start(mt, 3); S.ts4 = moe_tile_start(mt, 4); S.ts5 = moe_tile_start(mt, 5); S.ts6 = moe_tile_start(mt, 6); S.ts7 = moe_tile_start(mt, 7);
                    if (RUN(16 + 2 * ch)) { S.nN = 28; S.a_rel = 0; S.estride = (size_t)7168 * DM * 2;
                        pg8::Gemm g{xs, (const bf16*)(ws + WS_WEU), 0, 0, DM};
                        pg8::EpiSwiGLU E{hid, DFE, -S.t0 * 256}; pg8::gemm_phase<pg8::EpiSwiGLU, pg8::MoeOrder, true, true>(lds, g, S, E); }
                    SEAM(16 + 2 * ch);
                    if (RUN(17 + 2 * ch)) { S.nN = 4; S.a_rel = 1; S.estride = (size_t)DM * DFE * 2;
                        pg8::Gemm g{hid, (const bf16*)(ws + WS_WED), 0, 0, DFE};
                        pg8::EpiBf16 E{xs, DM, 0}; pg8::gemm_phase<pg8::EpiBf16, pg8::MoeOrder, true, true>(lds, g, S, E); }
                    SEAM(17 + 2 * ch);
                }
            }
#endif
            if (RUN(26)) { NormArgs na{}; na.xin = out; na.g = gv + 6144; na.tok = tok; na.ecnt = ecnt; na.ys = xs; na.gate = ml + 5120; na.out = out; ph_norm<2>(na, lds, bid, nblk); }
        }
    }
#undef RUN
#undef SEAM
}

extern "C" void kernel_launch(void* const* d_in, const int* in_sizes, int n_in, void* d_out, int out_size, void* d_ws, size_t ws_size, hipStream_t stream) {
    static int grid = 0;
    if (grid == 0) {
        if (n_in != 17 || out_size != T * DM || ws_size < WS_END) { fprintf(stderr, "kernel_launch: unexpected problem (n_in %d out %d ws %zu)\n", n_in, out_size, ws_size); grid = -1; return; }
        int dev = 0, cus = 0, per_cu = 0;
        if (hipGetDevice(&dev) != hipSuccess || hipDeviceGetAttribute(&cus, hipDeviceAttributeMultiprocessorCount, dev) != hipSuccess) { grid = -1; return; }
        if (hipFuncSetAttribute((const void*)mega_fwd, hipFuncAttributeMaxDynamicSharedMemorySize, LDS_BYTES) != hipSuccess) { fprintf(stderr, "kernel_launch: hipFuncSetAttribute failed\n"); grid = -1; return; }
        if (hipOccupancyMaxActiveBlocksPerMultiprocessor(&per_cu, (const void*)mega_fwd, 512, LDS_BYTES) != hipSuccess || per_cu < 1) fprintf(stderr, "kernel_launch: occupancy query says %d\n", per_cu);
        (void)hipGetLastError();
        grid = cus;
    }
    if (grid < 0) return;
    if (hipMemsetAsync((unsigned char*)d_ws + WS_CTL, 0, CTL_BYTES, stream) != hipSuccess) return;
    MegaArgs a{};
    for (int i = 0; i < 17; ++i) a.in[i] = (const float*)d_in[i];
    a.out = (float*)d_out; a.ws = (unsigned char*)d_ws;
#if MK_SPLIT
    for (int p = 0; p < N_PHASES; ++p) { a.ph_lo = p; a.ph_hi = p + 1; hipLaunchKernelGGL(mega_fwd, dim3(grid), dim3(512), LDS_BYTES, stream, a); }
#else
    a.ph_lo = 0; a.ph_hi = N_PHASES;
    hipLaunchKernelGGL(mega_fwd, dim3(grid), dim3(512), LDS_BYTES, stream, a);
#endif
}
```

```cpp
#include <hip/hip_runtime.h>
#include <cstdio>
#include <cstdint>

#define LAS __attribute__((address_space(3)))
#define GAS __attribute__((address_space(1)))
typedef unsigned short bf16;
typedef short bf16x8 __attribute__((ext_vector_type(8)));
typedef float f32x4 __attribute__((ext_vector_type(4)));
typedef float f32x16 __attribute__((ext_vector_type(16)));
typedef unsigned u32x4 __attribute__((ext_vector_type(4)));
typedef unsigned u32x2 __attribute__((ext_vector_type(2)));

constexpr int NB = 8, SEQ = 4096, T = NB * SEQ, DM = 1024, NLAYER = 2;
constexpr int PW = 3840;
constexpr int NIN = 3656;
constexpr int COL_QI = 3072, COL_KI = 3584, COL_WI = 3648;
constexpr int DFF = 2816, DFE = 3584, NEXP = 8;
constexpr float EPS = 1e-6f;
constexpr int XS_TILES = 264;

constexpr size_t MiB = 1u << 20;
constexpr size_t WS_CTL = 0, CTL_BYTES = 1 * MiB;
constexpr size_t WS_MOD = 1 * MiB;
constexpr size_t WS_GV = 1 * MiB + 400 * 1024;
constexpr size_t WS_KMEAN = 1 * MiB + 512 * 1024;
constexpr size_t WS_MOBASEL = 1 * MiB + 768 * 1024;
constexpr size_t WS_TOK = 2 * MiB;
constexpr size_t WS_WIN = 4 * MiB;
constexpr size_t WS_WOUT = 19 * MiB;
constexpr size_t WS_WFU = 23 * MiB;
constexpr size_t WS_WFD = 34 * MiB;
constexpr size_t WS_ACT = 40 * MiB;
constexpr size_t WS_P = 104 * MiB;
constexpr size_t WS_HID = 104 * MiB;
constexpr size_t WS_XS = 336 * MiB;
constexpr size_t WS_YS = 336 * MiB;
constexpr size_t WS_MASK = 344 * MiB;
constexpr size_t WS_WEU = 402 * MiB;
constexpr size_t WS_WED = 468 * MiB;
constexpr size_t WS_END = 496 * MiB;
constexpr int CW_ECNT = 64;
constexpr int CW_KNMAX = 128;
constexpr int CW_QUEUE = 256;
constexpr int CW_BAR = 4096;

__device__ __forceinline__ float bf2f(unsigned v) { return __uint_as_float(v << 16); }
__device__ __forceinline__ unsigned f2bf(float f) { unsigned u = __float_as_uint(f); return (u + 0x7fffu + ((u >> 16) & 1u)) >> 16; }
__device__ __forceinline__ unsigned pk2(float lo, float hi) { return f2bf(lo) | (f2bf(hi) << 16); }
__device__ __forceinline__ unsigned cvt_pk_bf16(float lo, float hi) { unsigned r; asm volatile("v_cvt_pk_bf16_f32 %0, %1, %2" : "=v"(r) : "v"(lo), "v"(hi)); return r; }
__device__ __forceinline__ float wave_sum(float v) {
#pragma unroll
    for (int o = 1; o < 64; o <<= 1) v += __shfl_xor(v, o);
    return v;
}
__device__ __forceinline__ void ld8(const bf16* p, float* f) {
    const u32x4 u = *(const u32x4*)p;
    f[0] = __uint_as_float(u.x << 16); f[1] = __uint_as_float(u.x & 0xffff0000u);
    f[2] = __uint_as_float(u.y << 16); f[3] = __uint_as_float(u.y & 0xffff0000u);
    f[4] = __uint_as_float(u.z << 16); f[5] = __uint_as_float(u.z & 0xffff0000u);
    f[6] = __uint_as_float(u.w << 16); f[7] = __uint_as_float(u.w & 0xffff0000u);
}
__device__ __forceinline__ float alibi_slope(int mixer_pos, int h) { return exp2f(-8.0f * (float)(3 * h + mixer_pos + 1) / 12.0f); }
__device__ __forceinline__ float silu_f(float x) { return x * __builtin_amdgcn_rcpf(1.0f + __expf(-x)); }
__device__ __forceinline__ int otid() { int t = threadIdx.x; asm volatile("" : "+v"(t)); return t; }
#define XB_TMO      128
#define XB_XCNT(j)  (256  + 64 * (j))
#define XB_XSUB(j)  (1280 + 64 * (j))
#define XB_XGEN(j)  (2304 + 64 * (j))
#define XB_TOP      3328
#define XB_TOPGEN   3392
#define XCD_BAR_WORDS 3456
#define XB_SPIN_CAP (1u << 18)

__device__ __forceinline__ unsigned xb_ld(unsigned* p)              { return __hip_atomic_load(p, __ATOMIC_RELAXED, __HIP_MEMORY_SCOPE_AGENT); }
__device__ __forceinline__ unsigned xb_add(unsigned* p, unsigned v) { return __hip_atomic_fetch_add(p, v, __ATOMIC_RELAXED, __HIP_MEMORY_SCOPE_AGENT); }
__device__ __forceinline__ unsigned xb_xcc_id() { return (unsigned)__builtin_amdgcn_s_getreg((3 << 11) | 20) & 0xFu; }
#define XB_SPIN(cond, bar) do { unsigned _sp = 0; while (cond) { __builtin_amdgcn_s_sleep(1); \
    if ((++_sp & 255u) == 0u) { if (xb_ld(&(bar)[XB_TMO])) break; if (_sp > XB_SPIN_CAP) { atomicAdd(&(bar)[XB_TMO], 1u); break; } } } } while (0)

struct XcdBarrier {
    unsigned* bar; unsigned x;
    volatile LAS unsigned* st;
};

__device__ __forceinline__ XcdBarrier xcd_barrier_post(unsigned* bar, volatile LAS unsigned* st) {
    XcdBarrier b; b.bar = bar; b.x = xb_xcc_id(); b.st = st;
    if (threadIdx.x == 0) (void)xb_add(&bar[XB_XCNT(b.x)], 1u);
    return b;
}
__device__ __forceinline__ void xcd_barrier_complete(unsigned* bar, unsigned x, unsigned& nloc, unsigned& nx) {
    const unsigned G = gridDim.x * gridDim.y * gridDim.z;
    unsigned sum, cnt, mine, sp = 0u;
    for (;;) {
        asm volatile("" : "+s"(bar), "+s"(x));
        sum = 0u; cnt = 0u; mine = 0u;
#pragma unroll
        for (unsigned j = 0; j < 16; ++j) { const unsigned c = xb_ld(&bar[XB_XCNT(j)]); sum += c; cnt += (c > 0u) ? 1u : 0u; mine = (j == x) ? c : mine; }
        if (sum == G) break;
        __builtin_amdgcn_s_sleep(1);
        if ((++sp & 255u) == 0u) { if (xb_ld(&bar[XB_TMO])) break; if (sp > XB_SPIN_CAP) { atomicAdd(&bar[XB_TMO], 1u); break; } }
    }
    nloc = mine > 0u ? mine : 1u; nx = cnt > 0u ? cnt : 1u;
}

__device__ __forceinline__ void xcd_barrier(const XcdBarrier& b) {
    asm volatile("s_waitcnt vmcnt(0)" ::: "memory");
    __syncthreads();
    if (threadIdx.x == 0) {
        unsigned* bar = b.bar; unsigned bx = b.x; asm volatile("" : "+s"(bx));
        __builtin_amdgcn_s_waitcnt(0);
        unsigned nloc = b.st[0], nx = b.st[1];
        if (nloc == 0u) { xcd_barrier_complete(bar, bx, nloc, nx); b.st[0] = nloc; b.st[1] = nx; }
        const unsigned old = xb_add(&bar[XB_XSUB(bx)], 1u);
        const unsigned gen = old / nloc;
        if (old + 1u == (gen + 1u) * nloc) {
            __builtin_amdgcn_fence(__ATOMIC_RELEASE, "agent");
            asm volatile("s_waitcnt vmcnt(0)" ::: "memory");
            const unsigned og = xb_add(&bar[XB_TOP], 1u);
            const unsigned tg = og / nx;
            if (og + 1u == (tg + 1u) * nx) xb_add(&bar[XB_TOPGEN], 1u);
            else XB_SPIN(xb_ld(&bar[XB_TOPGEN]) == tg, bar);
            __builtin_amdgcn_fence(__ATOMIC_ACQUIRE, "agent");
            xb_add(&bar[XB_XGEN(bx)], 1u);
            asm volatile("s_waitcnt vmcnt(0)" ::: "memory");
        } else {
            XB_SPIN(xb_ld(&bar[XB_XGEN(bx)]) == gen, bar);
            __builtin_amdgcn_fence(__ATOMIC_ACQUIRE, "agent");
            asm volatile("s_waitcnt vmcnt(0)" ::: "memory");
        }
    }
    __syncthreads();
}
namespace pg8 {
#define PG8_LAS __attribute__((address_space(3)))
typedef unsigned short bf16_t;
typedef short bf16x8 __attribute__((ext_vector_type(8)));
typedef float f32x4 __attribute__((ext_vector_type(4)));
typedef unsigned u32x4 __attribute__((ext_vector_type(4)));
constexpr int BM = 256, BK = 64, HALF = 128, HTB = HALF * BK * 2  , STAGE_BYTES = 8 * HTB, NXCD = 8, WGM = 8;

__host__ __device__ __forceinline__ int lds_byte(int r, int c) { const int st = (r >> 4) * 2 + (c >> 5), rr = r & 15, cc = c & 31, ob = rr * 64 + cc * 2; return st * 1024 + (ob ^ (((ob >> 9) & 1) << 5)); }
__host__ __device__ __forceinline__ void stage_rc(int b, int& R, int& C) { const int st = b / 1024, sb = b % 1024, swz = sb ^ (((sb >> 9) & 1) << 5); R = (st >> 1) * 16 + swz / 64; C = (st & 1) * 32 + (swz % 64) / 2; }
__host__ __device__ __forceinline__ int perm32(int rho) { const int n = rho >> 4, i = rho & 15; return 8 * (i >> 2) + 4 * n + (i & 3); }

struct Unit { int pm, pn; };
struct Gemm { const bf16_t* A; const bf16_t* Bt; int M, N, K; };

struct StaticOrder {
    int nM, nN, nwg, G, c;
    __host__ __device__ void init(int M, int N, int G_, int c_) { nM = M / BM; nN = N / BM; nwg = nM * nN; G = G_; c = c_; }
    __host__ __device__ bool next(int i, Unit& u) const {
        const long L = (long)i * G + c; if (L >= nwg) return false;
        int wgid = (int)L; { const int q = nwg / NXCD, r = nwg % NXCD, xcd = wgid % NXCD, off = wgid / NXCD; wgid = (xcd < r ? xcd * (q + 1) : r * (q + 1) + (xcd - r) * q) + off; }
        const int nig = WGM * nN, gid = wgid / nig, fm = gid * WGM, gsz = (nM - fm) < WGM ? (nM - fm) : WGM;
        u.pm = fm + ((wgid % nig) % gsz); u.pn = (wgid % nig) / gsz; return true;
    }
    __device__ __forceinline__ void a_ready(const Unit&) const {}
    __device__ __forceinline__ void done(const Unit&) const {}
    __device__ __forceinline__ const char* a_base(const Gemm& g, const Unit& u, size_t tstep) const { return (const char*)g.A + (size_t)u.pm * tstep; }
    __device__ __forceinline__ const char* b_base(const Gemm& g, const Unit& u, size_t tstep) const { return (const char*)g.Bt + (size_t)u.pn * tstep; }
};


typedef int v4i_t __attribute__((ext_vector_type(4)));
typedef int v8i_t __attribute__((ext_vector_type(8)));
__device__ __forceinline__ v8i_t cat8(bf16x8 lo, bf16x8 hi) { const v4i_t a = __builtin_bit_cast(v4i_t, lo), b = __builtin_bit_cast(v4i_t, hi); return __builtin_shufflevector(a, b, 0, 1, 2, 3, 4, 5, 6, 7); }
__device__ __forceinline__ unsigned pk4_fp8(float a, float b, float c, float d) {
    a = fminf(fmaxf(a, -448.f), 448.f); b = fminf(fmaxf(b, -448.f), 448.f); c = fminf(fmaxf(c, -448.f), 448.f); d = fminf(fmaxf(d, -448.f), 448.f);
    int w = 0; w = __builtin_amdgcn_cvt_pk_fp8_f32(a, b, w, false); w = __builtin_amdgcn_cvt_pk_fp8_f32(c, d, w, true); return (unsigned)w; }

struct EpiBf16 {
    static constexpr bool PERM = true, AFTER_DRAIN = false;
    bf16_t* O; int ldc; int row_shift;
    __device__ __forceinline__ void operator()(const f32x4 (&acc)[2][2][4][2], const Unit& u, int wr, int wc, int fr, int fq) const {
        const int row0 = u.pm * BM + row_shift + wr * 64 + fr, col0 = u.pn * BM + wc * 32 + 8 * fq;
#pragma unroll
        for (int ai = 0; ai < 2; ++ai)
#pragma unroll
            for (int m = 0; m < 4; ++m) { bf16_t* rowp = O + (size_t)(row0 + ai * HALF + m * 16) * ldc + col0;
#pragma unroll
                for (int bj = 0; bj < 2; ++bj) { const f32x4 v0 = acc[ai][bj][m][0], v1 = acc[ai][bj][m][1];
                    u32x4 w; w.x = cvt_pk_bf16(v0[0], v0[1]); w.y = cvt_pk_bf16(v0[2], v0[3]); w.z = cvt_pk_bf16(v1[0], v1[1]); w.w = cvt_pk_bf16(v1[2], v1[3]);
                    *(u32x4*)(rowp + bj * HALF) = w; } }
    }
};
struct EpiSwiGLU {
    static constexpr bool PERM = true, AFTER_DRAIN = false;
    bf16_t* H; int ldh; int row_shift;
    __device__ __forceinline__ void operator()(const f32x4 (&acc)[2][2][4][2], const Unit& u, int wr, int wc, int fr, int fq) const {
        const int row0 = u.pm * BM + row_shift + wr * 64 + fr, col0 = u.pn * HALF + wc * 32 + 8 * fq;
#pragma unroll
        for (int ai = 0; ai < 2; ++ai)
#pragma unroll
            for (int m = 0; m < 4; ++m) { bf16_t* rowp = H + (size_t)(row0 + ai * HALF + m * 16) * ldh + col0;
                const f32x4 g0 = acc[ai][0][m][0], g1 = acc[ai][0][m][1], u0 = acc[ai][1][m][0], u1 = acc[ai][1][m][1];
                float h[8];
#pragma unroll
                for (int i = 0; i < 4; ++i) { h[i] = silu_f(g0[i]) * u0[i]; h[4 + i] = silu_f(g1[i]) * u1[i]; }
                u32x4 w; w.x = cvt_pk_bf16(h[0], h[1]); w.y = cvt_pk_bf16(h[2], h[3]); w.z = cvt_pk_bf16(h[4], h[5]); w.w = cvt_pk_bf16(h[6], h[7]);
                *(u32x4*)rowp = w; }
    }
};
struct EpiSwiGLU8 {
    static constexpr bool PERM = true, AFTER_DRAIN = false;
    unsigned char* H; int ldh; int row_shift;
    __device__ __forceinline__ void operator()(const f32x4 (&acc)[2][2][4][2], const Unit& u, int wr, int wc, int fr, int fq) const {
        const int row0 = u.pm * BM + row_shift + wr * 64 + fr, col0 = u.pn * HALF + wc * 32 + 8 * fq;
#pragma unroll
        for (int ai = 0; ai < 2; ++ai)
#pragma unroll
            for (int m = 0; m < 4; ++m) { unsigned char* rowp = H + (size_t)(row0 + ai * HALF + m * 16) * ldh + col0;
                const f32x4 g0 = acc[ai][0][m][0], g1 = acc[ai][0][m][1], u0 = acc[ai][1][m][0], u1 = acc[ai][1][m][1];
                float h[8];
#pragma unroll
                for (int i = 0; i < 4; ++i) { h[i] = silu_f(g0[i]) * u0[i]; h[4 + i] = silu_f(g1[i]) * u1[i]; }
                typedef unsigned u32x2_t __attribute__((ext_vector_type(2)));
                u32x2_t w; w.x = pk4_fp8(h[0], h[1], h[2], h[3]); w.y = pk4_fp8(h[4], h[5], h[6], h[7]);
                *(u32x2_t*)rowp = w;
                asm volatile("" ::: "memory"); }
    }
};
struct EpiRes {
    static constexpr bool PERM = false, AFTER_DRAIN = false;
    const float* xin; float* xout; const float* gate;
    __device__ __forceinline__ void operator()(const f32x4 (&acc)[2][2][4][2], const Unit& u, int wr, int wc, int fr, int fq) const {
        const int row0 = u.pm * BM + wr * 64 + fr, col0 = u.pn * BM + wc * 32 + 4 * fq;
        const float* gb = gate + (size_t)((u.pm * BM) / SEQ) * 6144;
        f32x4 gv[2][2];
#pragma unroll
        for (int bj = 0; bj < 2; ++bj)
#pragma unroll
            for (int n = 0; n < 2; ++n) gv[bj][n] = *(const f32x4*)(gb + col0 + bj * HALF + n * 16);
#pragma unroll
        for (int ai = 0; ai < 2; ++ai)
#pragma unroll
            for (int m = 0; m < 4; ++m) { const size_t off = (size_t)(row0 + ai * HALF + m * 16) * DM + col0;
#pragma unroll
                for (int bj = 0; bj < 2; ++bj)
#pragma unroll
                    for (int n = 0; n < 2; ++n) { const f32x4 x = *(const f32x4*)(xin + off + bj * HALF + n * 16);
                        *(f32x4*)(xout + off + bj * HALF + n * 16) = x + gv[bj][n] * acc[ai][bj][m][n]; } }
    }
};
struct MoeOrder {
    int nrt, nN, G, c; const PG8_LAS unsigned char* etab; size_t estride;
    __device__ __forceinline__ bool next(int i, Unit& u) const {
        const int L = i * G + c; if (nrt <= 0 || L >= nrt * nN) return false;
        u.pm = L % nrt; u.pn = L / nrt; return true;
    }
    __device__ __forceinline__ void a_ready(const Unit&) const {}
    __device__ __forceinline__ void done(const Unit&) const {}
    __device__ __forceinline__ const char* a_base(const Gemm& g, const Unit& u, size_t tstep) const { return (const char*)g.A + (size_t)u.pm * tstep; }
    __device__ __forceinline__ const char* b_base(const Gemm& g, const Unit& u, size_t tstep) const {
        const int e = __builtin_amdgcn_readfirstlane((int)etab[u.pm]);
        return (const char*)g.Bt + (size_t)e * estride + (size_t)u.pn * tstep;
    }
};
template <class Epi, class Sched, bool ALIGN_EPI = false, bool SP2 = false, bool FP8 = false, int sc_w = 0x7F7F7F7F, int sc_a = 0x7F7F7F7F>
__device__ __forceinline__ void gemm_phase(PG8_LAS unsigned char* lds, const Gemm g, const Sched& S, const Epi& E) {
    int tid_ = threadIdx.x; asm volatile("" : "+v"(tid_));
    const int tid = tid_, wid = __builtin_amdgcn_readfirstlane(tid >> 6), lane = tid & 63, wr = wid >> 2, wc = wid & 3, fr = lane & 15, fq = lane >> 4;
    constexpr int ES = FP8 ? 1 : 2;
    int K_ = g.K; asm volatile("" : "+s"(K_));
    const int K = K_, nt = K * ES / (BK * 2);
    unsigned voffA[2], voffB[2];
#pragma unroll
    for (int i = 0; i < 2; ++i) { int R, C; stage_rc(tid * 16 + i * 8192, R, C); const int Rb = Epi::PERM ? ((R & ~31) + perm32(R & 31)) : R;
        voffA[i] = (unsigned)(R * K * ES + C * 2); voffB[i] = (unsigned)(Rb * K * ES + C * 2); }
    const size_t kstep = (size_t)(BK * 2);
    const size_t hstep = (size_t)HALF * K * ES;
    const size_t tstep = 2 * hstep;
    const unsigned ldsw = (unsigned)wid * 1024u;
    const int aoff = lds_byte(wr * 64 + fr, fq * 8), boff = lds_byte(wc * 32 + fr, fq * 8);
#define PG8_SA(b, h) (((b) * 2 + (h)) * HTB)
#define PG8_SB(b, h) ((4 + (b) * 2 + (h)) * HTB)
#define PG8_STAGE(bufoff, gbase, voff) do { _Pragma("unroll") for (int _i = 0; _i < 2; ++_i) \
        __builtin_amdgcn_global_load_lds((const unsigned*)((const char*)(gbase) + (voff)[_i]), (PG8_LAS unsigned*)(lds + (bufoff) + ldsw + _i * 8192), 16, 0, 0); } while (0)
#define PG8_LDA(dst, b, h) do { _Pragma("unroll") for (int m = 0; m < 4; ++m) { \
        if constexpr (FP8) { const v4i_t l_ = *(const PG8_LAS v4i_t*)(lds + PG8_SA(b, h) + aoff + m * 2048), h_ = *(const PG8_LAS v4i_t*)(lds + PG8_SA(b, h) + aoff + m * 2048 + 1024); dst##F[m] = __builtin_shufflevector(l_, h_, 0, 1, 2, 3, 4, 5, 6, 7); } \
        else { _Pragma("unroll") for (int k = 0; k < 2; ++k) dst[m][k] = *(const PG8_LAS bf16x8*)(lds + PG8_SA(b, h) + aoff + m * 2048 + k * 1024); } } } while (0)
#define PG8_LDB(dst, b, h) do { _Pragma("unroll") for (int n = 0; n < 2; ++n) { \
        if constexpr (FP8) { const v4i_t l_ = *(const PG8_LAS v4i_t*)(lds + PG8_SB(b, h) + boff + n * 2048), h_ = *(const PG8_LAS v4i_t*)(lds + PG8_SB(b, h) + boff + n * 2048 + 1024); dst##F[n] = __builtin_shufflevector(l_, h_, 0, 1, 2, 3, 4, 5, 6, 7); } \
        else { _Pragma("unroll") for (int k = 0; k < 2; ++k) dst[n][k] = *(const PG8_LAS bf16x8*)(lds + PG8_SB(b, h) + boff + n * 2048 + k * 1024); } } } while (0)
#define PG8_MMA(ai, bj, At, Bt) do { __builtin_amdgcn_s_setprio(1); _Pragma("unroll") for (int m = 0; m < 4; ++m) _Pragma("unroll") for (int n = 0; n < 2; ++n) { \
        if constexpr (FP8) asm volatile("v_mfma_scale_f32_16x16x128_f8f6f4 %0, %1, %2, %0, %3, %4 op_sel_hi:[0,0,0]" : "+v"(acc[ai][bj][m][n]) : "v"(Bt##F[n]), "v"(At##F[m]), "v"(sc_w), "v"(sc_a)); \
        else { _Pragma("unroll") for (int k = 0; k < 2; ++k) acc[ai][bj][m][n] = __builtin_amdgcn_mfma_f32_16x16x32_bf16(Bt[n][k], At[m][k], acc[ai][bj][m][n], 0, 0, 0); } } \
        __builtin_amdgcn_s_setprio(0); } while (0)
#define PG8_WAIT_V(n) asm volatile("s_waitcnt vmcnt(" #n ")" ::: "memory")
#define PG8_WAIT_L(n) asm volatile("s_waitcnt lgkmcnt(" #n ")" ::: "memory")
#define PG8_BAR __builtin_amdgcn_s_barrier()
#define PG8_SCHED __builtin_amdgcn_sched_barrier(0)
    Unit cur, nxt; int ui = 0;
    if (!S.next(0, cur)) return;
    f32x4 acc[2][2][4][2];
#pragma unroll
    for (int a = 0; a < 2; ++a)
#pragma unroll
        for (int b = 0; b < 2; ++b)
#pragma unroll
            for (int m = 0; m < 4; ++m)
#pragma unroll
                for (int n = 0; n < 2; ++n) acc[a][b][m][n] = (f32x4){0.f, 0.f, 0.f, 0.f};
    bf16x8 At[4][2], B0[2][2], B1[2][2];
    v8i_t AtF[4], B0F[2], B1F[2];
    const char* cA = S.a_base(g, cur, tstep); const char* cB = S.b_base(g, cur, tstep);
    S.a_ready(cur);
    if constexpr (SP2) {
        PG8_STAGE(PG8_SB(0, 0), cB, voffB); PG8_STAGE(PG8_SB(0, 1), cB + hstep, voffB); PG8_STAGE(PG8_SA(0, 0), cA, voffA); PG8_STAGE(PG8_SA(0, 1), cA + hstep, voffA);
        if (wr == 1) PG8_BAR;
        PG8_WAIT_V(2); PG8_BAR;
        PG8_STAGE(PG8_SB(1, 0), cB + kstep, voffB); PG8_STAGE(PG8_SA(1, 0), cA + kstep, voffA); PG8_STAGE(PG8_SB(1, 1), cB + hstep + kstep, voffB);
        PG8_WAIT_V(6); PG8_BAR;
    } else {
        PG8_STAGE(PG8_SB(0, 0), cB, voffB); PG8_STAGE(PG8_SA(0, 0), cA, voffA); PG8_STAGE(PG8_SB(0, 1), cB + hstep, voffB); PG8_STAGE(PG8_SA(0, 1), cA + hstep, voffA);
        if (wr == 1) PG8_BAR;
        PG8_WAIT_V(4); PG8_BAR;
        PG8_STAGE(PG8_SB(1, 0), cB + kstep, voffB); PG8_STAGE(PG8_SA(1, 0), cA + kstep, voffA); PG8_STAGE(PG8_SB(1, 1), cB + hstep + kstep, voffB);
        PG8_WAIT_V(6); PG8_BAR;
    }
    for (;;) {
        const bool has_next = S.next(ui + 1, nxt);
        const char* nA = has_next ? S.a_base(g, nxt, tstep) : cA; const char* nB = has_next ? S.b_base(g, nxt, tstep) : cB;
        for (int t = 0; t < nt; t += 2) {
            const bool last = (t == nt - 2);
            const char* a1 = cA + (size_t)(t + 1) * kstep;
            const char* a2 = last ? nA : cA + (size_t)(t + 2) * kstep; const char* b2 = last ? nB : cB + (size_t)(t + 2) * kstep;
            const char* a3 = a2 + kstep; const char* b3 = b2 + kstep;
            if (last && has_next) S.a_ready(nxt);
            if constexpr (SP2) {
            PG8_LDB(B0, 0, 0); PG8_LDB(B1, 0, 1); PG8_SCHED; PG8_LDA(At, 0, 0); PG8_STAGE(PG8_SA(1, 1), a1 + hstep, voffA);
            PG8_WAIT_V(8); PG8_WAIT_L(0); PG8_BAR; PG8_MMA(0, 0, At, B0); PG8_MMA(0, 1, At, B1); PG8_BAR; PG8_SCHED;
            PG8_LDA(At, 0, 1); PG8_STAGE(PG8_SB(0, 0), b2, voffB); PG8_STAGE(PG8_SB(0, 1), b2 + hstep, voffB); PG8_STAGE(PG8_SA(0, 0), a2, voffA);
            PG8_WAIT_V(8); PG8_WAIT_L(0); PG8_BAR; PG8_MMA(1, 0, At, B0); PG8_MMA(1, 1, At, B1); PG8_BAR; PG8_SCHED;
            PG8_LDB(B0, 1, 0); PG8_LDB(B1, 1, 1); PG8_SCHED; PG8_LDA(At, 1, 0); PG8_STAGE(PG8_SA(0, 1), a2 + hstep, voffA);
            PG8_WAIT_V(8); PG8_WAIT_L(0); PG8_BAR; PG8_MMA(0, 0, At, B0); PG8_MMA(0, 1, At, B1); PG8_BAR; PG8_SCHED;
            PG8_LDA(At, 1, 1); PG8_STAGE(PG8_SB(1, 0), b3, voffB); PG8_STAGE(PG8_SB(1, 1), b3 + hstep, voffB); PG8_STAGE(PG8_SA(1, 0), a3, voffA);
            PG8_WAIT_V(8); PG8_WAIT_L(0); PG8_BAR; PG8_MMA(1, 0, At, B0); PG8_MMA(1, 1, At, B1); PG8_BAR; PG8_SCHED;
            } else {
            PG8_LDB(B0, 0, 0); PG8_SCHED; PG8_LDA(At, 0, 0); PG8_STAGE(PG8_SA(1, 1), a1 + hstep, voffA);
            PG8_WAIT_L(8); PG8_BAR; PG8_WAIT_L(0); PG8_MMA(0, 0, At, B0); PG8_BAR; PG8_SCHED;
            PG8_LDB(B1, 0, 1); PG8_STAGE(PG8_SB(0, 0), b2, voffB);
            PG8_BAR; PG8_WAIT_L(0); PG8_MMA(0, 1, At, B1); PG8_BAR;
            PG8_LDA(At, 0, 1); PG8_STAGE(PG8_SA(0, 0), a2, voffA);
            PG8_BAR; PG8_WAIT_L(0); PG8_MMA(1, 0, At, B0); PG8_BAR; PG8_SCHED;
            PG8_STAGE(PG8_SB(0, 1), b2 + hstep, voffB);
            PG8_WAIT_V(6); PG8_BAR; PG8_MMA(1, 1, At, B1); PG8_BAR;
            PG8_LDB(B0, 1, 0); PG8_SCHED; PG8_LDA(At, 1, 0); PG8_STAGE(PG8_SA(0, 1), a2 + hstep, voffA);
            PG8_WAIT_L(8); PG8_BAR; PG8_WAIT_L(0); PG8_MMA(0, 0, At, B0); PG8_BAR; PG8_SCHED;
            PG8_LDB(B1, 1, 1); PG8_STAGE(PG8_SB(1, 0), b3, voffB);
            PG8_BAR; PG8_WAIT_L(0); PG8_MMA(0, 1, At, B1); PG8_BAR;
            PG8_LDA(At, 1, 1); PG8_STAGE(PG8_SA(1, 0), a3, voffA);
            PG8_BAR; PG8_WAIT_L(0); PG8_MMA(1, 0, At, B0); PG8_BAR; PG8_SCHED;
            PG8_STAGE(PG8_SB(1, 1), b3 + hstep, voffB);
            PG8_WAIT_V(6); PG8_BAR; PG8_MMA(1, 1, At, B1); PG8_BAR;
            }
        }
        if constexpr (ALIGN_EPI) { if (wr == 0) PG8_BAR; }
        if constexpr (FP8) asm volatile("s_nop 15\n\ts_nop 15\n\ts_nop 15" ::: "memory");
        if constexpr (!Epi::AFTER_DRAIN) { E(acc, cur, wr, wc, fr, fq); S.done(cur); }
        if (!has_next) break;
#pragma unroll
        for (int a = 0; a < 2; ++a)
#pragma unroll
            for (int b = 0; b < 2; ++b)
#pragma unroll
                for (int m = 0; m < 4; ++m)
#pragma unroll
                    for (int n = 0; n < 2; ++n) acc[a][b][m][n] = (f32x4){0.f, 0.f, 0.f, 0.f};
        cur = nxt; cA = nA; cB = nB; ++ui;
        if constexpr (ALIGN_EPI) { if (wr == 1) PG8_BAR; }
    }
    PG8_WAIT_V(0);
    if constexpr (!ALIGN_EPI) { if (wr == 0) PG8_BAR; }
    PG8_BAR;
    if constexpr (Epi::AFTER_DRAIN) { E.fused(acc, cur, wr, wc, fr, fq, lds, wid, lane); S.done(cur); }
#undef PG8_SA
#undef PG8_SB
#undef PG8_STAGE
#undef PG8_LDA
#undef PG8_LDB
#undef PG8_MMA
#undef PG8_WAIT_V
#undef PG8_WAIT_L
#undef PG8_BAR
#undef PG8_SCHED
}
}

#define LDS_WAIT() asm volatile("s_waitcnt lgkmcnt(0)" ::: "memory")
#define VM_WAIT() asm volatile("s_waitcnt vmcnt(0)" ::: "memory")

template <bool F8 = false> __device__ __forceinline__ void transpose_item(const float* W, int ldw, int scol0, int ncol_valid, float scale, bf16* WT, int K, int drow0, int k0, LAS float* scr, int lane) {
    const int n = lane & 31; const bool ok = (scol0 + n) < ncol_valid;
#pragma unroll 8
    for (int i = 0; i < 32; ++i) { const int kk = 2 * i + (lane >> 5);
        float v = 0.f; if (ok) v = W[(size_t)(k0 + kk) * ldw + scol0 + n] * scale;
        scr[kk * 33 + n] = v; }
    LDS_WAIT(); asm volatile("" ::: "memory");
    const int c = lane & 7;
#pragma unroll
    for (int j = 0; j < 4; ++j) { const int nn = (lane >> 3) + 8 * j; const LAS float* s = scr + (8 * c) * 33 + nn;
        if (F8) { u32x2 o; o.x = pg8::pk4_fp8(s[0 * 33], s[1 * 33], s[2 * 33], s[3 * 33]); o.y = pg8::pk4_fp8(s[4 * 33], s[5 * 33], s[6 * 33], s[7 * 33]);
            *(u32x2*)((unsigned char*)WT + (size_t)(drow0 + nn) * K + k0 + 8 * c) = o; }
        else { u32x4 o; o.x = pk2(s[0 * 33], s[1 * 33]); o.y = pk2(s[2 * 33], s[3 * 33]); o.z = pk2(s[4 * 33], s[5 * 33]); o.w = pk2(s[6 * 33], s[7 * 33]);
            *(u32x4*)(WT + (size_t)(drow0 + nn) * K + k0 + 8 * c) = o; } }
    LDS_WAIT(); asm volatile("" ::: "memory");
}
struct PrepArgs { const float *w_in, *w_out, *wfg, *wfu, *wfd, *weg, *weu, *wed; unsigned char* ws; };
constexpr int PI_WIN = 2 * 16 * 120, PI_WOUT = 2 * 16 * 32, PI_FU = 16 * 176, PI_FD = 44 * 32, PI_EU = 8 * 16 * 224, PI_ED = 8 * 56 * 32;
constexpr int PREP_ITEMS = PI_WIN + PI_WOUT + PI_FU + PI_FD + PI_EU + PI_ED;
__device__ __forceinline__ void prep_item(const PrepArgs& a, int it, LAS float* scr, int lane) {
    int r = it;
    if (r < PI_WIN) { const int l = r / 1920; r %= 1920; const int kb = r / 120, nb = r % 120, n0 = nb * 32;
        float sc = 1.f; if (n0 < 256 || (n0 >= COL_QI && n0 < COL_KI)) sc = 0.125f; else if (n0 < 3072 && (n0 % 768) < 256) sc = 0.125f * 1.4426950408889634f; else if (n0 == COL_WI) sc = 0.35355339059327373f;
        transpose_item(a.w_in + (size_t)l * DM * NIN, NIN, n0, NIN, sc, (bf16*)(a.ws + WS_WIN) + (size_t)l * PW * DM, DM, n0, kb * 64, scr, lane); return; }
    r -= PI_WIN;
    if (r < PI_WOUT) { const int l = r / 512; r %= 512; const int kb = r / 32, nb = r % 32;
        transpose_item(a.w_out + (size_t)l * DM * DM, DM, nb * 32, DM, 1.f, (bf16*)(a.ws + WS_WOUT) + (size_t)l * DM * DM, DM, nb * 32, kb * 64, scr, lane); return; }
    r -= PI_WOUT;
    if (r < PI_FU) { const int kb = r / 176, nb = r % 176, r0 = nb * 32, blk = r0 >> 8, w = r0 & 255;
        transpose_item<true>(w < 128 ? a.wfg : a.wfu, DFF, blk * 128 + (w & 127), DFF, 32.f, (bf16*)(a.ws + WS_WFU), DM, r0, kb * 64, scr, lane); return; }
    r -= PI_FU;
    if (r < PI_FD) { const int kb = r / 32, nb = r % 32;
        transpose_item<true>(a.wfd, DM, nb * 32, DM, 64.f, (bf16*)(a.ws + WS_WFD), DFF, nb * 32, kb * 64, scr, lane); return; }
    r -= PI_FD;
    if (r < PI_EU) { const int e = r / 3584; r %= 3584; const int kb = r / 224, nb = r % 224, r0 = nb * 32, blk = r0 >> 8, w = r0 & 255;
        transpose_item<true>((w < 128 ? a.weg : a.weu) + (size_t)e * DM * DFE, DFE, blk * 128 + (w & 127), DFE, 32.f, (bf16*)(a.ws + WS_WEU + (size_t)e * 7168 * DM), DM, r0, kb * 64, scr, lane); return; }
    r -= PI_EU;
    { const int e = r / 1792; r %= 1792; const int kb = r / 32, nb = r % 32;
        transpose_item<true>(a.wed + (size_t)e * DFE * DM, DM, nb * 32, DM, 64.f, (bf16*)(a.ws + WS_WED + (size_t)e * DM * DFE), DFE, nb * 32, kb * 64, scr, lane); }
}
__device__ __forceinline__ void ph_prep(const PrepArgs& a, LAS unsigned char* lds, int bid, int nblk) {
    const int lane = otid() & 63, wave = otid() >> 6;
    LAS float* scr = (LAS float*)lds + wave * 64 * 33;
    const int gw = bid * 8 + wave, ngw = nblk * 8;
    for (int it = gw; it < PREP_ITEMS; it += ngw) prep_item(a, it, scr, lane);
}
__device__ __forceinline__ void ph_mod(const float* c, const float* w_ada, const float* b_ada, float* mod, LAS unsigned char* lds, int bid, int nblk) {
    LAS float* sc = (LAS float*)lds; LAS float* part = (LAS float*)(lds + 32768);
    const int tid = otid();
    if (bid >= 192) return;
    for (int i = tid; i < 8 * 1024; i += 512) { const float v = c[i]; sc[i] = v / (1.0f + __expf(-v)); }
    __syncthreads();
    for (int item = bid; item < 192; item += nblk) {
        const int l = item / 96, j0 = (item % 96) * 64, jj = tid & 63, kq = tid >> 6;
        float acc[8];
#pragma unroll
        for (int b = 0; b < 8; ++b) acc[b] = 0.f;
        const float* w = w_ada + (size_t)l * DM * 6144 + j0 + jj;
        for (int k = kq * 128; k < kq * 128 + 128; ++k) { const float wv = w[(size_t)k * 6144];
#pragma unroll
            for (int b = 0; b < 8; ++b) acc[b] += sc[b * 1024 + k] * wv; }
#pragma unroll
        for (int b = 0; b < 8; ++b) part[(kq * 8 + b) * 64 + jj] = acc[b];
        __syncthreads();
        { const int b = tid >> 6, j = tid & 63; float sum = 0.f;
#pragma unroll
          for (int q = 0; q < 8; ++q) sum += part[(q * 8 + b) * 64 + j];
          mod[(size_t)l * 8 * 6144 + (size_t)b * 6144 + j0 + j] = sum + b_ada[l * 6144 + j0 + j]; }
        __syncthreads();
    }
}

struct MoeTiles { int p0, p1, p2, p3, p4, p5, p6, p7; };
__device__ __forceinline__ MoeTiles moe_tiles(const unsigned* ecnt) {
#define ECNT_LD(i) ((int)((__hip_atomic_load(ecnt + (i), __ATOMIC_RELAXED, __HIP_MEMORY_SCOPE_AGENT) + 255u) >> 8))
    MoeTiles m; m.p0 = ECNT_LD(0); m.p1 = ECNT_LD(1); m.p2 = ECNT_LD(2); m.p3 = ECNT_LD(3); m.p4 = ECNT_LD(4); m.p5 = ECNT_LD(5); m.p6 = ECNT_LD(6); m.p7 = ECNT_LD(7); return m;
#undef ECNT_LD
}
__device__ __forceinline__ int moe_tile_start(const MoeTiles& m, int e) {
    int s = 0; s += (e > 0) ? m.p0 : 0; s += (e > 1) ? m.p1 : 0; s += (e > 2) ? m.p2 : 0; s += (e > 3) ? m.p3 : 0; s += (e > 4) ? m.p4 : 0; s += (e > 5) ? m.p5 : 0; s += (e > 6) ? m.p6 : 0; return s;
}
struct NormArgs {
    const float* xin; const float* g; const float* shift; const float* scale;
    bf16* act; unsigned char* act8;
    const float* w_router; int* tok; unsigned* ecnt;
    const bf16* ys; const float* gate; float* out;
};
template <int MODE> __device__ __forceinline__ void ph_norm(const NormArgs& a, LAS unsigned char* lds, int bid, int nblk) {
    LAS unsigned* lcnt = (LAS unsigned*)lds; LAS unsigned* lbase = lcnt + 8; typedef int info6[6]; LAS info6* linfo = (LAS info6*)(lds + 64);
    const int tid = otid(), lane = tid & 63, wave = tid >> 6;
    if (MODE == 1) { if (tid < 8) lcnt[tid] = 0u; __syncthreads(); }
    MoeTiles mt; if (MODE == 2) mt = moe_tiles(a.ecnt);
    for (int blk = bid; blk < T / 128; blk += nblk) {
        for (int i = 0; i < 16; ++i) {
            const int lr = wave + 8 * i, row = blk * 128 + lr, b = row / SEQ;
            const f32x4* xr = (const f32x4*)(a.xin + (size_t)row * DM) + lane;
            f32x4 v[4];
#pragma unroll
            for (int j = 0; j < 4; ++j) v[j] = xr[64 * j];
            if (MODE == 2) {
                const int* ti = a.tok + (size_t)row * 8; const int e0 = ti[0], e1 = ti[1], p0 = ti[2], p1 = ti[3]; const float g0 = __int_as_float(ti[4]), g1 = __int_as_float(ti[5]);
                const size_t s0 = (size_t)moe_tile_start(mt, e0) * 256 + p0, s1 = (size_t)moe_tile_start(mt, e1) * 256 + p1;
                const u32x2* y0 = (const u32x2*)(a.ys + s0 * DM) + lane; const u32x2* y1 = (const u32x2*)(a.ys + s1 * DM) + lane;
                const f32x4* gt = (const f32x4*)(a.gate + (size_t)b * 6144) + lane;
#pragma unroll
                for (int j = 0; j < 4; ++j) { const u32x2 a0 = y0[64 * j], a1 = y1[64 * j]; const f32x4 gv = gt[64 * j];
                    f32x4 y; y.x = g0 * bf2f(a0.x & 0xffffu) + g1 * bf2f(a1.x & 0xffffu); y.y = g0 * bf2f(a0.x >> 16) + g1 * bf2f(a1.x >> 16);
                    y.z = g0 * bf2f(a0.y & 0xffffu) + g1 * bf2f(a1.y & 0xffffu); y.w = g0 * bf2f(a0.y >> 16) + g1 * bf2f(a1.y >> 16);
                    v[j] = v[j] + gv * y; }
            }
            float ss = 0.f;
#pragma unroll
            for (int j = 0; j < 4; ++j) ss += (v[j].x * v[j].x + v[j].y * v[j].y) + (v[j].z * v[j].z + v[j].w * v[j].w);
            const float rstd = rsqrtf(wave_sum(ss) * (1.0f / DM) + EPS);
            const f32x4* gp = (const f32x4*)a.g + lane;
            if (MODE == 2) {
                f32x4* o = (f32x4*)(a.out + (size_t)row * DM) + lane;
#pragma unroll
                for (int j = 0; j < 4; ++j) o[64 * j] = v[j] * rstd * gp[64 * j];
            } else {
                const f32x4* sh = (const f32x4*)(a.shift + (size_t)b * 6144) + lane; const f32x4* sc = (const f32x4*)(a.scale + (size_t)b * 6144) + lane;
#pragma unroll
                for (int j = 0; j < 4; ++j) v[j] = v[j] * rstd * gp[64 * j] * (sc[64 * j] + 1.0f) + sh[64 * j];
                if (a.act8) { unsigned* o = (unsigned*)(a.act8 + (size_t)row * DM) + lane;
#pragma unroll
                    for (int j = 0; j < 4; ++j) o[64 * j] = pg8::pk4_fp8(v[j].x, v[j].y, v[j].z, v[j].w); }
                else { u32x2* o = (u32x2*)(a.act + (size_t)row * DM) + lane;
#pragma unroll
                    for (int j = 0; j < 4; ++j) { u32x2 w; w.x = pk2(v[j].x, v[j].y); w.y = pk2(v[j].z, v[j].w); o[64 * j] = w; } }
                if (MODE == 1) {
                    float lg[8];
#pragma unroll
                    for (int e = 0; e < 8; ++e) lg[e] = 0.f;
#pragma unroll
                    for (int j = 0; j < 4; ++j) { const float hv[4] = {v[j].x, v[j].y, v[j].z, v[j].w};
#pragma unroll
                        for (int q = 0; q < 4; ++q) { const f32x4* wr = (const f32x4*)(a.w_router + (size_t)(256 * j + 4 * lane + q) * 8); const f32x4 w0 = wr[0], w1 = wr[1];
                            lg[0] += hv[q] * w0.x; lg[1] += hv[q] * w0.y; lg[2] += hv[q] * w0.z; lg[3] += hv[q] * w0.w; lg[4] += hv[q] * w1.x; lg[5] += hv[q] * w1.y; lg[6] += hv[q] * w1.z; lg[7] += hv[q] * w1.w; } }
#pragma unroll
                    for (int e = 0; e < 8; ++e) lg[e] = wave_sum(lg[e]);
                    int e0 = 0; float v0 = lg[0];
#pragma unroll
                    for (int e = 1; e < 8; ++e) if (lg[e] > v0) { v0 = lg[e]; e0 = e; }
                    int e1 = -1; float v1 = -INFINITY;
#pragma unroll
                    for (int e = 0; e < 8; ++e) if (e != e0 && lg[e] > v1) { v1 = lg[e]; e1 = e; }
                    const float g0 = 1.0f / (1.0f + __expf(v1 - v0)), g1 = 1.0f - g0;
                    if (lane == 0) { const unsigned q0 = __hip_atomic_fetch_add(&lcnt[e0], 1u, __ATOMIC_RELAXED, __HIP_MEMORY_SCOPE_WORKGROUP), q1 = __hip_atomic_fetch_add(&lcnt[e1], 1u, __ATOMIC_RELAXED, __HIP_MEMORY_SCOPE_WORKGROUP);
                        linfo[lr][0] = e0; linfo[lr][1] = e1; linfo[lr][2] = (int)q0; linfo[lr][3] = (int)q1; linfo[lr][4] = __float_as_int(g0); linfo[lr][5] = __float_as_int(g1); }
                }
            }
        }
        if (MODE == 1) {
            __syncthreads();
            if (tid < 8) { lbase[tid] = atomicAdd(&a.ecnt[tid], lcnt[tid]); }
            __syncthreads();
            if (tid < 128) { int* ti = a.tok + (size_t)(blk * 128 + tid) * 8; const int e0 = linfo[tid][0], e1 = linfo[tid][1];
                ti[0] = e0; ti[1] = e1; ti[2] = linfo[tid][2] + (int)lbase[e0]; ti[3] = linfo[tid][3] + (int)lbase[e1]; ti[4] = linfo[tid][4]; ti[5] = linfo[tid][5]; ti[6] = 0; ti[7] = 0; }
            __syncthreads();
            if (tid < 8) lcnt[tid] = 0u;
            __syncthreads();
        }
    }
}
__device__ __forceinline__ void ph_gather(const unsigned char* act8, const int* tok, const unsigned* ecnt, unsigned char* xs8, int bid, int nblk) {
    const int lane = otid() & 63, gw = bid * 8 + (otid() >> 6), ngw = nblk * 8;
    const MoeTiles mt = moe_tiles(ecnt);
    for (int t = gw; t < T; t += ngw) {
        const int* ti = tok + (size_t)t * 8; const int e0 = ti[0], e1 = ti[1], p0 = ti[2], p1 = ti[3];
        const size_t s0 = (size_t)moe_tile_start(mt, e0) * 256 + p0, s1 = (size_t)moe_tile_start(mt, e1) * 256 + p1;
        const u32x4 a0 = ((const u32x4*)(act8 + (size_t)t * DM))[lane];
        ((u32x4*)(xs8 + s0 * DM))[lane] = a0; ((u32x4*)(xs8 + s1 * DM))[lane] = a0;
    }
    for (int i = gw; i < 8 * 256; i += ngw) { const int e = i >> 8, r = i & 255; const int cnt = (int)__hip_atomic_load(ecnt + e, __ATOMIC_RELAXED, __HIP_MEMORY_SCOPE_AGENT); const int padded = ((cnt + 255) >> 8) << 8;
        if (cnt + r < padded) { unsigned z0 = 0u; asm volatile("" : "+v"(z0)); const u32x4 z = {z0, z0, z0, z0};
            ((u32x4*)(xs8 + ((size_t)moe_tile_start(mt, e) * 256 + cnt + r) * DM))[lane] = z; } }
}

__device__ __forceinline__ void ld16(const bf16* p, float (&f)[16]) { ld8(p, &f[0]); ld8(p + 8, &f[8]); }
__device__ __forceinline__ float dot16x4(const float (&q)[16], const bf16* p) {
    float f[16]; ld16(p, f); float s0 = 0.f, s1 = 0.f;
#pragma unroll
    for (int i = 0; i < 16; i += 2) { s0 += q[i] * f[i]; s1 += q[i + 1] * f[i + 1]; }
    float s = s0 + s1; s += __shfl_xor(s, 1); s += __shfl_xor(s, 2); return s;
}
__device__ __forceinline__ void axpy16(float (&o)[16], float w, const bf16* p) {
    float f[16]; ld16(p, f);
#pragma unroll
    for (int i = 0; i < 16; ++i) o[i] += w * f[i];
}
__device__ __forceinline__ void head_norm_store16(float (&o)[16], const float* gh, bf16* dst) {
    float ss = 0.f;
#pragma unroll
    for (int i = 0; i < 16; ++i) ss += o[i] * o[i];
    ss += __shfl_xor(ss, 1); ss += __shfl_xor(ss, 2);
    const float r = rsqrtf(ss * (1.0f / 64.0f) + EPS);
#pragma unroll
    for (int i = 0; i < 2; ++i) { u32x4 w; const float* q = &o[8 * i]; const float* g = gh + 8 * i;
        w.x = pk2(q[0] * r * g[0], q[1] * r * g[1]); w.y = pk2(q[2] * r * g[2], q[3] * r * g[3]); w.z = pk2(q[4] * r * g[4], q[5] * r * g[5]); w.w = pk2(q[6] * r * g[6], q[7] * r * g[7]);
        *(u32x4*)(dst + 8 * i) = w; }
}
#define OSM_STEP(s, vrow) do { if ((s) > m) { const float a_ = __expf(m - (s)); l *= a_; _Pragma("unroll") for (int d_ = 0; d_ < 16; ++d_) o[d_] *= a_; m = (s); } \
    const float p_ = __expf((s) - m); l += p_; axpy16(o, p_, (vrow)); } while (0)
#define NAIVE_IDX() const int part = gidx & 3, idx = gidx >> 2; const int t = idx & (SEQ - 1), h = (idx >> 12) & 3, b = idx >> 14; const int po = 16 * part

__device__ __forceinline__ void sb_naive_one(const bf16* P, const float* gh, bf16* act, int gidx) {
    NAIVE_IDX();
    const bf16* Pb = P + (size_t)b * SEQ * PW + po;
    float q[16], o[16];
    ld16(Pb + (size_t)t * PW + h * 64, q);
#pragma unroll
    for (int i = 0; i < 16; ++i) o[i] = 0.f;
    float carry = 1.0f;
    for (int s = t - 1; s >= 0; --s) {
        float z = dot16x4(q, Pb + (size_t)s * PW + 256 + h * 64); z = fminf(fmaxf(z, -80.f), 80.f);
        const float e = __expf(z), om = 1.0f / (1.0f + e), beta = e * om, aw = beta * carry;
        axpy16(o, aw, Pb + (size_t)s * PW + 512 + h * 64);
        carry *= om;
        if (carry < 1e-30f) break;
    }
    head_norm_store16(o, gh + h * 64 + po, act + (size_t)(b * SEQ + t) * DM + h * 64 + po);
}
__device__ __forceinline__ void dil_naive_one(const bf16* P, const float* gh, bf16* act, int gidx) {
    NAIVE_IDX();
    const bf16* Pb = P + (size_t)b * SEQ * PW + 1536 + po;
    const float slope = alibi_slope(1, h);
    float q[16], o[16];
    ld16(Pb + (size_t)t * PW + h * 64, q);
#pragma unroll
    for (int i = 0; i < 16; ++i) o[i] = 0.f;
    float m = -INFINITY, l = 0.f;
    for (int br = 0; br < 3; ++br) { const int dil = br == 0 ? 1 : (br == 1 ? 4 : 16);
        for (int j = 0; j <= 128; ++j) { const int dist = j * dil, kp = t - dist; if (kp < 0) break;
            const float s = dot16x4(q, Pb + (size_t)kp * PW + 256 + h * 64) - slope * (float)dist;
            OSM_STEP(s, Pb + (size_t)kp * PW + 512 + h * 64); } }
    const float rl = 1.0f / l;
#pragma unroll
    for (int i = 0; i < 16; ++i) o[i] *= rl;
    head_norm_store16(o, gh + (8 + h) * 64 + po, act + (size_t)(b * SEQ + t) * DM + (8 + h) * 64 + po);
}
__device__ __forceinline__ unsigned moba_sel_one(const float (&q)[16], const float* kmean, int b, int t, int h, int po) {
    const int own = t >> 8; unsigned sel = 0u;
    if (own <= 3) sel = (1u << own) - 1u;
    else {
        float g[16];
#pragma unroll
        for (int blk = 0; blk < 16; ++blk) { float s = -INFINITY;
            if (blk < own) { const float* km = kmean + ((size_t)b * 16 + blk) * 256 + h * 64 + po; s = 0.f;
#pragma unroll
                for (int d = 0; d < 16; ++d) s += q[d] * km[d];
                s += __shfl_xor(s, 1); s += __shfl_xor(s, 2); }
            g[blk] = s; }
#pragma unroll
        for (int r = 0; r < 3; ++r) { int bi = 0; float bv = -INFINITY;
#pragma unroll
            for (int blk = 0; blk < 16; ++blk) { const bool free_ = !((sel >> blk) & 1u); if (free_ && g[blk] > bv) { bv = g[blk]; bi = blk; } }
            sel |= 1u << bi; }
    }
    return sel;
}
template <int MODE> __device__ __forceinline__ void masked_naive_one(const bf16* P, const unsigned long long* mask, const float* kmean, const float* gh, bf16* act, int gidx) {
    NAIVE_IDX();
    const int cb = MODE == 0 ? 768 : 2304, hb = MODE == 0 ? 4 : 12;
    const bf16* Pb = P + (size_t)b * SEQ * PW + cb + po;
    const float slope = alibi_slope(MODE == 0 ? 0 : 2, h);
    float q[16], o[16];
    ld16(Pb + (size_t)t * PW + h * 64, q);
#pragma unroll
    for (int i = 0; i < 16; ++i) o[i] = 0.f;
    float m = -INFINITY, l = 0.f;
    if (MODE == 0) {
        const unsigned long long* mr = mask + (size_t)(b * SEQ + t) * 64;
        for (int w = 0; w <= (t >> 6); ++w) { unsigned long long bits = mr[w];
            while (bits) { const int j = __builtin_ctzll(bits); bits &= bits - 1; const int kp = w * 64 + j;
                const float s = dot16x4(q, Pb + (size_t)kp * PW + 256 + h * 64) - slope * (float)(t - kp);
                OSM_STEP(s, Pb + (size_t)kp * PW + 512 + h * 64); } }
    } else {
        const int own = t >> 8; const unsigned sel = moba_sel_one(q, kmean, b, t, h, po);
        for (int blk = 0; blk <= own; ++blk) { if (blk < own && !((sel >> blk) & 1u)) continue;
            const int kend = blk == own ? t : blk * 256 + 255;
            for (int kp = blk * 256; kp <= kend; ++kp) {
                const float s = dot16x4(q, Pb + (size_t)kp * PW + 256 + h * 64) - slope * (float)(t - kp);
                OSM_STEP(s, Pb + (size_t)kp * PW + 512 + h * 64); } }
    }
    const float rl = 1.0f / l;
#pragma unroll
    for (int i = 0; i < 16; ++i) o[i] *= rl;
    head_norm_store16(o, gh + (hb + h) * 64 + po, act + (size_t)(b * SEQ + t) * DM + (hb + h) * 64 + po);
}
__device__ __forceinline__ void kmean_unit(const bf16* P, float* kmean, unsigned* knmax, int unit, LAS unsigned char* lds) {
    const int tid = otid();
    const int b = unit >> 4, blk = unit & 15, c = tid & 255, hf = tid >> 8;
    const bf16* p = P + ((size_t)b * SEQ + blk * 256 + hf * 128) * PW + 2304 + 256 + c;
    float s = 0.f;
    for (int r = 0; r < 128; ++r) s += bf2f(p[(size_t)r * PW]);
    LAS float* part = (LAS float*)lds;
    part[hf * 256 + c] = s;
    __syncthreads();
    if (hf == 0) kmean[(size_t)unit * 256 + c] = (part[c] + part[256 + c]) * (1.0f / 256.0f);
    { const int key = tid >> 1, mx = tid & 1; const bf16* kr = P + ((size_t)b * SEQ + blk * 256 + key) * PW + (mx ? 2304 : 768) + 256;
#pragma unroll
      for (int h = 0; h < 4; ++h) { float ss = 0.f;
#pragma unroll
          for (int c8 = 0; c8 < 8; ++c8) { float f[8]; ld8(kr + h * 64 + 8 * c8, f);
#pragma unroll
              for (int i = 0; i < 8; ++i) ss += f[i] * f[i]; }
          float nm = sqrtf(ss);
#pragma unroll
          for (int o_ = 2; o_ < 64; o_ <<= 1) nm = fmaxf(nm, __shfl_xor(nm, o_));
          if ((tid & 63) < 2) atomicMax(&knmax[(b * 2 + mx) * 4 + h], __float_as_uint(nm)); } }
    __syncthreads();
}
constexpr int DSA_LDS = 8 * 4096 * 4;
#define DSA_COUNT_GE(trial, out) do { int c_ = 0; \
    _Pragma("unroll") for (int g_ = 0; g_ < 8; ++g_) if (g_ * 8 < nreg) { \
        _Pragma("unroll") for (int r_ = 0; r_ < 8; ++r_) c_ += __builtin_popcountll(__ballot(K[g_ * 8 + r_] >= (trial))); } \
    (out) = c_; } while (0)
__device__ __forceinline__ void dsa_select_unit(const bf16* P, unsigned long long* mask, int unit, LAS unsigned* sc) {
    const int tid = otid(), lane = tid & 63, wid = tid >> 6, r32 = lane & 31, hi = lane >> 5;
    const int b = unit >> 9, t0 = (unit & 511) * 8;
    const bf16* Pb = P + (size_t)b * SEQ * PW;
    const int hrow = (r32 & 3) + 4 * ((r32 >> 3) & 1), qrow = 2 * ((r32 >> 2) & 1) + ((r32 >> 4) & 1);
    bf16x8 af[2][4];
#pragma unroll
    for (int qg = 0; qg < 2; ++qg)
#pragma unroll
        for (int s = 0; s < 4; ++s) af[qg][s] = *(const bf16x8*)(Pb + (size_t)(t0 + 4 * qg + qrow) * PW + COL_QI + hrow * 64 + 16 * s + 8 * hi);
    float wv[2][2][8];
#pragma unroll
    for (int qg = 0; qg < 2; ++qg)
#pragma unroll
        for (int qq = 0; qq < 2; ++qq) ld8(Pb + (size_t)(t0 + 4 * qg + 2 * hi + qq) * PW + COL_WI, wv[qg][qq]);
    const int ntile = (t0 + 8 + 31) >> 5;
    {
        bf16x8 bcur[4], bnxt[4];
        int kt = wid;
        if (kt < ntile) {
#pragma unroll
            for (int s = 0; s < 4; ++s) bcur[s] = *(const bf16x8*)(Pb + (size_t)(kt * 32 + r32) * PW + COL_KI + 16 * s + 8 * hi); }
        while (kt < ntile) {
            const int ktn = kt + 8;
            if (ktn < ntile) {
#pragma unroll
                for (int s = 0; s < 4; ++s) bnxt[s] = *(const bf16x8*)(Pb + (size_t)(ktn * 32 + r32) * PW + COL_KI + 16 * s + 8 * hi); }
            const int key = kt * 32 + r32;
#pragma unroll
            for (int qg = 0; qg < 2; ++qg) {
                f32x16 acc = {0.f, 0.f, 0.f, 0.f, 0.f, 0.f, 0.f, 0.f, 0.f, 0.f, 0.f, 0.f, 0.f, 0.f, 0.f, 0.f};
#pragma unroll
                for (int s = 0; s < 4; ++s) acc = __builtin_amdgcn_mfma_f32_32x32x16_bf16(af[qg][s], bcur[s], acc, 0, 0, 0);
#pragma unroll
                for (int qq = 0; qq < 2; ++qq) { float s = 0.f;
#pragma unroll
                    for (int h = 0; h < 8; ++h) s += wv[qg][qq][h] * fmaxf(acc[8 * qq + h], 0.f);
                    const int ql = 4 * qg + 2 * hi + qq;
                    const unsigned u = __float_as_uint(s); const unsigned sk = (u & 0x80000000u) ? ~u : (u | 0x80000000u);
                    sc[ql * 4096 + key] = (key <= t0 + ql) ? sk : 0u; }
            }
#pragma unroll
            for (int s = 0; s < 4; ++s) bcur[s] = bnxt[s];
            kt = ktn;
        }
    }
    __syncthreads();
    {
        const int t = t0 + wid, nvalid = t + 1, nk = ntile * 32, nreg = (nk + 63) >> 6;
        unsigned long long myword = 0ull;
        if (nvalid <= 256) {
            const int lo = lane * 64; myword = (nvalid >= lo + 64) ? ~0ull : (nvalid > lo ? ((1ull << (nvalid - lo)) - 1ull) : 0ull);
        } else {
            LAS unsigned* row = sc + wid * 4096;
            unsigned K[64];
#pragma unroll
            for (int r = 0; r < 64; ++r) K[r] = (r * 64 + lane < nk) ? row[r * 64 + lane] : 0u;
            unsigned prefix = 0u; int cnt_prefix = 4096, c_above = 0, bit = 32;
            while (bit > 0) { --bit; const unsigned trial = prefix | (1u << bit); int cnt; DSA_COUNT_GE(trial, cnt);
                if (cnt >= 256) { prefix = trial; cnt_prefix = cnt; } else c_above = cnt;
                if (cnt_prefix - c_above <= 128) break; }
            if (bit > 0) {
                const unsigned himask = ~((1u << bit) - 1u); const unsigned long long below = (1ull << lane) - 1ull; int base = 0;
#pragma unroll
                for (int g = 0; g < 8; ++g) if (g * 8 < nreg) {
#pragma unroll
                    for (int r = 0; r < 8; ++r) { const unsigned k = K[g * 8 + r]; const bool in = (k & himask) == prefix; const unsigned long long mk = __ballot(in);
                        if (in) row[base + __builtin_popcountll(mk & below)] = k; base += __builtin_popcountll(mk); } }
                const unsigned C0 = (lane < base) ? row[lane] : 0u, C1 = (64 + lane < base) ? row[64 + lane] : 0u;
                while (bit > 0) { --bit; const unsigned trial = prefix | (1u << bit);
                    const int cnt = c_above + __builtin_popcountll(__ballot(C0 >= trial)) + __builtin_popcountll(__ballot(C1 >= trial));
                    if (cnt >= 256) { prefix = trial; cnt_prefix = cnt; } }
            }
            if (cnt_prefix == 256) {
#pragma unroll
                for (int g = 0; g < 8; ++g) if (g * 8 < nreg) {
#pragma unroll
                    for (int r = 0; r < 8; ++r) { const unsigned long long word = __ballot(K[g * 8 + r] >= prefix); if (lane == g * 8 + r) myword = word; } }
            } else {
                int cgt; DSA_COUNT_GE(prefix + 1u, cgt);
                int need = 256 - cgt;
                const unsigned long long below = (1ull << lane) - 1ull;
#pragma unroll
                for (int g = 0; g < 8; ++g) if (g * 8 < nreg) {
#pragma unroll
                    for (int r = 0; r < 8; ++r) { const unsigned k = K[g * 8 + r];
                        const unsigned long long gt = __ballot(k > prefix), eq = __ballot(k == prefix);
                        const int c = __builtin_popcountll(eq); unsigned long long take;
                        if (c <= need) { take = eq; need -= c; }
                        else { const bool mine = ((eq >> lane) & 1ull) && (__builtin_popcountll(eq & below) < need); take = __ballot(mine); need = 0; }
                        const unsigned long long word = gt | take;
                        if (lane == g * 8 + r) myword = word; } }
            }
        }
        mask[(size_t)(b * SEQ + t) * 64 + lane] = myword;
    }
    __syncthreads();
}

#define MFMA32(a, b, c) __builtin_amdgcn_mfma_f32_32x32x16_bf16(a, b, c, 0, 0, 0)
__device__ __forceinline__ int crow(int r, int hi) { return (r & 3) + 8 * (r >> 2) + 4 * hi; }
constexpr int AT_KROW = 144, AT_VROW = 136;
constexpr int AT_KBUF = 64 * AT_KROW, AT_VBUF = 64 * AT_VROW;
constexpr int AT_KOFF = 0, AT_VOFF = 2 * AT_KBUF, AT_KMOFF = AT_VOFF + 2 * AT_VBUF, AT_MISC = AT_KMOFF + 4096;
typedef short s16x4 __attribute__((ext_vector_type(4)));

__device__ __forceinline__ void at_load(const bf16* Pb, int k0, int kcol, int vcol, int tid, u32x4& kr, u32x4& vr) {
    const bf16* row = Pb + (size_t)(k0 + (tid >> 3)) * PW + (tid & 7) * 8;
    kr = *(const u32x4*)(row + kcol); vr = *(const u32x4*)(row + vcol);
}
__device__ __forceinline__ void at_store(LAS unsigned char* lds, int buf, int tid, const u32x4& kr, const u32x4& vr) {
    const int key = tid >> 3, c = tid & 7;
    *(LAS u32x4*)(lds + AT_KOFF + buf * AT_KBUF + key * AT_KROW + c * 16) = kr;
    LAS unsigned short* vt = (LAS unsigned short*)(lds + AT_VOFF + buf * AT_VBUF + (8 * c) * AT_VROW + key * 2);
    vt[0 * (AT_VROW / 2)] = (unsigned short)(vr.x & 0xffffu); vt[1 * (AT_VROW / 2)] = (unsigned short)(vr.x >> 16);
    vt[2 * (AT_VROW / 2)] = (unsigned short)(vr.y & 0xffffu); vt[3 * (AT_VROW / 2)] = (unsigned short)(vr.y >> 16);
    vt[4 * (AT_VROW / 2)] = (unsigned short)(vr.z & 0xffffu); vt[5 * (AT_VROW / 2)] = (unsigned short)(vr.z >> 16);
    vt[6 * (AT_VROW / 2)] = (unsigned short)(vr.w & 0xffffu); vt[7 * (AT_VROW / 2)] = (unsigned short)(vr.w >> 16);
}
__device__ __forceinline__ f32x16 at_scores(LAS unsigned char* lds, int buf, int a, int r32, int hi, const bf16x8 (&qf)[4]) {
    f32x16 s = {0.f, 0.f, 0.f, 0.f, 0.f, 0.f, 0.f, 0.f, 0.f, 0.f, 0.f, 0.f, 0.f, 0.f, 0.f, 0.f};
    const LAS unsigned char* kp = lds + AT_KOFF + buf * AT_KBUF + (32 * a + r32) * AT_KROW + hi * 16;
#pragma unroll
    for (int sp = 0; sp < 4; ++sp) { const bf16x8 kf = *(const LAS bf16x8*)(kp + sp * 32); s = MFMA32(kf, qf[sp], s); }
    return s;
}
__device__ __forceinline__ void at_pv(LAS unsigned char* lds, int buf, int a, int r32, int hi, const f32x16& p, f32x16 (&o)[2]) {
#pragma unroll
    for (int s = 0; s < 2; ++s) {
        u32x4 w; w.x = cvt_pk_bf16(p[8 * s + 0], p[8 * s + 1]); w.y = cvt_pk_bf16(p[8 * s + 2], p[8 * s + 3]); w.z = cvt_pk_bf16(p[8 * s + 4], p[8 * s + 5]); w.w = cvt_pk_bf16(p[8 * s + 6], p[8 * s + 7]);
        const bf16x8 pf = __builtin_bit_cast(bf16x8, w);
#pragma unroll
        for (int dh = 0; dh < 2; ++dh) {
            const LAS unsigned char* vp = lds + AT_VOFF + buf * AT_VBUF + (32 * dh + r32) * AT_VROW + (32 * a + 16 * s + 4 * hi) * 2;
            const s16x4 v0 = *(const LAS s16x4*)vp, v1 = *(const LAS s16x4*)(vp + 16);
            const bf16x8 vf = {v0[0], v0[1], v0[2], v0[3], v1[0], v1[1], v1[2], v1[3]};
            o[dh] = MFMA32(vf, pf, o[dh]);
        }
    }
}
__device__ __forceinline__ void at_finish(f32x16 (&o)[2], float inv_l, int hi, const float* gh, bf16* dst) {
    float ss = 0.f;
#pragma unroll
    for (int dh = 0; dh < 2; ++dh)
#pragma unroll
        for (int r = 0; r < 16; ++r) { o[dh][r] *= inv_l; ss += o[dh][r] * o[dh][r]; }
    ss += __shfl_xor(ss, 32);
    const float rn = rsqrtf(ss * (1.0f / 64.0f) + EPS);
#pragma unroll
    for (int dh = 0; dh < 2; ++dh)
#pragma unroll
        for (int g = 0; g < 4; ++g) { const int d = 32 * dh + 8 * g + 4 * hi; const f32x4 gv = *(const f32x4*)(gh + d);
            u32x2 w; w.x = cvt_pk_bf16(o[dh][4 * g + 0] * rn * gv.x, o[dh][4 * g + 1] * rn * gv.y); w.y = cvt_pk_bf16(o[dh][4 * g + 2] * rn * gv.z, o[dh][4 * g + 3] * rn * gv.w);
            *(u32x2*)(dst + d) = w; }
}

constexpr float LOG2E = 1.4426950408889634f;
template <int MODE> __device__ __forceinline__ void attn_masked_unit(const bf16* P, const unsigned long long* mask, const float* kmean, const unsigned* knmax, const float* gh16, bf16* act, int b, int h, int qb, LAS unsigned char* lds) {
    const int tid = otid(), lane = tid & 63, wid = tid >> 6, r32 = lane & 31, hi = lane >> 5;
    const int cb = MODE == 0 ? 768 : 2304, hb = MODE == 0 ? 4 : 12;
    const bf16* Pb = P + (size_t)b * SEQ * PW + cb;
    const int kcol = 256 + h * 64, vcol = 512 + h * 64;
    const int q0 = qb * 256, tq = q0 + 32 * wid + r32, qmax = q0 + 32 * wid + 31;
    const float slope2 = alibi_slope(MODE == 0 ? 0 : 2, h) * LOG2E;
    bf16x8 qf[4];
#pragma unroll
    for (int sp = 0; sp < 4; ++sp) qf[sp] = *(const bf16x8*)(Pb + (size_t)tq * PW + h * 64 + 16 * sp + 8 * hi);
    float qn2 = 0.f;
#pragma unroll
    for (int sp = 0; sp < 4; ++sp)
#pragma unroll
        for (int i = 0; i < 8; ++i) { const float v = bf2f((unsigned)(unsigned short)qf[sp][i]); qn2 += v * v; }
    qn2 += __shfl_xor(qn2, 32);
    const float bound0 = sqrtf(qn2) * __uint_as_float(knmax[(b * 2 + MODE) * 4 + h]) * 1.01f + 1e-3f;
    LAS unsigned* misc = (LAS unsigned*)(lds + AT_MISC);
    unsigned sel = 0u, wgsel = 0xffffu;
    if (tid < 8) misc[tid] = 0u;
    if (MODE == 1) {
        LAS float* km = (LAS float*)(lds + AT_KMOFF);
        for (int i = tid; i < 16 * 64; i += 512) km[i] = kmean[((size_t)b * 16 + (i >> 6)) * 256 + h * 64 + (i & 63)];
        __syncthreads();
        if (qb <= 3) sel = (1u << qb) - 1u;
        else {
            u32x4 qraw[8];
#pragma unroll
            for (int c = 0; c < 8; ++c) qraw[c] = *(const u32x4*)(Pb + (size_t)tq * PW + h * 64 + 8 * c);
            float v1 = -INFINITY, v2 = -INFINITY, v3 = -INFINITY; int i1 = 0, i2 = 0, i3 = 0;
            for (int blk = 0; blk < qb; ++blk) {
                const LAS float* kb = km + blk * 64; float g0 = 0.f, g1 = 0.f;
#pragma unroll
                for (int c = 0; c < 8; ++c) { const u32x4 u = qraw[c];
                    g0 += __uint_as_float(u.x << 16) * kb[8 * c + 0]; g1 += __uint_as_float(u.x & 0xffff0000u) * kb[8 * c + 1];
                    g0 += __uint_as_float(u.y << 16) * kb[8 * c + 2]; g1 += __uint_as_float(u.y & 0xffff0000u) * kb[8 * c + 3];
                    g0 += __uint_as_float(u.z << 16) * kb[8 * c + 4]; g1 += __uint_as_float(u.z & 0xffff0000u) * kb[8 * c + 5];
                    g0 += __uint_as_float(u.w << 16) * kb[8 * c + 6]; g1 += __uint_as_float(u.w & 0xffff0000u) * kb[8 * c + 7]; }
                const float g = g0 + g1;
                if (g > v1) { v3 = v2; i3 = i2; v2 = v1; i2 = i1; v1 = g; i1 = blk; }
                else if (g > v2) { v3 = v2; i3 = i2; v2 = g; i2 = blk; }
                else if (g > v3) { v3 = g; i3 = blk; }
            }
            sel = (1u << i1) | (1u << i2) | (1u << i3);
        }
        unsigned ws_ = sel;
#pragma unroll
        for (int o_ = 1; o_ < 64; o_ <<= 1) ws_ |= (unsigned)__shfl_xor((int)ws_, o_);
        if (lane == 0) __hip_atomic_fetch_or(&misc[0], ws_, __ATOMIC_RELAXED, __HIP_MEMORY_SCOPE_WORKGROUP);
        __syncthreads();
        wgsel = misc[0] | (1u << qb);
    }
    float cr[16];
#pragma unroll
    for (int r = 0; r < 16; ++r) cr[r] = slope2 * (float)((r & 3) + 8 * (r >> 2));
    f32x16 o[2];
#pragma unroll
    for (int r = 0; r < 16; ++r) { o[0][r] = 0.f; o[1][r] = 0.f; }
    float m = -INFINITY, l = 0.f; bool done = false;
    const unsigned long long* mrow = mask + (size_t)(b * SEQ + tq) * 64;
#define AT_NEXT(x, y) do { (y) = (x) - 1; if (MODE == 1) { while ((y) >= 0 && !((wgsel >> ((y) >> 2)) & 1u)) (y) -= 4; } } while (0)
    int t = 4 * qb + 3, tn, tn2;
    u32x4 kr, vr, kr2, vr2;
    at_load(Pb, t * 64, kcol, vcol, tid, kr, vr);
    unsigned long long mw = (MODE == 0) ? mrow[t] : 0ull, mwn = 0ull, mwn2 = 0ull;
    at_store(lds, 0, tid, kr, vr);
    AT_NEXT(t, tn);
    if (tn >= 0) { at_load(Pb, tn * 64, kcol, vcol, tid, kr, vr); if (MODE == 0) mwn = mrow[tn]; }
    __syncthreads();
    int buf = 0, it = 0;
#define AT_STEP(KA, VA, MA, KB, VB, MB) { \
        tn2 = -1; if (tn >= 0) AT_NEXT(tn, tn2); \
        if (tn2 >= 0) { at_load(Pb, tn2 * 64, kcol, vcol, tid, KB, VB); if (MODE == 0) MB = mrow[tn2]; } \
        at_compute(); \
        if (lane == 0 && (done || tn < 0)) __hip_atomic_fetch_add(&misc[4 + it % 3], 1u, __ATOMIC_RELAXED, __HIP_MEMORY_SCOPE_WORKGROUP); \
        if (tid == 0) misc[4 + (it + 1) % 3] = 0u; \
        if (tn >= 0) at_store(lds, buf ^ 1, tid, KA, VA); \
        __syncthreads(); \
        nd = misc[4 + it % 3]; \
        buf ^= 1; t = tn; tn = tn2; mw = MA; ++it; }
    auto at_compute = [&]() __attribute__((always_inline)) {
        const int k0 = t * 64; const bool own = t >= 4 * qb;
        if (!done && k0 <= qmax) {
            const float ub = bound0 + slope2 * (float)(k0 + 63 - tq);
#if defined(PROBE_SUB) && PROBE_SUB == 6
            if (!own && __all(ub - m < -1e30f)) done = true;
#else
            if (!own && __all(ub - m < -151.0f)) done = true;
#endif
            else if (MODE == 0 || own || __any((sel >> (t >> 2)) & 1u)) {
                f32x16 s0 = at_scores(lds, buf, 0, r32, hi, qf), s1 = at_scores(lds, buf, 1, r32, hi, qf);
                float tb0 = slope2 * (float)(k0 + 4 * hi - tq);
                if (MODE == 1 && !own && !((sel >> (t >> 2)) & 1u)) tb0 = -INFINITY;
                const float tb1 = tb0 + 32.0f * slope2;
                float mx0 = -INFINITY, mx1 = -INFINITY;
                const unsigned wlo = (unsigned)(mw >> (4 * hi)), whi = (unsigned)(mw >> (32 + 4 * hi));
                const int lim = tq - k0 - 4 * hi;
#pragma unroll
                for (int r = 0; r < 16; ++r) { const int kk = (r & 3) + 8 * (r >> 2);
                    float x0 = s0[r] + cr[r], x1 = s1[r] + cr[r];
                    if (MODE == 0) { x0 = (wlo & (1u << kk)) ? x0 : -INFINITY; x1 = (whi & (1u << kk)) ? x1 : -INFINITY; }
                    else if (own) { x0 = (kk <= lim) ? x0 : -INFINITY; x1 = (kk + 32 <= lim) ? x1 : -INFINITY; }
                    s0[r] = x0; s1[r] = x1; mx0 = fmaxf(mx0, x0); mx1 = fmaxf(mx1, x1); }
                float mx = fmaxf(mx0 + tb0, mx1 + tb1);
                mx = fmaxf(mx, __shfl_xor(mx, 32));
                if (__any(mx - m > 8.0f)) {
                    const float mn = fmaxf(m, mx), alpha = (mn == -INFINITY) ? 1.0f : exp2f(m - mn);
                    l *= alpha; m = mn;
#pragma unroll
                    for (int r = 0; r < 16; ++r) { o[0][r] *= alpha; o[1][r] *= alpha; } }
                const float mt0 = (m == -INFINITY) ? INFINITY : m - tb0, mt1 = (m == -INFINITY) ? INFINITY : m - tb1;
                float ps = 0.f;
#pragma unroll
                for (int r = 0; r < 16; ++r) { s0[r] = __builtin_amdgcn_exp2f(s0[r] - mt0); s1[r] = __builtin_amdgcn_exp2f(s1[r] - mt1); ps += s0[r] + s1[r]; }
                l += ps;
                at_pv(lds, buf, 0, r32, hi, s0, o);
                at_pv(lds, buf, 1, r32, hi, s1, o);
            }
        }
    };
    unsigned nd = 0u;
    while (t >= 0) {
        AT_STEP(kr, vr, mwn, kr2, vr2, mwn2);
        if (nd == 8u || t < 0) break;
        AT_STEP(kr2, vr2, mwn2, kr, vr, mwn);
        if (nd == 8u) break;
    }
#undef AT_STEP
#undef AT_NEXT
    l += __shfl_xor(l, 32);
    at_finish(o, 1.0f / l, hi, gh16 + (hb + h) * 64, act + (size_t)(b * SEQ + tq) * DM + (hb + h) * 64);
    __syncthreads();
}

template <int DUMMY> __device__ __forceinline__ void attn_sb_unit(const bf16* P, const float* gh16, bf16* act, int b, int h, int qb, LAS unsigned char* lds) {
    const int tid = otid(), lane = tid & 63, wid = tid >> 6, r32 = lane & 31, hi = lane >> 5;
    const bf16* Pb = P + (size_t)b * SEQ * PW;
    const int kcol = 256 + h * 64, vcol = 512 + h * 64;
    const int q0 = qb * 256, tq = q0 + 32 * wid + r32, qmax = q0 + 32 * wid + 31;
    bf16x8 qf[4];
#pragma unroll
    for (int sp = 0; sp < 4; ++sp) qf[sp] = *(const bf16x8*)(Pb + (size_t)tq * PW + h * 64 + 16 * sp + 8 * hi);
    LAS unsigned* vote = (LAS unsigned*)(lds + AT_MISC);
    if (tid < 3) vote[tid] = 0u;
    f32x16 o[2];
#pragma unroll
    for (int r = 0; r < 16; ++r) { o[0][r] = 0.f; o[1][r] = 0.f; }
    float carry = 1.0f; bool done = false;
    int t = 4 * qb + 3;
    u32x4 kr, vr;
    at_load(Pb, t * 64, kcol, vcol, tid, kr, vr);
    at_store(lds, 0, tid, kr, vr);
    __syncthreads();
    int buf = 0, it = 0;
    while (t >= 0) {
        const int tn = t - 1;
        if (tn >= 0) at_load(Pb, tn * 64, kcol, vcol, tid, kr, vr);
        const int k0 = t * 64;
        if (!done && k0 < qmax) {
#pragma unroll
            for (int ai = 0; ai < 2; ++ai) { const int a = 1 - ai, ks = k0 + 32 * a;
                if (ks < qmax) {
                    f32x16 s = at_scores(lds, buf, a, r32, hi, qf);
                    float G[4];
#pragma unroll
                    for (int g = 0; g < 4; ++g) { float gp = 1.0f;
#pragma unroll
                        for (int i = 0; i < 4; ++i) { const int r = 4 * g + i; const int kp = ks + 8 * g + 4 * hi + i; const bool valid = kp < tq;
                            const float z = fminf(fmaxf(s[r], -80.f), 80.f); const float e = __expf(z); float om = __builtin_amdgcn_rcpf(1.0f + e); float beta = e * om;
                            om = valid ? om : 1.0f; beta = valid ? beta : 0.0f;
                            s[r] = beta; gp *= om; }
                        G[g] = gp; }
                    float Gp[4];
#pragma unroll
                    for (int g = 0; g < 4; ++g) Gp[g] = __shfl_xor(G[g], 32);
                    float SP[4]; SP[3] = 1.0f;
#pragma unroll
                    for (int g = 2; g >= 0; --g) SP[g] = SP[g + 1] * (G[g + 1] * Gp[g + 1]);
                    const float tot = SP[0] * (G[0] * Gp[0]);
#pragma unroll
                    for (int g = 0; g < 4; ++g) { float suf = carry * SP[g] * (hi ? 1.0f : Gp[g]);
#pragma unroll
                        for (int i = 3; i >= 0; --i) { const int r = 4 * g + i; const float beta = s[r]; s[r] = beta * suf; suf *= (1.0f - beta); } }
                    carry *= tot;
                    at_pv(lds, buf, a, r32, hi, s, o);
                }
            }
            done = __all(carry < 1e-30f);
        }
        if (lane == 0 && (done || k0 == 0)) __hip_atomic_fetch_add(&vote[it % 3], 1u, __ATOMIC_RELAXED, __HIP_MEMORY_SCOPE_WORKGROUP);
        if (tid == 0) vote[(it + 1) % 3] = 0u;
        if (tn >= 0) at_store(lds, buf ^ 1, tid, kr, vr);
        __syncthreads();
        const unsigned nd = vote[it % 3];
        buf ^= 1; t = tn; ++it;
        if (nd == 8u) break;
    }
    at_finish(o, 1.0f, hi, gh16 + h * 64, act + (size_t)(b * SEQ + tq) * DM + h * 64);
    __syncthreads();
}

constexpr int DL_VROW = 72, DL_VT = 0, DL_VTW = 64 * DL_VROW, DL_CB = 8 * DL_VTW, DL_CBROW = 65, DL_ML = DL_CB + 256 * DL_CBROW * 4;
template <int BR> __device__ __forceinline__ int dl_kpos(int rho, int j, int q0, int wid) {
    if (BR == 0) return q0 + 32 * wid - 128 + 32 * j + rho;
    if (BR == 1) return q0 + (wid & 3) + 4 * (32 * (wid >> 2) - 128 + 32 * j + rho);
    return q0 + 2 * wid + (rho >> 4) + 16 * (-128 + 16 * j + (rho & 15));
}
template <int BR> __device__ __forceinline__ void dilated_branch(const bf16* Pb, int h, int q0, float slope, LAS unsigned char* lds, int wid, int r32, int hi, const float* ghh, bf16* actb) {
    constexpr int R = BR == 0 ? 1 : (BR == 1 ? 4 : 16), W = 128 * R, NSUB = BR == 2 ? 9 : 5;
    const int qpos = BR == 0 ? q0 + 32 * wid + r32 : (BR == 1 ? q0 + (wid & 3) + 4 * (32 * (wid >> 2) + r32) : q0 + 2 * wid + (r32 >> 4) + 16 * (r32 & 15));
    bf16x8 qf[4];
#pragma unroll
    for (int sp = 0; sp < 4; ++sp) qf[sp] = *(const bf16x8*)(Pb + (size_t)qpos * PW + h * 64 + 16 * sp + 8 * hi);
    LAS unsigned char* vt = lds + DL_VT + wid * DL_VTW;
    f32x16 o[2];
#pragma unroll
    for (int r = 0; r < 16; ++r) { o[0][r] = 0.f; o[1][r] = 0.f; }
    float m = -INFINITY, l = 0.f;
    bf16x8 kf[4], kn[4]; u32x4 vv[4], vn[4];
    { const int kp0 = dl_kpos<BR>(r32, 0, q0, wid); const bf16* krow = Pb + (size_t)(kp0 < 0 ? 0 : kp0) * PW;
#pragma unroll
      for (int sp = 0; sp < 4; ++sp) kf[sp] = *(const bf16x8*)(krow + 256 + h * 64 + 16 * sp + 8 * hi);
#pragma unroll
      for (int i = 0; i < 4; ++i) vv[i] = *(const u32x4*)(krow + 512 + h * 64 + 32 * hi + 8 * i); }
    for (int j = 0; j < NSUB; ++j) {
        if (j + 1 < NSUB) {
            const int kp1 = dl_kpos<BR>(r32, j + 1, q0, wid); const bf16* krow = Pb + (size_t)(kp1 < 0 ? 0 : kp1) * PW;
#pragma unroll
            for (int sp = 0; sp < 4; ++sp) kn[sp] = *(const bf16x8*)(krow + 256 + h * 64 + 16 * sp + 8 * hi);
#pragma unroll
            for (int i = 0; i < 4; ++i) vn[i] = *(const u32x4*)(krow + 512 + h * 64 + 32 * hi + 8 * i); }
        f32x16 s = {0.f, 0.f, 0.f, 0.f, 0.f, 0.f, 0.f, 0.f, 0.f, 0.f, 0.f, 0.f, 0.f, 0.f, 0.f, 0.f};
#pragma unroll
        for (int sp = 0; sp < 4; ++sp) s = MFMA32(kf[sp], qf[sp], s);
#pragma unroll
        for (int i = 0; i < 4; ++i) { LAS unsigned short* w = (LAS unsigned short*)(vt + (32 * hi + 8 * i) * DL_VROW + r32 * 2);
            w[0 * (DL_VROW / 2)] = (unsigned short)(vv[i].x & 0xffffu); w[1 * (DL_VROW / 2)] = (unsigned short)(vv[i].x >> 16);
            w[2 * (DL_VROW / 2)] = (unsigned short)(vv[i].y & 0xffffu); w[3 * (DL_VROW / 2)] = (unsigned short)(vv[i].y >> 16);
            w[4 * (DL_VROW / 2)] = (unsigned short)(vv[i].z & 0xffffu); w[5 * (DL_VROW / 2)] = (unsigned short)(vv[i].z >> 16);
            w[6 * (DL_VROW / 2)] = (unsigned short)(vv[i].w & 0xffffu); w[7 * (DL_VROW / 2)] = (unsigned short)(vv[i].w >> 16); }
        float mx = -INFINITY;
#pragma unroll
        for (int r = 0; r < 16; ++r) { const int kp = dl_kpos<BR>(crow(r, hi), j, q0, wid); const int d = qpos - kp;
            const bool valid = (kp >= 0) && (d >= 0) && (d <= W) && ((d & (R - 1)) == 0);
            s[r] = valid ? s[r] - slope * (float)d : -INFINITY; mx = fmaxf(mx, s[r]); }
        mx = fmaxf(mx, __shfl_xor(mx, 32));
        const float mn = fmaxf(m, mx), mu = (mn == -INFINITY) ? 0.f : mn;
        const float alpha = __builtin_amdgcn_exp2f(m - mu);
        float ps = 0.f;
#pragma unroll
        for (int r = 0; r < 16; ++r) { s[r] = __builtin_amdgcn_exp2f(s[r] - mu); ps += s[r]; }
        l = l * alpha + ps; m = mn;
#pragma unroll
        for (int r = 0; r < 16; ++r) { o[0][r] *= alpha; o[1][r] *= alpha; }
        asm volatile("s_waitcnt lgkmcnt(0)" ::: "memory");
#pragma unroll
        for (int sk = 0; sk < 2; ++sk) {
            u32x4 w; w.x = cvt_pk_bf16(s[8 * sk + 0], s[8 * sk + 1]); w.y = cvt_pk_bf16(s[8 * sk + 2], s[8 * sk + 3]); w.z = cvt_pk_bf16(s[8 * sk + 4], s[8 * sk + 5]); w.w = cvt_pk_bf16(s[8 * sk + 6], s[8 * sk + 7]);
            const bf16x8 pf = __builtin_bit_cast(bf16x8, w);
#pragma unroll
            for (int dh = 0; dh < 2; ++dh) { const LAS unsigned char* vp = vt + (32 * dh + r32) * DL_VROW + (16 * sk + 4 * hi) * 2;
                const s16x4 v0 = *(const LAS s16x4*)vp, v1 = *(const LAS s16x4*)(vp + 16);
                const bf16x8 vf = {v0[0], v0[1], v0[2], v0[3], v1[0], v1[1], v1[2], v1[3]};
                o[dh] = MFMA32(vf, pf, o[dh]); } }
        asm volatile("s_waitcnt lgkmcnt(0)" ::: "memory");
#pragma unroll
        for (int i = 0; i < 4; ++i) { kf[i] = kn[i]; vv[i] = vn[i]; }
    }
    l += __shfl_xor(l, 32);
    const int qi = qpos - q0;
    LAS float* cb = (LAS float*)(lds + DL_CB) + qi * DL_CBROW; LAS float* ml = (LAS float*)(lds + DL_ML);
    if (BR > 0) {
        const float M0 = ml[qi], L0 = ml[256 + qi];
        const float mn = fmaxf(M0, m), a0 = __builtin_amdgcn_exp2f(M0 - mn), a1 = __builtin_amdgcn_exp2f(m - mn);
#pragma unroll
        for (int dh = 0; dh < 2; ++dh)
#pragma unroll
            for (int r = 0; r < 16; ++r) o[dh][r] = o[dh][r] * a1 + cb[32 * dh + crow(r, hi)] * a0;
        l = l * a1 + L0 * a0; m = mn;
    }
    if (BR < 2) {
        __syncthreads();
#pragma unroll
        for (int dh = 0; dh < 2; ++dh)
#pragma unroll
            for (int r = 0; r < 16; ++r) cb[32 * dh + crow(r, hi)] = o[dh][r];
        if (hi == 0) { ml[qi] = m; ml[256 + qi] = l; }
        __syncthreads();
    } else {
        at_finish(o, 1.0f / l, hi, ghh, actb + (size_t)qpos * DM);
    }
}
__device__ __forceinline__ void attn_dilated_unit(const bf16* P, const float* gh16, bf16* act, int b, int h, int qb, LAS unsigned char* lds) {
    const int tid = otid(), lane = tid & 63, wid = tid >> 6, r32 = lane & 31, hi = lane >> 5;
    const bf16* Pb = P + (size_t)b * SEQ * PW + 1536;
    const float slope = alibi_slope(1, h) * LOG2E;
    const float* ghh = gh16 + (8 + h) * 64; bf16* actb = act + (size_t)b * SEQ * DM + (8 + h) * 64;
    dilated_branch<0>(Pb, h, qb * 256, slope, lds, wid, r32, hi, ghh, actb);
    dilated_branch<1>(Pb, h, qb * 256, slope, lds, wid, r32, hi, ghh, actb);
    dilated_branch<2>(Pb, h, qb * 256, slope, lds, wid, r32, hi, ghh, actb);
    __syncthreads();
}

#ifndef MK_SPLIT
#define MK_SPLIT 0
#endif
constexpr int MISC_OFF = 131072, LDS_BYTES = 131072 + 1024;
constexpr int N_PHASES = 19;
struct MegaArgs { const float* in[17]; float* out; unsigned char* ws; int ph_lo, ph_hi, li, pad; };

__global__ void __launch_bounds__(512, 2) mega_fwd(MegaArgs a) {
    extern __shared__ __attribute__((aligned(16))) unsigned char lds_raw[];
    LAS unsigned char* lds = (LAS unsigned char*)lds_raw;
    volatile LAS unsigned* MISC = (volatile LAS unsigned*)(lds + MISC_OFF);
    const int tid = threadIdx.x, bid = blockIdx.x, nblk = gridDim.x;
    for (int u = tid; u < (LDS_BYTES - MISC_OFF) / 4; u += 512) MISC[u] = 0u;
    __syncthreads();
    if (tid < 17) { const unsigned long long p = (unsigned long long)a.in[tid]; MISC[64 + 2 * tid] = (unsigned)p; MISC[65 + 2 * tid] = (unsigned)(p >> 32); }
    __syncthreads();
#define INP(i) ((const float*)(((unsigned long long)(unsigned)__builtin_amdgcn_readfirstlane((int)MISC[65 + 2 * (i)]) << 32) | (unsigned long long)(unsigned)__builtin_amdgcn_readfirstlane((int)MISC[64 + 2 * (i)])))
    unsigned char* ws = a.ws;
    unsigned* ctl = (unsigned*)(ws + WS_CTL);
    XcdBarrier bar; bar.bar = ctl + CW_BAR + a.li * XCD_BAR_WORDS; bar.x = 0; bar.st = nullptr;
    if (!MK_SPLIT) bar = xcd_barrier_post(ctl + CW_BAR + a.li * XCD_BAR_WORDS, MISC + 8);
    const int lo = a.ph_lo, hi = a.ph_hi;
#define RUN(k) (lo <= (k) && (k) < hi)
#define SEAM(k) do { if (RUN(k) && RUN((k) + 1)) { if (!MK_SPLIT) xcd_barrier(bar); } } while (0)
    float* out = a.out;
    float* mod = (float*)(ws + WS_MOD); float* kmean = (float*)(ws + WS_KMEAN); const float* gv = (const float*)(ws + WS_GV);
    int* tok = (int*)(ws + WS_TOK); bf16* act = (bf16*)(ws + WS_ACT); bf16* P = (bf16*)(ws + WS_P); bf16* hid = (bf16*)(ws + WS_HID); unsigned char* xs = ws + WS_XS; bf16* ys = (bf16*)(ws + WS_YS);
    unsigned long long* mask = (unsigned long long*)(ws + WS_MASK); unsigned* ecnt = ctl + CW_ECNT;

    if (RUN(0)) {
        PrepArgs pa{INP(5), INP(7), INP(9), INP(10), INP(11), INP(13), INP(14), INP(15), ws};
        ph_prep(pa, lds, bid, nblk);
        __syncthreads();
        ph_mod(INP(1), INP(2), INP(3), mod, lds, bid, nblk);
        { float* gvw = (float*)(ws + WS_GV); const float* s4 = INP(4); const float* s6 = INP(6); const float* s8 = INP(8); const float* s16 = INP(16);
          for (int i = bid * 512 + otid(); i < 7168; i += nblk * 512) gvw[i] = i < 2048 ? s4[i] : (i < 4096 ? s6[i - 2048] : (i < 6144 ? s8[i - 4096] : s16[i - 6144])); }
    }
    SEAM(0);
    for (int l = 0; l < NLAYER; ++l) {
        const int pb = 1 + 8 * l;
        const float* ml = mod + (size_t)l * 8 * 6144; const float* xin = (l == 0) ? INP(0) : out; const float* gh = gv + 2048 + l * 1024;
        if (RUN(pb)) { NormArgs na{}; na.xin = xin; na.g = gv + l * DM; na.shift = ml; na.scale = ml + 1024; na.act = act; ph_norm<0>(na, lds, bid, nblk); }
        SEAM(pb);
        if (RUN(pb + 1)) { pg8::Gemm g{act, (const bf16*)(ws + WS_WIN) + (size_t)l * PW * DM, T, PW, DM}; pg8::StaticOrder S; S.init(T, PW, nblk, bid);
            pg8::EpiBf16 E{P, PW, 0}; pg8::gemm_phase<pg8::EpiBf16, pg8::StaticOrder, true, true>(lds, g, S, E); }
        SEAM(pb + 1);
        if (RUN(pb + 2)) {
            for (int u = bid, r = 0; u < NB * 512; u += nblk, ++r) { const int unit = (r & 1) ? (r * nblk + nblk - 1 - bid) : u; if (unit < NB * 512) dsa_select_unit(P, mask, unit, (LAS unsigned*)lds); }
            for (int unit = bid; unit < NB * 16; unit += nblk) kmean_unit(P, kmean, ctl + CW_KNMAX + l * 64, unit, lds);
#if defined(PROBE_SUB) && PROBE_SUB == 1
            if (l == 1) for (int u = bid, r = 0; u < NB * 512; u += nblk, ++r) { const int unit = (r & 1) ? (r * nblk + nblk - 1 - bid) : u; if (unit < NB * 512) dsa_select_unit(P, mask, unit, (LAS unsigned*)lds); }
#endif
#if defined(PROBE_SUB) && PROBE_SUB == 2
            if (l == 1) for (int u = bid; u < 512; u += nblk) attn_sb_unit<0>(P, gh, act, u & 7, (u >> 3) & 3, u >> 5, lds);
#endif
#if defined(PROBE_SUB) && PROBE_SUB == 3
            if (l == 1) for (int u = bid; u < 512; u += nblk) attn_dilated_unit(P, gh, act, u & 7, (u >> 3) & 3, u >> 5, lds);
#endif
#ifndef NO_SB
            for (int u = bid; u < 512; u += nblk) attn_sb_unit<0>(P, gh, act, u & 7, (u >> 3) & 3, u >> 5, lds);
#endif
#ifndef NO_DIL
            for (int u = bid; u < 512; u += nblk) attn_dilated_unit(P, gh, act, u & 7, (u >> 3) & 3, u >> 5, lds);
#endif
        }
        SEAM(pb + 2);
        if (RUN(pb + 3)) {
            LAS unsigned* qslot = (LAS unsigned*)(lds + AT_MISC + 64);
            for (;;) { if (otid() == 0) qslot[0] = atomicAdd(&ctl[CW_QUEUE + 2 * l], 1u);
                __syncthreads(); const unsigned u = qslot[0]; __syncthreads();
                if (u >= 512u) break;
                attn_masked_unit<0>(P, mask, kmean, ctl + CW_KNMAX + l * 64, gh, act, (int)(u & 7u), 3 - (int)((u >> 3) & 3u), 15 - (int)(u >> 5), lds); }
#if defined(PROBE_SUB) && PROBE_SUB == 4
            if (l == 1) for (;;) { if (otid() == 0) qslot[0] = atomicAdd(&ctl[CW_QUEUE + 8], 1u);
                __syncthreads(); const unsigned u = qslot[0]; __syncthreads();
                if (u >= 512u) break;
                attn_masked_unit<0>(P, mask, kmean, ctl + CW_KNMAX + l * 64, gh, act, (int)(u & 7u), 3 - (int)((u >> 3) & 3u), 15 - (int)(u >> 5), lds); }
#endif
#if defined(PROBE_SUB) && PROBE_SUB == 5
            if (l == 1) for (;;) { if (otid() == 0) qslot[0] = atomicAdd(&ctl[CW_QUEUE + 8], 1u);
                __syncthreads(); const unsigned u = qslot[0]; __syncthreads();
                if (u >= 512u) break;
                attn_masked_unit<1>(P, mask, kmean, ctl + CW_KNMAX + l * 64, gh, act, (int)(u & 7u), 3 - (int)((u >> 3) & 3u), 15 - (int)(u >> 5), lds); }
#endif
            for (;;) { if (otid() == 0) qslot[0] = atomicAdd(&ctl[CW_QUEUE + 2 * l + 1], 1u);
                __syncthreads(); const unsigned u = qslot[0]; __syncthreads();
                if (u >= 512u) break;
                attn_masked_unit<1>(P, mask, kmean, ctl + CW_KNMAX + l * 64, gh, act, (int)(u & 7u), 3 - (int)((u >> 3) & 3u), 15 - (int)(u >> 5), lds); }
        }
        SEAM(pb + 3);
        if (RUN(pb + 4)) { pg8::Gemm g{act, (const bf16*)(ws + WS_WOUT) + (size_t)l * DM * DM, T, DM, DM}; pg8::StaticOrder S; S.init(T, DM, nblk, bid);
            pg8::EpiRes E{xin, out, ml + 2048}; pg8::gemm_phase<pg8::EpiRes, pg8::StaticOrder, true, true>(lds, g, S, E); }
        SEAM(pb + 4);
        if (l == 0) {
            if (RUN(6)) { NormArgs na{}; na.xin = out; na.g = gv + 4096; na.shift = ml + 3072; na.scale = ml + 4096; na.act8 = (unsigned char*)act; ph_norm<0>(na, lds, bid, nblk); }
            SEAM(6);
#ifndef NO_FF
            if (RUN(7)) { pg8::Gemm g{act, (const bf16*)(ws + WS_WFU), T, 2 * DFF, DM}; pg8::StaticOrder S; S.init(T, 2 * DFF, nblk, bid);
                pg8::EpiSwiGLU8 E{(unsigned char*)hid, DFF, 0}; pg8::gemm_phase<pg8::EpiSwiGLU8, pg8::StaticOrder, true, true, true, 0x7A7A7A7A>(lds, g, S, E); }
            SEAM(7);
            if (RUN(8)) { pg8::Gemm g{hid, (const bf16*)(ws + WS_WFD), T, DM, DFF}; pg8::StaticOrder S; S.init(T, DM, nblk, bid);
                pg8::EpiRes E{out, out, ml + 5120}; pg8::gemm_phase<pg8::EpiRes, pg8::StaticOrder, true, true, true, 0x79797979>(lds, g, S, E); }
            SEAM(8);
#endif
        } else {
            if (RUN(14)) { NormArgs na{}; na.xin = out; na.g = gv + 4096 + DM; na.shift = ml + 3072; na.scale = ml + 4096; na.act8 = (unsigned char*)act; na.w_router = INP(12); na.tok = tok; na.ecnt = ecnt;
                ph_norm<1>(na, lds, bid, nblk); }
            SEAM(14);
            if (RUN(15)) ph_gather((const unsigned char*)act, tok, ecnt, xs, bid, nblk);
            SEAM(15);
            if (RUN(16) || RUN(17)) {
                LAS unsigned char* etab = lds + MISC_OFF + 512;
                int ntot;
                { const MoeTiles mt = moe_tiles(ecnt); ntot = moe_tile_start(mt, 7) + mt.p7;
                  const int t_ = otid(); if (t_ < XS_TILES) { int e_ = 0;
#pragma unroll
                      for (int k = 1; k < 8; ++k) e_ += (t_ >= moe_tile_start(mt, k)) ? 1 : 0;
                      etab[t_] = (unsigned char)e_; }
                  __syncthreads(); }
                pg8::MoeOrder S; S.nrt = ntot; S.G = nblk; S.c = bid; S.etab = etab;
                if (RUN(16)) { S.nN = 28; S.estride = (size_t)7168 * DM;
                    pg8::Gemm g{(const bf16*)xs, (const bf16*)(ws + WS_WEU), 0, 0, DM};
                    pg8::EpiSwiGLU8 E{(unsigned char*)hid, DFE, 0}; pg8::gemm_phase<pg8::EpiSwiGLU8, pg8::MoeOrder, true, true, true, 0x7A7A7A7A>(lds, g, S, E); }
                SEAM(16);
                if (RUN(17)) { S.nN = 4; S.estride = (size_t)DM * DFE;
                    pg8::Gemm g{hid, (const bf16*)(ws + WS_WED), 0, 0, DFE};
                    pg8::EpiBf16 E{ys, DM, 0}; pg8::gemm_phase<pg8::EpiBf16, pg8::MoeOrder, true, true, true, 0x79797979>(lds, g, S, E); }
                SEAM(17);
            }
            if (RUN(18)) { NormArgs na{}; na.xin = out; na.g = gv + 6144; na.tok = tok; na.ecnt = ecnt; na.ys = ys; na.gate = ml + 5120; na.out = out; ph_norm<2>(na, lds, bid, nblk); }
        }
    }
#undef RUN
#undef SEAM
}

extern "C" void kernel_launch(void* const* d_in, const int* in_sizes, int n_in, void* d_out, int out_size, void* d_ws, size_t ws_size, hipStream_t stream) {
    static int grid = 0;
    if (grid == 0) {
        if (n_in != 17 || out_size != T * DM || ws_size < WS_END) { fprintf(stderr, "kernel_launch: unexpected problem (n_in %d out %d ws %zu)\n", n_in, out_size, ws_size); grid = -1; return; }
        int dev = 0, cus = 0, per_cu = 0;
        if (hipGetDevice(&dev) != hipSuccess || hipDeviceGetAttribute(&cus, hipDeviceAttributeMultiprocessorCount, dev) != hipSuccess) { grid = -1; return; }
        if (hipFuncSetAttribute((const void*)mega_fwd, hipFuncAttributeMaxDynamicSharedMemorySize, LDS_BYTES) != hipSuccess) { fprintf(stderr, "kernel_launch: hipFuncSetAttribute failed\n"); grid = -1; return; }
        if (hipOccupancyMaxActiveBlocksPerMultiprocessor(&per_cu, (const void*)mega_fwd, 512, LDS_BYTES) != hipSuccess || per_cu < 1) fprintf(stderr, "kernel_launch: occupancy query says %d\n", per_cu);
        (void)hipGetLastError();
        grid = cus;
    }
    if (grid < 0) return;
    if (hipMemsetAsync((unsigned char*)d_ws + WS_CTL, 0, CTL_BYTES, stream) != hipSuccess) return;
    MegaArgs a{};
    for (int i = 0; i < 17; ++i) a.in[i] = (const float*)d_in[i];
    a.out = (float*)d_out; a.ws = (unsigned char*)d_ws;
#if MK_SPLIT
    for (int p = 0; p < N_PHASES; ++p) { a.ph_lo = p; a.ph_hi = p + 1; hipLaunchKernelGGL(mega_fwd, dim3(grid), dim3(512), LDS_BYTES, stream, a); }
#elif defined(PROBE_PHASE)
    a.li = 0; a.ph_lo = 0; a.ph_hi = PROBE_PHASE + 1; hipLaunchKernelGGL(mega_fwd, dim3(grid), dim3(512), LDS_BYTES, stream, a);
    a.li = 1; a.ph_lo = PROBE_PHASE; a.ph_hi = PROBE_PHASE + 1; hipLaunchKernelGGL(mega_fwd, dim3(grid), dim3(512), LDS_BYTES, stream, a);
    a.li = 2; a.ph_lo = PROBE_PHASE + 1; a.ph_hi = N_PHASES; hipLaunchKernelGGL(mega_fwd, dim3(grid), dim3(512), LDS_BYTES, stream, a);
#else
    a.ph_lo = 0; a.ph_hi = N_PHASES;
    hipLaunchKernelGGL(mega_fwd, dim3(grid), dim3(512), LDS_BYTES, stream, a);
#endif
}
```

```cpp
#include <hip/hip_runtime.h>
#include <cstdio>
#include <cstdint>

#define LAS __attribute__((address_space(3)))
#define GAS __attribute__((address_space(1)))
typedef unsigned short bf16;
typedef short bf16x8 __attribute__((ext_vector_type(8)));
typedef float f32x4 __attribute__((ext_vector_type(4)));
typedef float f32x16 __attribute__((ext_vector_type(16)));
typedef unsigned u32x4 __attribute__((ext_vector_type(4)));
typedef unsigned u32x2 __attribute__((ext_vector_type(2)));

constexpr int NB = 8, SEQ = 4096, T = NB * SEQ, DM = 1024, NLAYER = 2;
constexpr int PW = 3840;
constexpr int NIN = 3656;
constexpr int COL_QI = 3072, COL_KI = 3584, COL_WI = 3648;
constexpr int DFF = 2816, DFE = 3584, NEXP = 8;
constexpr float EPS = 1e-6f;
constexpr int XS_TILES = 264;

constexpr size_t MiB = 1u << 20;
constexpr size_t WS_CTL = 0, CTL_BYTES = 1 * MiB;
constexpr size_t WS_MOD = 1 * MiB;
constexpr size_t WS_GV = 1 * MiB + 400 * 1024;
constexpr size_t WS_KMEAN = 1 * MiB + 512 * 1024;
constexpr size_t WS_MOBASEL = 1 * MiB + 768 * 1024;
constexpr size_t WS_TOK = 2 * MiB;
constexpr size_t WS_WIN = 4 * MiB;
constexpr size_t WS_WOUT = 19 * MiB;
constexpr size_t WS_WFU = 23 * MiB;
constexpr size_t WS_WFD = 34 * MiB;
constexpr size_t WS_ACT = 40 * MiB;
constexpr size_t WS_P = 104 * MiB;
constexpr size_t WS_HID = 104 * MiB;
constexpr size_t WS_XS = 336 * MiB;
constexpr size_t WS_YS = 336 * MiB;
constexpr size_t WS_MASK = 344 * MiB;
constexpr size_t WS_WEU = 402 * MiB;
constexpr size_t WS_WED = 468 * MiB;
constexpr size_t WS_END = 496 * MiB;
constexpr int CW_ECNT = 64;
constexpr int CW_KNMAX = 128;
constexpr int CW_QUEUE = 256;
constexpr int CW_BAR = 4096;

__device__ __forceinline__ float bf2f(unsigned v) { return __uint_as_float(v << 16); }
__device__ __forceinline__ unsigned f2bf(float f) { unsigned u = __float_as_uint(f); return (u + 0x7fffu + ((u >> 16) & 1u)) >> 16; }
__device__ __forceinline__ unsigned pk2(float lo, float hi) { return f2bf(lo) | (f2bf(hi) << 16); }
__device__ __forceinline__ unsigned cvt_pk_bf16(float lo, float hi) { unsigned r; asm volatile("v_cvt_pk_bf16_f32 %0, %1, %2" : "=v"(r) : "v"(lo), "v"(hi)); return r; }
__device__ __forceinline__ float wave_sum(float v) {
#pragma unroll
    for (int o = 1; o < 64; o <<= 1) v += __shfl_xor(v, o);
    return v;
}
__device__ __forceinline__ void ld8(const bf16* p, float* f) {
    const u32x4 u = *(const u32x4*)p;
    f[0] = __uint_as_float(u.x << 16); f[1] = __uint_as_float(u.x & 0xffff0000u);
    f[2] = __uint_as_float(u.y << 16); f[3] = __uint_as_float(u.y & 0xffff0000u);
    f[4] = __uint_as_float(u.z << 16); f[5] = __uint_as_float(u.z & 0xffff0000u);
    f[6] = __uint_as_float(u.w << 16); f[7] = __uint_as_float(u.w & 0xffff0000u);
}
__device__ __forceinline__ float alibi_slope(int mixer_pos, int h) { return exp2f(-8.0f * (float)(3 * h + mixer_pos + 1) / 12.0f); }
__device__ __forceinline__ float silu_f(float x) { return x * __builtin_amdgcn_rcpf(1.0f + __expf(-x)); }
__device__ __forceinline__ int otid() { int t = threadIdx.x; asm volatile("" : "+v"(t)); return t; }
#define XB_TMO      128
#define XB_XCNT(j)  (256  + 64 * (j))
#define XB_XSUB(j)  (1280 + 64 * (j))
#define XB_XGEN(j)  (2304 + 64 * (j))
#define XB_TOP      3328
#define XB_TOPGEN   3392
#define XCD_BAR_WORDS 3456
#define XB_SPIN_CAP (1u << 18)

__device__ __forceinline__ unsigned xb_ld(unsigned* p)              { return __hip_atomic_load(p, __ATOMIC_RELAXED, __HIP_MEMORY_SCOPE_AGENT); }
__device__ __forceinline__ unsigned xb_add(unsigned* p, unsigned v) { return __hip_atomic_fetch_add(p, v, __ATOMIC_RELAXED, __HIP_MEMORY_SCOPE_AGENT); }
__device__ __forceinline__ unsigned xb_xcc_id() { return (unsigned)__builtin_amdgcn_s_getreg((3 << 11) | 20) & 0xFu; }
#define XB_SPIN(cond, bar) do { unsigned _sp = 0; while (cond) { __builtin_amdgcn_s_sleep(1); \
    if ((++_sp & 255u) == 0u) { if (xb_ld(&(bar)[XB_TMO])) break; if (_sp > XB_SPIN_CAP) { atomicAdd(&(bar)[XB_TMO], 1u); break; } } } } while (0)

struct XcdBarrier {
    unsigned* bar; unsigned x;
    volatile LAS unsigned* st;
};

__device__ __forceinline__ XcdBarrier xcd_barrier_post(unsigned* bar, volatile LAS unsigned* st) {
    XcdBarrier b; b.bar = bar; b.x = xb_xcc_id(); b.st = st;
    if (threadIdx.x == 0) (void)xb_add(&bar[XB_XCNT(b.x)], 1u);
    return b;
}
__device__ __forceinline__ void xcd_barrier_complete(unsigned* bar, unsigned x, unsigned& nloc, unsigned& nx) {
    const unsigned G = gridDim.x * gridDim.y * gridDim.z;
    unsigned sum, cnt, mine, sp = 0u;
    for (;;) {
        asm volatile("" : "+s"(bar), "+s"(x));
        sum = 0u; cnt = 0u; mine = 0u;
#pragma unroll
        for (unsigned j = 0; j < 16; ++j) { const unsigned c = xb_ld(&bar[XB_XCNT(j)]); sum += c; cnt += (c > 0u) ? 1u : 0u; mine = (j == x) ? c : mine; }
        if (sum == G) break;
        __builtin_amdgcn_s_sleep(1);
        if ((++sp & 255u) == 0u) { if (xb_ld(&bar[XB_TMO])) break; if (sp > XB_SPIN_CAP) { atomicAdd(&bar[XB_TMO], 1u); break; } }
    }
    nloc = mine > 0u ? mine : 1u; nx = cnt > 0u ? cnt : 1u;
}

__device__ __forceinline__ void xcd_barrier(const XcdBarrier& b) {
    asm volatile("s_waitcnt vmcnt(0)" ::: "memory");
    __syncthreads();
    if (threadIdx.x == 0) {
        unsigned* bar = b.bar; unsigned bx = b.x; asm volatile("" : "+s"(bx));
        __builtin_amdgcn_s_waitcnt(0);
        unsigned nloc = b.st[0], nx = b.st[1];
        if (nloc == 0u) { xcd_barrier_complete(bar, bx, nloc, nx); b.st[0] = nloc; b.st[1] = nx; }
        const unsigned old = xb_add(&bar[XB_XSUB(bx)], 1u);
        const unsigned gen = old / nloc;
        if (old + 1u == (gen + 1u) * nloc) {
            __builtin_amdgcn_fence(__ATOMIC_RELEASE, "agent");
            asm volatile("s_waitcnt vmcnt(0)" ::: "memory");
            const unsigned og = xb_add(&bar[XB_TOP], 1u);
            const unsigned tg = og / nx;
            if (og + 1u == (tg + 1u) * nx) xb_add(&bar[XB_TOPGEN], 1u);
            else XB_SPIN(xb_ld(&bar[XB_TOPGEN]) == tg, bar);
            __builtin_amdgcn_fence(__ATOMIC_ACQUIRE, "agent");
            xb_add(&bar[XB_XGEN(bx)], 1u);
            asm volatile("s_waitcnt vmcnt(0)" ::: "memory");
        } else {
            XB_SPIN(xb_ld(&bar[XB_XGEN(bx)]) == gen, bar);
            __builtin_amdgcn_fence(__ATOMIC_ACQUIRE, "agent");
            asm volatile("s_waitcnt vmcnt(0)" ::: "memory");
        }
    }
    __syncthreads();
}
namespace pg8 {
#define PG8_LAS __attribute__((address_space(3)))
typedef unsigned short bf16_t;
typedef short bf16x8 __attribute__((ext_vector_type(8)));
typedef float f32x4 __attribute__((ext_vector_type(4)));
typedef unsigned u32x4 __attribute__((ext_vector_type(4)));
constexpr int BM = 256, BK = 64, HALF = 128, HTB = HALF * BK * 2  , STAGE_BYTES = 8 * HTB, NXCD = 8, WGM = 8;

__host__ __device__ __forceinline__ int lds_byte(int r, int c) { const int st = (r >> 4) * 2 + (c >> 5), rr = r & 15, cc = c & 31, ob = rr * 64 + cc * 2; return st * 1024 + (ob ^ (((ob >> 9) & 1) << 5)); }
__host__ __device__ __forceinline__ void stage_rc(int b, int& R, int& C) { const int st = b / 1024, sb = b % 1024, swz = sb ^ (((sb >> 9) & 1) << 5); R = (st >> 1) * 16 + swz / 64; C = (st & 1) * 32 + (swz % 64) / 2; }
__host__ __device__ __forceinline__ int perm32(int rho) { const int n = rho >> 4, i = rho & 15; return 8 * (i >> 2) + 4 * n + (i & 3); }

struct Unit { int pm, pn; };
struct Gemm { const bf16_t* A; const bf16_t* Bt; int M, N, K; };

struct StaticOrder {
    int nM, nN, nwg, G, c;
    __host__ __device__ void init(int M, int N, int G_, int c_) { nM = M / BM; nN = N / BM; nwg = nM * nN; G = G_; c = c_; }
    __host__ __device__ bool next(int i, Unit& u) const {
        const long L = (long)i * G + c; if (L >= nwg) return false;
        int wgid = (int)L; { const int q = nwg / NXCD, r = nwg % NXCD, xcd = wgid % NXCD, off = wgid / NXCD; wgid = (xcd < r ? xcd * (q + 1) : r * (q + 1) + (xcd - r) * q) + off; }
        const int nig = WGM * nN, gid = wgid / nig, fm = gid * WGM, gsz = (nM - fm) < WGM ? (nM - fm) : WGM;
        u.pm = fm + ((wgid % nig) % gsz); u.pn = (wgid % nig) / gsz; return true;
    }
    __device__ __forceinline__ void a_ready(const Unit&) const {}
    __device__ __forceinline__ void done(const Unit&) const {}
    __device__ __forceinline__ const char* a_base(const Gemm& g, const Unit& u, size_t tstep) const { return (const char*)g.A + (size_t)u.pm * tstep; }
    __device__ __forceinline__ const char* b_base(const Gemm& g, const Unit& u, size_t tstep) const { return (const char*)g.Bt + (size_t)u.pn * tstep; }
};


typedef int v4i_t __attribute__((ext_vector_type(4)));
typedef int v8i_t __attribute__((ext_vector_type(8)));
__device__ __forceinline__ v8i_t cat8(bf16x8 lo, bf16x8 hi) { const v4i_t a = __builtin_bit_cast(v4i_t, lo), b = __builtin_bit_cast(v4i_t, hi); return __builtin_shufflevector(a, b, 0, 1, 2, 3, 4, 5, 6, 7); }
__device__ __forceinline__ unsigned pk4_fp8(float a, float b, float c, float d) {
    a = fminf(fmaxf(a, -448.f), 448.f); b = fminf(fmaxf(b, -448.f), 448.f); c = fminf(fmaxf(c, -448.f), 448.f); d = fminf(fmaxf(d, -448.f), 448.f);
    int w = 0; w = __builtin_amdgcn_cvt_pk_fp8_f32(a, b, w, false); w = __builtin_amdgcn_cvt_pk_fp8_f32(c, d, w, true); return (unsigned)w; }

struct EpiBf16 {
    static constexpr bool PERM = true, AFTER_DRAIN = false;
    bf16_t* O; int ldc; int row_shift;
    __device__ __forceinline__ void operator()(const f32x4 (&acc)[2][2][4][2], const Unit& u, int wr, int wc, int fr, int fq) const {
        const int row0 = u.pm * BM + row_shift + wr * 64 + fr, col0 = u.pn * BM + wc * 32 + 8 * fq;
#pragma unroll
        for (int ai = 0; ai < 2; ++ai)
#pragma unroll
            for (int m = 0; m < 4; ++m) { bf16_t* rowp = O + (size_t)(row0 + ai * HALF + m * 16) * ldc + col0;
#pragma unroll
                for (int bj = 0; bj < 2; ++bj) { const f32x4 v0 = acc[ai][bj][m][0], v1 = acc[ai][bj][m][1];
                    u32x4 w; w.x = cvt_pk_bf16(v0[0], v0[1]); w.y = cvt_pk_bf16(v0[2], v0[3]); w.z = cvt_pk_bf16(v1[0], v1[1]); w.w = cvt_pk_bf16(v1[2], v1[3]);
                    *(u32x4*)(rowp + bj * HALF) = w; } }
    }
};
struct EpiSwiGLU {
    static constexpr bool PERM = true, AFTER_DRAIN = false;
    bf16_t* H; int ldh; int row_shift;
    __device__ __forceinline__ void operator()(const f32x4 (&acc)[2][2][4][2], const Unit& u, int wr, int wc, int fr, int fq) const {
        const int row0 = u.pm * BM + row_shift + wr * 64 + fr, col0 = u.pn * HALF + wc * 32 + 8 * fq;
#pragma unroll
        for (int ai = 0; ai < 2; ++ai)
#pragma unroll
            for (int m = 0; m < 4; ++m) { bf16_t* rowp = H + (size_t)(row0 + ai * HALF + m * 16) * ldh + col0;
                const f32x4 g0 = acc[ai][0][m][0], g1 = acc[ai][0][m][1], u0 = acc[ai][1][m][0], u1 = acc[ai][1][m][1];
                float h[8];
#pragma unroll
                for (int i = 0; i < 4; ++i) { h[i] = silu_f(g0[i]) * u0[i]; h[4 + i] = silu_f(g1[i]) * u1[i]; }
                u32x4 w; w.x = cvt_pk_bf16(h[0], h[1]); w.y = cvt_pk_bf16(h[2], h[3]); w.z = cvt_pk_bf16(h[4], h[5]); w.w = cvt_pk_bf16(h[6], h[7]);
                *(u32x4*)rowp = w; }
    }
};
struct EpiSwiGLU8 {
    static constexpr bool PERM = true, AFTER_DRAIN = false;
    unsigned char* H; int ldh; int row_shift;
    __device__ __forceinline__ void operator()(const f32x4 (&acc)[2][2][4][2], const Unit& u, int wr, int wc, int fr, int fq) const {
        const int row0 = u.pm * BM + row_shift + wr * 64 + fr, col0 = u.pn * HALF + wc * 32 + 8 * fq;
#pragma unroll
        for (int ai = 0; ai < 2; ++ai)
#pragma unroll
            for (int m = 0; m < 4; ++m) { unsigned char* rowp = H + (size_t)(row0 + ai * HALF + m * 16) * ldh + col0;
                const f32x4 g0 = acc[ai][0][m][0], g1 = acc[ai][0][m][1], u0 = acc[ai][1][m][0], u1 = acc[ai][1][m][1];
                float h[8];
#pragma unroll
                for (int i = 0; i < 4; ++i) { h[i] = silu_f(g0[i]) * u0[i]; h[4 + i] = silu_f(g1[i]) * u1[i]; }
                typedef unsigned u32x2_t __attribute__((ext_vector_type(2)));
                u32x2_t w; w.x = pk4_fp8(h[0], h[1], h[2], h[3]); w.y = pk4_fp8(h[4], h[5], h[6], h[7]);
                *(u32x2_t*)rowp = w;
                asm volatile("" ::: "memory"); }
    }
};
struct EpiRes {
    static constexpr bool PERM = false, AFTER_DRAIN = false;
    const float* xin; float* xout; const float* gate;
    __device__ __forceinline__ void operator()(const f32x4 (&acc)[2][2][4][2], const Unit& u, int wr, int wc, int fr, int fq) const {
        const int row0 = u.pm * BM + wr * 64 + fr, col0 = u.pn * BM + wc * 32 + 4 * fq;
        const float* gb = gate + (size_t)((u.pm * BM) / SEQ) * 6144;
        f32x4 gv[2][2];
#pragma unroll
        for (int bj = 0; bj < 2; ++bj)
#pragma unroll
            for (int n = 0; n < 2; ++n) gv[bj][n] = *(const f32x4*)(gb + col0 + bj * HALF + n * 16);
#pragma unroll
        for (int ai = 0; ai < 2; ++ai)
#pragma unroll
            for (int m = 0; m < 4; ++m) { const size_t off = (size_t)(row0 + ai * HALF + m * 16) * DM + col0;
#pragma unroll
                for (int bj = 0; bj < 2; ++bj)
#pragma unroll
                    for (int n = 0; n < 2; ++n) { const f32x4 x = *(const f32x4*)(xin + off + bj * HALF + n * 16);
                        *(f32x4*)(xout + off + bj * HALF + n * 16) = x + gv[bj][n] * acc[ai][bj][m][n]; } }
    }
};
struct MoeOrder {
    int nrt, nN, G, c; const PG8_LAS unsigned char* etab; size_t estride;
    __device__ __forceinline__ bool next(int i, Unit& u) const {
        const int L = i * G + c; if (nrt <= 0 || L >= nrt * nN) return false;
        u.pm = L % nrt; u.pn = L / nrt; return true;
    }
    __device__ __forceinline__ void a_ready(const Unit&) const {}
    __device__ __forceinline__ void done(const Unit&) const {}
    __device__ __forceinline__ const char* a_base(const Gemm& g, const Unit& u, size_t tstep) const { return (const char*)g.A + (size_t)u.pm * tstep; }
    __device__ __forceinline__ const char* b_base(const Gemm& g, const Unit& u, size_t tstep) const {
        const int e = __builtin_amdgcn_readfirstlane((int)etab[u.pm]);
        return (const char*)g.Bt + (size_t)e * estride + (size_t)u.pn * tstep;
    }
};
template <class Epi, class Sched, bool ALIGN_EPI = false, bool SP2 = false, bool FP8 = false, int sc_w = 0x7F7F7F7F, int sc_a = 0x7F7F7F7F>
__device__ __forceinline__ void gemm_phase(PG8_LAS unsigned char* lds, const Gemm g, const Sched& S, const Epi& E) {
    int tid_ = threadIdx.x; asm volatile("" : "+v"(tid_));
    const int tid = tid_, wid = __builtin_amdgcn_readfirstlane(tid >> 6), lane = tid & 63, wr = wid >> 2, wc = wid & 3, fr = lane & 15, fq = lane >> 4;
    constexpr int ES = FP8 ? 1 : 2;
    int K_ = g.K; asm volatile("" : "+s"(K_));
    const int K = K_, nt = K * ES / (BK * 2);
    unsigned voffA[2], voffB[2];
#pragma unroll
    for (int i = 0; i < 2; ++i) { int R, C; stage_rc(tid * 16 + i * 8192, R, C); const int Rb = Epi::PERM ? ((R & ~31) + perm32(R & 31)) : R;
        voffA[i] = (unsigned)(R * K * ES + C * 2); voffB[i] = (unsigned)(Rb * K * ES + C * 2); }
    const size_t kstep = (size_t)(BK * 2);
    const size_t hstep = (size_t)HALF * K * ES;
    const size_t tstep = 2 * hstep;
    const unsigned ldsw = (unsigned)wid * 1024u;
    const int aoff = lds_byte(wr * 64 + fr, fq * 8), boff = lds_byte(wc * 32 + fr, fq * 8);
#define PG8_SA(b, h) (((b) * 2 + (h)) * HTB)
#define PG8_SB(b, h) ((4 + (b) * 2 + (h)) * HTB)
#define PG8_STAGE(bufoff, gbase, voff) do { _Pragma("unroll") for (int _i = 0; _i < 2; ++_i) \
        __builtin_amdgcn_global_load_lds((const unsigned*)((const char*)(gbase) + (voff)[_i]), (PG8_LAS unsigned*)(lds + (bufoff) + ldsw + _i * 8192), 16, 0, 0); } while (0)
#define PG8_LDA(dst, b, h) do { _Pragma("unroll") for (int m = 0; m < 4; ++m) { \
        if constexpr (FP8) { const v4i_t l_ = *(const PG8_LAS v4i_t*)(lds + PG8_SA(b, h) + aoff + m * 2048), h_ = *(const PG8_LAS v4i_t*)(lds + PG8_SA(b, h) + aoff + m * 2048 + 1024); dst##F[m] = __builtin_shufflevector(l_, h_, 0, 1, 2, 3, 4, 5, 6, 7); } \
        else { _Pragma("unroll") for (int k = 0; k < 2; ++k) dst[m][k] = *(const PG8_LAS bf16x8*)(lds + PG8_SA(b, h) + aoff + m * 2048 + k * 1024); } } } while (0)
#define PG8_LDB(dst, b, h) do { _Pragma("unroll") for (int n = 0; n < 2; ++n) { \
        if constexpr (FP8) { const v4i_t l_ = *(const PG8_LAS v4i_t*)(lds + PG8_SB(b, h) + boff + n * 2048), h_ = *(const PG8_LAS v4i_t*)(lds + PG8_SB(b, h) + boff + n * 2048 + 1024); dst##F[n] = __builtin_shufflevector(l_, h_, 0, 1, 2, 3, 4, 5, 6, 7); } \
        else { _Pragma("unroll") for (int k = 0; k < 2; ++k) dst[n][k] = *(const PG8_LAS bf16x8*)(lds + PG8_SB(b, h) + boff + n * 2048 + k * 1024); } } } while (0)
#define PG8_MMA(ai, bj, At, Bt) do { __builtin_amdgcn_s_setprio(1); _Pragma("unroll") for (int m = 0; m < 4; ++m) _Pragma("unroll") for (int n = 0; n < 2; ++n) { \
        if constexpr (FP8) asm volatile("v_mfma_scale_f32_16x16x128_f8f6f4 %0, %1, %2, %0, %3, %4 op_sel_hi:[0,0,0]" : "+v"(acc[ai][bj][m][n]) : "v"(Bt##F[n]), "v"(At##F[m]), "v"(sc_w), "v"(sc_a)); \
        else { _Pragma("unroll") for (int k = 0; k < 2; ++k) acc[ai][bj][m][n] = __builtin_amdgcn_mfma_f32_16x16x32_bf16(Bt[n][k], At[m][k], acc[ai][bj][m][n], 0, 0, 0); } } \
        __builtin_amdgcn_s_setprio(0); } while (0)
#define PG8_WAIT_V(n) asm volatile("s_waitcnt vmcnt(" #n ")" ::: "memory")
#define PG8_WAIT_L(n) asm volatile("s_waitcnt lgkmcnt(" #n ")" ::: "memory")
#define PG8_BAR __builtin_amdgcn_s_barrier()
#define PG8_SCHED __builtin_amdgcn_sched_barrier(0)
    Unit cur, nxt; int ui = 0;
    if (!S.next(0, cur)) return;
    f32x4 acc[2][2][4][2];
#pragma unroll
    for (int a = 0; a < 2; ++a)
#pragma unroll
        for (int b = 0; b < 2; ++b)
#pragma unroll
            for (int m = 0; m < 4; ++m)
#pragma unroll
                for (int n = 0; n < 2; ++n) acc[a][b][m][n] = (f32x4){0.f, 0.f, 0.f, 0.f};
    bf16x8 At[4][2], B0[2][2], B1[2][2];
    v8i_t AtF[4], B0F[2], B1F[2];
    const char* cA = S.a_base(g, cur, tstep); const char* cB = S.b_base(g, cur, tstep);
    S.a_ready(cur);
    if constexpr (SP2) {
        PG8_STAGE(PG8_SB(0, 0), cB, voffB); PG8_STAGE(PG8_SB(0, 1), cB + hstep, voffB); PG8_STAGE(PG8_SA(0, 0), cA, voffA); PG8_STAGE(PG8_SA(0, 1), cA + hstep, voffA);
        if (wr == 1) PG8_BAR;
        PG8_WAIT_V(2); PG8_BAR;
        PG8_STAGE(PG8_SB(1, 0), cB + kstep, voffB); PG8_STAGE(PG8_SA(1, 0), cA + kstep, voffA); PG8_STAGE(PG8_SB(1, 1), cB + hstep + kstep, voffB);
        PG8_WAIT_V(6); PG8_BAR;
    } else {
        PG8_STAGE(PG8_SB(0, 0), cB, voffB); PG8_STAGE(PG8_SA(0, 0), cA, voffA); PG8_STAGE(PG8_SB(0, 1), cB + hstep, voffB); PG8_STAGE(PG8_SA(0, 1), cA + hstep, voffA);
        if (wr == 1) PG8_BAR;
        PG8_WAIT_V(4); PG8_BAR;
        PG8_STAGE(PG8_SB(1, 0), cB + kstep, voffB); PG8_STAGE(PG8_SA(1, 0), cA + kstep, voffA); PG8_STAGE(PG8_SB(1, 1), cB + hstep + kstep, voffB);
        PG8_WAIT_V(6); PG8_BAR;
    }
    for (;;) {
        const bool has_next = S.next(ui + 1, nxt);
        const char* nA = has_next ? S.a_base(g, nxt, tstep) : cA; const char* nB = has_next ? S.b_base(g, nxt, tstep) : cB;
        for (int t = 0; t < nt; t += 2) {
            const bool last = (t == nt - 2);
            const char* a1 = cA + (size_t)(t + 1) * kstep;
            const char* a2 = last ? nA : cA + (size_t)(t + 2) * kstep; const char* b2 = last ? nB : cB + (size_t)(t + 2) * kstep;
            const char* a3 = a2 + kstep; const char* b3 = b2 + kstep;
            if (last && has_next) S.a_ready(nxt);
            if constexpr (SP2) {
            PG8_LDB(B0, 0, 0); PG8_LDB(B1, 0, 1); PG8_SCHED; PG8_LDA(At, 0, 0); PG8_STAGE(PG8_SA(1, 1), a1 + hstep, voffA);
            PG8_WAIT_V(8); PG8_WAIT_L(0); PG8_BAR; PG8_MMA(0, 0, At, B0); PG8_MMA(0, 1, At, B1); PG8_BAR; PG8_SCHED;
            PG8_LDA(At, 0, 1); PG8_STAGE(PG8_SB(0, 0), b2, voffB); PG8_STAGE(PG8_SB(0, 1), b2 + hstep, voffB); PG8_STAGE(PG8_SA(0, 0), a2, voffA);
            PG8_WAIT_V(8); PG8_WAIT_L(0); PG8_BAR; PG8_MMA(1, 0, At, B0); PG8_MMA(1, 1, At, B1); PG8_BAR; PG8_SCHED;
            PG8_LDB(B0, 1, 0); PG8_LDB(B1, 1, 1); PG8_SCHED; PG8_LDA(At, 1, 0); PG8_STAGE(PG8_SA(0, 1), a2 + hstep, voffA);
            PG8_WAIT_V(8); PG8_WAIT_L(0); PG8_BAR; PG8_MMA(0, 0, At, B0); PG8_MMA(0, 1, At, B1); PG8_BAR; PG8_SCHED;
            PG8_LDA(At, 1, 1); PG8_STAGE(PG8_SB(1, 0), b3, voffB); PG8_STAGE(PG8_SB(1, 1), b3 + hstep, voffB); PG8_STAGE(PG8_SA(1, 0), a3, voffA);
            PG8_WAIT_V(8); PG8_WAIT_L(0); PG8_BAR; PG8_MMA(1, 0, At, B0); PG8_MMA(1, 1, At, B1); PG8_BAR; PG8_SCHED;
            } else {
            PG8_LDB(B0, 0, 0); PG8_SCHED; PG8_LDA(At, 0, 0); PG8_STAGE(PG8_SA(1, 1), a1 + hstep, voffA);
            PG8_WAIT_L(8); PG8_BAR; PG8_WAIT_L(0); PG8_MMA(0, 0, At, B0); PG8_BAR; PG8_SCHED;
            PG8_LDB(B1, 0, 1); PG8_STAGE(PG8_SB(0, 0), b2, voffB);
            PG8_BAR; PG8_WAIT_L(0); PG8_MMA(0, 1, At, B1); PG8_BAR;
            PG8_LDA(At, 0, 1); PG8_STAGE(PG8_SA(0, 0), a2, voffA);
            PG8_BAR; PG8_WAIT_L(0); PG8_MMA(1, 0, At, B0); PG8_BAR; PG8_SCHED;
            PG8_STAGE(PG8_SB(0, 1), b2 + hstep, voffB);
            PG8_WAIT_V(6); PG8_BAR; PG8_MMA(1, 1, At, B1); PG8_BAR;
            PG8_LDB(B0, 1, 0); PG8_SCHED; PG8_LDA(At, 1, 0); PG8_STAGE(PG8_SA(0, 1), a2 + hstep, voffA);
            PG8_WAIT_L(8); PG8_BAR; PG8_WAIT_L(0); PG8_MMA(0, 0, At, B0); PG8_BAR; PG8_SCHED;
            PG8_LDB(B1, 1, 1); PG8_STAGE(PG8_SB(1, 0), b3, voffB);
            PG8_BAR; PG8_WAIT_L(0); PG8_MMA(0, 1, At, B1); PG8_BAR;
            PG8_LDA(At, 1, 1); PG8_STAGE(PG8_SA(1, 0), a3, voffA);
            PG8_BAR; PG8_WAIT_L(0); PG8_MMA(1, 0, At, B0); PG8_BAR; PG8_SCHED;
            PG8_STAGE(PG8_SB(1, 1), b3 + hstep, voffB);
            PG8_WAIT_V(6); PG8_BAR; PG8_MMA(1, 1, At, B1); PG8_BAR;
            }
        }
        if constexpr (ALIGN_EPI) { if (wr == 0) PG8_BAR; }
        if constexpr (FP8) asm volatile("s_nop 15\n\ts_nop 15\n\ts_nop 15" ::: "memory");
        if constexpr (!Epi::AFTER_DRAIN) { E(acc, cur, wr, wc, fr, fq); S.done(cur); }
        if (!has_next) break;
#pragma unroll
        for (int a = 0; a < 2; ++a)
#pragma unroll
            for (int b = 0; b < 2; ++b)
#pragma unroll
                for (int m = 0; m < 4; ++m)
#pragma unroll
                    for (int n = 0; n < 2; ++n) acc[a][b][m][n] = (f32x4){0.f, 0.f, 0.f, 0.f};
        cur = nxt; cA = nA; cB = nB; ++ui;
        if constexpr (ALIGN_EPI) { if (wr == 1) PG8_BAR; }
    }
    PG8_WAIT_V(0);
    if constexpr (!ALIGN_EPI) { if (wr == 0) PG8_BAR; }
    PG8_BAR;
    if constexpr (Epi::AFTER_DRAIN) { E.fused(acc, cur, wr, wc, fr, fq, lds, wid, lane); S.done(cur); }
#undef PG8_SA
#undef PG8_SB
#undef PG8_STAGE
#undef PG8_LDA
#undef PG8_LDB
#undef PG8_MMA
#undef PG8_WAIT_V
#undef PG8_WAIT_L
#undef PG8_BAR
#undef PG8_SCHED
}
}

#define LDS_WAIT() asm volatile("s_waitcnt lgkmcnt(0)" ::: "memory")
#define VM_WAIT() asm volatile("s_waitcnt vmcnt(0)" ::: "memory")

template <bool F8 = false> __device__ __forceinline__ void transpose_item(const float* W, int ldw, int scol0, int ncol_valid, float scale, bf16* WT, int K, int drow0, int k0, LAS float* scr, int lane) {
    const int n = lane & 31; const bool ok = (scol0 + n) < ncol_valid;
    float v[32];
    const float* wp = W + (size_t)(k0 + (lane >> 5)) * ldw + scol0 + n;
#pragma unroll
    for (int i = 0; i < 32; ++i) v[i] = ok ? wp[(size_t)(2 * i) * ldw] : 0.f;
#pragma unroll
    for (int i = 0; i < 32; ++i) scr[(2 * i + (lane >> 5)) * 33 + n] = v[i] * scale;
    LDS_WAIT(); asm volatile("" ::: "memory");
    const int c = lane & 7;
#pragma unroll
    for (int j = 0; j < 4; ++j) { const int nn = (lane >> 3) + 8 * j; const LAS float* s = scr + (8 * c) * 33 + nn;
        if (F8) { u32x2 o; o.x = pg8::pk4_fp8(s[0 * 33], s[1 * 33], s[2 * 33], s[3 * 33]); o.y = pg8::pk4_fp8(s[4 * 33], s[5 * 33], s[6 * 33], s[7 * 33]);
            *(u32x2*)((unsigned char*)WT + (size_t)(drow0 + nn) * K + k0 + 8 * c) = o; }
        else { u32x4 o; o.x = pk2(s[0 * 33], s[1 * 33]); o.y = pk2(s[2 * 33], s[3 * 33]); o.z = pk2(s[4 * 33], s[5 * 33]); o.w = pk2(s[6 * 33], s[7 * 33]);
            *(u32x4*)(WT + (size_t)(drow0 + nn) * K + k0 + 8 * c) = o; } }
    LDS_WAIT(); asm volatile("" ::: "memory");
}
struct PrepArgs { const float *w_in, *w_out, *wfg, *wfu, *wfd, *weg, *weu, *wed; unsigned char* ws; };
constexpr int PI_WIN = 2 * 16 * 120, PI_WOUT = 2 * 16 * 32, PI_FU = 16 * 176, PI_FD = 44 * 32, PI_EU = 8 * 16 * 224, PI_ED = 8 * 56 * 32;
constexpr int PREP_ITEMS = PI_WIN + PI_WOUT + PI_FU + PI_FD + PI_EU + PI_ED;
__device__ __forceinline__ void prep_item(const PrepArgs& a, int it, LAS float* scr, int lane) {
    int r = it;
    if (r < PI_WIN) { const int l = r / 1920; r %= 1920; const int kb = r / 120, nb = r % 120, n0 = nb * 32;
        float sc = 1.f; if (n0 < 256 || (n0 >= COL_QI && n0 < COL_KI)) sc = 0.125f; else if (n0 < 3072 && (n0 % 768) < 256) sc = 0.125f * 1.4426950408889634f; else if (n0 == COL_WI) sc = 0.35355339059327373f;
        transpose_item(a.w_in + (size_t)l * DM * NIN, NIN, n0, NIN, sc, (bf16*)(a.ws + WS_WIN) + (size_t)l * PW * DM, DM, n0, kb * 64, scr, lane); return; }
    r -= PI_WIN;
    if (r < PI_WOUT) { const int l = r / 512; r %= 512; const int kb = r / 32, nb = r % 32;
        transpose_item(a.w_out + (size_t)l * DM * DM, DM, nb * 32, DM, 1.f, (bf16*)(a.ws + WS_WOUT) + (size_t)l * DM * DM, DM, nb * 32, kb * 64, scr, lane); return; }
    r -= PI_WOUT;
    if (r < PI_FU) { const int kb = r / 176, nb = r % 176, r0 = nb * 32, blk = r0 >> 8, w = r0 & 255;
        transpose_item<true>(w < 128 ? a.wfg : a.wfu, DFF, blk * 128 + (w & 127), DFF, 32.f, (bf16*)(a.ws + WS_WFU), DM, r0, kb * 64, scr, lane); return; }
    r -= PI_FU;
    if (r < PI_FD) { const int kb = r / 32, nb = r % 32;
        transpose_item<true>(a.wfd, DM, nb * 32, DM, 64.f, (bf16*)(a.ws + WS_WFD), DFF, nb * 32, kb * 64, scr, lane); return; }
    r -= PI_FD;
    if (r < PI_EU) { const int e = r / 3584; r %= 3584; const int kb = r / 224, nb = r % 224, r0 = nb * 32, blk = r0 >> 8, w = r0 & 255;
        transpose_item<true>((w < 128 ? a.weg : a.weu) + (size_t)e * DM * DFE, DFE, blk * 128 + (w & 127), DFE, 32.f, (bf16*)(a.ws + WS_WEU + (size_t)e * 7168 * DM), DM, r0, kb * 64, scr, lane); return; }
    r -= PI_EU;
    { const int e = r / 1792; r %= 1792; const int kb = r / 32, nb = r % 32;
        transpose_item<true>(a.wed + (size_t)e * DFE * DM, DM, nb * 32, DM, 64.f, (bf16*)(a.ws + WS_WED + (size_t)e * DM * DFE), DFE, nb * 32, kb * 64, scr, lane); }
}
__device__ __forceinline__ void ph_prep(const PrepArgs& a, LAS unsigned char* lds, int bid, int nblk) {
    const int lane = otid() & 63, wave = otid() >> 6;
    LAS float* scr = (LAS float*)lds + wave * 64 * 33;
    const int gw = bid * 8 + wave, ngw = nblk * 8;
    for (int it = gw; it < PREP_ITEMS; it += ngw) prep_item(a, it, scr, lane);
}
__device__ __forceinline__ void ph_mod(const float* c, const float* w_ada, const float* b_ada, float* mod, LAS unsigned char* lds, int bid, int nblk) {
    LAS float* sc = (LAS float*)lds; LAS float* part = (LAS float*)(lds + 32768);
    const int tid = otid();
    if (bid >= 192) return;
    for (int i = tid; i < 8 * 1024; i += 512) { const float v = c[i]; sc[i] = v / (1.0f + __expf(-v)); }
    __syncthreads();
    for (int item = bid; item < 192; item += nblk) {
        const int l = item / 96, j0 = (item % 96) * 64, jj = tid & 63, kq = tid >> 6;
        float acc[8];
#pragma unroll
        for (int b = 0; b < 8; ++b) acc[b] = 0.f;
        const float* w = w_ada + (size_t)l * DM * 6144 + j0 + jj;
#pragma unroll 16
        for (int k = kq * 128; k < kq * 128 + 128; ++k) { const float wv = w[(size_t)k * 6144];
#pragma unroll
            for (int b = 0; b < 8; ++b) acc[b] += sc[b * 1024 + k] * wv; }
#pragma unroll
        for (int b = 0; b < 8; ++b) part[(kq * 8 + b) * 64 + jj] = acc[b];
        __syncthreads();
        { const int b = tid >> 6, j = tid & 63; float sum = 0.f;
#pragma unroll
          for (int q = 0; q < 8; ++q) sum += part[(q * 8 + b) * 64 + j];
          mod[(size_t)l * 8 * 6144 + (size_t)b * 6144 + j0 + j] = sum + b_ada[l * 6144 + j0 + j]; }
        __syncthreads();
    }
}

struct MoeTiles { int p0, p1, p2, p3, p4, p5, p6, p7; };
__device__ __forceinline__ MoeTiles moe_tiles(const unsigned* ecnt) {
#define ECNT_LD(i) ((int)((__hip_atomic_load(ecnt + (i), __ATOMIC_RELAXED, __HIP_MEMORY_SCOPE_AGENT) + 255u) >> 8))
    MoeTiles m; m.p0 = ECNT_LD(0); m.p1 = ECNT_LD(1); m.p2 = ECNT_LD(2); m.p3 = ECNT_LD(3); m.p4 = ECNT_LD(4); m.p5 = ECNT_LD(5); m.p6 = ECNT_LD(6); m.p7 = ECNT_LD(7); return m;
#undef ECNT_LD
}
__device__ __forceinline__ int moe_tile_start(const MoeTiles& m, int e) {
    int s = 0; s += (e > 0) ? m.p0 : 0; s += (e > 1) ? m.p1 : 0; s += (e > 2) ? m.p2 : 0; s += (e > 3) ? m.p3 : 0; s += (e > 4) ? m.p4 : 0; s += (e > 5) ? m.p5 : 0; s += (e > 6) ? m.p6 : 0; return s;
}
struct NormArgs {
    const float* xin; const float* g; const float* shift; const float* scale;
    bf16* act; unsigned char* act8;
    const float* w_router; int* tok; unsigned* ecnt;
    const bf16* ys; const float* gate; float* out;
};
template <int MODE> __device__ __forceinline__ void ph_norm(const NormArgs& a, LAS unsigned char* lds, int bid, int nblk) {
    LAS unsigned* lcnt = (LAS unsigned*)lds; LAS unsigned* lbase = lcnt + 8; typedef int info6[6]; LAS info6* linfo = (LAS info6*)(lds + 64);
    const int tid = otid(), lane = tid & 63, wave = tid >> 6;
    if (MODE == 1) { if (tid < 8) lcnt[tid] = 0u; __syncthreads(); }
    MoeTiles mt; if (MODE == 2) mt = moe_tiles(a.ecnt);
    for (int blk = bid; blk < T / 128; blk += nblk) {
        for (int i = 0; i < 16; ++i) {
            const int lr = wave + 8 * i, row = blk * 128 + lr, b = row / SEQ;
            const f32x4* xr = (const f32x4*)(a.xin + (size_t)row * DM) + lane;
            f32x4 v[4];
#pragma unroll
            for (int j = 0; j < 4; ++j) v[j] = xr[64 * j];
            if (MODE == 2) {
                const int* ti = a.tok + (size_t)row * 8; const int e0 = ti[0], e1 = ti[1], p0 = ti[2], p1 = ti[3]; const float g0 = __int_as_float(ti[4]), g1 = __int_as_float(ti[5]);
                const size_t s0 = (size_t)moe_tile_start(mt, e0) * 256 + p0, s1 = (size_t)moe_tile_start(mt, e1) * 256 + p1;
                const u32x2* y0 = (const u32x2*)(a.ys + s0 * DM) + lane; const u32x2* y1 = (const u32x2*)(a.ys + s1 * DM) + lane;
                const f32x4* gt = (const f32x4*)(a.gate + (size_t)b * 6144) + lane;
#pragma unroll
                for (int j = 0; j < 4; ++j) { const u32x2 a0 = y0[64 * j], a1 = y1[64 * j]; const f32x4 gv = gt[64 * j];
                    f32x4 y; y.x = g0 * bf2f(a0.x & 0xffffu) + g1 * bf2f(a1.x & 0xffffu); y.y = g0 * bf2f(a0.x >> 16) + g1 * bf2f(a1.x >> 16);
                    y.z = g0 * bf2f(a0.y & 0xffffu) + g1 * bf2f(a1.y & 0xffffu); y.w = g0 * bf2f(a0.y >> 16) + g1 * bf2f(a1.y >> 16);
                    v[j] = v[j] + gv * y; }
            }
            float ss = 0.f;
#pragma unroll
            for (int j = 0; j < 4; ++j) ss += (v[j].x * v[j].x + v[j].y * v[j].y) + (v[j].z * v[j].z + v[j].w * v[j].w);
            const float rstd = rsqrtf(wave_sum(ss) * (1.0f / DM) + EPS);
            const f32x4* gp = (const f32x4*)a.g + lane;
            if (MODE == 2) {
                f32x4* o = (f32x4*)(a.out + (size_t)row * DM) + lane;
#pragma unroll
                for (int j = 0; j < 4; ++j) o[64 * j] = v[j] * rstd * gp[64 * j];
            } else {
                const f32x4* sh = (const f32x4*)(a.shift + (size_t)b * 6144) + lane; const f32x4* sc = (const f32x4*)(a.scale + (size_t)b * 6144) + lane;
#pragma unroll
                for (int j = 0; j < 4; ++j) v[j] = v[j] * rstd * gp[64 * j] * (sc[64 * j] + 1.0f) + sh[64 * j];
                if (a.act8) { unsigned* o = (unsigned*)(a.act8 + (size_t)row * DM) + lane;
#pragma unroll
                    for (int j = 0; j < 4; ++j) o[64 * j] = pg8::pk4_fp8(v[j].x, v[j].y, v[j].z, v[j].w); }
                else { u32x2* o = (u32x2*)(a.act + (size_t)row * DM) + lane;
#pragma unroll
                    for (int j = 0; j < 4; ++j) { u32x2 w; w.x = pk2(v[j].x, v[j].y); w.y = pk2(v[j].z, v[j].w); o[64 * j] = w; } }
                if (MODE == 1) {
                    float lg[8];
#pragma unroll
                    for (int e = 0; e < 8; ++e) lg[e] = 0.f;
#pragma unroll
                    for (int j = 0; j < 4; ++j) { const float hv[4] = {v[j].x, v[j].y, v[j].z, v[j].w};
#pragma unroll
                        for (int q = 0; q < 4; ++q) { const f32x4* wr = (const f32x4*)(a.w_router + (size_t)(256 * j + 4 * lane + q) * 8); const f32x4 w0 = wr[0], w1 = wr[1];
                            lg[0] += hv[q] * w0.x; lg[1] += hv[q] * w0.y; lg[2] += hv[q] * w0.z; lg[3] += hv[q] * w0.w; lg[4] += hv[q] * w1.x; lg[5] += hv[q] * w1.y; lg[6] += hv[q] * w1.z; lg[7] += hv[q] * w1.w; } }
#pragma unroll
                    for (int e = 0; e < 8; ++e) lg[e] = wave_sum(lg[e]);
                    int e0 = 0; float v0 = lg[0];
#pragma unroll
                    for (int e = 1; e < 8; ++e) if (lg[e] > v0) { v0 = lg[e]; e0 = e; }
                    int e1 = -1; float v1 = -INFINITY;
#pragma unroll
                    for (int e = 0; e < 8; ++e) if (e != e0 && lg[e] > v1) { v1 = lg[e]; e1 = e; }
                    const float g0 = 1.0f / (1.0f + __expf(v1 - v0)), g1 = 1.0f - g0;
                    if (lane == 0) { const unsigned q0 = __hip_atomic_fetch_add(&lcnt[e0], 1u, __ATOMIC_RELAXED, __HIP_MEMORY_SCOPE_WORKGROUP), q1 = __hip_atomic_fetch_add(&lcnt[e1], 1u, __ATOMIC_RELAXED, __HIP_MEMORY_SCOPE_WORKGROUP);
                        linfo[lr][0] = e0; linfo[lr][1] = e1; linfo[lr][2] = (int)q0; linfo[lr][3] = (int)q1; linfo[lr][4] = __float_as_int(g0); linfo[lr][5] = __float_as_int(g1); }
                }
            }
        }
        if (MODE == 1) {
            __syncthreads();
            if (tid < 8) { lbase[tid] = atomicAdd(&a.ecnt[tid], lcnt[tid]); }
            __syncthreads();
            if (tid < 128) { int* ti = a.tok + (size_t)(blk * 128 + tid) * 8; const int e0 = linfo[tid][0], e1 = linfo[tid][1];
                ti[0] = e0; ti[1] = e1; ti[2] = linfo[tid][2] + (int)lbase[e0]; ti[3] = linfo[tid][3] + (int)lbase[e1]; ti[4] = linfo[tid][4]; ti[5] = linfo[tid][5]; ti[6] = 0; ti[7] = 0; }
            __syncthreads();
            if (tid < 8) lcnt[tid] = 0u;
            __syncthreads();
        }
    }
}
__device__ __forceinline__ void ph_gather(const unsigned char* act8, const int* tok, const unsigned* ecnt, unsigned char* xs8, int bid, int nblk) {
    const int lane = otid() & 63, gw = bid * 8 + (otid() >> 6), ngw = nblk * 8;
    const MoeTiles mt = moe_tiles(ecnt);
    for (int t = gw; t < T; t += 4 * ngw) {
        int e0[4], e1[4], p0[4], p1[4]; u32x4 a0[4];
#pragma unroll
        for (int q = 0; q < 4; ++q) { const int* ti = tok + (size_t)(t + q * ngw) * 8; e0[q] = ti[0]; e1[q] = ti[1]; p0[q] = ti[2]; p1[q] = ti[3];
            a0[q] = ((const u32x4*)(act8 + (size_t)(t + q * ngw) * DM))[lane]; }
#pragma unroll
        for (int q = 0; q < 4; ++q) { const size_t s0 = (size_t)moe_tile_start(mt, e0[q]) * 256 + p0[q], s1 = (size_t)moe_tile_start(mt, e1[q]) * 256 + p1[q];
            ((u32x4*)(xs8 + s0 * DM))[lane] = a0[q]; ((u32x4*)(xs8 + s1 * DM))[lane] = a0[q]; }
    }
    for (int i = gw; i < 8 * 256; i += ngw) { const int e = i >> 8, r = i & 255; const int cnt = (int)__hip_atomic_load(ecnt + e, __ATOMIC_RELAXED, __HIP_MEMORY_SCOPE_AGENT); const int padded = ((cnt + 255) >> 8) << 8;
        if (cnt + r < padded) { unsigned z0 = 0u; asm volatile("" : "+v"(z0)); const u32x4 z = {z0, z0, z0, z0};
            ((u32x4*)(xs8 + ((size_t)moe_tile_start(mt, e) * 256 + cnt + r) * DM))[lane] = z; } }
}

__device__ __forceinline__ void ld16(const bf16* p, float (&f)[16]) { ld8(p, &f[0]); ld8(p + 8, &f[8]); }
__device__ __forceinline__ float dot16x4(const float (&q)[16], const bf16* p) {
    float f[16]; ld16(p, f); float s0 = 0.f, s1 = 0.f;
#pragma unroll
    for (int i = 0; i < 16; i += 2) { s0 += q[i] * f[i]; s1 += q[i + 1] * f[i + 1]; }
    float s = s0 + s1; s += __shfl_xor(s, 1); s += __shfl_xor(s, 2); return s;
}
__device__ __forceinline__ void axpy16(float (&o)[16], float w, const bf16* p) {
    float f[16]; ld16(p, f);
#pragma unroll
    for (int i = 0; i < 16; ++i) o[i] += w * f[i];
}
__device__ __forceinline__ void head_norm_store16(float (&o)[16], const float* gh, bf16* dst) {
    float ss = 0.f;
#pragma unroll
    for (int i = 0; i < 16; ++i) ss += o[i] * o[i];
    ss += __shfl_xor(ss, 1); ss += __shfl_xor(ss, 2);
    const float r = rsqrtf(ss * (1.0f / 64.0f) + EPS);
#pragma unroll
    for (int i = 0; i < 2; ++i) { u32x4 w; const float* q = &o[8 * i]; const float* g = gh + 8 * i;
        w.x = pk2(q[0] * r * g[0], q[1] * r * g[1]); w.y = pk2(q[2] * r * g[2], q[3] * r * g[3]); w.z = pk2(q[4] * r * g[4], q[5] * r * g[5]); w.w = pk2(q[6] * r * g[6], q[7] * r * g[7]);
        *(u32x4*)(dst + 8 * i) = w; }
}
#define OSM_STEP(s, vrow) do { if ((s) > m) { const float a_ = __expf(m - (s)); l *= a_; _Pragma("unroll") for (int d_ = 0; d_ < 16; ++d_) o[d_] *= a_; m = (s); } \
    const float p_ = __expf((s) - m); l += p_; axpy16(o, p_, (vrow)); } while (0)
#define NAIVE_IDX() const int part = gidx & 3, idx = gidx >> 2; const int t = idx & (SEQ - 1), h = (idx >> 12) & 3, b = idx >> 14; const int po = 16 * part

__device__ __forceinline__ void sb_naive_one(const bf16* P, const float* gh, bf16* act, int gidx) {
    NAIVE_IDX();
    const bf16* Pb = P + (size_t)b * SEQ * PW + po;
    float q[16], o[16];
    ld16(Pb + (size_t)t * PW + h * 64, q);
#pragma unroll
    for (int i = 0; i < 16; ++i) o[i] = 0.f;
    float carry = 1.0f;
    for (int s = t - 1; s >= 0; --s) {
        float z = dot16x4(q, Pb + (size_t)s * PW + 256 + h * 64); z = fminf(fmaxf(z, -80.f), 80.f);
        const float e = __expf(z), om = 1.0f / (1.0f + e), beta = e * om, aw = beta * carry;
        axpy16(o, aw, Pb + (size_t)s * PW + 512 + h * 64);
        carry *= om;
        if (carry < 1e-30f) break;
    }
    head_norm_store16(o, gh + h * 64 + po, act + (size_t)(b * SEQ + t) * DM + h * 64 + po);
}
__device__ __forceinline__ void dil_naive_one(const bf16* P, const float* gh, bf16* act, int gidx) {
    NAIVE_IDX();
    const bf16* Pb = P + (size_t)b * SEQ * PW + 1536 + po;
    const float slope = alibi_slope(1, h);
    float q[16], o[16];
    ld16(Pb + (size_t)t * PW + h * 64, q);
#pragma unroll
    for (int i = 0; i < 16; ++i) o[i] = 0.f;
    float m = -INFINITY, l = 0.f;
    for (int br = 0; br < 3; ++br) { const int dil = br == 0 ? 1 : (br == 1 ? 4 : 16);
        for (int j = 0; j <= 128; ++j) { const int dist = j * dil, kp = t - dist; if (kp < 0) break;
            const float s = dot16x4(q, Pb + (size_t)kp * PW + 256 + h * 64) - slope * (float)dist;
            OSM_STEP(s, Pb + (size_t)kp * PW + 512 + h * 64); } }
    const float rl = 1.0f / l;
#pragma unroll
    for (int i = 0; i < 16; ++i) o[i] *= rl;
    head_norm_store16(o, gh + (8 + h) * 64 + po, act + (size_t)(b * SEQ + t) * DM + (8 + h) * 64 + po);
}
__device__ __forceinline__ unsigned moba_sel_one(const float (&q)[16], const float* kmean, int b, int t, int h, int po) {
    const int own = t >> 8; unsigned sel = 0u;
    if (own <= 3) sel = (1u << own) - 1u;
    else {
        float g[16];
#pragma unroll
        for (int blk = 0; blk < 16; ++blk) { float s = -INFINITY;
            if (blk < own) { const float* km = kmean + ((size_t)b * 16 + blk) * 256 + h * 64 + po; s = 0.f;
#pragma unroll
                for (int d = 0; d < 16; ++d) s += q[d] * km[d];
                s += __shfl_xor(s, 1); s += __shfl_xor(s, 2); }
            g[blk] = s; }
#pragma unroll
        for (int r = 0; r < 3; ++r) { int bi = 0; float bv = -INFINITY;
#pragma unroll
            for (int blk = 0; blk < 16; ++blk) { const bool free_ = !((sel >> blk) & 1u); if (free_ && g[blk] > bv) { bv = g[blk]; bi = blk; } }
            sel |= 1u << bi; }
    }
    return sel;
}
template <int MODE> __device__ __forceinline__ void masked_naive_one(const bf16* P, const unsigned long long* mask, const float* kmean, const float* gh, bf16* act, int gidx) {
    NAIVE_IDX();
    const int cb = MODE == 0 ? 768 : 2304, hb = MODE == 0 ? 4 : 12;
    const bf16* Pb = P + (size_t)b * SEQ * PW + cb + po;
    const float slope = alibi_slope(MODE == 0 ? 0 : 2, h);
    float q[16], o[16];
    ld16(Pb + (size_t)t * PW + h * 64, q);
#pragma unroll
    for (int i = 0; i < 16; ++i) o[i] = 0.f;
    float m = -INFINITY, l = 0.f;
    if (MODE == 0) {
        const unsigned long long* mr = mask + (size_t)(b * SEQ + t) * 64;
        for (int w = 0; w <= (t >> 6); ++w) { unsigned long long bits = mr[w];
            while (bits) { const int j = __builtin_ctzll(bits); bits &= bits - 1; const int kp = w * 64 + j;
                const float s = dot16x4(q, Pb + (size_t)kp * PW + 256 + h * 64) - slope * (float)(t - kp);
                OSM_STEP(s, Pb + (size_t)kp * PW + 512 + h * 64); } }
    } else {
        const int own = t >> 8; const unsigned sel = moba_sel_one(q, kmean, b, t, h, po);
        for (int blk = 0; blk <= own; ++blk) { if (blk < own && !((sel >> blk) & 1u)) continue;
            const int kend = blk == own ? t : blk * 256 + 255;
            for (int kp = blk * 256; kp <= kend; ++kp) {
                const float s = dot16x4(q, Pb + (size_t)kp * PW + 256 + h * 64) - slope * (float)(t - kp);
                OSM_STEP(s, Pb + (size_t)kp * PW + 512 + h * 64); } }
    }
    const float rl = 1.0f / l;
#pragma unroll
    for (int i = 0; i < 16; ++i) o[i] *= rl;
    head_norm_store16(o, gh + (hb + h) * 64 + po, act + (size_t)(b * SEQ + t) * DM + (hb + h) * 64 + po);
}
__device__ __forceinline__ void kmean_unit(const bf16* P, float* kmean, unsigned* knmax, int unit, LAS unsigned char* lds) {
    const int tid = otid();
    const int b = unit >> 4, blk = unit & 15;
    { const int g = tid >> 5, c8 = tid & 31;
      const bf16* p = P + ((size_t)b * SEQ + blk * 256 + g * 16) * PW + 2304 + 256 + c8 * 8;
      float s[8];
#pragma unroll
      for (int i = 0; i < 8; ++i) s[i] = 0.f;
#pragma unroll
      for (int r = 0; r < 16; ++r) { float f[8]; ld8(p + (size_t)r * PW, f);
#pragma unroll
          for (int i = 0; i < 8; ++i) s[i] += f[i]; }
      LAS float* part = (LAS float*)lds;
#pragma unroll
      for (int i = 0; i < 8; ++i) part[g * 256 + c8 * 8 + i] = s[i];
      __syncthreads();
      if (tid < 256) { float t = 0.f;
#pragma unroll
          for (int g2 = 0; g2 < 16; ++g2) t += part[g2 * 256 + tid];
          kmean[(size_t)unit * 256 + tid] = t * (1.0f / 256.0f); } }
    { const int key = tid >> 1, mx = tid & 1; const bf16* kr = P + ((size_t)b * SEQ + blk * 256 + key) * PW + (mx ? 2304 : 768) + 256;
#pragma unroll
      for (int h = 0; h < 4; ++h) { float ss = 0.f;
#pragma unroll
          for (int c8 = 0; c8 < 8; ++c8) { float f[8]; ld8(kr + h * 64 + 8 * c8, f);
#pragma unroll
              for (int i = 0; i < 8; ++i) ss += f[i] * f[i]; }
          float nm = sqrtf(ss);
#pragma unroll
          for (int o_ = 2; o_ < 64; o_ <<= 1) nm = fmaxf(nm, __shfl_xor(nm, o_));
          if ((tid & 63) < 2) atomicMax(&knmax[(b * 2 + mx) * 4 + h], __float_as_uint(nm)); } }
    __syncthreads();
}
constexpr int DSA_LDS = 8 * 4096 * 4;
#define DSA_COUNT_GE(trial, out) do { int c_ = 0; \
    _Pragma("unroll") for (int g_ = 0; g_ < 8; ++g_) if (g_ * 8 < nreg) { \
        _Pragma("unroll") for (int r_ = 0; r_ < 8; ++r_) c_ += __builtin_popcountll(__ballot(K[g_ * 8 + r_] >= (trial))); } \
    (out) = c_; } while (0)
__device__ __forceinline__ void dsa_select_unit(const bf16* P, unsigned long long* mask, int unit, LAS unsigned* sc) {
    const int tid = otid(), lane = tid & 63, wid = tid >> 6, r32 = lane & 31, hi = lane >> 5;
    const int b = unit >> 9, t0 = (unit & 511) * 8;
    const bf16* Pb = P + (size_t)b * SEQ * PW;
    const int hrow = (r32 & 3) + 4 * ((r32 >> 3) & 1), qrow = 2 * ((r32 >> 2) & 1) + ((r32 >> 4) & 1);
    bf16x8 af[2][4];
#pragma unroll
    for (int qg = 0; qg < 2; ++qg)
#pragma unroll
        for (int s = 0; s < 4; ++s) af[qg][s] = *(const bf16x8*)(Pb + (size_t)(t0 + 4 * qg + qrow) * PW + COL_QI + hrow * 64 + 16 * s + 8 * hi);
    float wv[2][2][8];
#pragma unroll
    for (int qg = 0; qg < 2; ++qg)
#pragma unroll
        for (int qq = 0; qq < 2; ++qq) ld8(Pb + (size_t)(t0 + 4 * qg + 2 * hi + qq) * PW + COL_WI, wv[qg][qq]);
    const int ntile = (t0 + 8 + 31) >> 5;
    {
        bf16x8 fa[4], fb[4], fc[4];
#define DSA_LOAD(F, kt_) do { if ((kt_) < ntile) { _Pragma("unroll") for (int s = 0; s < 4; ++s) F[s] = *(const bf16x8*)(Pb + (size_t)((kt_) * 32 + r32) * PW + COL_KI + 16 * s + 8 * hi); } } while (0)
#define DSA_SCORE(F, kt_) do { if ((kt_) < ntile) { const int key = (kt_) * 32 + r32; \
            _Pragma("unroll") for (int qg = 0; qg < 2; ++qg) { \
                f32x16 acc = {0.f, 0.f, 0.f, 0.f, 0.f, 0.f, 0.f, 0.f, 0.f, 0.f, 0.f, 0.f, 0.f, 0.f, 0.f, 0.f}; \
                _Pragma("unroll") for (int s = 0; s < 4; ++s) acc = __builtin_amdgcn_mfma_f32_32x32x16_bf16(af[qg][s], F[s], acc, 0, 0, 0); \
                _Pragma("unroll") for (int qq = 0; qq < 2; ++qq) { float s = 0.f; \
                    _Pragma("unroll") for (int h = 0; h < 8; ++h) s += wv[qg][qq][h] * fmaxf(acc[8 * qq + h], 0.f); \
                    const int ql = 4 * qg + 2 * hi + qq; \
                    const unsigned u = __float_as_uint(s); const unsigned sk = (u & 0x80000000u) ? ~u : (u | 0x80000000u); \
                    sc[ql * 4096 + key] = (key <= t0 + ql) ? sk : 0u; } } } } while (0)
#if defined(PROBE_SUB) && PROBE_SUB == 7
        for (int rep_ = 0; rep_ < 2; ++rep_) {
#endif
        int kt = wid;
        DSA_LOAD(fa, kt); DSA_LOAD(fb, kt + 8);
        while (kt < ntile) {
            DSA_LOAD(fc, kt + 16); DSA_SCORE(fa, kt);
            DSA_LOAD(fa, kt + 24); DSA_SCORE(fb, kt + 8);
            DSA_LOAD(fb, kt + 32); DSA_SCORE(fc, kt + 16);
            kt += 24;
        }
#if defined(PROBE_SUB) && PROBE_SUB == 7
        }
#endif
#undef DSA_LOAD
#undef DSA_SCORE
    }
    __syncthreads();
    {
        const int t = t0 + wid, nvalid = t + 1, nk = ntile * 32, nreg = (nk + 63) >> 6;
        unsigned long long myword = 0ull;
        if (nvalid <= 256) {
            const int lo = lane * 64; myword = (nvalid >= lo + 64) ? ~0ull : (nvalid > lo ? ((1ull << (nvalid - lo)) - 1ull) : 0ull);
        } else {
            LAS unsigned* row = sc + wid * 4096;
            unsigned K[64];
#pragma unroll
            for (int r = 0; r < 64; ++r) K[r] = (r * 64 + lane < nk) ? row[r * 64 + lane] : 0u;
            unsigned prefix = 0u; int cnt_prefix = 4096, c_above = 0, bit = 32;
            while (bit > 0) { --bit; const unsigned trial = prefix | (1u << bit); int cnt; DSA_COUNT_GE(trial, cnt);
                if (cnt >= 256) { prefix = trial; cnt_prefix = cnt; } else c_above = cnt;
                if (cnt_prefix - c_above <= 128) break; }
            if (bit > 0) {
                const unsigned himask = ~((1u << bit) - 1u); const unsigned long long below = (1ull << lane) - 1ull; int base = 0;
#pragma unroll
                for (int g = 0; g < 8; ++g) if (g * 8 < nreg) {
#pragma unroll
                    for (int r = 0; r < 8; ++r) { const unsigned k = K[g * 8 + r]; const bool in = (k & himask) == prefix; const unsigned long long mk = __ballot(in);
                        if (in) row[base + __builtin_popcountll(mk & below)] = k; base += __builtin_popcountll(mk); } }
                const unsigned C0 = (lane < base) ? row[lane] : 0u, C1 = (64 + lane < base) ? row[64 + lane] : 0u;
                while (bit > 0) { --bit; const unsigned trial = prefix | (1u << bit);
                    const int cnt = c_above + __builtin_popcountll(__ballot(C0 >= trial)) + __builtin_popcountll(__ballot(C1 >= trial));
                    if (cnt >= 256) { prefix = trial; cnt_prefix = cnt; } }
            }
            if (cnt_prefix == 256) {
#pragma unroll
                for (int g = 0; g < 8; ++g) if (g * 8 < nreg) {
#pragma unroll
                    for (int r = 0; r < 8; ++r) { const unsigned long long word = __ballot(K[g * 8 + r] >= prefix); if (lane == g * 8 + r) myword = word; } }
            } else {
                int cgt; DSA_COUNT_GE(prefix + 1u, cgt);
                int need = 256 - cgt;
                const unsigned long long below = (1ull << lane) - 1ull;
#pragma unroll
                for (int g = 0; g < 8; ++g) if (g * 8 < nreg) {
#pragma unroll
                    for (int r = 0; r < 8; ++r) { const unsigned k = K[g * 8 + r];
                        const unsigned long long gt = __ballot(k > prefix), eq = __ballot(k == prefix);
                        const int c = __builtin_popcountll(eq); unsigned long long take;
                        if (c <= need) { take = eq; need -= c; }
                        else { const bool mine = ((eq >> lane) & 1ull) && (__builtin_popcountll(eq & below) < need); take = __ballot(mine); need = 0; }
                        const unsigned long long word = gt | take;
                        if (lane == g * 8 + r) myword = word; } }
            }
        }
        mask[(size_t)(b * SEQ + t) * 64 + lane] = myword;
    }
    __syncthreads();
}

#define MFMA32(a, b, c) __builtin_amdgcn_mfma_f32_32x32x16_bf16(a, b, c, 0, 0, 0)
__device__ __forceinline__ int crow(int r, int hi) { return (r & 3) + 8 * (r >> 2) + 4 * hi; }
constexpr int AT_KROW = 144, AT_VROW = 136;
constexpr int AT_KBUF = 64 * AT_KROW, AT_VBUF = 64 * AT_VROW;
constexpr int AT_KOFF = 0, AT_VOFF = 2 * AT_KBUF, AT_KMOFF = AT_VOFF + 2 * AT_VBUF, AT_MISC = AT_KMOFF + 4096;
typedef short s16x4 __attribute__((ext_vector_type(4)));

__device__ __forceinline__ void at_load(const bf16* Pb, int k0, int kcol, int vcol, int tid, u32x4& kr, u32x4& vr) {
    const bf16* row = Pb + (size_t)(k0 + (tid >> 3)) * PW + (tid & 7) * 8;
    kr = *(const u32x4*)(row + kcol); vr = *(const u32x4*)(row + vcol);
}
__device__ __forceinline__ void at_store(LAS unsigned char* lds, int buf, int tid, const u32x4& kr, const u32x4& vr) {
    const int key = tid >> 3, c = tid & 7;
    *(LAS u32x4*)(lds + AT_KOFF + buf * AT_KBUF + key * AT_KROW + c * 16) = kr;
    LAS unsigned short* vt = (LAS unsigned short*)(lds + AT_VOFF + buf * AT_VBUF + (8 * c) * AT_VROW + key * 2);
    vt[0 * (AT_VROW / 2)] = (unsigned short)(vr.x & 0xffffu); vt[1 * (AT_VROW / 2)] = (unsigned short)(vr.x >> 16);
    vt[2 * (AT_VROW / 2)] = (unsigned short)(vr.y & 0xffffu); vt[3 * (AT_VROW / 2)] = (unsigned short)(vr.y >> 16);
    vt[4 * (AT_VROW / 2)] = (unsigned short)(vr.z & 0xffffu); vt[5 * (AT_VROW / 2)] = (unsigned short)(vr.z >> 16);
    vt[6 * (AT_VROW / 2)] = (unsigned short)(vr.w & 0xffffu); vt[7 * (AT_VROW / 2)] = (unsigned short)(vr.w >> 16);
}
__device__ __forceinline__ f32x16 at_scores(LAS unsigned char* lds, int buf, int a, int r32, int hi, const bf16x8 (&qf)[4]) {
    f32x16 s = {0.f, 0.f, 0.f, 0.f, 0.f, 0.f, 0.f, 0.f, 0.f, 0.f, 0.f, 0.f, 0.f, 0.f, 0.f, 0.f};
    const LAS unsigned char* kp = lds + AT_KOFF + buf * AT_KBUF + (32 * a + r32) * AT_KROW + hi * 16;
#pragma unroll
    for (int sp = 0; sp < 4; ++sp) { const bf16x8 kf = *(const LAS bf16x8*)(kp + sp * 32); s = MFMA32(kf, qf[sp], s); }
    return s;
}
__device__ __forceinline__ void at_pv(LAS unsigned char* lds, int buf, int a, int r32, int hi, const f32x16& p, f32x16 (&o)[2]) {
#pragma unroll
    for (int s = 0; s < 2; ++s) {
        u32x4 w; w.x = cvt_pk_bf16(p[8 * s + 0], p[8 * s + 1]); w.y = cvt_pk_bf16(p[8 * s + 2], p[8 * s + 3]); w.z = cvt_pk_bf16(p[8 * s + 4], p[8 * s + 5]); w.w = cvt_pk_bf16(p[8 * s + 6], p[8 * s + 7]);
        const bf16x8 pf = __builtin_bit_cast(bf16x8, w);
#pragma unroll
        for (int dh = 0; dh < 2; ++dh) {
            const LAS unsigned char* vp = lds + AT_VOFF + buf * AT_VBUF + (32 * dh + r32) * AT_VROW + (32 * a + 16 * s + 4 * hi) * 2;
            const s16x4 v0 = *(const LAS s16x4*)vp, v1 = *(const LAS s16x4*)(vp + 16);
            const bf16x8 vf = {v0[0], v0[1], v0[2], v0[3], v1[0], v1[1], v1[2], v1[3]};
            o[dh] = MFMA32(vf, pf, o[dh]);
        }
    }
}
__device__ __forceinline__ void at_finish(f32x16 (&o)[2], float inv_l, int hi, const float* gh, bf16* dst) {
    float ss = 0.f;
#pragma unroll
    for (int dh = 0; dh < 2; ++dh)
#pragma unroll
        for (int r = 0; r < 16; ++r) { o[dh][r] *= inv_l; ss += o[dh][r] * o[dh][r]; }
    ss += __shfl_xor(ss, 32);
    const float rn = rsqrtf(ss * (1.0f / 64.0f) + EPS);
#pragma unroll
    for (int dh = 0; dh < 2; ++dh)
#pragma unroll
        for (int g = 0; g < 4; ++g) { const int d = 32 * dh + 8 * g + 4 * hi; const f32x4 gv = *(const f32x4*)(gh + d);
            u32x2 w; w.x = cvt_pk_bf16(o[dh][4 * g + 0] * rn * gv.x, o[dh][4 * g + 1] * rn * gv.y); w.y = cvt_pk_bf16(o[dh][4 * g + 2] * rn * gv.z, o[dh][4 * g + 3] * rn * gv.w);
            *(u32x2*)(dst + d) = w; }
}

constexpr float LOG2E = 1.4426950408889634f;
template <int MODE> __device__ __forceinline__ void attn_masked_unit(const bf16* P, const unsigned long long* mask, const float* kmean, const unsigned* knmax, const float* gh16, bf16* act, int b, int h, int qb, LAS unsigned char* lds) {
    const int tid = otid(), lane = tid & 63, wid = tid >> 6, r32 = lane & 31, hi = lane >> 5;
    const int cb = MODE == 0 ? 768 : 2304, hb = MODE == 0 ? 4 : 12;
    const bf16* Pb = P + (size_t)b * SEQ * PW + cb;
    const int kcol = 256 + h * 64, vcol = 512 + h * 64;
    const int q0 = qb * 256, tq = q0 + 32 * wid + r32, qmax = q0 + 32 * wid + 31;
    const float slope2 = alibi_slope(MODE == 0 ? 0 : 2, h) * LOG2E;
    bf16x8 qf[4];
#pragma unroll
    for (int sp = 0; sp < 4; ++sp) qf[sp] = *(const bf16x8*)(Pb + (size_t)tq * PW + h * 64 + 16 * sp + 8 * hi);
    float qn2 = 0.f;
#pragma unroll
    for (int sp = 0; sp < 4; ++sp)
#pragma unroll
        for (int i = 0; i < 8; ++i) { const float v = bf2f((unsigned)(unsigned short)qf[sp][i]); qn2 += v * v; }
    qn2 += __shfl_xor(qn2, 32);
    const float bound0 = sqrtf(qn2) * __uint_as_float(knmax[(b * 2 + MODE) * 4 + h]) * 1.01f + 1e-3f;
    LAS unsigned* misc = (LAS unsigned*)(lds + AT_MISC);
    unsigned sel = 0u, wgsel = 0xffffu;
    if (tid < 8) misc[tid] = 0u;
    if (MODE == 1) {
        LAS float* km = (LAS float*)(lds + AT_KMOFF);
        for (int i = tid; i < 16 * 64; i += 512) km[i] = kmean[((size_t)b * 16 + (i >> 6)) * 256 + h * 64 + (i & 63)];
        __syncthreads();
        if (qb <= 3) sel = (1u << qb) - 1u;
        else {
            u32x4 qraw[8];
#pragma unroll
            for (int c = 0; c < 8; ++c) qraw[c] = *(const u32x4*)(Pb + (size_t)tq * PW + h * 64 + 8 * c);
            float v1 = -INFINITY, v2 = -INFINITY, v3 = -INFINITY; int i1 = 0, i2 = 0, i3 = 0;
            for (int blk = 0; blk < qb; ++blk) {
                const LAS f32x4* kb = (const LAS f32x4*)(km + blk * 64); float g0 = 0.f, g1 = 0.f;
#pragma unroll
                for (int c = 0; c < 8; ++c) { const u32x4 u = qraw[c]; const f32x4 ka = kb[2 * c], kc = kb[2 * c + 1];
                    g0 += __uint_as_float(u.x << 16) * ka.x; g1 += __uint_as_float(u.x & 0xffff0000u) * ka.y;
                    g0 += __uint_as_float(u.y << 16) * ka.z; g1 += __uint_as_float(u.y & 0xffff0000u) * ka.w;
                    g0 += __uint_as_float(u.z << 16) * kc.x; g1 += __uint_as_float(u.z & 0xffff0000u) * kc.y;
                    g0 += __uint_as_float(u.w << 16) * kc.z; g1 += __uint_as_float(u.w & 0xffff0000u) * kc.w; }
                const float g = g0 + g1;
                if (g > v1) { v3 = v2; i3 = i2; v2 = v1; i2 = i1; v1 = g; i1 = blk; }
                else if (g > v2) { v3 = v2; i3 = i2; v2 = g; i2 = blk; }
                else if (g > v3) { v3 = g; i3 = blk; }
            }
            sel = (1u << i1) | (1u << i2) | (1u << i3);
        }
        unsigned ws_ = sel;
#pragma unroll
        for (int o_ = 1; o_ < 64; o_ <<= 1) ws_ |= (unsigned)__shfl_xor((int)ws_, o_);
        if (lane == 0) __hip_atomic_fetch_or(&misc[0], ws_, __ATOMIC_RELAXED, __HIP_MEMORY_SCOPE_WORKGROUP);
        __syncthreads();
        wgsel = misc[0] | (1u << qb);
    }
    float cr[16];
#pragma unroll
    for (int r = 0; r < 16; ++r) cr[r] = slope2 * (float)((r & 3) + 8 * (r >> 2));
    f32x16 o[2];
#pragma unroll
    for (int r = 0; r < 16; ++r) { o[0][r] = 0.f; o[1][r] = 0.f; }
    float m = -INFINITY, l = 0.f; bool done = false;
    const unsigned long long* mrow = mask + (size_t)(b * SEQ + tq) * 64;
#define AT_NEXT(x, y) do { (y) = (x) - 1; if (MODE == 1) { while ((y) >= 0 && !((wgsel >> ((y) >> 2)) & 1u)) (y) -= 4; } } while (0)
    int t = 4 * qb + 3, tn, tn2;
    u32x4 kr, vr, kr2, vr2;
    at_load(Pb, t * 64, kcol, vcol, tid, kr, vr);
    unsigned long long mw = (MODE == 0) ? mrow[t] : 0ull, mwn = 0ull, mwn2 = 0ull;
    at_store(lds, 0, tid, kr, vr);
    AT_NEXT(t, tn);
    if (tn >= 0) { at_load(Pb, tn * 64, kcol, vcol, tid, kr, vr); if (MODE == 0) mwn = mrow[tn]; }
    __syncthreads();
    int buf = 0, it = 0;
#define AT_STEP(KA, VA, MA, KB, VB, MB) { \
        tn2 = -1; if (tn >= 0) AT_NEXT(tn, tn2); \
        if (tn2 >= 0) { at_load(Pb, tn2 * 64, kcol, vcol, tid, KB, VB); if (MODE == 0) MB = mrow[tn2]; } \
        at_compute(); \
        if (lane == 0 && (done || tn < 0)) __hip_atomic_fetch_add(&misc[4 + it % 3], 1u, __ATOMIC_RELAXED, __HIP_MEMORY_SCOPE_WORKGROUP); \
        if (tid == 0) misc[4 + (it + 1) % 3] = 0u; \
        if (tn >= 0) at_store(lds, buf ^ 1, tid, KA, VA); \
        __syncthreads(); \
        nd = misc[4 + it % 3]; \
        buf ^= 1; t = tn; tn = tn2; mw = MA; ++it; }
    auto at_compute = [&]() __attribute__((always_inline)) {
        const int k0 = t * 64; const bool own = t >= 4 * qb;
        if (!done && k0 <= qmax) {
            const float ub = bound0 + slope2 * (float)(k0 + 63 - tq);
#if defined(PROBE_SUB) && PROBE_SUB == 6
            if (!own && __all(ub - m < -1e30f)) done = true;
#else
            if (!own && __all(ub - m < -151.0f)) done = true;
#endif
            else if (MODE == 0 || own || __any((sel >> (t >> 2)) & 1u)) {
                f32x16 s0 = at_scores(lds, buf, 0, r32, hi, qf), s1 = at_scores(lds, buf, 1, r32, hi, qf);
                float tb0 = slope2 * (float)(k0 + 4 * hi - tq);
                if (MODE == 1 && !own && !((sel >> (t >> 2)) & 1u)) tb0 = -INFINITY;
                const float tb1 = tb0 + 32.0f * slope2;
                float mx0 = -INFINITY, mx1 = -INFINITY;
                const unsigned wlo = (unsigned)(mw >> (4 * hi)), whi = (unsigned)(mw >> (32 + 4 * hi));
                const int lim = tq - k0 - 4 * hi;
#pragma unroll
                for (int r = 0; r < 16; ++r) { const int kk = (r & 3) + 8 * (r >> 2);
                    float x0 = s0[r] + cr[r], x1 = s1[r] + cr[r];
                    if (MODE == 0) { x0 = (wlo & (1u << kk)) ? x0 : -INFINITY; x1 = (whi & (1u << kk)) ? x1 : -INFINITY; }
                    else if (own) { x0 = (kk <= lim) ? x0 : -INFINITY; x1 = (kk + 32 <= lim) ? x1 : -INFINITY; }
                    s0[r] = x0; s1[r] = x1; mx0 = fmaxf(mx0, x0); mx1 = fmaxf(mx1, x1); }
                float mx = fmaxf(mx0 + tb0, mx1 + tb1);
                mx = fmaxf(mx, __shfl_xor(mx, 32));
                if (__any(mx - m > 8.0f)) {
                    const float mn = fmaxf(m, mx), alpha = (mn == -INFINITY) ? 1.0f : exp2f(m - mn);
                    l *= alpha; m = mn;
#pragma unroll
                    for (int r = 0; r < 16; ++r) { o[0][r] *= alpha; o[1][r] *= alpha; } }
                const float mt0 = (m == -INFINITY) ? INFINITY : m - tb0, mt1 = (m == -INFINITY) ? INFINITY : m - tb1;
                float ps = 0.f;
#pragma unroll
                for (int r = 0; r < 16; ++r) { s0[r] = __builtin_amdgcn_exp2f(s0[r] - mt0); s1[r] = __builtin_amdgcn_exp2f(s1[r] - mt1); ps += s0[r] + s1[r]; }
                l += ps;
                at_pv(lds, buf, 0, r32, hi, s0, o);
                at_pv(lds, buf, 1, r32, hi, s1, o);
            }
        }
    };
    unsigned nd = 0u;
    while (t >= 0) {
        AT_STEP(kr, vr, mwn, kr2, vr2, mwn2);
        if (nd == 8u || t < 0) break;
        AT_STEP(kr2, vr2, mwn2, kr, vr, mwn);
        if (nd == 8u) break;
    }
#undef AT_STEP
#undef AT_NEXT
    l += __shfl_xor(l, 32);
    at_finish(o, 1.0f / l, hi, gh16 + (hb + h) * 64, act + (size_t)(b * SEQ + tq) * DM + (hb + h) * 64);
    __syncthreads();
}

template <int DUMMY> __device__ __forceinline__ void attn_sb_unit(const bf16* P, const float* gh16, bf16* act, int b, int h, int qb, LAS unsigned char* lds) {
    const int tid = otid(), lane = tid & 63, wid = tid >> 6, r32 = lane & 31, hi = lane >> 5;
    const bf16* Pb = P + (size_t)b * SEQ * PW;
    const int kcol = 256 + h * 64, vcol = 512 + h * 64;
    const int q0 = qb * 256, tq = q0 + 32 * wid + r32, qmax = q0 + 32 * wid + 31;
    bf16x8 qf[4];
#pragma unroll
    for (int sp = 0; sp < 4; ++sp) qf[sp] = *(const bf16x8*)(Pb + (size_t)tq * PW + h * 64 + 16 * sp + 8 * hi);
    LAS unsigned* vote = (LAS unsigned*)(lds + AT_MISC);
    if (tid < 3) vote[tid] = 0u;
    f32x16 o[2];
#pragma unroll
    for (int r = 0; r < 16; ++r) { o[0][r] = 0.f; o[1][r] = 0.f; }
    float carry = 1.0f; bool done = false;
    int t = 4 * qb + 3;
    u32x4 kr, vr;
    at_load(Pb, t * 64, kcol, vcol, tid, kr, vr);
    at_store(lds, 0, tid, kr, vr);
    __syncthreads();
    int buf = 0, it = 0;
    while (t >= 0) {
        const int tn = t - 1;
        if (tn >= 0) at_load(Pb, tn * 64, kcol, vcol, tid, kr, vr);
        const int k0 = t * 64;
        if (!done && k0 < qmax) {
#pragma unroll
            for (int ai = 0; ai < 2; ++ai) { const int a = 1 - ai, ks = k0 + 32 * a;
                if (ks < qmax) {
                    f32x16 s = at_scores(lds, buf, a, r32, hi, qf);
                    float G[4];
#pragma unroll
                    for (int g = 0; g < 4; ++g) { float gp = 1.0f;
#pragma unroll
                        for (int i = 0; i < 4; ++i) { const int r = 4 * g + i; const int kp = ks + 8 * g + 4 * hi + i; const bool valid = kp < tq;
                            const float z = fminf(fmaxf(s[r], -80.f), 80.f); const float e = __expf(z); float om = __builtin_amdgcn_rcpf(1.0f + e); float beta = e * om;
                            om = valid ? om : 1.0f; beta = valid ? beta : 0.0f;
                            s[r] = beta; gp *= om; }
                        G[g] = gp; }
                    float Gp[4];
#pragma unroll
                    for (int g = 0; g < 4; ++g) Gp[g] = __shfl_xor(G[g], 32);
                    float SP[4]; SP[3] = 1.0f;
#pragma unroll
                    for (int g = 2; g >= 0; --g) SP[g] = SP[g + 1] * (G[g + 1] * Gp[g + 1]);
                    const float tot = SP[0] * (G[0] * Gp[0]);
#pragma unroll
                    for (int g = 0; g < 4; ++g) { float suf = carry * SP[g] * (hi ? 1.0f : Gp[g]);
#pragma unroll
                        for (int i = 3; i >= 0; --i) { const int r = 4 * g + i; const float beta = s[r]; s[r] = beta * suf; suf *= (1.0f - beta); } }
                    carry *= tot;
                    at_pv(lds, buf, a, r32, hi, s, o);
                }
            }
            done = __all(carry < 1e-30f);
        }
        if (lane == 0 && (done || k0 == 0)) __hip_atomic_fetch_add(&vote[it % 3], 1u, __ATOMIC_RELAXED, __HIP_MEMORY_SCOPE_WORKGROUP);
        if (tid == 0) vote[(it + 1) % 3] = 0u;
        if (tn >= 0) at_store(lds, buf ^ 1, tid, kr, vr);
        __syncthreads();
        const unsigned nd = vote[it % 3];
        buf ^= 1; t = tn; ++it;
        if (nd == 8u) break;
    }
    at_finish(o, 1.0f, hi, gh16 + h * 64, act + (size_t)(b * SEQ + tq) * DM + h * 64);
    __syncthreads();
}

constexpr int DL_VROW = 72, DL_VT = 0, DL_VTW = 64 * DL_VROW, DL_CB = 8 * DL_VTW, DL_CBROW = 65, DL_ML = DL_CB + 256 * DL_CBROW * 4;
template <int BR> __device__ __forceinline__ int dl_kpos(int rho, int j, int q0, int wid) {
    if (BR == 0) return q0 + 32 * wid - 128 + 32 * j + rho;
    if (BR == 1) return q0 + (wid & 3) + 4 * (32 * (wid >> 2) - 128 + 32 * j + rho);
    return q0 + 2 * wid + (rho >> 4) + 16 * (-128 + 16 * j + (rho & 15));
}
template <int BR> __device__ __forceinline__ void dilated_branch(const bf16* Pb, int h, int q0, float slope, LAS unsigned char* lds, int wid, int r32, int hi, const float* ghh, bf16* actb) {
    constexpr int R = BR == 0 ? 1 : (BR == 1 ? 4 : 16), W = 128 * R, NSUB = BR == 2 ? 9 : 5;
    const int qpos = BR == 0 ? q0 + 32 * wid + r32 : (BR == 1 ? q0 + (wid & 3) + 4 * (32 * (wid >> 2) + r32) : q0 + 2 * wid + (r32 >> 4) + 16 * (r32 & 15));
    bf16x8 qf[4];
#pragma unroll
    for (int sp = 0; sp < 4; ++sp) qf[sp] = *(const bf16x8*)(Pb + (size_t)qpos * PW + h * 64 + 16 * sp + 8 * hi);
    LAS unsigned char* vt = lds + DL_VT + wid * DL_VTW;
    f32x16 o[2];
#pragma unroll
    for (int r = 0; r < 16; ++r) { o[0][r] = 0.f; o[1][r] = 0.f; }
    float m = -INFINITY, l = 0.f;
    bf16x8 kf[4], kn[4]; u32x4 vv[4], vn[4];
    { const int kp0 = dl_kpos<BR>(r32, 0, q0, wid); const bf16* krow = Pb + (size_t)(kp0 < 0 ? 0 : kp0) * PW;
#pragma unroll
      for (int sp = 0; sp < 4; ++sp) kf[sp] = *(const bf16x8*)(krow + 256 + h * 64 + 16 * sp + 8 * hi);
#pragma unroll
      for (int i = 0; i < 4; ++i) vv[i] = *(const u32x4*)(krow + 512 + h * 64 + 32 * hi + 8 * i); }
    for (int j = 0; j < NSUB; ++j) {
        if (j + 1 < NSUB) {
            const int kp1 = dl_kpos<BR>(r32, j + 1, q0, wid); const bf16* krow = Pb + (size_t)(kp1 < 0 ? 0 : kp1) * PW;
#pragma unroll
            for (int sp = 0; sp < 4; ++sp) kn[sp] = *(const bf16x8*)(krow + 256 + h * 64 + 16 * sp + 8 * hi);
#pragma unroll
            for (int i = 0; i < 4; ++i) vn[i] = *(const u32x4*)(krow + 512 + h * 64 + 32 * hi + 8 * i); }
        f32x16 s = {0.f, 0.f, 0.f, 0.f, 0.f, 0.f, 0.f, 0.f, 0.f, 0.f, 0.f, 0.f, 0.f, 0.f, 0.f, 0.f};
#pragma unroll
        for (int sp = 0; sp < 4; ++sp) s = MFMA32(kf[sp], qf[sp], s);
#pragma unroll
        for (int i = 0; i < 4; ++i) { LAS unsigned short* w = (LAS unsigned short*)(vt + (32 * hi + 8 * i) * DL_VROW + r32 * 2);
            w[0 * (DL_VROW / 2)] = (unsigned short)(vv[i].x & 0xffffu); w[1 * (DL_VROW / 2)] = (unsigned short)(vv[i].x >> 16);
            w[2 * (DL_VROW / 2)] = (unsigned short)(vv[i].y & 0xffffu); w[3 * (DL_VROW / 2)] = (unsigned short)(vv[i].y >> 16);
            w[4 * (DL_VROW / 2)] = (unsigned short)(vv[i].z & 0xffffu); w[5 * (DL_VROW / 2)] = (unsigned short)(vv[i].z >> 16);
            w[6 * (DL_VROW / 2)] = (unsigned short)(vv[i].w & 0xffffu); w[7 * (DL_VROW / 2)] = (unsigned short)(vv[i].w >> 16); }
        float mx = -INFINITY;
#pragma unroll
        for (int r = 0; r < 16; ++r) { const int kp = dl_kpos<BR>(crow(r, hi), j, q0, wid); const int d = qpos - kp;
            const bool valid = (kp >= 0) && (d >= 0) && (d <= W) && ((d & (R - 1)) == 0);
            s[r] = valid ? s[r] - slope * (float)d : -INFINITY; mx = fmaxf(mx, s[r]); }
        mx = fmaxf(mx, __shfl_xor(mx, 32));
        const float mn = fmaxf(m, mx), mu = (mn == -INFINITY) ? 0.f : mn;
        const float alpha = __builtin_amdgcn_exp2f(m - mu);
        float ps = 0.f;
#pragma unroll
        for (int r = 0; r < 16; ++r) { s[r] = __builtin_amdgcn_exp2f(s[r] - mu); ps += s[r]; }
        l = l * alpha + ps; m = mn;
#pragma unroll
        for (int r = 0; r < 16; ++r) { o[0][r] *= alpha; o[1][r] *= alpha; }
        asm volatile("s_waitcnt lgkmcnt(0)" ::: "memory");
#pragma unroll
        for (int sk = 0; sk < 2; ++sk) {
            u32x4 w; w.x = cvt_pk_bf16(s[8 * sk + 0], s[8 * sk + 1]); w.y = cvt_pk_bf16(s[8 * sk + 2], s[8 * sk + 3]); w.z = cvt_pk_bf16(s[8 * sk + 4], s[8 * sk + 5]); w.w = cvt_pk_bf16(s[8 * sk + 6], s[8 * sk + 7]);
            const bf16x8 pf = __builtin_bit_cast(bf16x8, w);
#pragma unroll
            for (int dh = 0; dh < 2; ++dh) { const LAS unsigned char* vp = vt + (32 * dh + r32) * DL_VROW + (16 * sk + 4 * hi) * 2;
                const s16x4 v0 = *(const LAS s16x4*)vp, v1 = *(const LAS s16x4*)(vp + 16);
                const bf16x8 vf = {v0[0], v0[1], v0[2], v0[3], v1[0], v1[1], v1[2], v1[3]};
                o[dh] = MFMA32(vf, pf, o[dh]); } }
        asm volatile("s_waitcnt lgkmcnt(0)" ::: "memory");
#pragma unroll
        for (int i = 0; i < 4; ++i) { kf[i] = kn[i]; vv[i] = vn[i]; }
    }
    l += __shfl_xor(l, 32);
    const int qi = qpos - q0;
    LAS float* cb = (LAS float*)(lds + DL_CB) + qi * DL_CBROW; LAS float* ml = (LAS float*)(lds + DL_ML);
    if (BR > 0) {
        const float M0 = ml[qi], L0 = ml[256 + qi];
        const float mn = fmaxf(M0, m), a0 = __builtin_amdgcn_exp2f(M0 - mn), a1 = __builtin_amdgcn_exp2f(m - mn);
#pragma unroll
        for (int dh = 0; dh < 2; ++dh)
#pragma unroll
            for (int r = 0; r < 16; ++r) o[dh][r] = o[dh][r] * a1 + cb[32 * dh + crow(r, hi)] * a0;
        l = l * a1 + L0 * a0; m = mn;
    }
    if (BR < 2) {
        __syncthreads();
#pragma unroll
        for (int dh = 0; dh < 2; ++dh)
#pragma unroll
            for (int r = 0; r < 16; ++r) cb[32 * dh + crow(r, hi)] = o[dh][r];
        if (hi == 0) { ml[qi] = m; ml[256 + qi] = l; }
        __syncthreads();
    } else {
        at_finish(o, 1.0f / l, hi, ghh, actb + (size_t)qpos * DM);
    }
}
__device__ __forceinline__ void attn_dilated_unit(const bf16* P, const float* gh16, bf16* act, int b, int h, int qb, LAS unsigned char* lds) {
    const int tid = otid(), lane = tid & 63, wid = tid >> 6, r32 = lane & 31, hi = lane >> 5;
    const bf16* Pb = P + (size_t)b * SEQ * PW + 1536;
    const float slope = alibi_slope(1, h) * LOG2E;
    const float* ghh = gh16 + (8 + h) * 64; bf16* actb = act + (size_t)b * SEQ * DM + (8 + h) * 64;
    dilated_branch<0>(Pb, h, qb * 256, slope, lds, wid, r32, hi, ghh, actb);
    dilated_branch<1>(Pb, h, qb * 256, slope, lds, wid, r32, hi, ghh, actb);
    dilated_branch<2>(Pb, h, qb * 256, slope, lds, wid, r32, hi, ghh, actb);
    __syncthreads();
}

#ifndef MK_SPLIT
#define MK_SPLIT 0
#endif
constexpr int MISC_OFF = 131072, LDS_BYTES = 131072 + 1024;
constexpr int N_PHASES = 19;
struct MegaArgs { const float* in[17]; float* out; unsigned char* ws; int ph_lo, ph_hi, li, pad; };

__global__ void __launch_bounds__(512, 2) mega_fwd(MegaArgs a) {
    extern __shared__ __attribute__((aligned(16))) unsigned char lds_raw[];
    LAS unsigned char* lds = (LAS unsigned char*)lds_raw;
    volatile LAS unsigned* MISC = (volatile LAS unsigned*)(lds + MISC_OFF);
    const int tid = threadIdx.x, bid = blockIdx.x, nblk = gridDim.x;
    for (int u = tid; u < (LDS_BYTES - MISC_OFF) / 4; u += 512) MISC[u] = 0u;
    __syncthreads();
    if (tid < 17) { const unsigned long long p = (unsigned long long)a.in[tid]; MISC[64 + 2 * tid] = (unsigned)p; MISC[65 + 2 * tid] = (unsigned)(p >> 32); }
    __syncthreads();
#define INP(i) ((const float*)(((unsigned long long)(unsigned)__builtin_amdgcn_readfirstlane((int)MISC[65 + 2 * (i)]) << 32) | (unsigned long long)(unsigned)__builtin_amdgcn_readfirstlane((int)MISC[64 + 2 * (i)])))
    unsigned char* ws = a.ws;
    unsigned* ctl = (unsigned*)(ws + WS_CTL);
    XcdBarrier bar; bar.bar = ctl + CW_BAR + a.li * XCD_BAR_WORDS; bar.x = 0; bar.st = nullptr;
    if (!MK_SPLIT) bar = xcd_barrier_post(ctl + CW_BAR + a.li * XCD_BAR_WORDS, MISC + 8);
    const int lo = a.ph_lo, hi = a.ph_hi;
#define RUN(k) (lo <= (k) && (k) < hi)
#define SEAM(k) do { if (RUN(k) && RUN((k) + 1)) { if (!MK_SPLIT) xcd_barrier(bar); } } while (0)
    float* out = a.out;
    float* mod = (float*)(ws + WS_MOD); float* kmean = (float*)(ws + WS_KMEAN); const float* gv = (const float*)(ws + WS_GV);
    int* tok = (int*)(ws + WS_TOK); bf16* act = (bf16*)(ws + WS_ACT); bf16* P = (bf16*)(ws + WS_P); bf16* hid = (bf16*)(ws + WS_HID); unsigned char* xs = ws + WS_XS; bf16* ys = (bf16*)(ws + WS_YS);
    unsigned long long* mask = (unsigned long long*)(ws + WS_MASK); unsigned* ecnt = ctl + CW_ECNT;

    if (RUN(0)) {
        PrepArgs pa{INP(5), INP(7), INP(9), INP(10), INP(11), INP(13), INP(14), INP(15), ws};
        ph_prep(pa, lds, bid, nblk);
        __syncthreads();
        ph_mod(INP(1), INP(2), INP(3), mod, lds, bid, nblk);
        { float* gvw = (float*)(ws + WS_GV); const float* s4 = INP(4); const float* s6 = INP(6); const float* s8 = INP(8); const float* s16 = INP(16);
          for (int i = bid * 512 + otid(); i < 7168; i += nblk * 512) gvw[i] = i < 2048 ? s4[i] : (i < 4096 ? s6[i - 2048] : (i < 6144 ? s8[i - 4096] : s16[i - 6144])); }
    }
    SEAM(0);
    for (int l = 0; l < NLAYER; ++l) {
        const int pb = 1 + 8 * l;
        const float* ml = mod + (size_t)l * 8 * 6144; const float* xin = (l == 0) ? INP(0) : out; const float* gh = gv + 2048 + l * 1024;
        if (RUN(pb)) { NormArgs na{}; na.xin = xin; na.g = gv + l * DM; na.shift = ml; na.scale = ml + 1024; na.act = act; ph_norm<0>(na, lds, bid, nblk); }
        SEAM(pb);
        if (RUN(pb + 1)) { pg8::Gemm g{act, (const bf16*)(ws + WS_WIN) + (size_t)l * PW * DM, T, PW, DM}; pg8::StaticOrder S; S.init(T, PW, nblk, bid);
            pg8::EpiBf16 E{P, PW, 0}; pg8::gemm_phase<pg8::EpiBf16, pg8::StaticOrder, true, true>(lds, g, S, E); }
        SEAM(pb + 1);
        if (RUN(pb + 2)) {
            for (int u = bid, r = 0; u < NB * 512; u += nblk, ++r) { const int unit = (r & 1) ? (r * nblk + nblk - 1 - bid) : u; if (unit < NB * 512) dsa_select_unit(P, mask, unit, (LAS unsigned*)lds); }
            for (int unit = bid; unit < NB * 16; unit += nblk) kmean_unit(P, kmean, ctl + CW_KNMAX + l * 64, unit, lds);
#if defined(PROBE_SUB) && PROBE_SUB == 1
            if (l == 1) for (int u = bid, r = 0; u < NB * 512; u += nblk, ++r) { const int unit = (r & 1) ? (r * nblk + nblk - 1 - bid) : u; if (unit < NB * 512) dsa_select_unit(P, mask, unit, (LAS unsigned*)lds); }
#endif
#if defined(PROBE_SUB) && PROBE_SUB == 2
            if (l == 1) for (int u = bid; u < 512; u += nblk) attn_sb_unit<0>(P, gh, act, u & 7, (u >> 3) & 3, u >> 5, lds);
#endif
#if defined(PROBE_SUB) && PROBE_SUB == 3
            if (l == 1) for (int u = bid; u < 512; u += nblk) attn_dilated_unit(P, gh, act, u & 7, (u >> 3) & 3, u >> 5, lds);
#endif
#ifndef NO_SB
            for (int u = bid; u < 512; u += nblk) attn_sb_unit<0>(P, gh, act, u & 7, (u >> 3) & 3, u >> 5, lds);
#endif
#ifndef NO_DIL
            for (int u = bid; u < 512; u += nblk) attn_dilated_unit(P, gh, act, u & 7, (u >> 3) & 3, u >> 5, lds);
#endif
        }
        SEAM(pb + 2);
        if (RUN(pb + 3)) {
            LAS unsigned* qslot = (LAS unsigned*)(lds + AT_MISC + 64);
            for (;;) { if (otid() == 0) qslot[0] = atomicAdd(&ctl[CW_QUEUE + 2 * l], 1u);
                __syncthreads(); const unsigned u = qslot[0]; __syncthreads();
                if (u >= 512u) break;
                attn_masked_unit<0>(P, mask, kmean, ctl + CW_KNMAX + l * 64, gh, act, (int)(u & 7u), 3 - (int)((u >> 3) & 3u), 15 - (int)(u >> 5), lds); }
#if defined(PROBE_SUB) && PROBE_SUB == 4
            if (l == 1) for (;;) { if (otid() == 0) qslot[0] = atomicAdd(&ctl[CW_QUEUE + 8], 1u);
                __syncthreads(); const unsigned u = qslot[0]; __syncthreads();
                if (u >= 512u) break;
                attn_masked_unit<0>(P, mask, kmean, ctl + CW_KNMAX + l * 64, gh, act, (int)(u & 7u), 3 - (int)((u >> 3) & 3u), 15 - (int)(u >> 5), lds); }
#endif
#if defined(PROBE_SUB) && PROBE_SUB == 5
            if (l == 1) for (;;) { if (otid() == 0) qslot[0] = atomicAdd(&ctl[CW_QUEUE + 8], 1u);
                __syncthreads(); const unsigned u = qslot[0]; __syncthreads();
                if (u >= 512u) break;
                attn_masked_unit<1>(P, mask, kmean, ctl + CW_KNMAX + l * 64, gh, act, (int)(u & 7u), 3 - (int)((u >> 3) & 3u), 15 - (int)(u >> 5), lds); }
#endif
            for (;;) { if (otid() == 0) qslot[0] = atomicAdd(&ctl[CW_QUEUE + 2 * l + 1], 1u);
                __syncthreads(); const unsigned u = qslot[0]; __syncthreads();
                if (u >= 512u) break;
                attn_masked_unit<1>(P, mask, kmean, ctl + CW_KNMAX + l * 64, gh, act, (int)(u & 7u), 3 - (int)((u >> 3) & 3u), 15 - (int)(u >> 5), lds); }
        }
        SEAM(pb + 3);
        if (RUN(pb + 4)) { pg8::Gemm g{act, (const bf16*)(ws + WS_WOUT) + (size_t)l * DM * DM, T, DM, DM}; pg8::StaticOrder S; S.init(T, DM, nblk, bid);
            pg8::EpiRes E{xin, out, ml + 2048}; pg8::gemm_phase<pg8::EpiRes, pg8::StaticOrder, true, true>(lds, g, S, E); }
        SEAM(pb + 4);
        if (l == 0) {
            if (RUN(6)) { NormArgs na{}; na.xin = out; na.g = gv + 4096; na.shift = ml + 3072; na.scale = ml + 4096; na.act8 = (unsigned char*)act; ph_norm<0>(na, lds, bid, nblk); }
            SEAM(6);
#ifndef NO_FF
            if (RUN(7)) { pg8::Gemm g{act, (const bf16*)(ws + WS_WFU), T, 2 * DFF, DM}; pg8::StaticOrder S; S.init(T, 2 * DFF, nblk, bid);
                pg8::EpiSwiGLU8 E{(unsigned char*)hid, DFF, 0}; pg8::gemm_phase<pg8::EpiSwiGLU8, pg8::StaticOrder, true, true, true, 0x7A7A7A7A>(lds, g, S, E); }
            SEAM(7);
            if (RUN(8)) { pg8::Gemm g{hid, (const bf16*)(ws + WS_WFD), T, DM, DFF}; pg8::StaticOrder S; S.init(T, DM, nblk, bid);
                pg8::EpiRes E{out, out, ml + 5120}; pg8::gemm_phase<pg8::EpiRes, pg8::StaticOrder, true, true, true, 0x79797979>(lds, g, S, E); }
            SEAM(8);
#endif
        } else {
            if (RUN(14)) { NormArgs na{}; na.xin = out; na.g = gv + 4096 + DM; na.shift = ml + 3072; na.scale = ml + 4096; na.act8 = (unsigned char*)act; na.w_router = INP(12); na.tok = tok; na.ecnt = ecnt;
                ph_norm<1>(na, lds, bid, nblk); }
            SEAM(14);
            if (RUN(15)) ph_gather((const unsigned char*)act, tok, ecnt, xs, bid, nblk);
            SEAM(15);
            if (RUN(16) || RUN(17)) {
                LAS unsigned char* etab = lds + MISC_OFF + 512;
                int ntot;
                { const MoeTiles mt = moe_tiles(ecnt); ntot = moe_tile_start(mt, 7) + mt.p7;
                  const int t_ = otid(); if (t_ < XS_TILES) { int e_ = 0;
#pragma unroll
                      for (int k = 1; k < 8; ++k) e_ += (t_ >= moe_tile_start(mt, k)) ? 1 : 0;
                      etab[t_] = (unsigned char)e_; }
                  __syncthreads(); }
                pg8::MoeOrder S; S.nrt = ntot; S.G = nblk; S.c = bid; S.etab = etab;
                if (RUN(16)) { S.nN = 28; S.estride = (size_t)7168 * DM;
                    pg8::Gemm g{(const bf16*)xs, (const bf16*)(ws + WS_WEU), 0, 0, DM};
                    pg8::EpiSwiGLU8 E{(unsigned char*)hid, DFE, 0}; pg8::gemm_phase<pg8::EpiSwiGLU8, pg8::MoeOrder, true, true, true, 0x7A7A7A7A>(lds, g, S, E); }
                SEAM(16);
                if (RUN(17)) { S.nN = 4; S.estride = (size_t)DM * DFE;
                    pg8::Gemm g{hid, (const bf16*)(ws + WS_WED), 0, 0, DFE};
                    pg8::EpiBf16 E{ys, DM, 0}; pg8::gemm_phase<pg8::EpiBf16, pg8::MoeOrder, true, true, true, 0x79797979>(lds, g, S, E); }
                SEAM(17);
            }
            if (RUN(18)) { NormArgs na{}; na.xin = out; na.g = gv + 6144; na.tok = tok; na.ecnt = ecnt; na.ys = ys; na.gate = ml + 5120; na.out = out; ph_norm<2>(na, lds, bid, nblk); }
        }
    }
#undef RUN
#undef SEAM
}

extern "C" void kernel_launch(void* const* d_in, const int* in_sizes, int n_in, void* d_out, int out_size, void* d_ws, size_t ws_size, hipStream_t stream) {
    static int grid = 0;
    if (grid == 0) {
        if (n_in != 17 || out_size != T * DM || ws_size < WS_END) { fprintf(stderr, "kernel_launch: unexpected problem (n_in %d out %d ws %zu)\n", n_in, out_size, ws_size); grid = -1; return; }
        int dev = 0, cus = 0, per_cu = 0;
        if (hipGetDevice(&dev) != hipSuccess || hipDeviceGetAttribute(&cus, hipDeviceAttributeMultiprocessorCount, dev) != hipSuccess) { grid = -1; return; }
        if (hipFuncSetAttribute((const void*)mega_fwd, hipFuncAttributeMaxDynamicSharedMemorySize, LDS_BYTES) != hipSuccess) { fprintf(stderr, "kernel_launch: hipFuncSetAttribute failed\n"); grid = -1; return; }
        if (hipOccupancyMaxActiveBlocksPerMultiprocessor(&per_cu, (const void*)mega_fwd, 512, LDS_BYTES) != hipSuccess || per_cu < 1) fprintf(stderr, "kernel_launch: occupancy query says %d\n", per_cu);
        (void)hipGetLastError();
        grid = cus;
    }
    if (grid < 0) return;
    if (hipMemsetAsync((unsigned char*)d_ws + WS_CTL, 0, CTL_BYTES, stream) != hipSuccess) return;
    MegaArgs a{};
    for (int i = 0; i < 17; ++i) a.in[i] = (const float*)d_in[i];
    a.out = (float*)d_out; a.ws = (unsigned char*)d_ws;
#if MK_SPLIT
    for (int p = 0; p < N_PHASES; ++p) { a.ph_lo = p; a.ph_hi = p + 1; hipLaunchKernelGGL(mega_fwd, dim3(grid), dim3(512), LDS_BYTES, stream, a); }
#elif defined(PROBE_PHASE)
    a.li = 0; a.ph_lo = 0; a.ph_hi = PROBE_PHASE + 1; hipLaunchKernelGGL(mega_fwd, dim3(grid), dim3(512), LDS_BYTES, stream, a);
    a.li = 1; a.ph_lo = PROBE_PHASE; a.ph_hi = PROBE_PHASE + 1; hipLaunchKernelGGL(mega_fwd, dim3(grid), dim3(512), LDS_BYTES, stream, a);
    a.li = 2; a.ph_lo = PROBE_PHASE + 1; a.ph_hi = N_PHASES; hipLaunchKernelGGL(mega_fwd, dim3(grid), dim3(512), LDS_BYTES, stream, a);
#else
    a.ph_lo = 0; a.ph_hi = N_PHASES;
    hipLaunchKernelGGL(mega_fwd, dim3(grid), dim3(512), LDS_BYTES, stream, a);
#endif
}
```

```cpp
#define WIN_FP8 1
#define WOUT_FP8 1
#define MOE_GATHER_A 1
#define PREP_LAZY 1
#define DL_TR 1
#define AT_TR 1
#define SWIGLU_PK 1
#define AT_BFI 1
#define WIN_VARIANT_C 1
#define SB_WAVE 1
#define HEAD_PASS 1
#define DSA_BITSLICE 1
#include <hip/hip_runtime.h>
#include <cstdio>
#include <cstdint>

#define LAS __attribute__((address_space(3)))
#define GAS __attribute__((address_space(1)))
typedef unsigned short bf16;
typedef short bf16x8 __attribute__((ext_vector_type(8)));
typedef float f32x4 __attribute__((ext_vector_type(4)));
typedef float f32x16 __attribute__((ext_vector_type(16)));
typedef unsigned u32x4 __attribute__((ext_vector_type(4)));
typedef unsigned u32x2 __attribute__((ext_vector_type(2)));

constexpr int NB = 8, SEQ = 4096, T = NB * SEQ, DM = 1024, NLAYER = 2;
constexpr int PW = 3840;
constexpr int NIN = 3656;
constexpr int COL_QI = 3072, COL_KI = 3584, COL_WI = 3648;
constexpr int DFF = 2816, DFE = 3584, NEXP = 8;
constexpr float EPS = 1e-6f;
constexpr int XS_TILES = 264;

constexpr size_t MiB = 1u << 20;
constexpr size_t WS_CTL = 0, CTL_BYTES = 1 * MiB;
constexpr size_t WS_MOD = 1 * MiB;
constexpr size_t WS_GV = 1 * MiB + 400 * 1024;
constexpr size_t WS_KMEAN = 1 * MiB + 512 * 1024;
constexpr size_t WS_MOBASEL = 1 * MiB + 768 * 1024;
constexpr size_t WS_TOK = 2 * MiB;
constexpr size_t WS_WIN = 4 * MiB;
constexpr size_t WS_WIN8 = 458 * MiB;
#if defined(WIN_VARIANT_C)
constexpr unsigned WIN_BF16_TILES = 0x7000u; constexpr int WIN_NB16 = 3, WIN_FULL8 = 5; constexpr unsigned long long WIN_LIST16 = 0xEDCull, WIN_LIST8 = 0xBA9876543210ull;
#elif defined(WIN_VARIANT_B)
constexpr unsigned WIN_BF16_TILES = 0x4600u; constexpr int WIN_NB16 = 3, WIN_FULL8 = 5; constexpr unsigned long long WIN_LIST16 = 0xEA9ull, WIN_LIST8 = 0xDCB876543210ull;
#else
constexpr unsigned WIN_BF16_TILES = 0x7600u;
constexpr int WIN_NB16 = 5, WIN_FULL8 = 4; constexpr unsigned long long WIN_LIST16 = 0xEDCA9ull, WIN_LIST8 = 0xB876543210ull;
#endif
constexpr size_t WS_ACT8W = 360 * MiB;
constexpr size_t WS_WOUT = 19 * MiB;
constexpr size_t WS_WFU = 23 * MiB;
constexpr size_t WS_WFD = 34 * MiB;
constexpr size_t WS_ELIST = 37 * MiB;
constexpr size_t WS_ACT = 40 * MiB;
constexpr size_t WS_P = 104 * MiB;
constexpr size_t WS_HID = 104 * MiB;
constexpr size_t WS_XS = 336 * MiB;
constexpr size_t WS_YS = 336 * MiB;
constexpr size_t WS_MASK = 344 * MiB;
constexpr size_t WS_WEU = 402 * MiB;
constexpr size_t WS_WED = 468 * MiB;
constexpr size_t WS_XB = 496 * MiB;
constexpr size_t WS_END = 560 * MiB;
constexpr int CW_ECNT = 64;
constexpr int CW_KNMAX = 128;
constexpr int CW_QUEUE = 256;
constexpr int CW_PREPQ = 352, CW_PDONE = 353;
constexpr int CW_BAR = 4096;

__device__ __forceinline__ float bf2f(unsigned v) { return __uint_as_float(v << 16); }
__device__ __forceinline__ unsigned f2bf(float f) { unsigned u = __float_as_uint(f); return (u + 0x7fffu + ((u >> 16) & 1u)) >> 16; }
__device__ __forceinline__ unsigned pk2(float lo, float hi) { return f2bf(lo) | (f2bf(hi) << 16); }
__device__ __forceinline__ unsigned cvt_pk_bf16(float lo, float hi) { unsigned r; asm volatile("v_cvt_pk_bf16_f32 %0, %1, %2" : "=v"(r) : "v"(lo), "v"(hi)); return r; }
__device__ __forceinline__ float wave_sum(float v) {
#pragma unroll
    for (int o = 1; o < 64; o <<= 1) v += __shfl_xor(v, o);
    return v;
}
__device__ __forceinline__ void ld8(const bf16* p, float* f) {
    const u32x4 u = *(const u32x4*)p;
    f[0] = __uint_as_float(u.x << 16); f[1] = __uint_as_float(u.x & 0xffff0000u);
    f[2] = __uint_as_float(u.y << 16); f[3] = __uint_as_float(u.y & 0xffff0000u);
    f[4] = __uint_as_float(u.z << 16); f[5] = __uint_as_float(u.z & 0xffff0000u);
    f[6] = __uint_as_float(u.w << 16); f[7] = __uint_as_float(u.w & 0xffff0000u);
}
__device__ __forceinline__ float alibi_slope(int mixer_pos, int h) { return exp2f(-8.0f * (float)(3 * h + mixer_pos + 1) / 12.0f); }
__device__ __forceinline__ float silu_f(float x) { return x * __builtin_amdgcn_rcpf(1.0f + __expf(-x)); }
__device__ __forceinline__ int otid() { int t = threadIdx.x; asm volatile("" : "+v"(t)); return t; }
#define XB_TMO      128
#define XB_XCNT(j)  (256  + 64 * (j))
#define XB_XSUB(j)  (1280 + 64 * (j))
#define XB_XGEN(j)  (2304 + 64 * (j))
#define XB_TOP      3328
#define XB_TOPGEN   3392
#define XCD_BAR_WORDS 3456
#define XB_SPIN_CAP (1u << 18)

__device__ __forceinline__ unsigned xb_ld(unsigned* p)              { return __hip_atomic_load(p, __ATOMIC_RELAXED, __HIP_MEMORY_SCOPE_AGENT); }
__device__ __forceinline__ unsigned xb_add(unsigned* p, unsigned v) { return __hip_atomic_fetch_add(p, v, __ATOMIC_RELAXED, __HIP_MEMORY_SCOPE_AGENT); }
__device__ __forceinline__ unsigned xb_xcc_id() { return (unsigned)__builtin_amdgcn_s_getreg((3 << 11) | 20) & 0xFu; }
#define XB_SPIN(cond, bar) do { unsigned _sp = 0; while (cond) { __builtin_amdgcn_s_sleep(1); \
    if ((++_sp & 255u) == 0u) { if (xb_ld(&(bar)[XB_TMO])) break; if (_sp > XB_SPIN_CAP) { atomicAdd(&(bar)[XB_TMO], 1u); break; } } } } while (0)

struct XcdBarrier {
    unsigned* bar; unsigned x;
    volatile LAS unsigned* st;
};

__device__ __forceinline__ XcdBarrier xcd_barrier_post(unsigned* bar, volatile LAS unsigned* st) {
    XcdBarrier b; b.bar = bar; b.x = xb_xcc_id(); b.st = st;
    if (threadIdx.x == 0) (void)xb_add(&bar[XB_XCNT(b.x)], 1u);
    return b;
}
__device__ __forceinline__ void xcd_barrier_complete(unsigned* bar, unsigned x, unsigned& nloc, unsigned& nx) {
    const unsigned G = gridDim.x * gridDim.y * gridDim.z;
    unsigned sum, cnt, mine, sp = 0u;
    for (;;) {
        asm volatile("" : "+s"(bar), "+s"(x));
        sum = 0u; cnt = 0u; mine = 0u;
#pragma unroll
        for (unsigned j = 0; j < 16; ++j) { const unsigned c = xb_ld(&bar[XB_XCNT(j)]); sum += c; cnt += (c > 0u) ? 1u : 0u; mine = (j == x) ? c : mine; }
        if (sum == G) break;
        __builtin_amdgcn_s_sleep(1);
        if ((++sp & 255u) == 0u) { if (xb_ld(&bar[XB_TMO])) break; if (sp > XB_SPIN_CAP) { atomicAdd(&bar[XB_TMO], 1u); break; } }
    }
    nloc = mine > 0u ? mine : 1u; nx = cnt > 0u ? cnt : 1u;
}

__device__ __forceinline__ void xcd_barrier(const XcdBarrier& b) {
    asm volatile("s_waitcnt vmcnt(0)" ::: "memory");
    __syncthreads();
    if (threadIdx.x == 0) {
        unsigned* bar = b.bar; unsigned bx = b.x; asm volatile("" : "+s"(bx));
        __builtin_amdgcn_s_waitcnt(0);
        unsigned nloc = b.st[0], nx = b.st[1];
        if (nloc == 0u) { xcd_barrier_complete(bar, bx, nloc, nx); b.st[0] = nloc; b.st[1] = nx; }
        const unsigned old = xb_add(&bar[XB_XSUB(bx)], 1u);
        const unsigned gen = old / nloc;
        if (old + 1u == (gen + 1u) * nloc) {
            __builtin_amdgcn_fence(__ATOMIC_RELEASE, "agent");
            asm volatile("s_waitcnt vmcnt(0)" ::: "memory");
            const unsigned og = xb_add(&bar[XB_TOP], 1u);
            const unsigned tg = og / nx;
            if (og + 1u == (tg + 1u) * nx) xb_add(&bar[XB_TOPGEN], 1u);
            else XB_SPIN(xb_ld(&bar[XB_TOPGEN]) == tg, bar);
            __builtin_amdgcn_fence(__ATOMIC_ACQUIRE, "agent");
            xb_add(&bar[XB_XGEN(bx)], 1u);
            asm volatile("s_waitcnt vmcnt(0)" ::: "memory");
        } else {
            XB_SPIN(xb_ld(&bar[XB_XGEN(bx)]) == gen, bar);
            __builtin_amdgcn_fence(__ATOMIC_ACQUIRE, "agent");
            asm volatile("s_waitcnt vmcnt(0)" ::: "memory");
        }
    }
    __syncthreads();
}
namespace pg8 {
#define PG8_LAS __attribute__((address_space(3)))
typedef unsigned short bf16_t;
typedef short bf16x8 __attribute__((ext_vector_type(8)));
typedef float f32x4 __attribute__((ext_vector_type(4)));
typedef unsigned u32x4 __attribute__((ext_vector_type(4)));
constexpr int BM = 256, BK = 64, HALF = 128, HTB = HALF * BK * 2  , STAGE_BYTES = 8 * HTB, NXCD = 8, WGM = 8;

__host__ __device__ __forceinline__ int lds_byte(int r, int c) { const int st = (r >> 4) * 2 + (c >> 5), rr = r & 15, cc = c & 31, ob = rr * 64 + cc * 2; return st * 1024 + (ob ^ (((ob >> 9) & 1) << 5)); }
__host__ __device__ __forceinline__ void stage_rc(int b, int& R, int& C) { const int st = b / 1024, sb = b % 1024, swz = sb ^ (((sb >> 9) & 1) << 5); R = (st >> 1) * 16 + swz / 64; C = (st & 1) * 32 + (swz % 64) / 2; }
__host__ __device__ __forceinline__ int perm32(int rho) { const int n = rho >> 4, i = rho & 15; return 8 * (i >> 2) + 4 * n + (i & 3); }

struct Unit { int pm, pn; };
struct Gemm { const bf16_t* A; const bf16_t* Bt; int M, N, K; };

struct StaticOrder {
    int nM, nN, nwg, G, c;
    __host__ __device__ void init(int M, int N, int G_, int c_) { nM = M / BM; nN = N / BM; nwg = nM * nN; G = G_; c = c_; }
    __host__ __device__ bool next(int i, Unit& u) const {
        const long L = (long)i * G + c; if (L >= nwg) return false;
        int wgid = (int)L; { const int q = nwg / NXCD, r = nwg % NXCD, xcd = wgid % NXCD, off = wgid / NXCD; wgid = (xcd < r ? xcd * (q + 1) : r * (q + 1) + (xcd - r) * q) + off; }
        const int nig = WGM * nN, gid = wgid / nig, fm = gid * WGM, gsz = (nM - fm) < WGM ? (nM - fm) : WGM;
        u.pm = fm + ((wgid % nig) % gsz); u.pn = (wgid % nig) / gsz; return true;
    }
    __device__ __forceinline__ void a_ready(const Unit&) const {}
    __device__ __forceinline__ void done(const Unit&) const {}
    __device__ __forceinline__ const char* a_base(const Gemm& g, const Unit& u, size_t tstep) const { return (const char*)g.A + (size_t)u.pm * tstep; }
    __device__ __forceinline__ const char* b_base(const Gemm& g, const Unit& u, size_t tstep) const { return (const char*)g.Bt + (size_t)u.pn * tstep; }
};


typedef int v4i_t __attribute__((ext_vector_type(4)));
typedef int v8i_t __attribute__((ext_vector_type(8)));
__device__ __forceinline__ v8i_t cat8(bf16x8 lo, bf16x8 hi) { const v4i_t a = __builtin_bit_cast(v4i_t, lo), b = __builtin_bit_cast(v4i_t, hi); return __builtin_shufflevector(a, b, 0, 1, 2, 3, 4, 5, 6, 7); }
__device__ __forceinline__ unsigned pk4_fp8(float a, float b, float c, float d) {
    a = fminf(fmaxf(a, -448.f), 448.f); b = fminf(fmaxf(b, -448.f), 448.f); c = fminf(fmaxf(c, -448.f), 448.f); d = fminf(fmaxf(d, -448.f), 448.f);
    int w = 0; w = __builtin_amdgcn_cvt_pk_fp8_f32(a, b, w, false); w = __builtin_amdgcn_cvt_pk_fp8_f32(c, d, w, true); return (unsigned)w; }

struct EpiBf16 {
    static constexpr bool PERM = true, AFTER_DRAIN = false;
    bf16_t* O; int ldc; int row_shift;
    __device__ __forceinline__ void operator()(const f32x4 (&acc)[2][2][4][2], const Unit& u, int wr, int wc, int fr, int fq) const {
        const int row0 = u.pm * BM + row_shift + wr * 64 + fr, col0 = u.pn * BM + wc * 32 + 8 * fq;
#pragma unroll
        for (int ai = 0; ai < 2; ++ai)
#pragma unroll
            for (int m = 0; m < 4; ++m) { bf16_t* rowp = O + (size_t)(row0 + ai * HALF + m * 16) * ldc + col0;
#pragma unroll
                for (int bj = 0; bj < 2; ++bj) { const f32x4 v0 = acc[ai][bj][m][0], v1 = acc[ai][bj][m][1];
                    u32x4 w; w.x = cvt_pk_bf16(v0[0], v0[1]); w.y = cvt_pk_bf16(v0[2], v0[3]); w.z = cvt_pk_bf16(v1[0], v1[1]); w.w = cvt_pk_bf16(v1[2], v1[3]);
                    *(u32x4*)(rowp + bj * HALF) = w; } }
    }
};
struct EpiSwiGLU {
    static constexpr bool PERM = true, AFTER_DRAIN = false;
    bf16_t* H; int ldh; int row_shift;
    __device__ __forceinline__ void operator()(const f32x4 (&acc)[2][2][4][2], const Unit& u, int wr, int wc, int fr, int fq) const {
        const int row0 = u.pm * BM + row_shift + wr * 64 + fr, col0 = u.pn * HALF + wc * 32 + 8 * fq;
#pragma unroll
        for (int ai = 0; ai < 2; ++ai)
#pragma unroll
            for (int m = 0; m < 4; ++m) { bf16_t* rowp = H + (size_t)(row0 + ai * HALF + m * 16) * ldh + col0;
                const f32x4 g0 = acc[ai][0][m][0], g1 = acc[ai][0][m][1], u0 = acc[ai][1][m][0], u1 = acc[ai][1][m][1];
                float h[8];
#pragma unroll
                for (int i = 0; i < 4; ++i) { h[i] = silu_f(g0[i]) * u0[i]; h[4 + i] = silu_f(g1[i]) * u1[i]; }
                u32x4 w; w.x = cvt_pk_bf16(h[0], h[1]); w.y = cvt_pk_bf16(h[2], h[3]); w.z = cvt_pk_bf16(h[4], h[5]); w.w = cvt_pk_bf16(h[6], h[7]);
                *(u32x4*)rowp = w; }
    }
};
struct EpiSwiGLU8 {
    static constexpr bool PERM = true, AFTER_DRAIN = false;
    unsigned char* H; int ldh; int row_shift;
    __device__ __forceinline__ void operator()(const f32x4 (&acc)[2][2][4][2], const Unit& u, int wr, int wc, int fr, int fq) const {
        const int row0 = u.pm * BM + row_shift + wr * 64 + fr, col0 = u.pn * HALF + wc * 32 + 8 * fq;
#pragma unroll
        for (int ai = 0; ai < 2; ++ai)
#pragma unroll
            for (int m = 0; m < 4; ++m) { unsigned char* rowp = H + (size_t)(row0 + ai * HALF + m * 16) * ldh + col0;
                const f32x4 g0 = acc[ai][0][m][0], g1 = acc[ai][0][m][1], u0 = acc[ai][1][m][0], u1 = acc[ai][1][m][1];
                float h[8];
#ifdef SWIGLU_PK
                typedef float f32x2_t __attribute__((ext_vector_type(2)));
#pragma unroll
                for (int i = 0; i < 4; i += 2) {
                    const f32x2_t ga = {g0[i], g0[i + 1]}, gb = {g1[i], g1[i + 1]}, ua = {u0[i], u0[i + 1]}, ub = {u1[i], u1[i + 1]};
                    f32x2_t ea = {__builtin_amdgcn_exp2f(-ga.x), __builtin_amdgcn_exp2f(-ga.y)}, eb = {__builtin_amdgcn_exp2f(-gb.x), __builtin_amdgcn_exp2f(-gb.y)};
                    ea = ea + 1.0f; eb = eb + 1.0f;
                    const f32x2_t ra = {__builtin_amdgcn_rcpf(ea.x), __builtin_amdgcn_rcpf(ea.y)}, rb = {__builtin_amdgcn_rcpf(eb.x), __builtin_amdgcn_rcpf(eb.y)};
                    const f32x2_t ha = (ga * ua) * ra, hb = (gb * ub) * rb;
                    h[i] = ha.x; h[i + 1] = ha.y; h[4 + i] = hb.x; h[4 + i + 1] = hb.y; }
#else
#pragma unroll
                for (int i = 0; i < 4; ++i) { h[i] = silu_f(g0[i]) * u0[i]; h[4 + i] = silu_f(g1[i]) * u1[i]; }
#endif
                typedef unsigned u32x2_t __attribute__((ext_vector_type(2)));
                u32x2_t w; w.x = pk4_fp8(h[0], h[1], h[2], h[3]); w.y = pk4_fp8(h[4], h[5], h[6], h[7]);
                *(u32x2_t*)rowp = w;
                asm volatile("" ::: "memory"); }
    }
};
struct EpiRes {
    static constexpr bool PERM = true, AFTER_DRAIN = false;
    const float* xin32; const bf16_t* xin16; bf16_t* xout; const float* gate;
    __device__ __forceinline__ void operator()(const f32x4 (&acc)[2][2][4][2], const Unit& u, int wr, int wc, int fr, int fq) const {
        const int row0 = u.pm * BM + wr * 64 + fr, col0 = u.pn * BM + wc * 32 + 8 * fq;
        const float* gb = gate + (size_t)((u.pm * BM) / SEQ) * 6144;
        f32x4 gv[2][2];
#pragma unroll
        for (int bj = 0; bj < 2; ++bj)
#pragma unroll
            for (int n = 0; n < 2; ++n) gv[bj][n] = *(const f32x4*)(gb + col0 + bj * HALF + n * 4);
#pragma unroll
        for (int ai = 0; ai < 2; ++ai)
#pragma unroll
            for (int m = 0; m < 4; ++m) { const size_t off = (size_t)(row0 + ai * HALF + m * 16) * DM + col0;
#pragma unroll
                for (int bj = 0; bj < 2; ++bj) { f32x4 x0, x1;
                    if (xin32) { x0 = *(const f32x4*)(xin32 + off + bj * HALF); x1 = *(const f32x4*)(xin32 + off + bj * HALF + 4); }
                    else { const u32x4 w = *(const u32x4*)(xin16 + off + bj * HALF);
                        x0 = (f32x4){__uint_as_float(w.x << 16), __uint_as_float(w.x & 0xffff0000u), __uint_as_float(w.y << 16), __uint_as_float(w.y & 0xffff0000u)};
                        x1 = (f32x4){__uint_as_float(w.z << 16), __uint_as_float(w.z & 0xffff0000u), __uint_as_float(w.w << 16), __uint_as_float(w.w & 0xffff0000u)}; }
                    x0 = x0 + gv[bj][0] * acc[ai][bj][m][0]; x1 = x1 + gv[bj][1] * acc[ai][bj][m][1];
                    u32x4 o; o.x = cvt_pk_bf16(x0[0], x0[1]); o.y = cvt_pk_bf16(x0[2], x0[3]); o.z = cvt_pk_bf16(x1[0], x1[1]); o.w = cvt_pk_bf16(x1[2], x1[3]);
                    *(u32x4*)(xout + off + bj * HALF) = o; } }
    }
};
struct SubOrder {
    int nM, nN, nwg, G, c, full, skip; unsigned long long list;
    __host__ __device__ void init(int M, int ncol, unsigned long long list_, int G_, int c_, int full_, int skip_) { nM = M / BM; nN = ncol; nwg = nM * nN; G = G_; c = c_; full = full_; skip = skip_; list = list_; }
    __host__ __device__ bool next(int i, Unit& u) const {
        long L;
        if (i >= full) { if (c < skip) return false; L = (long)full * G + (long)(i - full) * (G - skip) + (c - skip); } else L = (long)i * G + c;
        if (L >= nwg) return false;
        int wgid = (int)L; { const int q = nwg / NXCD, r = nwg % NXCD, xcd = wgid % NXCD, off = wgid / NXCD; wgid = (xcd < r ? xcd * (q + 1) : r * (q + 1) + (xcd - r) * q) + off; }
        const int nig = WGM * nN, gid = wgid / nig, fm = gid * WGM, gsz = (nM - fm) < WGM ? (nM - fm) : WGM;
        u.pm = fm + ((wgid % nig) % gsz); u.pn = (int)((list >> (4 * ((wgid % nig) / gsz))) & 15ull); return true;
    }
    __device__ __forceinline__ void a_ready(const Unit&) const {}
    __device__ __forceinline__ void done(const Unit&) const {}
    __device__ __forceinline__ const char* a_base(const Gemm& g, const Unit& u, size_t tstep) const { return (const char*)g.A + (size_t)u.pm * tstep; }
    __device__ __forceinline__ const char* b_base(const Gemm& g, const Unit& u, size_t tstep) const { return (const char*)g.Bt + (size_t)u.pn * tstep; }
};
struct MoeOrder {
    int nrt, nN, G, c, mode; const PG8_LAS unsigned char* etab; size_t estride; int pm0, pn0, cnt; const PG8_LAS unsigned* rowtab;
    __device__ __forceinline__ bool next(int i, Unit& u) const {
        if (nrt <= 0) return false;
        if (mode == 2) { if (i >= cnt) return false; u.pm = pm0; u.pn = pn0 + i; return true; }
        if (mode == 0) {
            const int full = nrt / G, rem = nrt - full * G;
            if (i < full * nN) { u.pm = (i / nN) * G + c; u.pn = i % nN; return true; }
            const int L = (i - full * nN) * G + c; if (rem <= 0 || L >= rem * nN) return false;
            u.pm = full * G + L % rem; u.pn = L / rem; return true;
        }
        if ((G & 31) == 0) { const int x = c & 7, y = c >> 3, ppr = G / nN;
            const int pm = i * ppr + x + 8 * (y >> 2); if (pm >= nrt) return false; u.pm = pm; u.pn = y & 3; return true; }
        const int L = i * G + c; if (L >= nrt * nN) return false; u.pm = L / nN; u.pn = L % nN; return true;
    }
    __device__ __forceinline__ void a_ready(const Unit&) const {}
    __device__ __forceinline__ void done(const Unit&) const {}
    __device__ __forceinline__ const char* a_base(const Gemm& g, const Unit& u, size_t tstep) const { return mode == 2 ? (const char*)g.A : (const char*)g.A + (size_t)u.pm * tstep; }
    __device__ __forceinline__ const char* b_base(const Gemm& g, const Unit& u, size_t tstep) const {
        const int e = __builtin_amdgcn_readfirstlane((int)etab[u.pm]);
        return (const char*)g.Bt + (size_t)e * estride + (size_t)u.pn * tstep;
    }
};
template <class Epi, class Sched, bool ALIGN_EPI = false, bool SP2 = false, bool FP8 = false, int sc_w = 0x7F7F7F7F, int sc_a = 0x7F7F7F7F, bool GA = false>
__device__ __forceinline__ void gemm_phase(PG8_LAS unsigned char* lds, const Gemm g, const Sched& S, const Epi& E) {
    int tid_ = threadIdx.x; asm volatile("" : "+v"(tid_));
    const int tid = tid_, wid = __builtin_amdgcn_readfirstlane(tid >> 6), lane = tid & 63, wr = wid >> 2, wc = wid & 3, fr = lane & 15, fq = lane >> 4;
    constexpr int ES = FP8 ? 1 : 2;
    int K_ = g.K; asm volatile("" : "+s"(K_));
    const int K = K_, nt = K * ES / (BK * 2);
    unsigned voffA[2], voffA1[2], voffB[2];
#pragma unroll
    for (int i = 0; i < 2; ++i) { int R, C; stage_rc(tid * 16 + i * 8192, R, C); const int Rb = Epi::PERM ? ((R & ~31) + perm32(R & 31)) : R;
        voffB[i] = (unsigned)(Rb * K * ES + C * 2);
        if constexpr (GA) { voffA[i] = S.rowtab[R] + (unsigned)(C * 2); voffA1[i] = S.rowtab[R + HALF] + (unsigned)(C * 2); }
        else { voffA[i] = (unsigned)(R * K * ES + C * 2); voffA1[i] = voffA[i]; } }
    const size_t kstep = (size_t)(BK * 2);
    const size_t hstep = (size_t)HALF * K * ES;
    const size_t hstepA = GA ? (size_t)0 : hstep;
    const size_t tstep = 2 * hstep;
    const unsigned ldsw = (unsigned)wid * 1024u;
    const int aoff = lds_byte(wr * 64 + fr, fq * 8), boff = lds_byte(wc * 32 + fr, fq * 8);
#define PG8_SA(b, h) (((b) * 2 + (h)) * HTB)
#define PG8_SB(b, h) ((4 + (b) * 2 + (h)) * HTB)
#define PG8_STAGE(bufoff, gbase, voff) do { _Pragma("unroll") for (int _i = 0; _i < 2; ++_i) \
        __builtin_amdgcn_global_load_lds((const unsigned*)((const char*)(gbase) + (voff)[_i]), (PG8_LAS unsigned*)(lds + (bufoff) + ldsw + _i * 8192), 16, 0, 0); } while (0)
#define PG8_LDA(dst, b, h) do { _Pragma("unroll") for (int m = 0; m < 4; ++m) { \
        if constexpr (FP8) { const v4i_t l_ = *(const PG8_LAS v4i_t*)(lds + PG8_SA(b, h) + aoff + m * 2048), h_ = *(const PG8_LAS v4i_t*)(lds + PG8_SA(b, h) + aoff + m * 2048 + 1024); dst##F[m] = __builtin_shufflevector(l_, h_, 0, 1, 2, 3, 4, 5, 6, 7); } \
        else { _Pragma("unroll") for (int k = 0; k < 2; ++k) dst[m][k] = *(const PG8_LAS bf16x8*)(lds + PG8_SA(b, h) + aoff + m * 2048 + k * 1024); } } } while (0)
#define PG8_LDB(dst, b, h) do { _Pragma("unroll") for (int n = 0; n < 2; ++n) { \
        if constexpr (FP8) { const v4i_t l_ = *(const PG8_LAS v4i_t*)(lds + PG8_SB(b, h) + boff + n * 2048), h_ = *(const PG8_LAS v4i_t*)(lds + PG8_SB(b, h) + boff + n * 2048 + 1024); dst##F[n] = __builtin_shufflevector(l_, h_, 0, 1, 2, 3, 4, 5, 6, 7); } \
        else { _Pragma("unroll") for (int k = 0; k < 2; ++k) dst[n][k] = *(const PG8_LAS bf16x8*)(lds + PG8_SB(b, h) + boff + n * 2048 + k * 1024); } } } while (0)
#define PG8_MMA(ai, bj, At, Bt) do { __builtin_amdgcn_s_setprio(1); _Pragma("unroll") for (int m = 0; m < 4; ++m) _Pragma("unroll") for (int n = 0; n < 2; ++n) { \
        if constexpr (FP8) asm volatile("v_mfma_scale_f32_16x16x128_f8f6f4 %0, %1, %2, %0, %3, %4 op_sel_hi:[0,0,0]" : "+v"(acc[ai][bj][m][n]) : "v"(Bt##F[n]), "v"(At##F[m]), "v"(sc_w), "v"(sc_a)); \
        else { _Pragma("unroll") for (int k = 0; k < 2; ++k) acc[ai][bj][m][n] = __builtin_amdgcn_mfma_f32_16x16x32_bf16(Bt[n][k], At[m][k], acc[ai][bj][m][n], 0, 0, 0); } } \
        __builtin_amdgcn_s_setprio(0); } while (0)
#define PG8_WAIT_V(n) asm volatile("s_waitcnt vmcnt(" #n ")" ::: "memory")
#define PG8_WAIT_L(n) asm volatile("s_waitcnt lgkmcnt(" #n ")" ::: "memory")
#define PG8_BAR __builtin_amdgcn_s_barrier()
#define PG8_SCHED __builtin_amdgcn_sched_barrier(0)
    Unit cur, nxt; int ui = 0;
    if (!S.next(0, cur)) return;
    f32x4 acc[2][2][4][2];
#pragma unroll
    for (int a = 0; a < 2; ++a)
#pragma unroll
        for (int b = 0; b < 2; ++b)
#pragma unroll
            for (int m = 0; m < 4; ++m)
#pragma unroll
                for (int n = 0; n < 2; ++n) acc[a][b][m][n] = (f32x4){0.f, 0.f, 0.f, 0.f};
    bf16x8 At[4][2], B0[2][2], B1[2][2];
    v8i_t AtF[4], B0F[2], B1F[2];
    const char* cA = S.a_base(g, cur, tstep); const char* cB = S.b_base(g, cur, tstep);
    S.a_ready(cur);
    if constexpr (SP2) {
        PG8_STAGE(PG8_SB(0, 0), cB, voffB); PG8_STAGE(PG8_SB(0, 1), cB + hstep, voffB); PG8_STAGE(PG8_SA(0, 0), cA, voffA); PG8_STAGE(PG8_SA(0, 1), cA + hstepA, voffA1);
        if (wr == 1) PG8_BAR;
        PG8_WAIT_V(2); PG8_BAR;
        PG8_STAGE(PG8_SB(1, 0), cB + kstep, voffB); PG8_STAGE(PG8_SA(1, 0), cA + kstep, voffA); PG8_STAGE(PG8_SB(1, 1), cB + hstep + kstep, voffB);
        PG8_WAIT_V(6); PG8_BAR;
    } else {
        PG8_STAGE(PG8_SB(0, 0), cB, voffB); PG8_STAGE(PG8_SA(0, 0), cA, voffA); PG8_STAGE(PG8_SB(0, 1), cB + hstep, voffB); PG8_STAGE(PG8_SA(0, 1), cA + hstepA, voffA1);
        if (wr == 1) PG8_BAR;
        PG8_WAIT_V(4); PG8_BAR;
        PG8_STAGE(PG8_SB(1, 0), cB + kstep, voffB); PG8_STAGE(PG8_SA(1, 0), cA + kstep, voffA); PG8_STAGE(PG8_SB(1, 1), cB + hstep + kstep, voffB);
        PG8_WAIT_V(6); PG8_BAR;
    }
    for (;;) {
        const bool has_next = S.next(ui + 1, nxt);
        const char* nA = has_next ? S.a_base(g, nxt, tstep) : cA; const char* nB = has_next ? S.b_base(g, nxt, tstep) : cB;
        for (int t = 0; t < nt; t += 2) {
            const bool last = (t == nt - 2);
            const char* a1 = cA + (size_t)(t + 1) * kstep;
            const char* a2 = last ? nA : cA + (size_t)(t + 2) * kstep; const char* b2 = last ? nB : cB + (size_t)(t + 2) * kstep;
            const char* a3 = a2 + kstep; const char* b3 = b2 + kstep;
            if (last && has_next) S.a_ready(nxt);
            if constexpr (SP2) {
            PG8_LDB(B0, 0, 0); PG8_LDB(B1, 0, 1); PG8_SCHED; PG8_LDA(At, 0, 0); PG8_STAGE(PG8_SA(1, 1), a1 + hstepA, voffA1);
            PG8_WAIT_V(8); PG8_WAIT_L(0); PG8_BAR; PG8_MMA(0, 0, At, B0); PG8_MMA(0, 1, At, B1); PG8_BAR; PG8_SCHED;
            PG8_LDA(At, 0, 1); PG8_STAGE(PG8_SB(0, 0), b2, voffB); PG8_STAGE(PG8_SB(0, 1), b2 + hstep, voffB); PG8_STAGE(PG8_SA(0, 0), a2, voffA);
            PG8_WAIT_V(8); PG8_WAIT_L(0); PG8_BAR; PG8_MMA(1, 0, At, B0); PG8_MMA(1, 1, At, B1); PG8_BAR; PG8_SCHED;
            PG8_LDB(B0, 1, 0); PG8_LDB(B1, 1, 1); PG8_SCHED; PG8_LDA(At, 1, 0); PG8_STAGE(PG8_SA(0, 1), a2 + hstepA, voffA1);
            PG8_WAIT_V(8); PG8_WAIT_L(0); PG8_BAR; PG8_MMA(0, 0, At, B0); PG8_MMA(0, 1, At, B1); PG8_BAR; PG8_SCHED;
            PG8_LDA(At, 1, 1); PG8_STAGE(PG8_SB(1, 0), b3, voffB); PG8_STAGE(PG8_SB(1, 1), b3 + hstep, voffB); PG8_STAGE(PG8_SA(1, 0), a3, voffA);
            PG8_WAIT_V(8); PG8_WAIT_L(0); PG8_BAR; PG8_MMA(1, 0, At, B0); PG8_MMA(1, 1, At, B1); PG8_BAR; PG8_SCHED;
            } else {
            PG8_LDB(B0, 0, 0); PG8_SCHED; PG8_LDA(At, 0, 0); PG8_STAGE(PG8_SA(1, 1), a1 + hstepA, voffA1);
            PG8_WAIT_L(8); PG8_BAR; PG8_WAIT_L(0); PG8_MMA(0, 0, At, B0); PG8_BAR; PG8_SCHED;
            PG8_LDB(B1, 0, 1); PG8_STAGE(PG8_SB(0, 0), b2, voffB);
            PG8_BAR; PG8_WAIT_L(0); PG8_MMA(0, 1, At, B1); PG8_BAR;
            PG8_LDA(At, 0, 1); PG8_STAGE(PG8_SA(0, 0), a2, voffA);
            PG8_BAR; PG8_WAIT_L(0); PG8_MMA(1, 0, At, B0); PG8_BAR; PG8_SCHED;
            PG8_STAGE(PG8_SB(0, 1), b2 + hstep, voffB);
            PG8_WAIT_V(6); PG8_BAR; PG8_MMA(1, 1, At, B1); PG8_BAR;
            PG8_LDB(B0, 1, 0); PG8_SCHED; PG8_LDA(At, 1, 0); PG8_STAGE(PG8_SA(0, 1), a2 + hstepA, voffA1);
            PG8_WAIT_L(8); PG8_BAR; PG8_WAIT_L(0); PG8_MMA(0, 0, At, B0); PG8_BAR; PG8_SCHED;
            PG8_LDB(B1, 1, 1); PG8_STAGE(PG8_SB(1, 0), b3, voffB);
            PG8_BAR; PG8_WAIT_L(0); PG8_MMA(0, 1, At, B1); PG8_BAR;
            PG8_LDA(At, 1, 1); PG8_STAGE(PG8_SA(1, 0), a3, voffA);
            PG8_BAR; PG8_WAIT_L(0); PG8_MMA(1, 0, At, B0); PG8_BAR; PG8_SCHED;
            PG8_STAGE(PG8_SB(1, 1), b3 + hstep, voffB);
            PG8_WAIT_V(6); PG8_BAR; PG8_MMA(1, 1, At, B1); PG8_BAR;
            }
        }
        if constexpr (ALIGN_EPI) { if (wr == 0) PG8_BAR; }
        asm volatile("s_nop 15\n\ts_nop 15\n\ts_nop 15" ::: "memory");
        if constexpr (!Epi::AFTER_DRAIN) { E(acc, cur, wr, wc, fr, fq); S.done(cur); }
        if (!has_next) break;
#pragma unroll
        for (int a = 0; a < 2; ++a)
#pragma unroll
            for (int b = 0; b < 2; ++b)
#pragma unroll
                for (int m = 0; m < 4; ++m)
#pragma unroll
                    for (int n = 0; n < 2; ++n) acc[a][b][m][n] = (f32x4){0.f, 0.f, 0.f, 0.f};
        cur = nxt; cA = nA; cB = nB; ++ui;
        if constexpr (ALIGN_EPI) { if (wr == 1) PG8_BAR; }
    }
    PG8_WAIT_V(0);
    if constexpr (!ALIGN_EPI) { if (wr == 0) PG8_BAR; }
    PG8_BAR;
    if constexpr (Epi::AFTER_DRAIN) { E.fused(acc, cur, wr, wc, fr, fq, lds, wid, lane); S.done(cur); }
#undef PG8_SA
#undef PG8_SB
#undef PG8_STAGE
#undef PG8_LDA
#undef PG8_LDB
#undef PG8_MMA
#undef PG8_WAIT_V
#undef PG8_WAIT_L
#undef PG8_BAR
#undef PG8_SCHED
}
}

#define LDS_WAIT() asm volatile("s_waitcnt lgkmcnt(0)" ::: "memory")
#define VM_WAIT() asm volatile("s_waitcnt vmcnt(0)" ::: "memory")

template <bool F8 = false> __device__ __forceinline__ void transpose_item(const float* W, int ldw, int scol0, int ncol_valid, float scale, bf16* WT, int K, int drow0, int k0, LAS float* scr, int lane) {
    const int n4 = lane & 7, kr = lane >> 3; const bool ok = (scol0 + 4 * n4) < ncol_valid;
    f32x4 v[8];
    const float* wp = W + (size_t)(k0 + kr) * ldw + scol0 + 4 * n4;
#pragma unroll
    for (int i = 0; i < 8; ++i) v[i] = ok ? *(const f32x4*)(wp + (size_t)(8 * i) * ldw) : (f32x4){0.f, 0.f, 0.f, 0.f};
#pragma unroll
    for (int i = 0; i < 8; ++i) { LAS float* d = scr + (8 * i + kr) * 33 + 4 * n4; d[0] = v[i].x * scale; d[1] = v[i].y * scale; d[2] = v[i].z * scale; d[3] = v[i].w * scale; }
    LDS_WAIT(); asm volatile("" ::: "memory");
    const int c = lane & 7;
#pragma unroll
    for (int j = 0; j < 4; ++j) { const int nn = (lane >> 3) + 8 * j; const LAS float* s = scr + (8 * c) * 33 + nn;
        if (F8) { u32x2 o; o.x = pg8::pk4_fp8(s[0 * 33], s[1 * 33], s[2 * 33], s[3 * 33]); o.y = pg8::pk4_fp8(s[4 * 33], s[5 * 33], s[6 * 33], s[7 * 33]);
            *(u32x2*)((unsigned char*)WT + (size_t)(drow0 + nn) * K + k0 + 8 * c) = o; }
        else { u32x4 o; o.x = pk2(s[0 * 33], s[1 * 33]); o.y = pk2(s[2 * 33], s[3 * 33]); o.z = pk2(s[4 * 33], s[5 * 33]); o.w = pk2(s[6 * 33], s[7 * 33]);
            *(u32x4*)(WT + (size_t)(drow0 + nn) * K + k0 + 8 * c) = o; } }
    LDS_WAIT(); asm volatile("" ::: "memory");
}
#ifdef SWIGLU_PK
constexpr float SC_GATE = 32.f * 1.4426950408889634f, SC_UP = 32.f / 1.4426950408889634f;
#else
constexpr float SC_GATE = 32.f, SC_UP = 32.f;
#endif
struct PrepArgs { const float *w_in, *w_out, *wfg, *wfu, *wfd, *weg, *weu, *wed; unsigned char* ws; };
constexpr int PI_WIN = 2 * 16 * 120, PI_WOUT = 2 * 16 * 32, PI_FU = 16 * 176, PI_FD = 44 * 32, PI_EU = 8 * 16 * 224, PI_ED = 8 * 56 * 32;
constexpr int PREP_ITEMS = PI_WIN + PI_WOUT + PI_FU + PI_FD + PI_EU + PI_ED;
constexpr int PI_STATIC = PI_WIN + PI_WOUT + PI_FU + PI_FD, LAZY_BATCHES = (PI_EU + PI_ED) / 8, LAZY_NB = 4;
__device__ __forceinline__ void prep_item(const PrepArgs& a, int it, LAS float* scr, int lane) {
    int r = it;
    if (r < PI_WIN) { const int l = r / 1920; r %= 1920; const int kb = r / 120, nb = r % 120, n0 = nb * 32;
        float sc = 1.f; if (n0 >= COL_QI && n0 < COL_KI) sc = 0.125f; else if (n0 < 3072 && (n0 % 768) < 256) sc = 0.125f * 1.4426950408889634f; else if (n0 == COL_WI) sc = 0.35355339059327373f;
#ifdef WIN_FP8
        if (!((WIN_BF16_TILES >> (n0 >> 8)) & 1)) { transpose_item<true>(a.w_in + (size_t)l * DM * NIN, NIN, n0, NIN, sc * 32.f, (bf16*)(a.ws + WS_WIN8 + (size_t)l * PW * DM), DM, n0, kb * 64, scr, lane); return; }
        transpose_item(a.w_in + (size_t)l * DM * NIN, NIN, n0, NIN, sc, (bf16*)(a.ws + WS_WIN) + (size_t)l * PW * DM, DM, n0, kb * 64, scr, lane); return; }
#else
        transpose_item(a.w_in + (size_t)l * DM * NIN, NIN, n0, NIN, sc, (bf16*)(a.ws + WS_WIN) + (size_t)l * PW * DM, DM, n0, kb * 64, scr, lane); return; }
#endif
    r -= PI_WIN;
    if (r < PI_WOUT) { const int l = r / 512; r %= 512; const int kb = r / 32, nb = r % 32;
#ifdef WOUT_FP8
        transpose_item<true>(a.w_out + (size_t)l * DM * DM, DM, nb * 32, DM, 64.f, (bf16*)(a.ws + WS_WOUT + (size_t)l * DM * DM), DM, nb * 32, kb * 64, scr, lane); return; }
#else
        transpose_item(a.w_out + (size_t)l * DM * DM, DM, nb * 32, DM, 1.f, (bf16*)(a.ws + WS_WOUT) + (size_t)l * DM * DM, DM, nb * 32, kb * 64, scr, lane); return; }
#endif
    r -= PI_WOUT;
    if (r < PI_FU) { const int kb = r / 176, nb = r % 176, r0 = nb * 32, blk = r0 >> 8, w = r0 & 255;
        transpose_item<true>(w < 128 ? a.wfg : a.wfu, DFF, blk * 128 + (w & 127), DFF, w < 128 ? SC_GATE : SC_UP, (bf16*)(a.ws + WS_WFU), DM, r0, kb * 64, scr, lane); return; }
    r -= PI_FU;
    if (r < PI_FD) { const int kb = r / 32, nb = r % 32;
        transpose_item<true>(a.wfd, DM, nb * 32, DM, 64.f, (bf16*)(a.ws + WS_WFD), DFF, nb * 32, kb * 64, scr, lane); return; }
    r -= PI_FD;
    if (r < PI_EU) { const int e = r / 3584; r %= 3584; const int kb = r / 224, nb = r % 224, r0 = nb * 32, blk = r0 >> 8, w = r0 & 255;
        transpose_item<true>((w < 128 ? a.weg : a.weu) + (size_t)e * DM * DFE, DFE, blk * 128 + (w & 127), DFE, w < 128 ? SC_GATE : SC_UP, (bf16*)(a.ws + WS_WEU + (size_t)e * 7168 * DM), DM, r0, kb * 64, scr, lane); return; }
    r -= PI_EU;
    { const int e = r / 1792; r %= 1792; const int kb = r / 32, nb = r % 32;
        transpose_item<true>(a.wed + (size_t)e * DFE * DM, DM, nb * 32, DM, 64.f, (bf16*)(a.ws + WS_WED + (size_t)e * DM * DFE), DFE, nb * 32, kb * 64, scr, lane); }
}
__device__ __forceinline__ void ph_prep(const PrepArgs& a, LAS unsigned char* lds, int bid, int nblk) {
    const int lane = otid() & 63, wave = otid() >> 6;
    LAS float* scr = (LAS float*)lds + wave * 64 * 33;
    const int gw = bid * 8 + wave, ngw = nblk * 8;
#ifdef PREP_LAZY
    for (int it = gw; it < PI_STATIC; it += ngw) prep_item(a, it, scr, lane);
#else
    for (int it = gw; it < PREP_ITEMS; it += ngw) prep_item(a, it, scr, lane);
#endif
}
__device__ __forceinline__ void prep_lazy(const PrepArgs& a, unsigned* ctl, int done_word, int nblk, LAS unsigned char* lds) {
    const int tid = otid(), lane = tid & 63, wave = tid >> 6;
    LAS float* scr = (LAS float*)lds + wave * 64 * 33; LAS unsigned* slot = (LAS unsigned*)(lds + 71680);
    __syncthreads();
    if (tid == 0 && done_word >= 0) __hip_atomic_fetch_add(ctl + done_word, 1u, __ATOMIC_RELAXED, __HIP_MEMORY_SCOPE_AGENT);
    for (;;) {
        if (tid == 0) { unsigned b = 0xffffffffu;
            if (done_word < 0 || __hip_atomic_load(ctl + done_word, __ATOMIC_RELAXED, __HIP_MEMORY_SCOPE_AGENT) < (unsigned)nblk) b = __hip_atomic_fetch_add(ctl + CW_PREPQ, 1u, __ATOMIC_RELAXED, __HIP_MEMORY_SCOPE_AGENT);
            slot[0] = b; }
        __syncthreads(); const unsigned b = slot[0]; __syncthreads();
        if (b >= (unsigned)(LAZY_BATCHES / LAZY_NB)) break;
#pragma unroll 1
        for (int k = 0; k < LAZY_NB; ++k) prep_item(a, PI_STATIC + ((int)b * LAZY_NB + k) * 8 + wave, scr, lane);
    }
    __syncthreads();
}
__device__ __forceinline__ void ph_mod(const float* c, const float* w_ada, const float* b_ada, float* mod, LAS unsigned char* lds, int bid, int nblk) {
    LAS float* sc = (LAS float*)lds; LAS float* part = (LAS float*)(lds + 32768);
    const int tid = otid();
    if (bid >= 192) return;
    for (int i = tid; i < 8 * 1024; i += 512) { const float v = c[i]; sc[i] = v / (1.0f + __expf(-v)); }
    __syncthreads();
    for (int item = bid; item < 192; item += nblk) {
        const int l = item / 96, j0 = (item % 96) * 64, jj = tid & 63, kq = tid >> 6;
        float acc[8];
#pragma unroll
        for (int b = 0; b < 8; ++b) acc[b] = 0.f;
        const float* w = w_ada + (size_t)l * DM * 6144 + j0 + jj;
#pragma unroll 16
        for (int k = kq * 128; k < kq * 128 + 128; ++k) { const float wv = w[(size_t)k * 6144];
#pragma unroll
            for (int b = 0; b < 8; ++b) acc[b] += sc[b * 1024 + k] * wv; }
#pragma unroll
        for (int b = 0; b < 8; ++b) part[(kq * 8 + b) * 64 + jj] = acc[b];
        __syncthreads();
        { const int b = tid >> 6, j = tid & 63; float sum = 0.f;
#pragma unroll
          for (int q = 0; q < 8; ++q) sum += part[(q * 8 + b) * 64 + j];
          mod[(size_t)l * 8 * 6144 + (size_t)b * 6144 + j0 + j] = sum + b_ada[l * 6144 + j0 + j]; }
        __syncthreads();
    }
}

struct MoeTiles { int p0, p1, p2, p3, p4, p5, p6, p7; };
__device__ __forceinline__ MoeTiles moe_tiles(const unsigned* ecnt) {
#define ECNT_LD(i) ((int)((__hip_atomic_load(ecnt + (i), __ATOMIC_RELAXED, __HIP_MEMORY_SCOPE_AGENT) + 255u) >> 8))
    MoeTiles m; m.p0 = ECNT_LD(0); m.p1 = ECNT_LD(1); m.p2 = ECNT_LD(2); m.p3 = ECNT_LD(3); m.p4 = ECNT_LD(4); m.p5 = ECNT_LD(5); m.p6 = ECNT_LD(6); m.p7 = ECNT_LD(7); return m;
#undef ECNT_LD
}
__device__ __forceinline__ int moe_tile_start(const MoeTiles& m, int e) {
    int s = 0; s += (e > 0) ? m.p0 : 0; s += (e > 1) ? m.p1 : 0; s += (e > 2) ? m.p2 : 0; s += (e > 3) ? m.p3 : 0; s += (e > 4) ? m.p4 : 0; s += (e > 5) ? m.p5 : 0; s += (e > 6) ? m.p6 : 0; return s;
}
struct NormArgs {
    const float* xin; const bf16* xin16; const float* g; const float* shift; const float* scale;
    bf16* act; unsigned char* act8;
    const float* w_router; int* tok; unsigned* ecnt; int* elist;
    const bf16* ys; const float* gate; float* out;
};
template <int MODE> __device__ __forceinline__ void ph_norm(const NormArgs& a, LAS unsigned char* lds, int bid, int nblk) {
    LAS unsigned* lcnt = (LAS unsigned*)lds; LAS unsigned* lbase = lcnt + 8; typedef int info6[6]; LAS info6* linfo = (LAS info6*)(lds + 64);
    const int tid = otid(), lane = tid & 63, wave = tid >> 6;
    if (MODE == 1) { if (tid < 8) lcnt[tid] = 0u; __syncthreads(); }
    MoeTiles mt; if (MODE == 2) mt = moe_tiles(a.ecnt);
    for (int blk = bid; blk < T / 128; blk += nblk) {
      for (int i4 = 0; i4 < 16; i4 += 4) {
        f32x4 vq[4][4]; u32x2 yq0[4][4], yq1[4][4]; float gq0[4], gq1[4];
#pragma unroll
        for (int q = 0; q < 4; ++q) { const int row_ = blk * 128 + wave + 8 * (i4 + q);
            if (a.xin) { const f32x4* xr = (const f32x4*)(a.xin + (size_t)row_ * DM) + lane;
#pragma unroll
                for (int j = 0; j < 4; ++j) vq[q][j] = xr[64 * j]; }
            else { const u32x2* xr = (const u32x2*)(a.xin16 + (size_t)row_ * DM) + lane;
#pragma unroll
                for (int j = 0; j < 4; ++j) { const u32x2 w = xr[64 * j];
                    vq[q][j] = (f32x4){__uint_as_float(w.x << 16), __uint_as_float(w.x & 0xffff0000u), __uint_as_float(w.y << 16), __uint_as_float(w.y & 0xffff0000u)}; } }
            if (MODE == 2) {
                const int* ti = a.tok + (size_t)row_ * 8; const int e0 = ti[0], e1 = ti[1], p0 = ti[2], p1 = ti[3]; gq0[q] = __int_as_float(ti[4]); gq1[q] = __int_as_float(ti[5]);
                const size_t s0 = (size_t)moe_tile_start(mt, e0) * 256 + p0, s1 = (size_t)moe_tile_start(mt, e1) * 256 + p1;
                const u32x2* y0 = (const u32x2*)(a.ys + s0 * DM) + lane; const u32x2* y1 = (const u32x2*)(a.ys + s1 * DM) + lane;
#pragma unroll
                for (int j = 0; j < 4; ++j) { yq0[q][j] = y0[64 * j]; yq1[q][j] = y1[64 * j]; } } }
#pragma unroll
        for (int q = 0; q < 4; ++q) {
            const int i = i4 + q;
            const int lr = wave + 8 * i, row = blk * 128 + lr, b = row / SEQ;
            f32x4 v[4];
#pragma unroll
            for (int j = 0; j < 4; ++j) v[j] = vq[q][j];
            if (MODE == 2) {
                const float g0 = gq0[q], g1 = gq1[q];
                const f32x4* gt = (const f32x4*)(a.gate + (size_t)b * 6144) + lane;
#pragma unroll
                for (int j = 0; j < 4; ++j) { const u32x2 a0 = yq0[q][j], a1 = yq1[q][j]; const f32x4 gv = gt[64 * j];
                    f32x4 y; y.x = g0 * bf2f(a0.x & 0xffffu) + g1 * bf2f(a1.x & 0xffffu); y.y = g0 * bf2f(a0.x >> 16) + g1 * bf2f(a1.x >> 16);
                    y.z = g0 * bf2f(a0.y & 0xffffu) + g1 * bf2f(a1.y & 0xffffu); y.w = g0 * bf2f(a0.y >> 16) + g1 * bf2f(a1.y >> 16);
                    v[j] = v[j] + gv * y; }
            }
            float ss = 0.f;
#pragma unroll
            for (int j = 0; j < 4; ++j) ss += (v[j].x * v[j].x + v[j].y * v[j].y) + (v[j].z * v[j].z + v[j].w * v[j].w);
            const float rstd = rsqrtf(wave_sum(ss) * (1.0f / DM) + EPS);
            const f32x4* gp = (const f32x4*)a.g + lane;
            if (MODE == 2) {
                f32x4* o = (f32x4*)(a.out + (size_t)row * DM) + lane;
#if defined(PROBE_T) || defined(PROBE_A)
                { const unsigned long long* tp = (const unsigned long long*)(a.ecnt - CW_ECNT); const float code_ = (float)((tp[151] / (tp[152] ? tp[152] : 1ull)) / 250ull) * 10.0f;
#pragma unroll
                  for (int j = 0; j < 4; ++j) v[j] = v[j] * (1.0f + 0.001f * code_); }
#endif
#pragma unroll
                for (int j = 0; j < 4; ++j) o[64 * j] = v[j] * rstd * gp[64 * j];
            } else {
                const f32x4* sh = (const f32x4*)(a.shift + (size_t)b * 6144) + lane; const f32x4* sc = (const f32x4*)(a.scale + (size_t)b * 6144) + lane;
#pragma unroll
                for (int j = 0; j < 4; ++j) v[j] = v[j] * rstd * gp[64 * j] * (sc[64 * j] + 1.0f) + sh[64 * j];
                if (a.act8) { unsigned* o = (unsigned*)(a.act8 + (size_t)row * DM) + lane;
#pragma unroll
                    for (int j = 0; j < 4; ++j) o[64 * j] = pg8::pk4_fp8(v[j].x, v[j].y, v[j].z, v[j].w); }
                if (a.act) { u32x2* o = (u32x2*)(a.act + (size_t)row * DM) + lane;
#pragma unroll
                    for (int j = 0; j < 4; ++j) { u32x2 w; w.x = pk2(v[j].x, v[j].y); w.y = pk2(v[j].z, v[j].w); o[64 * j] = w; } }
                if (MODE == 1) {
                    float lg[8];
#pragma unroll
                    for (int e = 0; e < 8; ++e) lg[e] = 0.f;
#pragma unroll
                    for (int j = 0; j < 4; ++j) { const float hv[4] = {v[j].x, v[j].y, v[j].z, v[j].w};
#pragma unroll
                        for (int q = 0; q < 4; ++q) { const f32x4* wr = (const f32x4*)(a.w_router + (size_t)(256 * j + 4 * lane + q) * 8); const f32x4 w0 = wr[0], w1 = wr[1];
                            lg[0] += hv[q] * w0.x; lg[1] += hv[q] * w0.y; lg[2] += hv[q] * w0.z; lg[3] += hv[q] * w0.w; lg[4] += hv[q] * w1.x; lg[5] += hv[q] * w1.y; lg[6] += hv[q] * w1.z; lg[7] += hv[q] * w1.w; } }
#pragma unroll
                    for (int e = 0; e < 8; ++e) lg[e] = wave_sum(lg[e]);
                    int e0 = 0; float v0 = lg[0];
#pragma unroll
                    for (int e = 1; e < 8; ++e) if (lg[e] > v0) { v0 = lg[e]; e0 = e; }
                    int e1 = -1; float v1 = -INFINITY;
#pragma unroll
                    for (int e = 0; e < 8; ++e) if (e != e0 && lg[e] > v1) { v1 = lg[e]; e1 = e; }
                    const float g0 = 1.0f / (1.0f + __expf(v1 - v0)), g1 = 1.0f - g0;
                    if (lane == 0) { const unsigned q0 = __hip_atomic_fetch_add(&lcnt[e0], 1u, __ATOMIC_RELAXED, __HIP_MEMORY_SCOPE_WORKGROUP), q1 = __hip_atomic_fetch_add(&lcnt[e1], 1u, __ATOMIC_RELAXED, __HIP_MEMORY_SCOPE_WORKGROUP);
                        linfo[lr][0] = e0; linfo[lr][1] = e1; linfo[lr][2] = (int)q0; linfo[lr][3] = (int)q1; linfo[lr][4] = __float_as_int(g0); linfo[lr][5] = __float_as_int(g1); }
                }
            }
        }
      }
        if (MODE == 1) {
            __syncthreads();
            if (tid < 8) { lbase[tid] = atomicAdd(&a.ecnt[tid], lcnt[tid]); }
            __syncthreads();
            if (tid < 128) { int* ti = a.tok + (size_t)(blk * 128 + tid) * 8; const int e0 = linfo[tid][0], e1 = linfo[tid][1];
                const int p0_ = linfo[tid][2] + (int)lbase[e0], p1_ = linfo[tid][3] + (int)lbase[e1];
                ti[0] = e0; ti[1] = e1; ti[2] = p0_; ti[3] = p1_; ti[4] = linfo[tid][4]; ti[5] = linfo[tid][5]; ti[6] = 0; ti[7] = 0;
                if (a.elist) { a.elist[e0 * T + p0_] = blk * 128 + tid; a.elist[e1 * T + p1_] = blk * 128 + tid; } }
            __syncthreads();
            if (tid < 8) lcnt[tid] = 0u;
            __syncthreads();
        }
    }
}
__device__ __forceinline__ void ph_gather(const unsigned char* act8, const int* tok, const unsigned* ecnt, unsigned char* xs8, int bid, int nblk) {
    const int lane = otid() & 63, gw = bid * 8 + (otid() >> 6), ngw = nblk * 8;
    const MoeTiles mt = moe_tiles(ecnt);
    for (int t = gw; t < T; t += 4 * ngw) {
        int e0[4], e1[4], p0[4], p1[4]; u32x4 a0[4];
#pragma unroll
        for (int q = 0; q < 4; ++q) { const int* ti = tok + (size_t)(t + q * ngw) * 8; e0[q] = ti[0]; e1[q] = ti[1]; p0[q] = ti[2]; p1[q] = ti[3];
            a0[q] = ((const u32x4*)(act8 + (size_t)(t + q * ngw) * DM))[lane]; }
#pragma unroll
        for (int q = 0; q < 4; ++q) { const size_t s0 = (size_t)moe_tile_start(mt, e0[q]) * 256 + p0[q], s1 = (size_t)moe_tile_start(mt, e1[q]) * 256 + p1[q];
            ((u32x4*)(xs8 + s0 * DM))[lane] = a0[q]; ((u32x4*)(xs8 + s1 * DM))[lane] = a0[q]; }
    }
    for (int i = gw; i < 8 * 256; i += ngw) { const int e = i >> 8, r = i & 255; const int cnt = (int)__hip_atomic_load(ecnt + e, __ATOMIC_RELAXED, __HIP_MEMORY_SCOPE_AGENT); const int padded = ((cnt + 255) >> 8) << 8;
        if (cnt + r < padded) { unsigned z0 = 0u; asm volatile("" : "+v"(z0)); const u32x4 z = {z0, z0, z0, z0};
            ((u32x4*)(xs8 + ((size_t)moe_tile_start(mt, e) * 256 + cnt + r) * DM))[lane] = z; } }
}

__device__ __forceinline__ void ld16(const bf16* p, float (&f)[16]) { ld8(p, &f[0]); ld8(p + 8, &f[8]); }
__device__ __forceinline__ float dot16x4(const float (&q)[16], const bf16* p) {
    float f[16]; ld16(p, f); float s0 = 0.f, s1 = 0.f;
#pragma unroll
    for (int i = 0; i < 16; i += 2) { s0 += q[i] * f[i]; s1 += q[i + 1] * f[i + 1]; }
    float s = s0 + s1; s += __shfl_xor(s, 1); s += __shfl_xor(s, 2); return s;
}
__device__ __forceinline__ void axpy16(float (&o)[16], float w, const bf16* p) {
    float f[16]; ld16(p, f);
#pragma unroll
    for (int i = 0; i < 16; ++i) o[i] += w * f[i];
}
__device__ __forceinline__ void head_norm_store16(float (&o)[16], const float* gh, bf16* dst) {
    float ss = 0.f;
#pragma unroll
    for (int i = 0; i < 16; ++i) ss += o[i] * o[i];
    ss += __shfl_xor(ss, 1); ss += __shfl_xor(ss, 2);
    const float r = rsqrtf(ss * (1.0f / 64.0f) + EPS);
#pragma unroll
    for (int i = 0; i < 2; ++i) { u32x4 w; const float* q = &o[8 * i]; const float* g = gh + 8 * i;
        w.x = pk2(q[0] * r * g[0], q[1] * r * g[1]); w.y = pk2(q[2] * r * g[2], q[3] * r * g[3]); w.z = pk2(q[4] * r * g[4], q[5] * r * g[5]); w.w = pk2(q[6] * r * g[6], q[7] * r * g[7]);
        *(u32x4*)(dst + 8 * i) = w; }
}
#define OSM_STEP(s, vrow) do { if ((s) > m) { const float a_ = __expf(m - (s)); l *= a_; _Pragma("unroll") for (int d_ = 0; d_ < 16; ++d_) o[d_] *= a_; m = (s); } \
    const float p_ = __expf((s) - m); l += p_; axpy16(o, p_, (vrow)); } while (0)
#define NAIVE_IDX() const int part = gidx & 3, idx = gidx >> 2; const int t = idx & (SEQ - 1), h = (idx >> 12) & 3, b = idx >> 14; const int po = 16 * part

__device__ __forceinline__ void sb_naive_one(const bf16* P, const float* gh, bf16* act, int gidx) {
    NAIVE_IDX();
    const bf16* Pb = P + (size_t)b * SEQ * PW + po;
    float q[16], o[16];
    ld16(Pb + (size_t)t * PW + h * 64, q);
#pragma unroll
    for (int i = 0; i < 16; ++i) o[i] = 0.f;
    float carry = 1.0f;
    for (int s = t - 1; s >= 0; --s) {
        float z = dot16x4(q, Pb + (size_t)s * PW + 256 + h * 64); z = fminf(fmaxf(z, -80.f), 80.f);
        const float e = __expf(z), om = 1.0f / (1.0f + e), beta = e * om, aw = beta * carry;
        axpy16(o, aw, Pb + (size_t)s * PW + 512 + h * 64);
        carry *= om;
        if (carry < 1e-30f) break;
    }
    head_norm_store16(o, gh + h * 64 + po, act + (size_t)(b * SEQ + t) * DM + h * 64 + po);
}
__device__ __forceinline__ void dil_naive_one(const bf16* P, const float* gh, bf16* act, int gidx) {
    NAIVE_IDX();
    const bf16* Pb = P + (size_t)b * SEQ * PW + 1536 + po;
    const float slope = alibi_slope(1, h);
    float q[16], o[16];
    ld16(Pb + (size_t)t * PW + h * 64, q);
#pragma unroll
    for (int i = 0; i < 16; ++i) o[i] = 0.f;
    float m = -INFINITY, l = 0.f;
    for (int br = 0; br < 3; ++br) { const int dil = br == 0 ? 1 : (br == 1 ? 4 : 16);
        for (int j = 0; j <= 128; ++j) { const int dist = j * dil, kp = t - dist; if (kp < 0) break;
            const float s = dot16x4(q, Pb + (size_t)kp * PW + 256 + h * 64) - slope * (float)dist;
            OSM_STEP(s, Pb + (size_t)kp * PW + 512 + h * 64); } }
    const float rl = 1.0f / l;
#pragma unroll
    for (int i = 0; i < 16; ++i) o[i] *= rl;
    head_norm_store16(o, gh + (8 + h) * 64 + po, act + (size_t)(b * SEQ + t) * DM + (8 + h) * 64 + po);
}
__device__ __forceinline__ unsigned moba_sel_one(const float (&q)[16], const float* kmean, int b, int t, int h, int po) {
    const int own = t >> 8; unsigned sel = 0u;
    if (own <= 3) sel = (1u << own) - 1u;
    else {
        float g[16];
#pragma unroll
        for (int blk = 0; blk < 16; ++blk) { float s = -INFINITY;
            if (blk < own) { const float* km = kmean + ((size_t)b * 16 + blk) * 256 + h * 64 + po; s = 0.f;
#pragma unroll
                for (int d = 0; d < 16; ++d) s += q[d] * km[d];
                s += __shfl_xor(s, 1); s += __shfl_xor(s, 2); }
            g[blk] = s; }
#pragma unroll
        for (int r = 0; r < 3; ++r) { int bi = 0; float bv = -INFINITY;
#pragma unroll
            for (int blk = 0; blk < 16; ++blk) { const bool free_ = !((sel >> blk) & 1u); if (free_ && g[blk] > bv) { bv = g[blk]; bi = blk; } }
            sel |= 1u << bi; }
    }
    return sel;
}
template <int MODE> __device__ __forceinline__ void masked_naive_one(const bf16* P, const unsigned long long* mask, const float* kmean, const float* gh, bf16* act, int gidx) {
    NAIVE_IDX();
    const int cb = MODE == 0 ? 768 : 2304, hb = MODE == 0 ? 4 : 12;
    const bf16* Pb = P + (size_t)b * SEQ * PW + cb + po;
    const float slope = alibi_slope(MODE == 0 ? 0 : 2, h);
    float q[16], o[16];
    ld16(Pb + (size_t)t * PW + h * 64, q);
#pragma unroll
    for (int i = 0; i < 16; ++i) o[i] = 0.f;
    float m = -INFINITY, l = 0.f;
    if (MODE == 0) {
        const unsigned long long* mr = mask + (size_t)(b * SEQ + t) * 64;
        for (int w = 0; w <= (t >> 6); ++w) { unsigned long long bits = mr[w];
            while (bits) { const int j = __builtin_ctzll(bits); bits &= bits - 1; const int kp = w * 64 + j;
                const float s = dot16x4(q, Pb + (size_t)kp * PW + 256 + h * 64) - slope * (float)(t - kp);
                OSM_STEP(s, Pb + (size_t)kp * PW + 512 + h * 64); } }
    } else {
        const int own = t >> 8; const unsigned sel = moba_sel_one(q, kmean, b, t, h, po);
        for (int blk = 0; blk <= own; ++blk) { if (blk < own && !((sel >> blk) & 1u)) continue;
            const int kend = blk == own ? t : blk * 256 + 255;
            for (int kp = blk * 256; kp <= kend; ++kp) {
                const float s = dot16x4(q, Pb + (size_t)kp * PW + 256 + h * 64) - slope * (float)(t - kp);
                OSM_STEP(s, Pb + (size_t)kp * PW + 512 + h * 64); } }
    }
    const float rl = 1.0f / l;
#pragma unroll
    for (int i = 0; i < 16; ++i) o[i] *= rl;
    head_norm_store16(o, gh + (hb + h) * 64 + po, act + (size_t)(b * SEQ + t) * DM + (hb + h) * 64 + po);
}
__device__ __forceinline__ void kmean_unit(const bf16* P, float* kmean, unsigned* knmax, int unit, LAS unsigned char* lds) {
    const int tid = otid();
    const int b = unit >> 4, blk = unit & 15;
    { const int g = tid >> 5, c8 = tid & 31;
      const bf16* p = P + ((size_t)b * SEQ + blk * 256 + g * 16) * PW + 2304 + 256 + c8 * 8;
      float s[8];
#pragma unroll
      for (int i = 0; i < 8; ++i) s[i] = 0.f;
#pragma unroll
      for (int r = 0; r < 16; ++r) { float f[8]; ld8(p + (size_t)r * PW, f);
#pragma unroll
          for (int i = 0; i < 8; ++i) s[i] += f[i]; }
      LAS float* part = (LAS float*)lds;
#pragma unroll
      for (int i = 0; i < 8; ++i) part[g * 256 + c8 * 8 + i] = s[i];
      __syncthreads();
      if (tid < 256) { float t = 0.f;
#pragma unroll
          for (int g2 = 0; g2 < 16; ++g2) t += part[g2 * 256 + tid];
          kmean[(size_t)unit * 256 + tid] = t * (1.0f / 256.0f); } }
    { const int key = tid >> 1, mx = tid & 1; const bf16* kr = P + ((size_t)b * SEQ + blk * 256 + key) * PW + (mx ? 2304 : 768) + 256;
#pragma unroll
      for (int h = 0; h < 4; ++h) { float ss = 0.f;
#pragma unroll
          for (int c8 = 0; c8 < 8; ++c8) { float f[8]; ld8(kr + h * 64 + 8 * c8, f);
#pragma unroll
              for (int i = 0; i < 8; ++i) ss += f[i] * f[i]; }
          float nm = sqrtf(ss);
#pragma unroll
          for (int o_ = 2; o_ < 64; o_ <<= 1) nm = fmaxf(nm, __shfl_xor(nm, o_));
          if ((tid & 63) < 2) atomicMax(&knmax[(b * 2 + mx) * 4 + h], __float_as_uint(nm)); } }
    __syncthreads();
}
constexpr int DSA_LDS = 8 * 4096 * 4;
#define DSA_COUNT_GE(trial, out) do { int cl0_ = 0, cl1_ = 0; const unsigned t_ = (unsigned)__builtin_amdgcn_readfirstlane((int)(trial)); \
    _Pragma("unroll") for (int g_ = 0; g_ < 8; ++g_) if (g_ * 8 < nreg) { \
        asm volatile("v_cmp_le_u32_e32 vcc, %10, %2\n\tv_addc_co_u32_e32 %0, vcc, 0, %0, vcc\n\tv_cmp_le_u32_e32 vcc, %10, %3\n\tv_addc_co_u32_e32 %1, vcc, 0, %1, vcc\n\t" \
                     "v_cmp_le_u32_e32 vcc, %10, %4\n\tv_addc_co_u32_e32 %0, vcc, 0, %0, vcc\n\tv_cmp_le_u32_e32 vcc, %10, %5\n\tv_addc_co_u32_e32 %1, vcc, 0, %1, vcc\n\t" \
                     "v_cmp_le_u32_e32 vcc, %10, %6\n\tv_addc_co_u32_e32 %0, vcc, 0, %0, vcc\n\tv_cmp_le_u32_e32 vcc, %10, %7\n\tv_addc_co_u32_e32 %1, vcc, 0, %1, vcc\n\t" \
                     "v_cmp_le_u32_e32 vcc, %10, %8\n\tv_addc_co_u32_e32 %0, vcc, 0, %0, vcc\n\tv_cmp_le_u32_e32 vcc, %10, %9\n\tv_addc_co_u32_e32 %1, vcc, 0, %1, vcc" \
                     : "+v"(cl0_), "+v"(cl1_) : "v"(K[g_ * 8 + 0]), "v"(K[g_ * 8 + 1]), "v"(K[g_ * 8 + 2]), "v"(K[g_ * 8 + 3]), "v"(K[g_ * 8 + 4]), "v"(K[g_ * 8 + 5]), "v"(K[g_ * 8 + 6]), "v"(K[g_ * 8 + 7]), "s"(t_) : "vcc"); } \
    const int cl_ = cl0_ + cl1_; int c_ = 0; \
    _Pragma("unroll") for (int b_ = 0; b_ < 7; ++b_) c_ += __builtin_popcountll(__ballot((cl_ >> b_) & 1)) << b_; \
    (out) = c_; } while (0)
typedef float f32x2_t __attribute__((ext_vector_type(2)));
#ifdef DSA_BITSLICE
#define DSA_SLOT(key) ((((key) & 63) << 6) + ((((key) >> 6) ^ (key)) & 63))
__device__ __forceinline__ int dsa_scan(int v) {
    v += __builtin_amdgcn_update_dpp(0, v, 0x111, 0xf, 0xf, false);
    v += __builtin_amdgcn_update_dpp(0, v, 0x112, 0xf, 0xf, false);
    v += __builtin_amdgcn_update_dpp(0, v, 0x114, 0xf, 0xe, false);
    v += __builtin_amdgcn_update_dpp(0, v, 0x118, 0xf, 0xc, false);
    v += __builtin_amdgcn_update_dpp(0, v, 0x142, 0xa, 0xf, false);
    v += __builtin_amdgcn_update_dpp(0, v, 0x143, 0xc, 0xf, false);
    return v; }
#else
#define DSA_SLOT(key) (key)
#endif
__device__ __forceinline__ void dsa_select_unit(const bf16* P, unsigned long long* mask, int unit, LAS unsigned* sc) {
#ifdef PROBE_T
    long long tacc = 0;
#define TSTAMP(beg_of, end_of) do { asm volatile("s_waitcnt lgkmcnt(0)" ::: "memory"); const long long c_ = clock64(); if (PROBE_T == (beg_of) || (PROBE_T == 5 && (beg_of) == 1)) tacc -= c_; if (PROBE_T == (end_of) || (PROBE_T == 5 && (end_of) == 4)) tacc += c_; } while (0)
#else
#define TSTAMP(a, b) do {} while (0)
#endif
    const int tid = otid(), lane = tid & 63, wid = tid >> 6, r32 = lane & 31, hi = lane >> 5;
    const int b = unit >> 9, t0 = (unit & 511) * 8;
    const bf16* Pb = P + (size_t)b * SEQ * PW;
    const int hrow = (r32 & 3) + 4 * ((r32 >> 3) & 1), qrow = 2 * ((r32 >> 2) & 1) + ((r32 >> 4) & 1);
    bf16x8 af[2][4];
#pragma unroll
    for (int qg = 0; qg < 2; ++qg)
#pragma unroll
        for (int s = 0; s < 4; ++s) af[qg][s] = *(const bf16x8*)(Pb + (size_t)(t0 + 4 * qg + qrow) * PW + COL_QI + hrow * 64 + 16 * s + 8 * hi);
    float wv[2][2][8];
#pragma unroll
    for (int qg = 0; qg < 2; ++qg)
#pragma unroll
        for (int qq = 0; qq < 2; ++qq) ld8(Pb + (size_t)(t0 + 4 * qg + 2 * hi + qq) * PW + COL_WI, wv[qg][qq]);
    const int ntile = (t0 + 8 + 31) >> 5;
    {
        bf16x8 fa[4], fb[4], fc[4];
#define DSA_LOAD(F, kt_) do { if ((kt_) < ntile) { _Pragma("unroll") for (int s = 0; s < 4; ++s) F[s] = *(const bf16x8*)(Pb + (size_t)((kt_) * 32 + r32) * PW + COL_KI + 16 * s + 8 * hi); } } while (0)
#define DSA_SCORE(F, kt_) do { if ((kt_) < ntile) { const int key = (kt_) * 32 + r32; \
            _Pragma("unroll") for (int qg = 0; qg < 2; ++qg) { \
                f32x16 acc = {0.f, 0.f, 0.f, 0.f, 0.f, 0.f, 0.f, 0.f, 0.f, 0.f, 0.f, 0.f, 0.f, 0.f, 0.f, 0.f}; \
                _Pragma("unroll") for (int s = 0; s < 4; ++s) acc = __builtin_amdgcn_mfma_f32_32x32x16_bf16(af[qg][s], F[s], acc, 0, 0, 0); \
                _Pragma("unroll") for (int qq = 0; qq < 2; ++qq) { float sA_ = 0.f, sB_ = 0.f; \
                    _Pragma("unroll") for (int h = 0; h < 8; h += 2) { sA_ = __builtin_fmaf(__builtin_amdgcn_fmed3f(acc[8 * qq + h], 0.f, 3.0e38f), wv[qg][qq][h], sA_); \
                        asm("" : "+v"(sA_));       \
                        sB_ = __builtin_fmaf(__builtin_amdgcn_fmed3f(acc[8 * qq + h + 1], 0.f, 3.0e38f), wv[qg][qq][h + 1], sB_); } \
                    const float s = sA_ + sB_;        \
                    const int ql = 4 * qg + 2 * hi + qq; \
                    const unsigned u = __float_as_uint(s); const unsigned sk = (u & 0x80000000u) ? ~u : (u | 0x80000000u); \
                    sc[ql * 4096 + DSA_SLOT(key)] = (key <= t0 + ql) ? sk : 0u; } } } } while (0)
#if defined(PROBE_SUB) && PROBE_SUB == 7
        for (int rep_ = 0; rep_ < 2; ++rep_) {
#endif
        int kt = wid;
        DSA_LOAD(fa, kt); DSA_LOAD(fb, kt + 8);
        while (kt < ntile) {
            DSA_LOAD(fc, kt + 16); DSA_SCORE(fa, kt);
            DSA_LOAD(fa, kt + 24); DSA_SCORE(fb, kt + 8);
            DSA_LOAD(fb, kt + 32); DSA_SCORE(fc, kt + 16);
            kt += 24;
        }
#if defined(PROBE_SUB) && PROBE_SUB == 7
        }
#endif
#undef DSA_LOAD
#undef DSA_SCORE
    }
    __syncthreads();
#if defined(PROBE_SUB) && PROBE_SUB == 8
    unsigned long long first_word = 0ull;
    for (int rep_ = 0; rep_ < 2; ++rep_)
#endif
    {
        const int t = t0 + wid, nvalid = t + 1, nk = ntile * 32, nreg = (nk + 63) >> 6;
        unsigned long long myword = 0ull;
        if (nvalid <= 256) {
            const int lo = lane * 64; myword = (nvalid >= lo + 64) ? ~0ull : (nvalid > lo ? ((1ull << (nvalid - lo)) - 1ull) : 0ull);
        } else {
#ifdef DSA_BITSLICE
            LAS unsigned* row = sc + wid * 4096;
            unsigned A[64];
#pragma unroll
            for (int r = 0; r < 64; ++r) A[r] = row[r * 64 + ((lane ^ r) & 63)];
#pragma unroll
            for (int blk = 0; blk < 64; blk += 32) {
#pragma unroll
                for (int js = 0; js < 5; ++js) { const int j = 16 >> js; const unsigned m = js == 0 ? 0x0000FFFFu : (js == 1 ? 0x00FF00FFu : (js == 2 ? 0x0F0F0F0Fu : (js == 3 ? 0x33333333u : 0x55555555u)));
#pragma unroll
                    for (int k = 0; k < 32; ++k) if ((k & j) == 0) { const unsigned a_ = A[blk + k], b_ = A[blk + k + j];
                        A[blk + k] = (a_ & ~(m << j)) | ((b_ << j) & (m << j)); A[blk + k + j] = (b_ & ~m) | ((a_ >> j) & m); } } }
            const int lim_ = nk - 64 * lane; const unsigned long long vm = lim_ >= 64 ? ~0ull : (lim_ <= 0 ? 0ull : ((1ull << lim_) - 1ull));
            unsigned c_lo = (unsigned)vm, c_hi = (unsigned)(vm >> 32), g_lo = 0u, g_hi = 0u; int need = 256, ncand = nk;
#pragma unroll
            for (int bb = 31; bb >= 0; --bb) {
                if (ncand != need) {
                const unsigned x_lo = c_lo & A[bb], x_hi = c_hi & A[32 + bb];
                const int cnt = __builtin_amdgcn_readlane(dsa_scan(__builtin_popcount(x_lo) + __builtin_popcount(x_hi)), 63);
                const bool up = cnt >= need;
                const unsigned fl = up ? 0u : ~0u;
                c_lo &= (A[bb] ^ fl); c_hi &= (A[32 + bb] ^ fl);
                g_lo |= x_lo & fl; g_hi |= x_hi & fl;
                need -= up ? 0 : cnt; ncand = up ? cnt : ncand - cnt; }
            }
            { const int mine = __builtin_popcount(c_lo) + __builtin_popcount(c_hi); const int incl = dsa_scan(mine); const int tot = __builtin_amdgcn_readlane(incl, 63);
              unsigned long long eq = ((unsigned long long)c_hi << 32) | c_lo;
              if (tot != need) { int k_ = need - (incl - mine); k_ = k_ < 0 ? 0 : (k_ > mine ? mine : k_);
                  while (__builtin_popcountll(eq) > k_) eq &= ~(1ull << (63 - __builtin_clzll(eq))); }
              myword = (((unsigned long long)g_hi << 32) | g_lo) | eq; }
#else
            LAS unsigned* row = sc + wid * 4096;
            unsigned K[64];
            TSTAMP(1, 0);
#pragma unroll
            for (int r = 0; r < 64; ++r) K[r] = (r * 64 + lane < nk) ? row[r * 64 + lane] : 0u;
            TSTAMP(2, 1);
            unsigned prefix = 0u; int cnt_prefix = 4096, c_above = 0, bit = 32;
            { int ca, cb; DSA_COUNT_GE(0xBC000000u, ca);
              if (ca >= 256) { DSA_COUNT_GE(0xC0000000u, cb);
                  if (cb < 256) { int cm; DSA_COUNT_GE(0xBE000000u, cm);
                      if (cm >= 256) { prefix = 0xBE000000u; cnt_prefix = cm; c_above = cb; } else { prefix = 0xBC000000u; cnt_prefix = ca; c_above = cm; }
                      bit = 25; } } }
            while (bit > 0 && cnt_prefix - c_above > 128) { --bit; const unsigned trial = prefix | (1u << bit); int cnt; DSA_COUNT_GE(trial, cnt);
                if (cnt >= 256) { prefix = trial; cnt_prefix = cnt; } else c_above = cnt; }
            TSTAMP(3, 2);
            if (bit > 0) {
                const unsigned himask = ~((1u << bit) - 1u); const unsigned long long below = (1ull << lane) - 1ull; int base = 0;
#pragma unroll
                for (int g = 0; g < 8; ++g) if (g * 8 < nreg) {
#pragma unroll
                    for (int r = 0; r < 8; ++r) { const unsigned k = K[g * 8 + r]; const bool in = (k & himask) == prefix; const unsigned long long mk = __ballot(in);
                        if (in) row[base + __builtin_popcountll(mk & below)] = k; base += __builtin_popcountll(mk); } }
                const unsigned C0 = (lane < base) ? row[lane] : 0u, C1 = (64 + lane < base) ? row[64 + lane] : 0u;
                while (bit > 1) { bit -= 2; const unsigned t1 = prefix | (1u << bit), t2 = prefix | (2u << bit), t3 = prefix | (3u << bit);
                    const int n1 = c_above + __builtin_popcountll(__ballot(C0 >= t1)) + __builtin_popcountll(__ballot(C1 >= t1));
                    const int n2 = c_above + __builtin_popcountll(__ballot(C0 >= t2)) + __builtin_popcountll(__ballot(C1 >= t2));
                    const int n3 = c_above + __builtin_popcountll(__ballot(C0 >= t3)) + __builtin_popcountll(__ballot(C1 >= t3));
                    if (n3 >= 256) { prefix = t3; cnt_prefix = n3; } else if (n2 >= 256) { prefix = t2; cnt_prefix = n2; } else if (n1 >= 256) { prefix = t1; cnt_prefix = n1; } }
                if (bit > 0) { --bit; const unsigned trial = prefix | (1u << bit);
                    const int cnt = c_above + __builtin_popcountll(__ballot(C0 >= trial)) + __builtin_popcountll(__ballot(C1 >= trial));
                    if (cnt >= 256) { prefix = trial; cnt_prefix = cnt; } }
            }
            TSTAMP(4, 3);
            if (cnt_prefix == 256) {
#pragma unroll
                for (int g = 0; g < 8; ++g) if (g * 8 < nreg) {
#pragma unroll
                    for (int r = 0; r < 8; ++r) { const unsigned long long word = __ballot(K[g * 8 + r] >= prefix); if (lane == g * 8 + r) myword = word; } }
            } else {
                int cgt; DSA_COUNT_GE(prefix + 1u, cgt);
                int need = 256 - cgt;
                const unsigned long long below = (1ull << lane) - 1ull;
#pragma unroll
                for (int g = 0; g < 8; ++g) if (g * 8 < nreg) {
#pragma unroll
                    for (int r = 0; r < 8; ++r) { const unsigned k = K[g * 8 + r];
                        const unsigned long long gt = __ballot(k > prefix), eq = __ballot(k == prefix);
                        const int c = __builtin_popcountll(eq); unsigned long long take;
                        if (c <= need) { take = eq; need -= c; }
                        else { const bool mine = ((eq >> lane) & 1ull) && (__builtin_popcountll(eq & below) < need); take = __ballot(mine); need = 0; }
                        const unsigned long long word = gt | take;
                        if (lane == g * 8 + r) myword = word; } }
            }
#endif
        }
#if defined(PROBE_SUB) && PROBE_SUB == 8
        if (rep_ == 0) first_word = myword; myword = first_word;
#endif
        if (nvalid > 256) TSTAMP(0, 4);
#ifdef PROBE_T
        if (blockIdx.x == 0 && tid == 0 && nvalid > 256) { unsigned long long* tp = (unsigned long long*)((unsigned char*)mask - WS_MASK); atomicAdd(&tp[151], (unsigned long long)tacc); atomicAdd(&tp[152], 1ull); }
#endif
        mask[(size_t)(b * SEQ + t) * 64 + lane] = myword;
    }
    __syncthreads();
}

#define MFMA32(a, b, c) __builtin_amdgcn_mfma_f32_32x32x16_bf16(a, b, c, 0, 0, 0)
__device__ __forceinline__ int crow(int r, int hi) { return (r & 3) + 8 * (r >> 2) + 4 * hi; }
constexpr int AT_KROW = 144, AT_VROW = 136;
constexpr int AT_KBUF = 64 * AT_KROW, AT_VBUF = 64 * AT_VROW;
constexpr int AT_KOFF = 0, AT_VOFF = 2 * AT_KBUF, AT_KMOFF = AT_VOFF + 2 * AT_VBUF, AT_MISC = AT_KMOFF + 4096;
typedef short s16x4 __attribute__((ext_vector_type(4)));

__device__ __forceinline__ void at_load(const bf16* Pb, int k0, int kcol, int vcol, int tid, u32x4& kr, u32x4& vr) {
    const bf16* row = Pb + (size_t)(k0 + (tid >> 3)) * PW + (tid & 7) * 8;
    kr = *(const u32x4*)(row + kcol); vr = *(const u32x4*)(row + vcol);
}
__device__ __forceinline__ void at_store(LAS unsigned char* lds, int buf, int tid, const u32x4& kr, const u32x4& vr) {
    const int key = tid >> 3, c = tid & 7;
    *(LAS u32x4*)(lds + AT_KOFF + buf * AT_KBUF + key * AT_KROW + c * 16) = kr;
#ifdef AT_TR
    *(LAS u32x4*)(lds + AT_VOFF + buf * AT_VBUF + 1024 * (key >> 3) + 512 * (c >> 2) + 64 * (key & 7) + 16 * ((c & 3) ^ ((key >> 2) & 3))) = vr;
}
#else
    LAS unsigned short* vt = (LAS unsigned short*)(lds + AT_VOFF + buf * AT_VBUF + (8 * c) * AT_VROW + key * 2);
    vt[0 * (AT_VROW / 2)] = (unsigned short)(vr.x & 0xffffu); vt[1 * (AT_VROW / 2)] = (unsigned short)(vr.x >> 16);
    vt[2 * (AT_VROW / 2)] = (unsigned short)(vr.y & 0xffffu); vt[3 * (AT_VROW / 2)] = (unsigned short)(vr.y >> 16);
    vt[4 * (AT_VROW / 2)] = (unsigned short)(vr.z & 0xffffu); vt[5 * (AT_VROW / 2)] = (unsigned short)(vr.z >> 16);
    vt[6 * (AT_VROW / 2)] = (unsigned short)(vr.w & 0xffffu); vt[7 * (AT_VROW / 2)] = (unsigned short)(vr.w >> 16);
}
#endif
__device__ __forceinline__ f32x16 at_scores(LAS unsigned char* lds, int buf, int a, int r32, int hi, const bf16x8 (&qf)[4], const f32x16 sinit = (f32x16){0.f, 0.f, 0.f, 0.f, 0.f, 0.f, 0.f, 0.f, 0.f, 0.f, 0.f, 0.f, 0.f, 0.f, 0.f, 0.f}) {
    f32x16 s = sinit;
    const LAS unsigned char* kp = lds + AT_KOFF + buf * AT_KBUF + (32 * a + r32) * AT_KROW + hi * 16;
#pragma unroll
    for (int sp = 0; sp < 4; ++sp) { const bf16x8 kf = *(const LAS bf16x8*)(kp + sp * 32); s = MFMA32(kf, qf[sp], s); }
    return s;
}
__device__ __forceinline__ void at_pv_both(LAS unsigned char* lds, int buf, int r32, int hi, const f32x16& p0, const f32x16& p1, f32x16 (&o)[2]) {
    s16x4 va[2][2][2], vb2[2][2][2];
    { const unsigned q4 = (unsigned)(r32 & 15) >> 2, p4 = (unsigned)r32 & 3u, g16 = ((unsigned)r32 >> 4) & 1u;
      const unsigned vb = (unsigned)(size_t)(lds + AT_VOFF) + (unsigned)(buf * AT_VBUF) + 64u * (4u * (unsigned)hi + q4) + 8u * (p4 & 1u);
      const unsigned a0 = vb + 16u * ((2u * g16 + (p4 >> 1)) ^ ((unsigned)hi & 3u)), a1 = vb + 16u * ((2u * g16 + (p4 >> 1)) ^ (((unsigned)hi + 2u) & 3u));
      asm volatile("ds_read_b64_tr_b16 %0, %16\n\tds_read_b64_tr_b16 %1, %17 offset:1024\n\tds_read_b64_tr_b16 %2, %16 offset:512\n\tds_read_b64_tr_b16 %3, %17 offset:1536\n\t"
                   "ds_read_b64_tr_b16 %4, %16 offset:2048\n\tds_read_b64_tr_b16 %5, %17 offset:3072\n\tds_read_b64_tr_b16 %6, %16 offset:2560\n\tds_read_b64_tr_b16 %7, %17 offset:3584\n\t"
                   "ds_read_b64_tr_b16 %8, %16 offset:4096\n\tds_read_b64_tr_b16 %9, %17 offset:5120\n\tds_read_b64_tr_b16 %10, %16 offset:4608\n\tds_read_b64_tr_b16 %11, %17 offset:5632\n\t"
                   "ds_read_b64_tr_b16 %12, %16 offset:6144\n\tds_read_b64_tr_b16 %13, %17 offset:7168\n\tds_read_b64_tr_b16 %14, %16 offset:6656\n\tds_read_b64_tr_b16 %15, %17 offset:7680\n\ts_waitcnt lgkmcnt(0)"
                   : "=&v"(va[0][0][0]), "=&v"(va[0][0][1]), "=&v"(va[0][1][0]), "=&v"(va[0][1][1]), "=&v"(va[1][0][0]), "=&v"(va[1][0][1]), "=&v"(va[1][1][0]), "=&v"(va[1][1][1]),
                     "=&v"(vb2[0][0][0]), "=&v"(vb2[0][0][1]), "=&v"(vb2[0][1][0]), "=&v"(vb2[0][1][1]), "=&v"(vb2[1][0][0]), "=&v"(vb2[1][0][1]), "=&v"(vb2[1][1][0]), "=&v"(vb2[1][1][1])
                   : "v"(a0), "v"(a1) : "memory"); }
#pragma unroll
    for (int s = 0; s < 2; ++s) {
        u32x4 w; w.x = cvt_pk_bf16(p0[8 * s + 0], p0[8 * s + 1]); w.y = cvt_pk_bf16(p0[8 * s + 2], p0[8 * s + 3]); w.z = cvt_pk_bf16(p0[8 * s + 4], p0[8 * s + 5]); w.w = cvt_pk_bf16(p0[8 * s + 6], p0[8 * s + 7]);
        u32x4 x; x.x = cvt_pk_bf16(p1[8 * s + 0], p1[8 * s + 1]); x.y = cvt_pk_bf16(p1[8 * s + 2], p1[8 * s + 3]); x.z = cvt_pk_bf16(p1[8 * s + 4], p1[8 * s + 5]); x.w = cvt_pk_bf16(p1[8 * s + 6], p1[8 * s + 7]);
        const bf16x8 pf0 = __builtin_bit_cast(bf16x8, w), pf1 = __builtin_bit_cast(bf16x8, x);
#pragma unroll
        for (int dh = 0; dh < 2; ++dh) { const bf16x8 vf0 = {va[s][dh][0][0], va[s][dh][0][1], va[s][dh][0][2], va[s][dh][0][3], va[s][dh][1][0], va[s][dh][1][1], va[s][dh][1][2], va[s][dh][1][3]};
            const bf16x8 vf1 = {vb2[s][dh][0][0], vb2[s][dh][0][1], vb2[s][dh][0][2], vb2[s][dh][0][3], vb2[s][dh][1][0], vb2[s][dh][1][1], vb2[s][dh][1][2], vb2[s][dh][1][3]};
            o[dh] = MFMA32(vf0, pf0, o[dh]); o[dh] = MFMA32(vf1, pf1, o[dh]); }
    }
}
__device__ __forceinline__ void at_pv(LAS unsigned char* lds, int buf, int a, int r32, int hi, const f32x16& p, f32x16 (&o)[2]) {
#ifdef AT_TR
    s16x4 vtr[2][2][2];
    { const unsigned q4 = (unsigned)(r32 & 15) >> 2, p4 = (unsigned)r32 & 3u, g16 = ((unsigned)r32 >> 4) & 1u;
      const unsigned vb = (unsigned)(size_t)(lds + AT_VOFF) + (unsigned)(buf * AT_VBUF) + 4096u * (unsigned)a + 64u * (4u * (unsigned)hi + q4) + 8u * (p4 & 1u);
      const unsigned a0 = vb + 16u * ((2u * g16 + (p4 >> 1)) ^ ((unsigned)hi & 3u)), a1 = vb + 16u * ((2u * g16 + (p4 >> 1)) ^ (((unsigned)hi + 2u) & 3u));
      asm volatile("ds_read_b64_tr_b16 %0, %8\n\tds_read_b64_tr_b16 %1, %9 offset:1024\n\tds_read_b64_tr_b16 %2, %8 offset:512\n\tds_read_b64_tr_b16 %3, %9 offset:1536\n\t"
                   "ds_read_b64_tr_b16 %4, %8 offset:2048\n\tds_read_b64_tr_b16 %5, %9 offset:3072\n\tds_read_b64_tr_b16 %6, %8 offset:2560\n\tds_read_b64_tr_b16 %7, %9 offset:3584\n\ts_waitcnt lgkmcnt(0)"
                   : "=&v"(vtr[0][0][0]), "=&v"(vtr[0][0][1]), "=&v"(vtr[0][1][0]), "=&v"(vtr[0][1][1]), "=&v"(vtr[1][0][0]), "=&v"(vtr[1][0][1]), "=&v"(vtr[1][1][0]), "=&v"(vtr[1][1][1])
                   : "v"(a0), "v"(a1) : "memory"); }
#pragma unroll
    for (int s = 0; s < 2; ++s) {
        u32x4 w; w.x = cvt_pk_bf16(p[8 * s + 0], p[8 * s + 1]); w.y = cvt_pk_bf16(p[8 * s + 2], p[8 * s + 3]); w.z = cvt_pk_bf16(p[8 * s + 4], p[8 * s + 5]); w.w = cvt_pk_bf16(p[8 * s + 6], p[8 * s + 7]);
        const bf16x8 pf = __builtin_bit_cast(bf16x8, w);
#pragma unroll
        for (int dh = 0; dh < 2; ++dh) { const bf16x8 vf = {vtr[s][dh][0][0], vtr[s][dh][0][1], vtr[s][dh][0][2], vtr[s][dh][0][3], vtr[s][dh][1][0], vtr[s][dh][1][1], vtr[s][dh][1][2], vtr[s][dh][1][3]};
            o[dh] = MFMA32(vf, pf, o[dh]); }
    }
    return;
#endif
#pragma unroll
    for (int s = 0; s < 2; ++s) {
        u32x4 w; w.x = cvt_pk_bf16(p[8 * s + 0], p[8 * s + 1]); w.y = cvt_pk_bf16(p[8 * s + 2], p[8 * s + 3]); w.z = cvt_pk_bf16(p[8 * s + 4], p[8 * s + 5]); w.w = cvt_pk_bf16(p[8 * s + 6], p[8 * s + 7]);
        const bf16x8 pf = __builtin_bit_cast(bf16x8, w);
#pragma unroll
        for (int dh = 0; dh < 2; ++dh) {
            const LAS unsigned char* vp = lds + AT_VOFF + buf * AT_VBUF + (32 * dh + r32) * AT_VROW + (32 * a + 16 * s + 4 * hi) * 2;
            const s16x4 v0 = *(const LAS s16x4*)vp, v1 = *(const LAS s16x4*)(vp + 16);
            const bf16x8 vf = {v0[0], v0[1], v0[2], v0[3], v1[0], v1[1], v1[2], v1[3]};
            o[dh] = MFMA32(vf, pf, o[dh]);
        }
    }
}
#ifdef WOUT_FP8
typedef unsigned char acto_t;
#else
typedef bf16 acto_t;
#endif
__device__ __forceinline__ void at_finish(f32x16 (&o)[2], float inv_l, int hi, const float* gh, acto_t* dst) {
    float ss = 0.f;
#pragma unroll
    for (int dh = 0; dh < 2; ++dh)
#pragma unroll
        for (int r = 0; r < 16; ++r) { o[dh][r] *= inv_l; ss += o[dh][r] * o[dh][r]; }
    ss += __shfl_xor(ss, 32);
    const float rn = rsqrtf(ss * (1.0f / 64.0f) + EPS);
#pragma unroll
    for (int dh = 0; dh < 2; ++dh)
#pragma unroll
        for (int g = 0; g < 4; ++g) { const int d = 32 * dh + 8 * g + 4 * hi; const f32x4 gv = *(const f32x4*)(gh + d);
#ifdef WOUT_FP8
            *(unsigned*)(dst + d) = pg8::pk4_fp8(o[dh][4 * g + 0] * rn * gv.x, o[dh][4 * g + 1] * rn * gv.y, o[dh][4 * g + 2] * rn * gv.z, o[dh][4 * g + 3] * rn * gv.w); }
#else
            u32x2 w; w.x = cvt_pk_bf16(o[dh][4 * g + 0] * rn * gv.x, o[dh][4 * g + 1] * rn * gv.y); w.y = cvt_pk_bf16(o[dh][4 * g + 2] * rn * gv.z, o[dh][4 * g + 3] * rn * gv.w);
            *(u32x2*)(dst + d) = w; }
#endif
}

constexpr float LOG2E = 1.4426950408889634f;
template <int MODE> __device__ __forceinline__ void attn_masked_unit(const bf16* P, const unsigned long long* mask, const float* kmean, const unsigned* knmax, const float* gh16, acto_t* act, int b, int h, int qb, LAS unsigned char* lds) {
    const int tid = otid(), lane = tid & 63, wid = tid >> 6, r32 = lane & 31, hi = lane >> 5;
    const int cb = MODE == 0 ? 768 : 2304, hb = MODE == 0 ? 4 : 12;
    const bf16* Pb = P + (size_t)b * SEQ * PW + cb;
    const int kcol = 256 + h * 64, vcol = 512 + h * 64;
    const int q0 = qb * 256, tq = q0 + 32 * wid + r32, qmax = q0 + 32 * wid + 31;
    const float slope2 = alibi_slope(MODE == 0 ? 0 : 2, h) * LOG2E;
    bf16x8 qf[4];
#pragma unroll
    for (int sp = 0; sp < 4; ++sp) qf[sp] = *(const bf16x8*)(Pb + (size_t)tq * PW + h * 64 + 16 * sp + 8 * hi);
    float qn2 = 0.f;
#pragma unroll
    for (int sp = 0; sp < 4; ++sp)
#pragma unroll
        for (int i = 0; i < 8; ++i) { const float v = bf2f((unsigned)(unsigned short)qf[sp][i]); qn2 += v * v; }
    qn2 += __shfl_xor(qn2, 32);
    const float bound0 = sqrtf(qn2) * __uint_as_float(knmax[(b * 2 + MODE) * 4 + h]) * 1.01f + 1e-3f;
    LAS unsigned* misc = (LAS unsigned*)(lds + AT_MISC);
    unsigned sel = 0u, wgsel = 0xffffu;
    if (tid < 8) misc[tid] = 0u;
    if (MODE == 1) {
        LAS float* km = (LAS float*)(lds + AT_KMOFF);
        for (int i = tid; i < 16 * 64; i += 512) km[i] = kmean[((size_t)b * 16 + (i >> 6)) * 256 + h * 64 + (i & 63)];
        __syncthreads();
        if (qb <= 3) sel = (1u << qb) - 1u;
        else {
            u32x4 qraw[8];
#pragma unroll
            for (int c = 0; c < 8; ++c) qraw[c] = *(const u32x4*)(Pb + (size_t)tq * PW + h * 64 + 8 * c);
            float v1 = -INFINITY, v2 = -INFINITY, v3 = -INFINITY; int i1 = 0, i2 = 0, i3 = 0;
            for (int blk = 0; blk < qb; ++blk) {
                const LAS f32x4* kb = (const LAS f32x4*)(km + blk * 64); float g0 = 0.f, g1 = 0.f;
#pragma unroll
                for (int c = 0; c < 8; ++c) { const u32x4 u = qraw[c]; const f32x4 ka = kb[2 * c], kc = kb[2 * c + 1];
                    g0 += __uint_as_float(u.x << 16) * ka.x; g1 += __uint_as_float(u.x & 0xffff0000u) * ka.y;
                    g0 += __uint_as_float(u.y << 16) * ka.z; g1 += __uint_as_float(u.y & 0xffff0000u) * ka.w;
                    g0 += __uint_as_float(u.z << 16) * kc.x; g1 += __uint_as_float(u.z & 0xffff0000u) * kc.y;
                    g0 += __uint_as_float(u.w << 16) * kc.z; g1 += __uint_as_float(u.w & 0xffff0000u) * kc.w; }
                const float g = g0 + g1;
                if (g > v1) { v3 = v2; i3 = i2; v2 = v1; i2 = i1; v1 = g; i1 = blk; }
                else if (g > v2) { v3 = v2; i3 = i2; v2 = g; i2 = blk; }
                else if (g > v3) { v3 = g; i3 = blk; }
            }
            sel = (1u << i1) | (1u << i2) | (1u << i3);
        }
        unsigned ws_ = sel;
#pragma unroll
        for (int o_ = 1; o_ < 64; o_ <<= 1) ws_ |= (unsigned)__shfl_xor((int)ws_, o_);
        if (lane == 0) __hip_atomic_fetch_or(&misc[0], ws_, __ATOMIC_RELAXED, __HIP_MEMORY_SCOPE_WORKGROUP);
        __syncthreads();
        wgsel = misc[0] | (1u << qb);
    }
    f32x16 cr;
#pragma unroll
    for (int r = 0; r < 16; ++r) cr[r] = slope2 * (float)((r & 3) + 8 * (r >> 2));
    f32x16 o[2];
#pragma unroll
    for (int r = 0; r < 16; ++r) { o[0][r] = 0.f; o[1][r] = 0.f; }
    float m = -INFINITY, l = 0.f; bool done = false;
    const unsigned long long* mrow = mask + (size_t)(b * SEQ + tq) * 64;
#define AT_NEXT(x, y) do { (y) = (x) - 1; if (MODE == 1) { while ((y) >= 0 && !((wgsel >> ((y) >> 2)) & 1u)) (y) -= 4; } } while (0)
    int t = 4 * qb + 3, tn, tn2;
    u32x4 kr, vr, kr2, vr2;
    at_load(Pb, t * 64, kcol, vcol, tid, kr, vr);
    unsigned long long mw = (MODE == 0) ? mrow[t] : 0ull, mwn = 0ull, mwn2 = 0ull;
    at_store(lds, 0, tid, kr, vr);
    AT_NEXT(t, tn);
    if (tn >= 0) { at_load(Pb, tn * 64, kcol, vcol, tid, kr, vr); if (MODE == 0) mwn = mrow[tn]; }
    __syncthreads();
    int buf = 0, it = 0;
#ifdef PROBE_A
    long long tacc = 0; int tcnt = 0;
#define ASTAMP(beg_of, end_of) do { const long long c_ = clock64(); if (PROBE_A == (beg_of) || (PROBE_A == 5 && (beg_of) == 1)) tacc -= c_; if (PROBE_A == (end_of) || (PROBE_A == 5 && (end_of) == 4)) tacc += c_; } while (0)
#else
#define ASTAMP(a, b) do {} while (0)
#endif
#define AT_STEP(KA, VA, MA, KB, VB, MB) { \
        ASTAMP(1, 0); \
        tn2 = -1; if (tn >= 0) AT_NEXT(tn, tn2); \
        if (tn2 >= 0) { at_load(Pb, tn2 * 64, kcol, vcol, tid, KB, VB); if (MODE == 0) MB = mrow[tn2]; } \
        ASTAMP(2, 1); \
        at_compute(); \
        ASTAMP(3, 2); \
        if (lane == 0 && (done || tn < 0)) __hip_atomic_fetch_add(&misc[4 + it % 3], 1u, __ATOMIC_RELAXED, __HIP_MEMORY_SCOPE_WORKGROUP); \
        if (tid == 0) misc[4 + (it + 1) % 3] = 0u; \
        if (tn >= 0) at_store(lds, buf ^ 1, tid, KA, VA); \
        ASTAMP(4, 3); \
        __syncthreads(); \
        ASTAMP(0, 4); \
        nd = misc[4 + it % 3]; \
        buf ^= 1; t = tn; tn = tn2; mw = MA; ++it; }
    auto at_compute = [&]() __attribute__((always_inline)) {
        const int k0 = t * 64; const bool own = t >= 4 * qb;
        if (!done && k0 <= qmax) {
            const float ub = bound0 + slope2 * (float)(k0 + 63 - tq);
#if defined(PROBE_SUB) && PROBE_SUB == 6
            if (!own && __all(ub - m < -1e30f)) done = true;
#else
            if (!own && __all(ub - m < -151.0f)) done = true;
#endif
            else if (MODE == 0 || own || __any((sel >> (t >> 2)) & 1u)) {
                f32x16 s0 = cr, s1 = cr;
                { const LAS unsigned char* kp0_ = lds + AT_KOFF + buf * AT_KBUF + r32 * AT_KROW + hi * 16; const LAS unsigned char* kp1_ = kp0_ + 32 * AT_KROW;
                  bf16x8 ka_[4], kb_[4];
#pragma unroll
                  for (int sp = 0; sp < 4; ++sp) { ka_[sp] = *(const LAS bf16x8*)(kp0_ + sp * 32); kb_[sp] = *(const LAS bf16x8*)(kp1_ + sp * 32); }
                  asm volatile("" : "+v"(ka_[0]), "+v"(ka_[1]), "+v"(ka_[2]), "+v"(ka_[3]), "+v"(kb_[0]), "+v"(kb_[1]), "+v"(kb_[2]), "+v"(kb_[3]));
#pragma unroll
                  for (int sp = 0; sp < 4; ++sp) { s0 = MFMA32(ka_[sp], qf[sp], s0); s1 = MFMA32(kb_[sp], qf[sp], s1); } }
                if (MODE == 0) asm volatile("s_nop 11" : "+v"(s0), "+v"(s1));
                float tb0 = slope2 * (float)(k0 + 4 * hi - tq);
                if (MODE == 1 && !own && !((sel >> (t >> 2)) & 1u)) tb0 = -INFINITY;
                const float tb1 = tb0 + 32.0f * slope2;
                float mx0 = -INFINITY, mx1 = -INFINITY;
                const unsigned wlo = (unsigned)(mw >> (4 * hi)), whi = (unsigned)(mw >> (32 + 4 * hi));
                const int lim = tq - k0 - 4 * hi;
                if (MODE == 1 && k0 + 63 > q0 + 32 * wid) {
#pragma unroll
                    for (int r = 0; r < 16; ++r) { const int kk = (r & 3) + 8 * (r >> 2); s0[r] = (kk <= lim) ? s0[r] : -INFINITY; s1[r] = (kk + 32 <= lim) ? s1[r] : -INFINITY; } }
#pragma unroll
                for (int r = 0; r < 16; ++r) { const int kk = (r & 3) + 8 * (r >> 2);
                    float x0 = s0[r], x1 = s1[r];
#ifdef AT_BFI
                    if (MODE == 0) { unsigned y0_, y1_;
                        const int b0_ = __builtin_amdgcn_sbfe((int)wlo, kk, 1), b1_ = __builtin_amdgcn_sbfe((int)whi, kk, 1);
                        asm("v_bfi_b32 %0, %1, %2, %3" : "=v"(y0_) : "v"(b0_), "v"(x0), "v"(0xff800000u)); asm("v_bfi_b32 %0, %1, %2, %3" : "=v"(y1_) : "v"(b1_), "v"(x1), "v"(0xff800000u));
                        x0 = __uint_as_float(y0_); x1 = __uint_as_float(y1_); }
#else
                    if (MODE == 0) { x0 = (wlo & (1u << kk)) ? x0 : -INFINITY; x1 = (whi & (1u << kk)) ? x1 : -INFINITY; }
#endif
                    s0[r] = x0; s1[r] = x1; mx0 = fmaxf(mx0, x0); mx1 = fmaxf(mx1, x1); }
                float mx = fmaxf(mx0 + tb0, mx1 + tb1);
                mx = fmaxf(mx, __shfl_xor(mx, 32));
                if (__any(mx - m > 8.0f)) {
                    const float mn = fmaxf(m, mx), alpha = (mn == -INFINITY) ? 1.0f : exp2f(m - mn);
                    l *= alpha; m = mn;
#pragma unroll
                    for (int r = 0; r < 16; ++r) { o[0][r] *= alpha; o[1][r] *= alpha; } }
                const float mt0 = (m == -INFINITY) ? INFINITY : m - tb0, mt1 = (m == -INFINITY) ? INFINITY : m - tb1;
                float ps = 0.f;
                float ps1 = 0.f;
#pragma unroll
                for (int r = 0; r < 16; ++r) { s0[r] = __builtin_amdgcn_exp2f(s0[r] - mt0); s1[r] = __builtin_amdgcn_exp2f(s1[r] - mt1); ps += s0[r]; asm("" : "+v"(ps)); ps1 += s1[r]; }
                ps += ps1;
                l += ps;
                at_pv_both(lds, buf, r32, hi, s0, s1, o);
            }
        }
    };
    unsigned nd = 0u;
    while (t >= 0) {
        AT_STEP(kr, vr, mwn, kr2, vr2, mwn2);
        if (nd == 8u || t < 0) break;
        AT_STEP(kr2, vr2, mwn2, kr, vr, mwn);
        if (nd == 8u) break;
    }
#undef AT_STEP
#ifdef PROBE_A
    if (MODE == 0 && blockIdx.x == 0 && tid == 64 * 5) { unsigned long long* tp = (unsigned long long*)((unsigned char*)mask - WS_MASK); atomicAdd(&tp[151], (unsigned long long)tacc); atomicAdd(&tp[152], (unsigned long long)it); }
#endif
#undef AT_NEXT
    l += __shfl_xor(l, 32);
    at_finish(o, 1.0f / l, hi, gh16 + (hb + h) * 64, act + (size_t)(b * SEQ + tq) * DM + (hb + h) * 64);
    __syncthreads();
}

template <int DUMMY> __device__ __forceinline__ void attn_sb_unit(const bf16* P, const float* gh16, acto_t* act, int b, int h, int qb, LAS unsigned char* lds) {
    const int tid = otid(), lane = tid & 63, wid = tid >> 6, r32 = lane & 31, hi = lane >> 5;
    const bf16* Pb = P + (size_t)b * SEQ * PW;
    const int kcol = 256 + h * 64, vcol = 512 + h * 64;
    const int q0 = qb * 256, tq = q0 + 32 * wid + r32, qmax = q0 + 32 * wid + 31;
    bf16x8 qf[4];
#pragma unroll
    for (int sp = 0; sp < 4; ++sp) qf[sp] = *(const bf16x8*)(Pb + (size_t)tq * PW + h * 64 + 16 * sp + 8 * hi);
    LAS unsigned* vote = (LAS unsigned*)(lds + AT_MISC);
    if (tid < 3) vote[tid] = 0u;
    f32x16 o[2];
#pragma unroll
    for (int r = 0; r < 16; ++r) { o[0][r] = 0.f; o[1][r] = 0.f; }
    float carry = 1.0f; bool done = false;
    int t = 4 * qb + 3;
    u32x4 kr, vr;
    at_load(Pb, t * 64, kcol, vcol, tid, kr, vr);
    at_store(lds, 0, tid, kr, vr);
    __syncthreads();
    int buf = 0, it = 0;
    while (t >= 0) {
        const int tn = t - 1;
        if (tn >= 0) at_load(Pb, tn * 64, kcol, vcol, tid, kr, vr);
        const int k0 = t * 64;
        if (!done && k0 < qmax) {
#pragma unroll
            for (int ai = 0; ai < 2; ++ai) { const int a = 1 - ai, ks = k0 + 32 * a;
                if (ks < qmax) {
                    f32x16 s = at_scores(lds, buf, a, r32, hi, qf);
                    float G[4];
#pragma unroll
                    for (int g = 0; g < 4; ++g) { float gp = 1.0f;
#pragma unroll
                        for (int i = 0; i < 4; ++i) { const int r = 4 * g + i; const int kp = ks + 8 * g + 4 * hi + i; const bool valid = kp < tq;
                            const float z = fminf(fmaxf(s[r], -80.f), 80.f); const float e = __expf(z); float om = __builtin_amdgcn_rcpf(1.0f + e); float beta = e * om;
                            om = valid ? om : 1.0f; beta = valid ? beta : 0.0f;
                            s[r] = beta; gp *= om; }
                        G[g] = gp; }
                    float Gp[4];
#pragma unroll
                    for (int g = 0; g < 4; ++g) Gp[g] = __shfl_xor(G[g], 32);
                    float SP[4]; SP[3] = 1.0f;
#pragma unroll
                    for (int g = 2; g >= 0; --g) SP[g] = SP[g + 1] * (G[g + 1] * Gp[g + 1]);
                    const float tot = SP[0] * (G[0] * Gp[0]);
#pragma unroll
                    for (int g = 0; g < 4; ++g) { float suf = carry * SP[g] * (hi ? 1.0f : Gp[g]);
#pragma unroll
                        for (int i = 3; i >= 0; --i) { const int r = 4 * g + i; const float beta = s[r]; s[r] = beta * suf; suf *= (1.0f - beta); } }
                    carry *= tot;
                    at_pv(lds, buf, a, r32, hi, s, o);
                }
            }
            done = __all(carry < 1e-30f);
        }
        if (lane == 0 && (done || k0 == 0)) __hip_atomic_fetch_add(&vote[it % 3], 1u, __ATOMIC_RELAXED, __HIP_MEMORY_SCOPE_WORKGROUP);
        if (tid == 0) vote[(it + 1) % 3] = 0u;
        if (tn >= 0) at_store(lds, buf ^ 1, tid, kr, vr);
        __syncthreads();
        const unsigned nd = vote[it % 3];
        buf ^= 1; t = tn; ++it;
        if (nd == 8u) break;
    }
    at_finish(o, 1.0f, hi, gh16 + h * 64, act + (size_t)(b * SEQ + tq) * DM + h * 64);
    __syncthreads();
}

template <int DUMMY> __device__ __forceinline__ void attn_sb_wave(const bf16* P, const float* gh16, acto_t* act, int b, int h, int qb, LAS unsigned char* lds) {
    const int tid = otid(), lane = tid & 63, wid = tid >> 6, r32 = lane & 31, hi = lane >> 5;
    const bf16* Pb = P + (size_t)b * SEQ * PW;
    const int kcol = 256 + h * 64;
    const int q0 = qb * 256, tq = q0 + 32 * wid + r32;
    bf16x8 qf[4];
#pragma unroll
    for (int sp = 0; sp < 4; ++sp) qf[sp] = *(const bf16x8*)(Pb + (size_t)tq * PW + h * 64 + 16 * sp + 8 * hi);
    LAS unsigned char* vt = lds + wid * 4608;
    f32x16 o[2];
#pragma unroll
    for (int r = 0; r < 16; ++r) { o[0][r] = 0.f; o[1][r] = 0.f; }
    float carry = 1.0f;
    const int lrow = lane >> 3, lch = lane & 7;
    LAS unsigned char* st_base = vt + 512 * (lch >> 2) + 64 * lrow;
    const unsigned q4 = (unsigned)(r32 & 15) >> 2, p4 = (unsigned)r32 & 3u, g16 = ((unsigned)r32 >> 4) & 1u;
    const unsigned vb = (unsigned)(size_t)vt + 64u * (4u * (unsigned)hi + q4) + 8u * (p4 & 1u);
    const unsigned tra0 = vb + 16u * ((2u * g16 + (p4 >> 1)) ^ ((unsigned)hi & 3u)), tra1 = vb + 16u * ((2u * g16 + (p4 >> 1)) ^ (((unsigned)hi + 2u) & 3u));
    u32x4 ksA[4], vvA[4], ksB[4], vvB[4];
    auto gld = [&](int ks_, u32x4 (&ks)[4], u32x4 (&vv)[4]) __attribute__((always_inline)) {
#pragma unroll
        for (int i = 0; i < 4; ++i) { const bf16* cp_ = Pb + (size_t)(ks_ + 8 * i + lrow) * PW + kcol + 8 * lch; ks[i] = *(const u32x4*)cp_; vv[i] = *(const u32x4*)(cp_ + 256); } };
    bool done = false;
    auto step = [&](int ks_, u32x4 (&ks)[4], u32x4 (&vv)[4]) __attribute__((always_inline)) {
#pragma unroll
        for (int i = 0; i < 4; ++i) *(LAS u32x4*)(st_base + 1024 * i + 16 * ((lch & 3) ^ ((2 * i + (lrow >> 2)) & 3))) = ks[i];
        bf16x8 kf[4];
#pragma unroll
        for (int sp = 0; sp < 4; ++sp) { const int ch_ = 2 * sp + hi; kf[sp] = *(const LAS bf16x8*)(vt + 1024 * (r32 >> 3) + 512 * (ch_ >> 2) + 64 * (r32 & 7) + 16 * ((ch_ & 3) ^ ((r32 >> 2) & 3))); }
        asm volatile("s_waitcnt lgkmcnt(0)" ::: "memory");
#pragma unroll
        for (int i = 0; i < 4; ++i) *(LAS u32x4*)(st_base + 1024 * i + 16 * ((lch & 3) ^ ((2 * i + (lrow >> 2)) & 3))) = vv[i];
        if (ks_ >= 64) gld(ks_ - 64, ks, vv);
        f32x16 s = {0.f, 0.f, 0.f, 0.f, 0.f, 0.f, 0.f, 0.f, 0.f, 0.f, 0.f, 0.f, 0.f, 0.f, 0.f, 0.f};
#pragma unroll
        for (int sp = 0; sp < 4; ++sp) s = MFMA32(kf[sp], qf[sp], s);
        float G[4];
#pragma unroll
        for (int g = 0; g < 4; ++g) { float gp = 1.0f;
#pragma unroll
            for (int i = 0; i < 4; ++i) { const int r = 4 * g + i; const int kp = ks_ + 8 * g + 4 * hi + i; const bool valid = kp < tq;
                const float z = __builtin_amdgcn_fmed3f(s[r], -115.41560327111707f, 115.41560327111707f); const float e = __builtin_amdgcn_exp2f(z); float om = __builtin_amdgcn_rcpf(1.0f + e); float beta = e * om;
                om = valid ? om : 1.0f; beta = valid ? beta : 0.0f;
                s[r] = beta; gp *= om; }
            G[g] = gp; }
        float Gp[4];
#pragma unroll
        for (int g = 0; g < 4; ++g) Gp[g] = __shfl_xor(G[g], 32);
        float SP[4]; SP[3] = 1.0f;
#pragma unroll
        for (int g = 2; g >= 0; --g) SP[g] = SP[g + 1] * (G[g + 1] * Gp[g + 1]);
        const float tot = SP[0] * (G[0] * Gp[0]);
#pragma unroll
        for (int g = 0; g < 4; ++g) { float suf = carry * SP[g] * (hi ? 1.0f : Gp[g]);
#pragma unroll
            for (int i = 3; i >= 0; --i) { const int r = 4 * g + i; const float beta = s[r]; s[r] = beta * suf; suf *= (1.0f - beta); } }
        carry *= tot;
        s16x4 vtr[2][2][2];
        asm volatile("ds_read_b64_tr_b16 %0, %8\n\tds_read_b64_tr_b16 %1, %9 offset:1024\n\tds_read_b64_tr_b16 %2, %8 offset:512\n\tds_read_b64_tr_b16 %3, %9 offset:1536\n\t"
                     "ds_read_b64_tr_b16 %4, %8 offset:2048\n\tds_read_b64_tr_b16 %5, %9 offset:3072\n\tds_read_b64_tr_b16 %6, %8 offset:2560\n\tds_read_b64_tr_b16 %7, %9 offset:3584\n\ts_waitcnt lgkmcnt(0)"
                     : "=&v"(vtr[0][0][0]), "=&v"(vtr[0][0][1]), "=&v"(vtr[0][1][0]), "=&v"(vtr[0][1][1]), "=&v"(vtr[1][0][0]), "=&v"(vtr[1][0][1]), "=&v"(vtr[1][1][0]), "=&v"(vtr[1][1][1])
                     : "v"(tra0), "v"(tra1) : "memory");
#pragma unroll
        for (int sk = 0; sk < 2; ++sk) {
            u32x4 w; w.x = cvt_pk_bf16(s[8 * sk + 0], s[8 * sk + 1]); w.y = cvt_pk_bf16(s[8 * sk + 2], s[8 * sk + 3]); w.z = cvt_pk_bf16(s[8 * sk + 4], s[8 * sk + 5]); w.w = cvt_pk_bf16(s[8 * sk + 6], s[8 * sk + 7]);
            const bf16x8 pf = __builtin_bit_cast(bf16x8, w);
#pragma unroll
            for (int dh = 0; dh < 2; ++dh) { const bf16x8 vf = {vtr[sk][dh][0][0], vtr[sk][dh][0][1], vtr[sk][dh][0][2], vtr[sk][dh][0][3], vtr[sk][dh][1][0], vtr[sk][dh][1][1], vtr[sk][dh][1][2], vtr[sk][dh][1][3]};
                o[dh] = MFMA32(vf, pf, o[dh]); } }
        done = __all(carry < 1e-30f);
    };
    int ks0 = q0 + 32 * wid;
    gld(ks0, ksA, vvA); if (ks0 >= 32) gld(ks0 - 32, ksB, vvB);
    for (; ks0 >= 0; ks0 -= 64) { step(ks0, ksA, vvA); if (done || ks0 < 32) break; step(ks0 - 32, ksB, vvB); if (done) break; }
    at_finish(o, 1.0f, hi, gh16 + h * 64, act + (size_t)(b * SEQ + tq) * DM + h * 64);
}

constexpr int DL_VROW = 72, DL_VT = 0, DL_VTW = 64 * DL_VROW, DL_CB = 8 * DL_VTW, DL_CBROW = 65, DL_ML = DL_CB + 256 * DL_CBROW * 4;
template <int BR> __device__ __forceinline__ int dl_kpos(int rho, int j, int q0, int wid) {
    if (BR == 0) return q0 + 32 * wid - 128 + 32 * j + rho;
    if (BR == 1) return q0 + (wid & 3) + 4 * (32 * (wid >> 2) - 128 + 32 * j + rho);
    return q0 + 2 * wid + (rho >> 4) + 16 * (-128 + 16 * j + (rho & 15));
}
template <int BR> __device__ __forceinline__ void dilated_branch(const bf16* Pb, int h, int q0, float slope, LAS unsigned char* lds, int wid, int r32, int hi, const float* ghh, acto_t* actb) {
    constexpr int R = BR == 0 ? 1 : (BR == 1 ? 4 : 16), W = 128 * R, NSUB = BR == 2 ? 9 : 5;
    const int qpos = BR == 0 ? q0 + 32 * wid + r32 : (BR == 1 ? q0 + (wid & 3) + 4 * (32 * (wid >> 2) + r32) : q0 + 2 * wid + (r32 >> 4) + 16 * (r32 & 15));
    bf16x8 qf[4];
#pragma unroll
    for (int sp = 0; sp < 4; ++sp) qf[sp] = *(const bf16x8*)(Pb + (size_t)qpos * PW + h * 64 + 16 * sp + 8 * hi);
    LAS unsigned char* vt = lds + DL_VT + wid * DL_VTW;
    f32x16 o[2];
#pragma unroll
    for (int r = 0; r < 16; ++r) { o[0][r] = 0.f; o[1][r] = 0.f; }
    float m = -INFINITY, l = 0.f;
    const int lane_ = r32 + 32 * hi, lrow = lane_ >> 3, lch = lane_ & 7;
    LAS unsigned char* st_base = vt + 512 * (lch >> 2) + 64 * lrow;
    const unsigned q4 = (unsigned)(r32 & 15) >> 2, p4 = (unsigned)r32 & 3u, g16 = ((unsigned)r32 >> 4) & 1u;
    const unsigned vb = (unsigned)(size_t)vt + 64u * (4u * (unsigned)hi + q4) + 8u * (p4 & 1u);
    const unsigned tra0 = vb + 16u * ((2u * g16 + (p4 >> 1)) ^ ((unsigned)hi & 3u)), tra1 = vb + 16u * ((2u * g16 + (p4 >> 1)) ^ (((unsigned)hi + 2u) & 3u));
    u32x4 ksA[4], vvA[4], ksB[4], vvB[4];
    const float sR = slope * (float)R; f32x16 sinit;
#pragma unroll
    for (int r = 0; r < 16; ++r) sinit[r] = sR * (float)((BR == 2 ? 8 * ((r >> 2) & 1) : 8 * (r >> 2)) + (r & 3));
    const unsigned ubp1 = (unsigned)min(128, qpos / R) + 1u;
    const unsigned ubp1_lo = (BR == 2 && r32 >= 16) ? 0u : ubp1, ubp1_hi = (BR == 2 && r32 < 16) ? 0u : ubp1;
    auto gld = [&](int jj, u32x4 (&ks)[4], u32x4 (&vv)[4]) __attribute__((always_inline)) {
#pragma unroll
        for (int i = 0; i < 4; ++i) { const int kp_ = dl_kpos<BR>(8 * i + lrow, jj, q0, wid); const bf16* cp_ = Pb + (size_t)(kp_ < 0 ? 0 : kp_) * PW + 256 + h * 64 + 8 * lch;
            ks[i] = *(const u32x4*)cp_; vv[i] = *(const u32x4*)(cp_ + 256); } };
    auto step = [&](int j, u32x4 (&ks)[4], u32x4 (&vv)[4]) __attribute__((always_inline)) {
#pragma unroll
        for (int i = 0; i < 4; ++i) *(LAS u32x4*)(st_base + 1024 * i + 16 * ((lch & 3) ^ ((2 * i + (lrow >> 2)) & 3))) = ks[i];
        bf16x8 kf[4];
#pragma unroll
        for (int sp = 0; sp < 4; ++sp) { const int ch_ = 2 * sp + hi; kf[sp] = *(const LAS bf16x8*)(vt + 1024 * (r32 >> 3) + 512 * (ch_ >> 2) + 64 * (r32 & 7) + 16 * ((ch_ & 3) ^ ((r32 >> 2) & 3))); }
        asm volatile("s_waitcnt lgkmcnt(0)" ::: "memory");
#pragma unroll
        for (int i = 0; i < 4; ++i) *(LAS u32x4*)(st_base + 1024 * i + 16 * ((lch & 3) ^ ((2 * i + (lrow >> 2)) & 3))) = vv[i];
        if (j + 2 < NSUB) gld(j + 2, ks, vv);
        f32x16 s = sinit;
#pragma unroll
        for (int sp = 0; sp < 4; ++sp) s = MFMA32(kf[sp], qf[sp], s);
        const int T0 = (BR == 2 ? (r32 & 15) + 128 - 16 * j : r32 + 128 - 32 * j) - 4 * hi; const float b0 = -sR * (float)T0;
        const int hiB = T0 < 31 ? T0 : 31, loB = (T0 - (int)ubp1 + 1) > 0 ? (T0 - (int)ubp1 + 1) : 0;
        const unsigned bandm = (T0 >= 0 && hiB >= loB) ? (((2u << hiB) - 1u) & ~((1u << loB) - 1u)) : 0u;
        const unsigned bm_lo = ubp1_lo ? bandm : 0u, bm_hi = ubp1_hi ? bandm : 0u;
        float mx = -INFINITY;
#pragma unroll
        for (int r = 0; r < 16; ++r) { const int c_r = (BR == 2 ? 8 * ((r >> 2) & 1) : 8 * (r >> 2)) + (r & 3);
            const int vb_ = __builtin_amdgcn_sbfe((int)((BR == 2 && r >= 8) ? bm_hi : bm_lo), c_r, 1); const float x_ = s[r] + b0; unsigned y_;
            asm("v_bfi_b32 %0, %1, %2, %3" : "=v"(y_) : "v"(vb_), "v"(x_), "v"(0xff800000u));
            s[r] = __uint_as_float(y_); mx = fmaxf(mx, s[r]); }
        mx = fmaxf(mx, __shfl_xor(mx, 32));
        if (__any(mx - m > 8.0f)) {
            const float mn = fmaxf(m, mx), alpha = (mn == -INFINITY) ? 1.0f : exp2f(m - mn);
            l *= alpha; m = mn;
#pragma unroll
            for (int r = 0; r < 16; ++r) { o[0][r] *= alpha; o[1][r] *= alpha; } }
        const float mu = (m == -INFINITY) ? INFINITY : m;
        float ps = 0.f;
#pragma unroll
        for (int r = 0; r < 16; ++r) { s[r] = __builtin_amdgcn_exp2f(s[r] - mu); ps += s[r]; }
        l += ps;
        s16x4 vtr[2][2][2];
        asm volatile("ds_read_b64_tr_b16 %0, %8\n\tds_read_b64_tr_b16 %1, %9 offset:1024\n\tds_read_b64_tr_b16 %2, %8 offset:512\n\tds_read_b64_tr_b16 %3, %9 offset:1536\n\t"
                     "ds_read_b64_tr_b16 %4, %8 offset:2048\n\tds_read_b64_tr_b16 %5, %9 offset:3072\n\tds_read_b64_tr_b16 %6, %8 offset:2560\n\tds_read_b64_tr_b16 %7, %9 offset:3584\n\ts_waitcnt lgkmcnt(0)"
                     : "=&v"(vtr[0][0][0]), "=&v"(vtr[0][0][1]), "=&v"(vtr[0][1][0]), "=&v"(vtr[0][1][1]), "=&v"(vtr[1][0][0]), "=&v"(vtr[1][0][1]), "=&v"(vtr[1][1][0]), "=&v"(vtr[1][1][1])
                     : "v"(tra0), "v"(tra1) : "memory");
#pragma unroll
        for (int sk = 0; sk < 2; ++sk) {
            u32x4 w; w.x = cvt_pk_bf16(s[8 * sk + 0], s[8 * sk + 1]); w.y = cvt_pk_bf16(s[8 * sk + 2], s[8 * sk + 3]); w.z = cvt_pk_bf16(s[8 * sk + 4], s[8 * sk + 5]); w.w = cvt_pk_bf16(s[8 * sk + 6], s[8 * sk + 7]);
            const bf16x8 pf = __builtin_bit_cast(bf16x8, w);
#pragma unroll
            for (int dh = 0; dh < 2; ++dh) { const bf16x8 vf = {vtr[sk][dh][0][0], vtr[sk][dh][0][1], vtr[sk][dh][0][2], vtr[sk][dh][0][3], vtr[sk][dh][1][0], vtr[sk][dh][1][1], vtr[sk][dh][1][2], vtr[sk][dh][1][3]};
                o[dh] = MFMA32(vf, pf, o[dh]); } }
    };
    gld(0, ksA, vvA); if (NSUB > 1) gld(1, ksB, vvB);
    for (int j = 0; j < NSUB; j += 2) { step(j, ksA, vvA); if (j + 1 < NSUB) step(j + 1, ksB, vvB); }
    l += __shfl_xor(l, 32);
    const int qi = qpos - q0;
    LAS float* cb = (LAS float*)(lds + DL_CB) + qi * DL_CBROW; LAS float* ml = (LAS float*)(lds + DL_ML);
    if (BR > 0) {
        const float M0 = ml[qi], L0 = ml[256 + qi];
        const float mn = fmaxf(M0, m), a0 = __builtin_amdgcn_exp2f(M0 - mn), a1 = __builtin_amdgcn_exp2f(m - mn);
#pragma unroll
        for (int dh = 0; dh < 2; ++dh)
#pragma unroll
            for (int r = 0; r < 16; ++r) o[dh][r] = o[dh][r] * a1 + cb[32 * dh + crow(r, hi)] * a0;
        l = l * a1 + L0 * a0; m = mn;
    }
    if (BR < 2) {
        __syncthreads();
#pragma unroll
        for (int dh = 0; dh < 2; ++dh)
#pragma unroll
            for (int r = 0; r < 16; ++r) cb[32 * dh + crow(r, hi)] = o[dh][r];
        if (hi == 0) { ml[qi] = m; ml[256 + qi] = l; }
        __syncthreads();
    } else {
        at_finish(o, 1.0f / l, hi, ghh, actb + (size_t)qpos * DM);
    }
}
__device__ __forceinline__ void attn_dilated_unit(const bf16* P, const float* gh16, acto_t* act, int b, int h, int qb, LAS unsigned char* lds) {
    const int tid = otid(), lane = tid & 63, wid = tid >> 6, r32 = lane & 31, hi = lane >> 5;
    const bf16* Pb = P + (size_t)b * SEQ * PW + 1536;
    const float slope = alibi_slope(1, h) * LOG2E;
    const float* ghh = gh16 + (8 + h) * 64; acto_t* actb = act + (size_t)b * SEQ * DM + (8 + h) * 64;
    dilated_branch<0>(Pb, h, qb * 256, slope, lds, wid, r32, hi, ghh, actb);
    dilated_branch<1>(Pb, h, qb * 256, slope, lds, wid, r32, hi, ghh, actb);
    dilated_branch<2>(Pb, h, qb * 256, slope, lds, wid, r32, hi, ghh, actb);
    __syncthreads();
}

#ifndef MK_SPLIT
#define MK_SPLIT 0
#endif
constexpr int MISC_OFF = 131072, ROWTAB_OFF = MISC_OFF + 1024, LDS_BYTES = 131072 + 2048 + 64;
constexpr int N_PHASES = 19;
struct MegaArgs { const float* in[17]; float* out; unsigned char* ws; int ph_lo, ph_hi, li, pad; };

__global__ void __launch_bounds__(512, 2) mega_fwd(MegaArgs a) {
    extern __shared__ __attribute__((aligned(16))) unsigned char lds_raw[];
    LAS unsigned char* lds = (LAS unsigned char*)lds_raw;
    volatile LAS unsigned* MISC = (volatile LAS unsigned*)(lds + MISC_OFF);
    const int tid = threadIdx.x, bid = blockIdx.x, nblk = gridDim.x;
    for (int u = tid; u < (LDS_BYTES - MISC_OFF) / 4; u += 512) MISC[u] = 0u;
    __syncthreads();
    if (tid < 17) { const unsigned long long p = (unsigned long long)a.in[tid]; MISC[64 + 2 * tid] = (unsigned)p; MISC[65 + 2 * tid] = (unsigned)(p >> 32); }
    __syncthreads();
#define INP(i) ((const float*)(((unsigned long long)(unsigned)__builtin_amdgcn_readfirstlane((int)MISC[65 + 2 * (i)]) << 32) | (unsigned long long)(unsigned)__builtin_amdgcn_readfirstlane((int)MISC[64 + 2 * (i)])))
    unsigned char* ws = a.ws;
    unsigned* ctl = (unsigned*)(ws + WS_CTL);
    XcdBarrier bar; bar.bar = ctl + CW_BAR + a.li * XCD_BAR_WORDS; bar.x = 0; bar.st = nullptr;
    if (!MK_SPLIT) bar = xcd_barrier_post(ctl + CW_BAR + a.li * XCD_BAR_WORDS, MISC + 8);
    const int lo = a.ph_lo, hi = a.ph_hi;
#define RUN(k) (lo <= (k) && (k) < hi)
#define SEAM(k) do { if (RUN(k) && RUN((k) + 1)) { if (!MK_SPLIT) xcd_barrier(bar); } } while (0)
    float* out = a.out;
    float* mod = (float*)(ws + WS_MOD); float* kmean = (float*)(ws + WS_KMEAN); const float* gv = (const float*)(ws + WS_GV);
    int* tok = (int*)(ws + WS_TOK); bf16* act = (bf16*)(ws + WS_ACT); bf16* P = (bf16*)(ws + WS_P); bf16* hid = (bf16*)(ws + WS_HID); unsigned char* xs = ws + WS_XS; bf16* ys = (bf16*)(ws + WS_YS);
    unsigned long long* mask = (unsigned long long*)(ws + WS_MASK); unsigned* ecnt = ctl + CW_ECNT;

    if (RUN(0)) {
        PrepArgs pa{INP(5), INP(7), INP(9), INP(10), INP(11), INP(13), INP(14), INP(15), ws};
        ph_prep(pa, lds, bid, nblk);
        __syncthreads();
        ph_mod(INP(1), INP(2), INP(3), mod, lds, bid, nblk);
        { float* gvw = (float*)(ws + WS_GV); const float* s4 = INP(4); const float* s6 = INP(6); const float* s8 = INP(8); const float* s16 = INP(16);
          for (int i = bid * 512 + otid(); i < 7168; i += nblk * 512) gvw[i] = i < 2048 ? s4[i] : (i < 4096 ? s6[i - 2048] : (i < 6144 ? s8[i - 4096] : s16[i - 6144])); }
    }
    SEAM(0);
#if defined(PROBE_SUB) && PROBE_SUB == 9
    for (int rep_ = 0; rep_ < 20; ++rep_) xcd_barrier(bar);
#endif
    for (int l = 0; l < NLAYER; ++l) {
        const int pb = 1 + 8 * l;
        const float* ml = mod + (size_t)l * 8 * 6144; bf16* xb = (bf16*)(ws + WS_XB); const float* gh = gv + 2048 + l * 1024;
#ifdef WIN_FP8
        if (RUN(pb)) { NormArgs na{}; if (l == 0) na.xin = INP(0); else na.xin16 = xb; na.g = gv + l * DM; na.shift = ml; na.scale = ml + 1024; na.act = act; na.act8 = ws + WS_ACT8W; ph_norm<0>(na, lds, bid, nblk); }
#else
        if (RUN(pb)) { NormArgs na{}; if (l == 0) na.xin = INP(0); else na.xin16 = xb; na.g = gv + l * DM; na.shift = ml; na.scale = ml + 1024; na.act = act; ph_norm<0>(na, lds, bid, nblk); }
#endif
        SEAM(pb);
#ifdef WIN_FP8
        if (RUN(pb + 1)) { pg8::EpiBf16 E{P, PW, 0};
            { pg8::Gemm g{act, (const bf16*)(ws + WS_WIN) + (size_t)l * PW * DM, T, PW, DM}; pg8::SubOrder S; S.init(T, WIN_NB16, WIN_LIST16, nblk, bid, 1 << 30, 0);
              pg8::gemm_phase<pg8::EpiBf16, pg8::SubOrder, true, true>(lds, g, S, E); }
            __syncthreads();
            { pg8::Gemm g{(const bf16*)(ws + WS_ACT8W), (const bf16*)(ws + WS_WIN8 + (size_t)l * PW * DM), T, PW, DM}; pg8::SubOrder S; S.init(T, 15 - WIN_NB16, WIN_LIST8, nblk, bid, WIN_FULL8, nblk / 2);
              pg8::gemm_phase<pg8::EpiBf16, pg8::SubOrder, true, true, true, 0x7A7A7A7A>(lds, g, S, E); } }
#else
        if (RUN(pb + 1)) { pg8::Gemm g{act, (const bf16*)(ws + WS_WIN) + (size_t)l * PW * DM, T, PW, DM}; pg8::StaticOrder S; S.init(T, PW, nblk, bid);
            pg8::EpiBf16 E{P, PW, 0}; pg8::gemm_phase<pg8::EpiBf16, pg8::StaticOrder, true, true>(lds, g, S, E); }
#endif
        SEAM(pb + 1);
        if (RUN(pb + 2)) {
            for (int u = bid, r = 0; u < NB * 512; u += nblk, ++r) { const int unit = (r & 1) ? (r * nblk + nblk - 1 - bid) : u; if (unit < NB * 512) dsa_select_unit(P, mask, unit, (LAS unsigned*)lds); }
            for (int unit = bid; unit < NB * 16; unit += nblk) kmean_unit(P, kmean, ctl + CW_KNMAX + l * 64, unit, lds);
#if defined(PROBE_SUB) && PROBE_SUB == 1
            if (l == 1) for (int u = bid, r = 0; u < NB * 512; u += nblk, ++r) { const int unit = (r & 1) ? (r * nblk + nblk - 1 - bid) : u; if (unit < NB * 512) dsa_select_unit(P, mask, unit, (LAS unsigned*)lds); }
#endif
#if defined(PROBE_SUB) && PROBE_SUB == 2
            if (l == 1) for (int u = bid; u < 512; u += nblk) attn_sb_unit<0>(P, gh, (acto_t*)act, u & 7, (u >> 3) & 3, u >> 5, lds);
#endif
#if defined(PROBE_SUB) && PROBE_SUB == 3
            if (l == 1) for (int u = bid; u < 512; u += nblk) attn_dilated_unit(P, gh, (acto_t*)act, u & 7, (u >> 3) & 3, u >> 5, lds);
#endif
#ifndef NO_SB
#ifdef SB_WAVE
            __syncthreads();
#ifdef HEAD_PASS
            for (int u = bid; u < 512; u += nblk) attn_sb_wave<0>(P, gh, (acto_t*)act, u & 7, 2 * ((u >> 8) & 1) + ((u >> 3) & 1), (u >> 4) & 15, lds);
#else
            for (int u = bid; u < 512; u += nblk) attn_sb_wave<0>(P, gh, (acto_t*)act, u & 7, (u >> 3) & 3, u >> 5, lds);
#endif
            __syncthreads();
#else
            for (int u = bid; u < 512; u += nblk) attn_sb_unit<0>(P, gh, (acto_t*)act, u & 7, (u >> 3) & 3, u >> 5, lds);
#endif
#endif
#ifndef NO_DIL
#ifdef HEAD_PASS
            for (int u = bid; u < 512; u += nblk) attn_dilated_unit(P, gh, (acto_t*)act, u & 7, 2 * ((u >> 8) & 1) + ((u >> 3) & 1), (u >> 4) & 15, lds);
#else
            for (int u = bid; u < 512; u += nblk) attn_dilated_unit(P, gh, (acto_t*)act, u & 7, (u >> 3) & 3, u >> 5, lds);
#endif
#endif
#ifdef PREP_LAZY
            { PrepArgs pa{INP(5), INP(7), INP(9), INP(10), INP(11), INP(13), INP(14), INP(15), ws}; prep_lazy(pa, ctl, CW_PDONE + 2 * l, nblk, lds); }
#endif
        }
        SEAM(pb + 2);
        if (RUN(pb + 3)) {
            LAS unsigned* qslot = (LAS unsigned*)(lds + AT_MISC + 64);
            for (;;) { if (otid() == 0) qslot[0] = atomicAdd(&ctl[CW_QUEUE + 2 * l], 1u);
                __syncthreads(); const unsigned u = qslot[0]; __syncthreads();
                if (u >= 512u) break;
                attn_masked_unit<0>(P, mask, kmean, ctl + CW_KNMAX + l * 64, gh, (acto_t*)act, (int)(u & 7u), 3 - (int)((u >> 3) & 3u), 15 - (int)(u >> 5), lds); }
#if defined(PROBE_SUB) && PROBE_SUB == 4
            if (l == 1) for (;;) { if (otid() == 0) qslot[0] = atomicAdd(&ctl[CW_QUEUE + 8], 1u);
                __syncthreads(); const unsigned u = qslot[0]; __syncthreads();
                if (u >= 512u) break;
                attn_masked_unit<0>(P, mask, kmean, ctl + CW_KNMAX + l * 64, gh, (acto_t*)act, (int)(u & 7u), 3 - (int)((u >> 3) & 3u), 15 - (int)(u >> 5), lds); }
#endif
#if defined(PROBE_SUB) && PROBE_SUB == 5
            if (l == 1) for (;;) { if (otid() == 0) qslot[0] = atomicAdd(&ctl[CW_QUEUE + 8], 1u);
                __syncthreads(); const unsigned u = qslot[0]; __syncthreads();
                if (u >= 512u) break;
                attn_masked_unit<1>(P, mask, kmean, ctl + CW_KNMAX + l * 64, gh, (acto_t*)act, (int)(u & 7u), 3 - (int)((u >> 3) & 3u), 15 - (int)(u >> 5), lds); }
#endif
            for (;;) { if (otid() == 0) qslot[0] = atomicAdd(&ctl[CW_QUEUE + 2 * l + 1], 1u);
                __syncthreads(); const unsigned u = qslot[0]; __syncthreads();
                if (u >= 512u) break;
                attn_masked_unit<1>(P, mask, kmean, ctl + CW_KNMAX + l * 64, gh, (acto_t*)act, (int)(u & 7u), 3 - (int)((u >> 3) & 3u), 15 - (int)(u >> 5), lds); }
#ifdef PREP_LAZY
            { PrepArgs pa{INP(5), INP(7), INP(9), INP(10), INP(11), INP(13), INP(14), INP(15), ws}; prep_lazy(pa, ctl, CW_PDONE + 2 * l + 1, nblk, lds); }
#endif
        }
        SEAM(pb + 3);
#ifdef WOUT_FP8
        if (RUN(pb + 4)) { pg8::Gemm g{act, (const bf16*)(ws + WS_WOUT + (size_t)l * DM * DM), T, DM, DM}; pg8::StaticOrder S; S.init(T, DM, nblk, bid);
            pg8::EpiRes E{l == 0 ? INP(0) : nullptr, xb, xb, ml + 2048}; pg8::gemm_phase<pg8::EpiRes, pg8::StaticOrder, true, true, true, 0x79797979>(lds, g, S, E); }
#else
        if (RUN(pb + 4)) { pg8::Gemm g{act, (const bf16*)(ws + WS_WOUT) + (size_t)l * DM * DM, T, DM, DM}; pg8::StaticOrder S; S.init(T, DM, nblk, bid);
            pg8::EpiRes E{l == 0 ? INP(0) : nullptr, xb, xb, ml + 2048}; pg8::gemm_phase<pg8::EpiRes, pg8::StaticOrder, true, true>(lds, g, S, E); }
#endif
        SEAM(pb + 4);
        if (l == 0) {
            if (RUN(6)) { NormArgs na{}; na.xin16 = xb; na.g = gv + 4096; na.shift = ml + 3072; na.scale = ml + 4096; na.act8 = (unsigned char*)act; ph_norm<0>(na, lds, bid, nblk); }
            SEAM(6);
#ifndef NO_FF
            if (RUN(7)) { pg8::Gemm g{act, (const bf16*)(ws + WS_WFU), T, 2 * DFF, DM}; pg8::StaticOrder S; S.init(T, 2 * DFF, nblk, bid);
                pg8::EpiSwiGLU8 E{(unsigned char*)hid, DFF, 0}; pg8::gemm_phase<pg8::EpiSwiGLU8, pg8::StaticOrder, true, true, true, 0x7A7A7A7A>(lds, g, S, E); }
            SEAM(7);
            if (RUN(8)) { pg8::Gemm g{hid, (const bf16*)(ws + WS_WFD), T, DM, DFF}; pg8::StaticOrder S; S.init(T, DM, nblk, bid);
                pg8::EpiRes E{nullptr, xb, xb, ml + 5120}; pg8::gemm_phase<pg8::EpiRes, pg8::StaticOrder, true, true, true, 0x79797979>(lds, g, S, E); }
            SEAM(8);
#endif
        } else {
            if (RUN(14)) { NormArgs na{}; na.xin16 = xb; na.g = gv + 4096 + DM; na.shift = ml + 3072; na.scale = ml + 4096; na.act8 = (unsigned char*)act; na.w_router = INP(12); na.tok = tok; na.ecnt = ecnt; na.elist = (int*)(ws + WS_ELIST);
                ph_norm<1>(na, lds, bid, nblk);
#ifdef PREP_LAZY
                { PrepArgs pa{INP(5), INP(7), INP(9), INP(10), INP(11), INP(13), INP(14), INP(15), ws}; prep_lazy(pa, ctl, -1, nblk, lds); }
#endif
            }
            SEAM(14);
#ifndef MOE_GATHER_A
            if (RUN(15)) ph_gather((const unsigned char*)act, tok, ecnt, xs, bid, nblk);
            SEAM(15);
#endif
            if (RUN(16) || RUN(17)) {
                LAS unsigned char* etab = lds + MISC_OFF + 512;
                int ntot;
                { const MoeTiles mt = moe_tiles(ecnt); ntot = moe_tile_start(mt, 7) + mt.p7;
                  const int t_ = otid(); if (t_ < XS_TILES) { int e_ = 0;
#pragma unroll
                      for (int k = 1; k < 8; ++k) e_ += (t_ >= moe_tile_start(mt, k)) ? 1 : 0;
                      etab[t_] = (unsigned char)e_; }
                  __syncthreads(); }
                pg8::MoeOrder S; S.nrt = ntot; S.G = nblk; S.c = bid; S.etab = etab;
#ifdef MOE_GATHER_A
                if (RUN(16)) { S.nN = 28; S.mode = 2; S.estride = (size_t)7168 * DM;
                    LAS unsigned* rowtab = (LAS unsigned*)(lds + ROWTAB_OFF); LAS int* einfo = (LAS int*)(lds + ROWTAB_OFF + 1024); S.rowtab = rowtab;
                    { const MoeTiles mt = moe_tiles(ecnt); const int t_ = otid(); if (t_ < 8) { einfo[t_] = moe_tile_start(mt, t_); einfo[8 + t_] = (int)__hip_atomic_load(ecnt + t_, __ATOMIC_RELAXED, __HIP_MEMORY_SCOPE_AGENT); } }
                    const int full = ntot / nblk, rem = ntot - full * nblk; const int* elist = (const int*)(ws + WS_ELIST);
                    pg8::Gemm g{act, (const bf16*)(ws + WS_WEU), 0, 0, DM}; pg8::EpiSwiGLU8 E{(unsigned char*)hid, DFE, 0};
                    for (int seg = 0;; ++seg) {
                        if (seg < full) { S.pm0 = seg * nblk + bid; S.pn0 = 0; S.cnt = 28; }
                        else { const int L = (seg - full) * nblk + bid; if (rem <= 0 || L >= rem * 28) break; S.pm0 = full * nblk + L % rem; S.pn0 = L / rem; S.cnt = 1; }
                        __syncthreads();
                        { const int t_ = otid(); if (t_ < 256) { const int e_ = (int)etab[S.pm0]; const int pos_ = (S.pm0 - einfo[e_]) * 256 + t_; const int tk_ = pos_ < einfo[8 + e_] ? elist[e_ * T + pos_] : 0; rowtab[t_] = (unsigned)tk_ * (unsigned)DM; } }
                        __syncthreads();
                        pg8::gemm_phase<pg8::EpiSwiGLU8, pg8::MoeOrder, true, true, true, 0x7A7A7A7A, 0x7F7F7F7F, true>(lds, g, S, E);
                    } }
#else
                if (RUN(16)) { S.nN = 28; S.mode = 0; S.estride = (size_t)7168 * DM;
                    pg8::Gemm g{(const bf16*)xs, (const bf16*)(ws + WS_WEU), 0, 0, DM};
                    pg8::EpiSwiGLU8 E{(unsigned char*)hid, DFE, 0}; pg8::gemm_phase<pg8::EpiSwiGLU8, pg8::MoeOrder, true, true, true, 0x7A7A7A7A>(lds, g, S, E); }
#endif
                SEAM(16);
                if (RUN(17)) { S.nN = 4; S.mode = 1; S.estride = (size_t)DM * DFE;
                    pg8::Gemm g{hid, (const bf16*)(ws + WS_WED), 0, 0, DFE};
                    pg8::EpiBf16 E{ys, DM, 0}; pg8::gemm_phase<pg8::EpiBf16, pg8::MoeOrder, true, true, true, 0x79797979>(lds, g, S, E); }
                SEAM(17);
            }
            if (RUN(18)) { NormArgs na{}; na.xin16 = xb; na.g = gv + 6144; na.tok = tok; na.ecnt = ecnt; na.ys = ys; na.gate = ml + 5120; na.out = out; ph_norm<2>(na, lds, bid, nblk); }
        }
    }
#undef RUN
#undef SEAM
}

extern "C" void kernel_launch(void* const* d_in, const int* in_sizes, int n_in, void* d_out, int out_size, void* d_ws, size_t ws_size, hipStream_t stream) {
    static int grid = 0;
    if (grid == 0) {
        if (n_in != 17 || out_size != T * DM || ws_size < WS_END) { fprintf(stderr, "kernel_launch: unexpected problem (n_in %d out %d ws %zu)\n", n_in, out_size, ws_size); grid = -1; return; }
        int dev = 0, cus = 0, per_cu = 0;
        if (hipGetDevice(&dev) != hipSuccess || hipDeviceGetAttribute(&cus, hipDeviceAttributeMultiprocessorCount, dev) != hipSuccess) { grid = -1; return; }
        if (hipFuncSetAttribute((const void*)mega_fwd, hipFuncAttributeMaxDynamicSharedMemorySize, LDS_BYTES) != hipSuccess) { fprintf(stderr, "kernel_launch: hipFuncSetAttribute failed\n"); grid = -1; return; }
        if (hipOccupancyMaxActiveBlocksPerMultiprocessor(&per_cu, (const void*)mega_fwd, 512, LDS_BYTES) != hipSuccess || per_cu < 1) fprintf(stderr, "kernel_launch: occupancy query says %d\n", per_cu);
        (void)hipGetLastError();
        grid = cus;
    }
    if (grid < 0) return;
    if (hipMemsetAsync((unsigned char*)d_ws + WS_CTL, 0, CTL_BYTES, stream) != hipSuccess) return;
    MegaArgs a{};
    for (int i = 0; i < 17; ++i) a.in[i] = (const float*)d_in[i];
    a.out = (float*)d_out; a.ws = (unsigned char*)d_ws;
#if MK_SPLIT
    for (int p = 0; p < N_PHASES; ++p) { a.ph_lo = p; a.ph_hi = p + 1; hipLaunchKernelGGL(mega_fwd, dim3(grid), dim3(512), LDS_BYTES, stream, a); }
#elif defined(PROBE_PHASE)
    a.li = 0; a.ph_lo = 0; a.ph_hi = PROBE_PHASE + 1; hipLaunchKernelGGL(mega_fwd, dim3(grid), dim3(512), LDS_BYTES, stream, a);
    a.li = 1; a.ph_lo = PROBE_PHASE; a.ph_hi = PROBE_PHASE + 1; hipLaunchKernelGGL(mega_fwd, dim3(grid), dim3(512), LDS_BYTES, stream, a);
    a.li = 2; a.ph_lo = PROBE_PHASE + 1; a.ph_hi = N_PHASES; hipLaunchKernelGGL(mega_fwd, dim3(grid), dim3(512), LDS_BYTES, stream, a);
#else
    a.ph_lo = 0; a.ph_hi = N_PHASES;
    hipLaunchKernelGGL(mega_fwd, dim3(grid), dim3(512), LDS_BYTES, stream, a);
#endif
}
```

```cpp
#define WIN_FP8 1
#define WOUT_FP8 1
#define MOE_GATHER_A 1
#define PREP_LAZY 1
#define DL_TR 1
#define AT_TR 1
#define SWIGLU_PK 1
#define AT_BFI 1
#define WIN_VARIANT_C 1
#define SB_WAVE 1
#define HEAD_PASS 1
#define DSA_BITSLICE 1
#include <hip/hip_runtime.h>
#include <cstdio>
#include <cstdint>

#define LAS __attribute__((address_space(3)))
#define GAS __attribute__((address_space(1)))
typedef unsigned short bf16;
typedef short bf16x8 __attribute__((ext_vector_type(8)));
typedef float f32x4 __attribute__((ext_vector_type(4)));
typedef float f32x16 __attribute__((ext_vector_type(16)));
typedef unsigned u32x4 __attribute__((ext_vector_type(4)));
typedef unsigned u32x2 __attribute__((ext_vector_type(2)));

constexpr int NB = 8, SEQ = 4096, T = NB * SEQ, DM = 1024, NLAYER = 2;
constexpr int PW = 3840;
constexpr int NIN = 3656;
constexpr int COL_QI = 3072, COL_KI = 3584, COL_WI = 3648;
constexpr int DFF = 2816, DFE = 3584, NEXP = 8;
constexpr float EPS = 1e-6f;
constexpr int XS_TILES = 264;

constexpr size_t MiB = 1u << 20;
constexpr size_t WS_CTL = 0, CTL_BYTES = 1 * MiB;
constexpr size_t WS_MOD = 1 * MiB;
constexpr size_t WS_GV = 1 * MiB + 400 * 1024;
constexpr size_t WS_KMEAN = 1 * MiB + 512 * 1024;
constexpr size_t WS_MOBASEL = 1 * MiB + 768 * 1024;
constexpr size_t WS_TOK = 2 * MiB;
constexpr size_t WS_WIN = 4 * MiB;
constexpr size_t WS_WIN8 = 458 * MiB;
#if defined(WIN_VARIANT_C)
constexpr unsigned WIN_BF16_TILES = 0x7000u; constexpr int WIN_NB16 = 3, WIN_FULL8 = 5; constexpr unsigned long long WIN_LIST16 = 0xEDCull, WIN_LIST8 = 0xBA9876543210ull;
#elif defined(WIN_VARIANT_B)
constexpr unsigned WIN_BF16_TILES = 0x4600u; constexpr int WIN_NB16 = 3, WIN_FULL8 = 5; constexpr unsigned long long WIN_LIST16 = 0xEA9ull, WIN_LIST8 = 0xDCB876543210ull;
#else
constexpr unsigned WIN_BF16_TILES = 0x7600u;
constexpr int WIN_NB16 = 5, WIN_FULL8 = 4; constexpr unsigned long long WIN_LIST16 = 0xEDCA9ull, WIN_LIST8 = 0xB876543210ull;
#endif
constexpr size_t WS_ACT8W = 360 * MiB;
constexpr size_t WS_WOUT = 19 * MiB;
constexpr size_t WS_WFU = 23 * MiB;
constexpr size_t WS_WFD = 34 * MiB;
constexpr size_t WS_ELIST = 37 * MiB;
constexpr size_t WS_ACT = 40 * MiB;
constexpr size_t WS_P = 104 * MiB;
constexpr size_t WS_HID = 104 * MiB;
constexpr size_t WS_XS = 336 * MiB;
constexpr size_t WS_YS = 336 * MiB;
constexpr size_t WS_MASK = 344 * MiB;
constexpr size_t WS_WEU = 402 * MiB;
constexpr size_t WS_WED = 468 * MiB;
constexpr size_t WS_XB = 496 * MiB;
constexpr size_t WS_END = 560 * MiB;
constexpr int CW_ECNT = 64;
constexpr int CW_KNMAX = 128;
constexpr int CW_QUEUE = 256;
constexpr int CW_PREPQ = 352, CW_PDONE = 353;
constexpr int CW_BAR = 4096;

__device__ __forceinline__ float bf2f(unsigned v) { return __uint_as_float(v << 16); }
__device__ __forceinline__ unsigned f2bf(float f) { unsigned u = __float_as_uint(f); return (u + 0x7fffu + ((u >> 16) & 1u)) >> 16; }
__device__ __forceinline__ unsigned pk2(float lo, float hi) { return f2bf(lo) | (f2bf(hi) << 16); }
__device__ __forceinline__ unsigned cvt_pk_bf16(float lo, float hi) { unsigned r; asm volatile("v_cvt_pk_bf16_f32 %0, %1, %2" : "=v"(r) : "v"(lo), "v"(hi)); return r; }
__device__ __forceinline__ float wave_sum(float v) {
#pragma unroll
    for (int o = 1; o < 64; o <<= 1) v += __shfl_xor(v, o);
    return v;
}
__device__ __forceinline__ void ld8(const bf16* p, float* f) {
    const u32x4 u = *(const u32x4*)p;
    f[0] = __uint_as_float(u.x << 16); f[1] = __uint_as_float(u.x & 0xffff0000u);
    f[2] = __uint_as_float(u.y << 16); f[3] = __uint_as_float(u.y & 0xffff0000u);
    f[4] = __uint_as_float(u.z << 16); f[5] = __uint_as_float(u.z & 0xffff0000u);
    f[6] = __uint_as_float(u.w << 16); f[7] = __uint_as_float(u.w & 0xffff0000u);
}
__device__ __forceinline__ float alibi_slope(int mixer_pos, int h) { return exp2f(-8.0f * (float)(3 * h + mixer_pos + 1) / 12.0f); }
__device__ __forceinline__ float silu_f(float x) { return x * __builtin_amdgcn_rcpf(1.0f + __expf(-x)); }
__device__ __forceinline__ int otid() { int t = threadIdx.x; asm volatile("" : "+v"(t)); return t; }
#define XB_TMO      128
#define XB_XCNT(j)  (256  + 64 * (j))
#define XB_XSUB(j)  (1280 + 64 * (j))
#define XB_XGEN(j)  (2304 + 64 * (j))
#define XB_TOP      3328
#define XB_TOPGEN   3392
#define XCD_BAR_WORDS 3456
#define XB_SPIN_CAP (1u << 18)

__device__ __forceinline__ unsigned xb_ld(unsigned* p)              { return __hip_atomic_load(p, __ATOMIC_RELAXED, __HIP_MEMORY_SCOPE_AGENT); }
__device__ __forceinline__ unsigned xb_add(unsigned* p, unsigned v) { return __hip_atomic_fetch_add(p, v, __ATOMIC_RELAXED, __HIP_MEMORY_SCOPE_AGENT); }
__device__ __forceinline__ unsigned xb_xcc_id() { return (unsigned)__builtin_amdgcn_s_getreg((3 << 11) | 20) & 0xFu; }
#define XB_SPIN(cond, bar) do { unsigned _sp = 0; while (cond) { __builtin_amdgcn_s_sleep(1); \
    if ((++_sp & 255u) == 0u) { if (xb_ld(&(bar)[XB_TMO])) break; if (_sp > XB_SPIN_CAP) { atomicAdd(&(bar)[XB_TMO], 1u); break; } } } } while (0)

struct XcdBarrier {
    unsigned* bar; unsigned x;
    volatile LAS unsigned* st;
};

__device__ __forceinline__ XcdBarrier xcd_barrier_post(unsigned* bar, volatile LAS unsigned* st) {
    XcdBarrier b; b.bar = bar; b.x = xb_xcc_id(); b.st = st;
    if (threadIdx.x == 0) (void)xb_add(&bar[XB_XCNT(b.x)], 1u);
    return b;
}
__device__ __forceinline__ void xcd_barrier_complete(unsigned* bar, unsigned x, unsigned& nloc, unsigned& nx) {
    const unsigned G = gridDim.x * gridDim.y * gridDim.z;
    unsigned sum, cnt, mine, sp = 0u;
    for (;;) {
        asm volatile("" : "+s"(bar), "+s"(x));
        sum = 0u; cnt = 0u; mine = 0u;
#pragma unroll
        for (unsigned j = 0; j < 16; ++j) { const unsigned c = xb_ld(&bar[XB_XCNT(j)]); sum += c; cnt += (c > 0u) ? 1u : 0u; mine = (j == x) ? c : mine; }
        if (sum == G) break;
        __builtin_amdgcn_s_sleep(1);
        if ((++sp & 255u) == 0u) { if (xb_ld(&bar[XB_TMO])) break; if (sp > XB_SPIN_CAP) { atomicAdd(&bar[XB_TMO], 1u); break; } }
    }
    nloc = mine > 0u ? mine : 1u; nx = cnt > 0u ? cnt : 1u;
}

__device__ __forceinline__ void xcd_barrier(const XcdBarrier& b) {
    asm volatile("s_waitcnt vmcnt(0)" ::: "memory");
    __syncthreads();
    if (threadIdx.x == 0) {
        unsigned* bar = b.bar; unsigned bx = b.x; asm volatile("" : "+s"(bx));
        __builtin_amdgcn_s_waitcnt(0);
        unsigned nloc = b.st[0], nx = b.st[1];
        if (nloc == 0u) { xcd_barrier_complete(bar, bx, nloc, nx); b.st[0] = nloc; b.st[1] = nx; }
        const unsigned old = xb_add(&bar[XB_XSUB(bx)], 1u);
        const unsigned gen = old / nloc;
        if (old + 1u == (gen + 1u) * nloc) {
            __builtin_amdgcn_fence(__ATOMIC_RELEASE, "agent");
            asm volatile("s_waitcnt vmcnt(0)" ::: "memory");
            const unsigned og = xb_add(&bar[XB_TOP], 1u);
            const unsigned tg = og / nx;
            if (og + 1u == (tg + 1u) * nx) xb_add(&bar[XB_TOPGEN], 1u);
            else XB_SPIN(xb_ld(&bar[XB_TOPGEN]) == tg, bar);
            __builtin_amdgcn_fence(__ATOMIC_ACQUIRE, "agent");
            xb_add(&bar[XB_XGEN(bx)], 1u);
            asm volatile("s_waitcnt vmcnt(0)" ::: "memory");
        } else {
            XB_SPIN(xb_ld(&bar[XB_XGEN(bx)]) == gen, bar);
            __builtin_amdgcn_fence(__ATOMIC_ACQUIRE, "agent");
            asm volatile("s_waitcnt vmcnt(0)" ::: "memory");
        }
    }
    __syncthreads();
}
namespace pg8 {
#define PG8_LAS __attribute__((address_space(3)))
typedef unsigned short bf16_t;
typedef short bf16x8 __attribute__((ext_vector_type(8)));
typedef float f32x4 __attribute__((ext_vector_type(4)));
typedef unsigned u32x4 __attribute__((ext_vector_type(4)));
constexpr int BM = 256, BK = 64, HALF = 128, HTB = HALF * BK * 2  , STAGE_BYTES = 8 * HTB, NXCD = 8, WGM = 8;

__host__ __device__ __forceinline__ int lds_byte(int r, int c) { const int st = (r >> 4) * 2 + (c >> 5), rr = r & 15, cc = c & 31, ob = rr * 64 + cc * 2; return st * 1024 + (ob ^ (((ob >> 9) & 1) << 5)); }
__host__ __device__ __forceinline__ void stage_rc(int b, int& R, int& C) { const int st = b / 1024, sb = b % 1024, swz = sb ^ (((sb >> 9) & 1) << 5); R = (st >> 1) * 16 + swz / 64; C = (st & 1) * 32 + (swz % 64) / 2; }
__host__ __device__ __forceinline__ int perm32(int rho) { const int n = rho >> 4, i = rho & 15; return 8 * (i >> 2) + 4 * n + (i & 3); }

struct Unit { int pm, pn; };
struct Gemm { const bf16_t* A; const bf16_t* Bt; int M, N, K; };

struct StaticOrder {
    int nM, nN, nwg, G, c;
    __host__ __device__ void init(int M, int N, int G_, int c_) { nM = M / BM; nN = N / BM; nwg = nM * nN; G = G_; c = c_; }
    __host__ __device__ bool next(int i, Unit& u) const {
        const long L = (long)i * G + c; if (L >= nwg) return false;
        int wgid = (int)L; { const int q = nwg / NXCD, r = nwg % NXCD, xcd = wgid % NXCD, off = wgid / NXCD; wgid = (xcd < r ? xcd * (q + 1) : r * (q + 1) + (xcd - r) * q) + off; }
        const int nig = WGM * nN, gid = wgid / nig, fm = gid * WGM, gsz = (nM - fm) < WGM ? (nM - fm) : WGM;
        u.pm = fm + ((wgid % nig) % gsz); u.pn = (wgid % nig) / gsz; return true;
    }
    __device__ __forceinline__ void a_ready(const Unit&) const {}
    __device__ __forceinline__ void done(const Unit&) const {}
    __device__ __forceinline__ const char* a_base(const Gemm& g, const Unit& u, size_t tstep) const { return (const char*)g.A + (size_t)u.pm * tstep; }
    __device__ __forceinline__ const char* b_base(const Gemm& g, const Unit& u, size_t tstep) const { return (const char*)g.Bt + (size_t)u.pn * tstep; }
};


typedef int v4i_t __attribute__((ext_vector_type(4)));
typedef int v8i_t __attribute__((ext_vector_type(8)));
__device__ __forceinline__ v8i_t cat8(bf16x8 lo, bf16x8 hi) { const v4i_t a = __builtin_bit_cast(v4i_t, lo), b = __builtin_bit_cast(v4i_t, hi); return __builtin_shufflevector(a, b, 0, 1, 2, 3, 4, 5, 6, 7); }
__device__ __forceinline__ unsigned pk4_fp8(float a, float b, float c, float d) {
    a = fminf(fmaxf(a, -448.f), 448.f); b = fminf(fmaxf(b, -448.f), 448.f); c = fminf(fmaxf(c, -448.f), 448.f); d = fminf(fmaxf(d, -448.f), 448.f);
    int w = 0; w = __builtin_amdgcn_cvt_pk_fp8_f32(a, b, w, false); w = __builtin_amdgcn_cvt_pk_fp8_f32(c, d, w, true); return (unsigned)w; }

struct EpiBf16 {
    static constexpr bool PERM = true, AFTER_DRAIN = false;
    bf16_t* O; int ldc; int row_shift;
    __device__ __forceinline__ void operator()(const f32x4 (&acc)[2][2][4][2], const Unit& u, int wr, int wc, int fr, int fq) const {
        const int row0 = u.pm * BM + row_shift + wr * 64 + fr, col0 = u.pn * BM + wc * 32 + 8 * fq;
#pragma unroll
        for (int ai = 0; ai < 2; ++ai)
#pragma unroll
            for (int m = 0; m < 4; ++m) { bf16_t* rowp = O + (size_t)(row0 + ai * HALF + m * 16) * ldc + col0;
#pragma unroll
                for (int bj = 0; bj < 2; ++bj) { const f32x4 v0 = acc[ai][bj][m][0], v1 = acc[ai][bj][m][1];
                    u32x4 w; w.x = cvt_pk_bf16(v0[0], v0[1]); w.y = cvt_pk_bf16(v0[2], v0[3]); w.z = cvt_pk_bf16(v1[0], v1[1]); w.w = cvt_pk_bf16(v1[2], v1[3]);
                    *(u32x4*)(rowp + bj * HALF) = w; } }
    }
};
struct EpiSwiGLU {
    static constexpr bool PERM = true, AFTER_DRAIN = false;
    bf16_t* H; int ldh; int row_shift;
    __device__ __forceinline__ void operator()(const f32x4 (&acc)[2][2][4][2], const Unit& u, int wr, int wc, int fr, int fq) const {
        const int row0 = u.pm * BM + row_shift + wr * 64 + fr, col0 = u.pn * HALF + wc * 32 + 8 * fq;
#pragma unroll
        for (int ai = 0; ai < 2; ++ai)
#pragma unroll
            for (int m = 0; m < 4; ++m) { bf16_t* rowp = H + (size_t)(row0 + ai * HALF + m * 16) * ldh + col0;
                const f32x4 g0 = acc[ai][0][m][0], g1 = acc[ai][0][m][1], u0 = acc[ai][1][m][0], u1 = acc[ai][1][m][1];
                float h[8];
#pragma unroll
                for (int i = 0; i < 4; ++i) { h[i] = silu_f(g0[i]) * u0[i]; h[4 + i] = silu_f(g1[i]) * u1[i]; }
                u32x4 w; w.x = cvt_pk_bf16(h[0], h[1]); w.y = cvt_pk_bf16(h[2], h[3]); w.z = cvt_pk_bf16(h[4], h[5]); w.w = cvt_pk_bf16(h[6], h[7]);
                *(u32x4*)rowp = w; }
    }
};
struct EpiSwiGLU8 {
    static constexpr bool PERM = true, AFTER_DRAIN = false;
    unsigned char* H; int ldh; int row_shift;
    __device__ __forceinline__ void operator()(const f32x4 (&acc)[2][2][4][2], const Unit& u, int wr, int wc, int fr, int fq) const {
        const int row0 = u.pm * BM + row_shift + wr * 64 + fr, col0 = u.pn * HALF + wc * 32 + 8 * fq;
#pragma unroll
        for (int ai = 0; ai < 2; ++ai)
#pragma unroll
            for (int m = 0; m < 4; ++m) { unsigned char* rowp = H + (size_t)(row0 + ai * HALF + m * 16) * ldh + col0;
                const f32x4 g0 = acc[ai][0][m][0], g1 = acc[ai][0][m][1], u0 = acc[ai][1][m][0], u1 = acc[ai][1][m][1];
                float h[8];
#ifdef SWIGLU_PK
                typedef float f32x2_t __attribute__((ext_vector_type(2)));
#pragma unroll
                for (int i = 0; i < 4; i += 2) {
                    const f32x2_t ga = {g0[i], g0[i + 1]}, gb = {g1[i], g1[i + 1]}, ua = {u0[i], u0[i + 1]}, ub = {u1[i], u1[i + 1]};
                    f32x2_t ea = {__builtin_amdgcn_exp2f(-ga.x), __builtin_amdgcn_exp2f(-ga.y)}, eb = {__builtin_amdgcn_exp2f(-gb.x), __builtin_amdgcn_exp2f(-gb.y)};
                    ea = ea + 1.0f; eb = eb + 1.0f;
                    const f32x2_t ra = {__builtin_amdgcn_rcpf(ea.x), __builtin_amdgcn_rcpf(ea.y)}, rb = {__builtin_amdgcn_rcpf(eb.x), __builtin_amdgcn_rcpf(eb.y)};
                    const f32x2_t ha = (ga * ua) * ra, hb = (gb * ub) * rb;
                    h[i] = ha.x; h[i + 1] = ha.y; h[4 + i] = hb.x; h[4 + i + 1] = hb.y; }
#else
#pragma unroll
                for (int i = 0; i < 4; ++i) { h[i] = silu_f(g0[i]) * u0[i]; h[4 + i] = silu_f(g1[i]) * u1[i]; }
#endif
                typedef unsigned u32x2_t __attribute__((ext_vector_type(2)));
                u32x2_t w; w.x = pk4_fp8(h[0], h[1], h[2], h[3]); w.y = pk4_fp8(h[4], h[5], h[6], h[7]);
                *(u32x2_t*)rowp = w;
                asm volatile("" ::: "memory"); }
    }
};
struct EpiRes {
    static constexpr bool PERM = true, AFTER_DRAIN = false;
    const float* xin32; const bf16_t* xin16; bf16_t* xout; const float* gate;
    __device__ __forceinline__ void operator()(const f32x4 (&acc)[2][2][4][2], const Unit& u, int wr, int wc, int fr, int fq) const {
        const int row0 = u.pm * BM + wr * 64 + fr, col0 = u.pn * BM + wc * 32 + 8 * fq;
        const float* gb = gate + (size_t)((u.pm * BM) / SEQ) * 6144;
        f32x4 gv[2][2];
#pragma unroll
        for (int bj = 0; bj < 2; ++bj)
#pragma unroll
            for (int n = 0; n < 2; ++n) gv[bj][n] = *(const f32x4*)(gb + col0 + bj * HALF + n * 4);
#pragma unroll
        for (int ai = 0; ai < 2; ++ai)
#pragma unroll
            for (int m = 0; m < 4; ++m) { const size_t off = (size_t)(row0 + ai * HALF + m * 16) * DM + col0;
#pragma unroll
                for (int bj = 0; bj < 2; ++bj) { f32x4 x0, x1;
                    if (xin32) { x0 = *(const f32x4*)(xin32 + off + bj * HALF); x1 = *(const f32x4*)(xin32 + off + bj * HALF + 4); }
                    else { const u32x4 w = *(const u32x4*)(xin16 + off + bj * HALF);
                        x0 = (f32x4){__uint_as_float(w.x << 16), __uint_as_float(w.x & 0xffff0000u), __uint_as_float(w.y << 16), __uint_as_float(w.y & 0xffff0000u)};
                        x1 = (f32x4){__uint_as_float(w.z << 16), __uint_as_float(w.z & 0xffff0000u), __uint_as_float(w.w << 16), __uint_as_float(w.w & 0xffff0000u)}; }
                    x0 = x0 + gv[bj][0] * acc[ai][bj][m][0]; x1 = x1 + gv[bj][1] * acc[ai][bj][m][1];
                    u32x4 o; o.x = cvt_pk_bf16(x0[0], x0[1]); o.y = cvt_pk_bf16(x0[2], x0[3]); o.z = cvt_pk_bf16(x1[0], x1[1]); o.w = cvt_pk_bf16(x1[2], x1[3]);
                    *(u32x4*)(xout + off + bj * HALF) = o; } }
    }
};
struct SubOrder {
    int nM, nN, nwg, G, c, full, skip; unsigned long long list;
    __host__ __device__ void init(int M, int ncol, unsigned long long list_, int G_, int c_, int full_, int skip_) { nM = M / BM; nN = ncol; nwg = nM * nN; G = G_; c = c_; full = full_; skip = skip_; list = list_; }
    __host__ __device__ bool next(int i, Unit& u) const {
        long L;
        if (i >= full) { if (c < skip) return false; L = (long)full * G + (long)(i - full) * (G - skip) + (c - skip); } else L = (long)i * G + c;
        if (L >= nwg) return false;
        int wgid = (int)L; { const int q = nwg / NXCD, r = nwg % NXCD, xcd = wgid % NXCD, off = wgid / NXCD; wgid = (xcd < r ? xcd * (q + 1) : r * (q + 1) + (xcd - r) * q) + off; }
        const int nig = WGM * nN, gid = wgid / nig, fm = gid * WGM, gsz = (nM - fm) < WGM ? (nM - fm) : WGM;
        u.pm = fm + ((wgid % nig) % gsz); u.pn = (int)((list >> (4 * ((wgid % nig) / gsz))) & 15ull); return true;
    }
    __device__ __forceinline__ void a_ready(const Unit&) const {}
    __device__ __forceinline__ void done(const Unit&) const {}
    __device__ __forceinline__ const char* a_base(const Gemm& g, const Unit& u, size_t tstep) const { return (const char*)g.A + (size_t)u.pm * tstep; }
    __device__ __forceinline__ const char* b_base(const Gemm& g, const Unit& u, size_t tstep) const { return (const char*)g.Bt + (size_t)u.pn * tstep; }
};
struct MoeOrder {
    int nrt, nN, G, c, mode; const PG8_LAS unsigned char* etab; size_t estride; int pm0, pn0, cnt; const PG8_LAS unsigned* rowtab;
    __device__ __forceinline__ bool next(int i, Unit& u) const {
        if (nrt <= 0) return false;
        if (mode == 2) { if (i >= cnt) return false; u.pm = pm0; u.pn = pn0 + i; return true; }
        if (mode == 0) {
            const int full = nrt / G, rem = nrt - full * G;
            if (i < full * nN) { u.pm = (i / nN) * G + c; u.pn = i % nN; return true; }
            const int L = (i - full * nN) * G + c; if (rem <= 0 || L >= rem * nN) return false;
            u.pm = full * G + L % rem; u.pn = L / rem; return true;
        }
        if ((G & 31) == 0) { const int x = c & 7, y = c >> 3, ppr = G / nN;
            const int pm = i * ppr + x + 8 * (y >> 2); if (pm >= nrt) return false; u.pm = pm; u.pn = y & 3; return true; }
        const int L = i * G + c; if (L >= nrt * nN) return false; u.pm = L / nN; u.pn = L % nN; return true;
    }
    __device__ __forceinline__ void a_ready(const Unit&) const {}
    __device__ __forceinline__ void done(const Unit&) const {}
    __device__ __forceinline__ const char* a_base(const Gemm& g, const Unit& u, size_t tstep) const { return mode == 2 ? (const char*)g.A : (const char*)g.A + (size_t)u.pm * tstep; }
    __device__ __forceinline__ const char* b_base(const Gemm& g, const Unit& u, size_t tstep) const {
        const int e = __builtin_amdgcn_readfirstlane((int)etab[u.pm]);
        return (const char*)g.Bt + (size_t)e * estride + (size_t)u.pn * tstep;
    }
};
template <class Epi, class Sched, bool ALIGN_EPI = false, bool SP2 = false, bool FP8 = false, int sc_w = 0x7F7F7F7F, int sc_a = 0x7F7F7F7F, bool GA = false>
__device__ __forceinline__ void gemm_phase(PG8_LAS unsigned char* lds, const Gemm g, const Sched& S, const Epi& E) {
    int tid_ = threadIdx.x; asm volatile("" : "+v"(tid_));
    const int tid = tid_, wid = __builtin_amdgcn_readfirstlane(tid >> 6), lane = tid & 63, wr = wid >> 2, wc = wid & 3, fr = lane & 15, fq = lane >> 4;
    constexpr int ES = FP8 ? 1 : 2;
    int K_ = g.K; asm volatile("" : "+s"(K_));
    const int K = K_, nt = K * ES / (BK * 2);
    unsigned voffA[2], voffA1[2], voffB[2];
#pragma unroll
    for (int i = 0; i < 2; ++i) { int R, C; stage_rc(tid * 16 + i * 8192, R, C); const int Rb = Epi::PERM ? ((R & ~31) + perm32(R & 31)) : R;
        voffB[i] = (unsigned)(Rb * K * ES + C * 2);
        if constexpr (GA) { voffA[i] = S.rowtab[R] + (unsigned)(C * 2); voffA1[i] = S.rowtab[R + HALF] + (unsigned)(C * 2); }
        else { voffA[i] = (unsigned)(R * K * ES + C * 2); voffA1[i] = voffA[i]; } }
    const size_t kstep = (size_t)(BK * 2);
    const size_t hstep = (size_t)HALF * K * ES;
    const size_t hstepA = GA ? (size_t)0 : hstep;
    const size_t tstep = 2 * hstep;
    const unsigned ldsw = (unsigned)wid * 1024u;
    const int aoff = lds_byte(wr * 64 + fr, fq * 8), boff = lds_byte(wc * 32 + fr, fq * 8);
#define PG8_SA(b, h) (((b) * 2 + (h)) * HTB)
#define PG8_SB(b, h) ((4 + (b) * 2 + (h)) * HTB)
#define PG8_STAGE(bufoff, gbase, voff) do { _Pragma("unroll") for (int _i = 0; _i < 2; ++_i) \
        __builtin_amdgcn_global_load_lds((const unsigned*)((const char*)(gbase) + (voff)[_i]), (PG8_LAS unsigned*)(lds + (bufoff) + ldsw + _i * 8192), 16, 0, 0); } while (0)
#define PG8_LDA(dst, b, h) do { _Pragma("unroll") for (int m = 0; m < 4; ++m) { \
        if constexpr (FP8) { const v4i_t l_ = *(const PG8_LAS v4i_t*)(lds + PG8_SA(b, h) + aoff + m * 2048), h_ = *(const PG8_LAS v4i_t*)(lds + PG8_SA(b, h) + aoff + m * 2048 + 1024); dst##F[m] = __builtin_shufflevector(l_, h_, 0, 1, 2, 3, 4, 5, 6, 7); } \
        else { _Pragma("unroll") for (int k = 0; k < 2; ++k) dst[m][k] = *(const PG8_LAS bf16x8*)(lds + PG8_SA(b, h) + aoff + m * 2048 + k * 1024); } } } while (0)
#define PG8_LDB(dst, b, h) do { _Pragma("unroll") for (int n = 0; n < 2; ++n) { \
        if constexpr (FP8) { const v4i_t l_ = *(const PG8_LAS v4i_t*)(lds + PG8_SB(b, h) + boff + n * 2048), h_ = *(const PG8_LAS v4i_t*)(lds + PG8_SB(b, h) + boff + n * 2048 + 1024); dst##F[n] = __builtin_shufflevector(l_, h_, 0, 1, 2, 3, 4, 5, 6, 7); } \
        else { _Pragma("unroll") for (int k = 0; k < 2; ++k) dst[n][k] = *(const PG8_LAS bf16x8*)(lds + PG8_SB(b, h) + boff + n * 2048 + k * 1024); } } } while (0)
#define PG8_MMA(ai, bj, At, Bt) do { __builtin_amdgcn_s_setprio(1); _Pragma("unroll") for (int m = 0; m < 4; ++m) _Pragma("unroll") for (int n = 0; n < 2; ++n) { \
        if constexpr (FP8) asm volatile("v_mfma_scale_f32_16x16x128_f8f6f4 %0, %1, %2, %0, %3, %4 op_sel_hi:[0,0,0]" : "+v"(acc[ai][bj][m][n]) : "v"(Bt##F[n]), "v"(At##F[m]), "v"(sc_w), "v"(sc_a)); \
        else { _Pragma("unroll") for (int k = 0; k < 2; ++k) acc[ai][bj][m][n] = __builtin_amdgcn_mfma_f32_16x16x32_bf16(Bt[n][k], At[m][k], acc[ai][bj][m][n], 0, 0, 0); } } \
        __builtin_amdgcn_s_setprio(0); } while (0)
#define PG8_WAIT_V(n) asm volatile("s_waitcnt vmcnt(" #n ")" ::: "memory")
#define PG8_WAIT_L(n) asm volatile("s_waitcnt lgkmcnt(" #n ")" ::: "memory")
#define PG8_BAR __builtin_amdgcn_s_barrier()
#define PG8_SCHED __builtin_amdgcn_sched_barrier(0)
    Unit cur, nxt; int ui = 0;
    if (!S.next(0, cur)) return;
    f32x4 acc[2][2][4][2];
#pragma unroll
    for (int a = 0; a < 2; ++a)
#pragma unroll
        for (int b = 0; b < 2; ++b)
#pragma unroll
            for (int m = 0; m < 4; ++m)
#pragma unroll
                for (int n = 0; n < 2; ++n) acc[a][b][m][n] = (f32x4){0.f, 0.f, 0.f, 0.f};
    bf16x8 At[4][2], B0[2][2], B1[2][2];
    v8i_t AtF[4], B0F[2], B1F[2];
    const char* cA = S.a_base(g, cur, tstep); const char* cB = S.b_base(g, cur, tstep);
    S.a_ready(cur);
    if constexpr (SP2) {
        PG8_STAGE(PG8_SB(0, 0), cB, voffB); PG8_STAGE(PG8_SB(0, 1), cB + hstep, voffB); PG8_STAGE(PG8_SA(0, 0), cA, voffA); PG8_STAGE(PG8_SA(0, 1), cA + hstepA, voffA1);
        if (wr == 1) PG8_BAR;
        PG8_WAIT_V(2); PG8_BAR;
        PG8_STAGE(PG8_SB(1, 0), cB + kstep, voffB); PG8_STAGE(PG8_SA(1, 0), cA + kstep, voffA); PG8_STAGE(PG8_SB(1, 1), cB + hstep + kstep, voffB);
        PG8_WAIT_V(6); PG8_BAR;
    } else {
        PG8_STAGE(PG8_SB(0, 0), cB, voffB); PG8_STAGE(PG8_SA(0, 0), cA, voffA); PG8_STAGE(PG8_SB(0, 1), cB + hstep, voffB); PG8_STAGE(PG8_SA(0, 1), cA + hstepA, voffA1);
        if (wr == 1) PG8_BAR;
        PG8_WAIT_V(4); PG8_BAR;
        PG8_STAGE(PG8_SB(1, 0), cB + kstep, voffB); PG8_STAGE(PG8_SA(1, 0), cA + kstep, voffA); PG8_STAGE(PG8_SB(1, 1), cB + hstep + kstep, voffB);
        PG8_WAIT_V(6); PG8_BAR;
    }
    for (;;) {
        const bool has_next = S.next(ui + 1, nxt);
        const char* nA = has_next ? S.a_base(g, nxt, tstep) : cA; const char* nB = has_next ? S.b_base(g, nxt, tstep) : cB;
        for (int t = 0; t < nt; t += 2) {
            const bool last = (t == nt - 2);
            const char* a1 = cA + (size_t)(t + 1) * kstep;
            const char* a2 = last ? nA : cA + (size_t)(t + 2) * kstep; const char* b2 = last ? nB : cB + (size_t)(t + 2) * kstep;
            const char* a3 = a2 + kstep; const char* b3 = b2 + kstep;
            if (last && has_next) S.a_ready(nxt);
            if constexpr (SP2) {
            PG8_LDB(B0, 0, 0); PG8_LDB(B1, 0, 1); PG8_SCHED; PG8_LDA(At, 0, 0); PG8_STAGE(PG8_SA(1, 1), a1 + hstepA, voffA1);
            PG8_WAIT_V(8); PG8_WAIT_L(0); PG8_BAR; PG8_MMA(0, 0, At, B0); PG8_MMA(0, 1, At, B1); PG8_BAR; PG8_SCHED;
            PG8_LDA(At, 0, 1); PG8_STAGE(PG8_SB(0, 0), b2, voffB); PG8_STAGE(PG8_SB(0, 1), b2 + hstep, voffB); PG8_STAGE(PG8_SA(0, 0), a2, voffA);
            PG8_WAIT_V(8); PG8_WAIT_L(0); PG8_BAR; PG8_MMA(1, 0, At, B0); PG8_MMA(1, 1, At, B1); PG8_BAR; PG8_SCHED;
            PG8_LDB(B0, 1, 0); PG8_LDB(B1, 1, 1); PG8_SCHED; PG8_LDA(At, 1, 0); PG8_STAGE(PG8_SA(0, 1), a2 + hstepA, voffA1);
            PG8_WAIT_V(8); PG8_WAIT_L(0); PG8_BAR; PG8_MMA(0, 0, At, B0); PG8_MMA(0, 1, At, B1); PG8_BAR; PG8_SCHED;
            PG8_LDA(At, 1, 1); PG8_STAGE(PG8_SB(1, 0), b3, voffB); PG8_STAGE(PG8_SB(1, 1), b3 + hstep, voffB); PG8_STAGE(PG8_SA(1, 0), a3, voffA);
            PG8_WAIT_V(8); PG8_WAIT_L(0); PG8_BAR; PG8_MMA(1, 0, At, B0); PG8_MMA(1, 1, At, B1); PG8_BAR; PG8_SCHED;
            } else {
            PG8_LDB(B0, 0, 0); PG8_SCHED; PG8_LDA(At, 0, 0); PG8_STAGE(PG8_SA(1, 1), a1 + hstepA, voffA1);
            PG8_WAIT_L(8); PG8_BAR; PG8_WAIT_L(0); PG8_MMA(0, 0, At, B0); PG8_BAR; PG8_SCHED;
            PG8_LDB(B1, 0, 1); PG8_STAGE(PG8_SB(0, 0), b2, voffB);
            PG8_BAR; PG8_WAIT_L(0); PG8_MMA(0, 1, At, B1); PG8_BAR;
            PG8_LDA(At, 0, 1); PG8_STAGE(PG8_SA(0, 0), a2, voffA);
            PG8_BAR; PG8_WAIT_L(0); PG8_MMA(1, 0, At, B0); PG8_BAR; PG8_SCHED;
            PG8_STAGE(PG8_SB(0, 1), b2 + hstep, voffB);
            PG8_WAIT_V(6); PG8_BAR; PG8_MMA(1, 1, At, B1); PG8_BAR;
            PG8_LDB(B0, 1, 0); PG8_SCHED; PG8_LDA(At, 1, 0); PG8_STAGE(PG8_SA(0, 1), a2 + hstepA, voffA1);
            PG8_WAIT_L(8); PG8_BAR; PG8_WAIT_L(0); PG8_MMA(0, 0, At, B0); PG8_BAR; PG8_SCHED;
            PG8_LDB(B1, 1, 1); PG8_STAGE(PG8_SB(1, 0), b3, voffB);
            PG8_BAR; PG8_WAIT_L(0); PG8_MMA(0, 1, At, B1); PG8_BAR;
            PG8_LDA(At, 1, 1); PG8_STAGE(PG8_SA(1, 0), a3, voffA);
            PG8_BAR; PG8_WAIT_L(0); PG8_MMA(1, 0, At, B0); PG8_BAR; PG8_SCHED;
            PG8_STAGE(PG8_SB(1, 1), b3 + hstep, voffB);
            PG8_WAIT_V(6); PG8_BAR; PG8_MMA(1, 1, At, B1); PG8_BAR;
            }
        }
        if constexpr (ALIGN_EPI) { if (wr == 0) PG8_BAR; }
        asm volatile("s_nop 15\n\ts_nop 15\n\ts_nop 15" ::: "memory");
        if constexpr (!Epi::AFTER_DRAIN) { E(acc, cur, wr, wc, fr, fq); S.done(cur); }
        if (!has_next) break;
#pragma unroll
        for (int a = 0; a < 2; ++a)
#pragma unroll
            for (int b = 0; b < 2; ++b)
#pragma unroll
                for (int m = 0; m < 4; ++m)
#pragma unroll
                    for (int n = 0; n < 2; ++n) acc[a][b][m][n] = (f32x4){0.f, 0.f, 0.f, 0.f};
        cur = nxt; cA = nA; cB = nB; ++ui;
        if constexpr (ALIGN_EPI) { if (wr == 1) PG8_BAR; }
    }
    PG8_WAIT_V(0);
    if constexpr (!ALIGN_EPI) { if (wr == 0) PG8_BAR; }
    PG8_BAR;
    if constexpr (Epi::AFTER_DRAIN) { E.fused(acc, cur, wr, wc, fr, fq, lds, wid, lane); S.done(cur); }
#undef PG8_SA
#undef PG8_SB
#undef PG8_STAGE
#undef PG8_LDA
#undef PG8_LDB
#undef PG8_MMA
#undef PG8_WAIT_V
#undef PG8_WAIT_L
#undef PG8_BAR
#undef PG8_SCHED
}
}

#define LDS_WAIT() asm volatile("s_waitcnt lgkmcnt(0)" ::: "memory")
#define VM_WAIT() asm volatile("s_waitcnt vmcnt(0)" ::: "memory")

template <bool F8 = false> __device__ __forceinline__ void transpose_item(const float* W, int ldw, int scol0, int ncol_valid, float scale, bf16* WT, int K, int drow0, int k0, LAS float* scr, int lane) {
    const int n4 = lane & 7, kr = lane >> 3; const bool ok = (scol0 + 4 * n4) < ncol_valid;
    f32x4 v[8];
    const float* wp = W + (size_t)(k0 + kr) * ldw + scol0 + 4 * n4;
#pragma unroll
    for (int i = 0; i < 8; ++i) v[i] = ok ? *(const f32x4*)(wp + (size_t)(8 * i) * ldw) : (f32x4){0.f, 0.f, 0.f, 0.f};
#pragma unroll
    for (int i = 0; i < 8; ++i) { LAS float* d = scr + (8 * i + kr) * 33 + 4 * n4; d[0] = v[i].x * scale; d[1] = v[i].y * scale; d[2] = v[i].z * scale; d[3] = v[i].w * scale; }
    LDS_WAIT(); asm volatile("" ::: "memory");
    const int c = lane & 7;
#pragma unroll
    for (int j = 0; j < 4; ++j) { const int nn = (lane >> 3) + 8 * j; const LAS float* s = scr + (8 * c) * 33 + nn;
        if (F8) { u32x2 o; o.x = pg8::pk4_fp8(s[0 * 33], s[1 * 33], s[2 * 33], s[3 * 33]); o.y = pg8::pk4_fp8(s[4 * 33], s[5 * 33], s[6 * 33], s[7 * 33]);
            *(u32x2*)((unsigned char*)WT + (size_t)(drow0 + nn) * K + k0 + 8 * c) = o; }
        else { u32x4 o; o.x = pk2(s[0 * 33], s[1 * 33]); o.y = pk2(s[2 * 33], s[3 * 33]); o.z = pk2(s[4 * 33], s[5 * 33]); o.w = pk2(s[6 * 33], s[7 * 33]);
            *(u32x4*)(WT + (size_t)(drow0 + nn) * K + k0 + 8 * c) = o; } }
    LDS_WAIT(); asm volatile("" ::: "memory");
}
#ifdef SWIGLU_PK
constexpr float SC_GATE = 32.f * 1.4426950408889634f, SC_UP = 32.f / 1.4426950408889634f;
#else
constexpr float SC_GATE = 32.f, SC_UP = 32.f;
#endif
struct PrepArgs { const float *w_in, *w_out, *wfg, *wfu, *wfd, *weg, *weu, *wed; unsigned char* ws; };
constexpr int PI_WIN = 2 * 16 * 120, PI_WOUT = 2 * 16 * 32, PI_FU = 16 * 176, PI_FD = 44 * 32, PI_EU = 8 * 16 * 224, PI_ED = 8 * 56 * 32;
constexpr int PREP_ITEMS = PI_WIN + PI_WOUT + PI_FU + PI_FD + PI_EU + PI_ED;
constexpr int PI_STATIC = PI_WIN + PI_WOUT + PI_FU + PI_FD, LAZY_BATCHES = (PI_EU + PI_ED) / 8, LAZY_NB = 4;
__device__ __forceinline__ void prep_item(const PrepArgs& a, int it, LAS float* scr, int lane) {
    int r = it;
    if (r < PI_WIN) { const int l = r / 1920; r %= 1920; const int kb = r / 120, nb = r % 120, n0 = nb * 32;
        float sc = 1.f; if (n0 >= COL_QI && n0 < COL_KI) sc = 0.125f; else if (n0 < 3072 && (n0 % 768) < 256) sc = 0.125f * 1.4426950408889634f; else if (n0 == COL_WI) sc = 0.35355339059327373f;
#ifdef WIN_FP8
        if (!((WIN_BF16_TILES >> (n0 >> 8)) & 1)) { transpose_item<true>(a.w_in + (size_t)l * DM * NIN, NIN, n0, NIN, sc * 32.f, (bf16*)(a.ws + WS_WIN8 + (size_t)l * PW * DM), DM, n0, kb * 64, scr, lane); return; }
        transpose_item(a.w_in + (size_t)l * DM * NIN, NIN, n0, NIN, sc, (bf16*)(a.ws + WS_WIN) + (size_t)l * PW * DM, DM, n0, kb * 64, scr, lane); return; }
#else
        transpose_item(a.w_in + (size_t)l * DM * NIN, NIN, n0, NIN, sc, (bf16*)(a.ws + WS_WIN) + (size_t)l * PW * DM, DM, n0, kb * 64, scr, lane); return; }
#endif
    r -= PI_WIN;
    if (r < PI_WOUT) { const int l = r / 512; r %= 512; const int kb = r / 32, nb = r % 32;
#ifdef WOUT_FP8
        transpose_item<true>(a.w_out + (size_t)l * DM * DM, DM, nb * 32, DM, 64.f, (bf16*)(a.ws + WS_WOUT + (size_t)l * DM * DM), DM, nb * 32, kb * 64, scr, lane); return; }
#else
        transpose_item(a.w_out + (size_t)l * DM * DM, DM, nb * 32, DM, 1.f, (bf16*)(a.ws + WS_WOUT) + (size_t)l * DM * DM, DM, nb * 32, kb * 64, scr, lane); return; }
#endif
    r -= PI_WOUT;
    if (r < PI_FU) { const int kb = r / 176, nb = r % 176, r0 = nb * 32, blk = r0 >> 8, w = r0 & 255;
        transpose_item<true>(w < 128 ? a.wfg : a.wfu, DFF, blk * 128 + (w & 127), DFF, w < 128 ? SC_GATE : SC_UP, (bf16*)(a.ws + WS_WFU), DM, r0, kb * 64, scr, lane); return; }
    r -= PI_FU;
    if (r < PI_FD) { const int kb = r / 32, nb = r % 32;
        transpose_item<true>(a.wfd, DM, nb * 32, DM, 64.f, (bf16*)(a.ws + WS_WFD), DFF, nb * 32, kb * 64, scr, lane); return; }
    r -= PI_FD;
    if (r < PI_EU) { const int e = r / 3584; r %= 3584; const int kb = r / 224, nb = r % 224, r0 = nb * 32, blk = r0 >> 8, w = r0 & 255;
        transpose_item<true>((w < 128 ? a.weg : a.weu) + (size_t)e * DM * DFE, DFE, blk * 128 + (w & 127), DFE, w < 128 ? SC_GATE : SC_UP, (bf16*)(a.ws + WS_WEU + (size_t)e * 7168 * DM), DM, r0, kb * 64, scr, lane); return; }
    r -= PI_EU;
    { const int e = r / 1792; r %= 1792; const int kb = r / 32, nb = r % 32;
        transpose_item<true>(a.wed + (size_t)e * DFE * DM, DM, nb * 32, DM, 64.f, (bf16*)(a.ws + WS_WED + (size_t)e * DM * DFE), DFE, nb * 32, kb * 64, scr, lane); }
}
__device__ __forceinline__ void ph_prep(const PrepArgs& a, LAS unsigned char* lds, int bid, int nblk) {
    const int lane = otid() & 63, wave = otid() >> 6;
    LAS float* scr = (LAS float*)lds + wave * 64 * 33;
    const int gw = bid * 8 + wave, ngw = nblk * 8;
#ifdef PREP_LAZY
    for (int it = gw; it < PI_STATIC; it += ngw) prep_item(a, it, scr, lane);
#else
    for (int it = gw; it < PREP_ITEMS; it += ngw) prep_item(a, it, scr, lane);
#endif
}
__device__ __forceinline__ void prep_lazy(const PrepArgs& a, unsigned* ctl, int done_word, int nblk, LAS unsigned char* lds) {
    const int tid = otid(), lane = tid & 63, wave = tid >> 6;
    LAS float* scr = (LAS float*)lds + wave * 64 * 33; LAS unsigned* slot = (LAS unsigned*)(lds + 71680);
    __syncthreads();
    if (tid == 0 && done_word >= 0) __hip_atomic_fetch_add(ctl + done_word, 1u, __ATOMIC_RELAXED, __HIP_MEMORY_SCOPE_AGENT);
    for (;;) {
        if (tid == 0) { unsigned b = 0xffffffffu;
            if (done_word < 0 || __hip_atomic_load(ctl + done_word, __ATOMIC_RELAXED, __HIP_MEMORY_SCOPE_AGENT) < (unsigned)nblk) b = __hip_atomic_fetch_add(ctl + CW_PREPQ, 1u, __ATOMIC_RELAXED, __HIP_MEMORY_SCOPE_AGENT);
            slot[0] = b; }
        __syncthreads(); const unsigned b = slot[0]; __syncthreads();
        if (b >= (unsigned)(LAZY_BATCHES / LAZY_NB)) break;
#pragma unroll 1
        for (int k = 0; k < LAZY_NB; ++k) prep_item(a, PI_STATIC + ((int)b * LAZY_NB + k) * 8 + wave, scr, lane);
    }
    __syncthreads();
}
__device__ __forceinline__ void ph_mod(const float* c, const float* w_ada, const float* b_ada, float* mod, LAS unsigned char* lds, int bid, int nblk) {
    LAS float* sc = (LAS float*)lds; LAS float* part = (LAS float*)(lds + 32768);
    const int tid = otid();
    if (bid >= 192) return;
    for (int i = tid; i < 8 * 1024; i += 512) { const float v = c[i]; sc[i] = v / (1.0f + __expf(-v)); }
    __syncthreads();
    for (int item = bid; item < 192; item += nblk) {
        const int l = item / 96, j0 = (item % 96) * 64, jj = tid & 63, kq = tid >> 6;
        float acc[8];
#pragma unroll
        for (int b = 0; b < 8; ++b) acc[b] = 0.f;
        const float* w = w_ada + (size_t)l * DM * 6144 + j0 + jj;
#pragma unroll 16
        for (int k = kq * 128; k < kq * 128 + 128; ++k) { const float wv = w[(size_t)k * 6144];
#pragma unroll
            for (int b = 0; b < 8; ++b) acc[b] += sc[b * 1024 + k] * wv; }
#pragma unroll
        for (int b = 0; b < 8; ++b) part[(kq * 8 + b) * 64 + jj] = acc[b];
        __syncthreads();
        { const int b = tid >> 6, j = tid & 63; float sum = 0.f;
#pragma unroll
          for (int q = 0; q < 8; ++q) sum += part[(q * 8 + b) * 64 + j];
          mod[(size_t)l * 8 * 6144 + (size_t)b * 6144 + j0 + j] = sum + b_ada[l * 6144 + j0 + j]; }
        __syncthreads();
    }
}

struct MoeTiles { int p0, p1, p2, p3, p4, p5, p6, p7; };
__device__ __forceinline__ MoeTiles moe_tiles(const unsigned* ecnt) {
#define ECNT_LD(i) ((int)((__hip_atomic_load(ecnt + (i), __ATOMIC_RELAXED, __HIP_MEMORY_SCOPE_AGENT) + 255u) >> 8))
    MoeTiles m; m.p0 = ECNT_LD(0); m.p1 = ECNT_LD(1); m.p2 = ECNT_LD(2); m.p3 = ECNT_LD(3); m.p4 = ECNT_LD(4); m.p5 = ECNT_LD(5); m.p6 = ECNT_LD(6); m.p7 = ECNT_LD(7); return m;
#undef ECNT_LD
}
__device__ __forceinline__ int moe_tile_start(const MoeTiles& m, int e) {
    int s = 0; s += (e > 0) ? m.p0 : 0; s += (e > 1) ? m.p1 : 0; s += (e > 2) ? m.p2 : 0; s += (e > 3) ? m.p3 : 0; s += (e > 4) ? m.p4 : 0; s += (e > 5) ? m.p5 : 0; s += (e > 6) ? m.p6 : 0; return s;
}
struct NormArgs {
    const float* xin; const bf16* xin16; const float* g; const float* shift; const float* scale;
    bf16* act; unsigned char* act8;
    const float* w_router; int* tok; unsigned* ecnt; int* elist;
    const bf16* ys; const float* gate; float* out;
};
template <int MODE> __device__ __forceinline__ void ph_norm(const NormArgs& a, LAS unsigned char* lds, int bid, int nblk) {
    LAS unsigned* lcnt = (LAS unsigned*)lds; LAS unsigned* lbase = lcnt + 8; typedef int info6[6]; LAS info6* linfo = (LAS info6*)(lds + 64);
    const int tid = otid(), lane = tid & 63, wave = tid >> 6;
    if (MODE == 1) { if (tid < 8) lcnt[tid] = 0u; __syncthreads(); }
    MoeTiles mt; if (MODE == 2) mt = moe_tiles(a.ecnt);
    for (int blk = bid; blk < T / 128; blk += nblk) {
      for (int i4 = 0; i4 < 16; i4 += 4) {
        f32x4 vq[4][4]; u32x2 yq0[4][4], yq1[4][4]; float gq0[4], gq1[4];
#pragma unroll
        for (int q = 0; q < 4; ++q) { const int row_ = blk * 128 + wave + 8 * (i4 + q);
            if (a.xin) { const f32x4* xr = (const f32x4*)(a.xin + (size_t)row_ * DM) + lane;
#pragma unroll
                for (int j = 0; j < 4; ++j) vq[q][j] = xr[64 * j]; }
            else { const u32x2* xr = (const u32x2*)(a.xin16 + (size_t)row_ * DM) + lane;
#pragma unroll
                for (int j = 0; j < 4; ++j) { const u32x2 w = xr[64 * j];
                    vq[q][j] = (f32x4){__uint_as_float(w.x << 16), __uint_as_float(w.x & 0xffff0000u), __uint_as_float(w.y << 16), __uint_as_float(w.y & 0xffff0000u)}; } }
            if (MODE == 2) {
                const int* ti = a.tok + (size_t)row_ * 8; const int e0 = ti[0], e1 = ti[1], p0 = ti[2], p1 = ti[3]; gq0[q] = __int_as_float(ti[4]); gq1[q] = __int_as_float(ti[5]);
                const size_t s0 = (size_t)moe_tile_start(mt, e0) * 256 + p0, s1 = (size_t)moe_tile_start(mt, e1) * 256 + p1;
                const u32x2* y0 = (const u32x2*)(a.ys + s0 * DM) + lane; const u32x2* y1 = (const u32x2*)(a.ys + s1 * DM) + lane;
#pragma unroll
                for (int j = 0; j < 4; ++j) { yq0[q][j] = y0[64 * j]; yq1[q][j] = y1[64 * j]; } } }
#pragma unroll
        for (int q = 0; q < 4; ++q) {
            const int i = i4 + q;
            const int lr = wave + 8 * i, row = blk * 128 + lr, b = row / SEQ;
            f32x4 v[4];
#pragma unroll
            for (int j = 0; j < 4; ++j) v[j] = vq[q][j];
            if (MODE == 2) {
                const float g0 = gq0[q], g1 = gq1[q];
                const f32x4* gt = (const f32x4*)(a.gate + (size_t)b * 6144) + lane;
#pragma unroll
                for (int j = 0; j < 4; ++j) { const u32x2 a0 = yq0[q][j], a1 = yq1[q][j]; const f32x4 gv = gt[64 * j];
                    f32x4 y; y.x = g0 * bf2f(a0.x & 0xffffu) + g1 * bf2f(a1.x & 0xffffu); y.y = g0 * bf2f(a0.x >> 16) + g1 * bf2f(a1.x >> 16);
                    y.z = g0 * bf2f(a0.y & 0xffffu) + g1 * bf2f(a1.y & 0xffffu); y.w = g0 * bf2f(a0.y >> 16) + g1 * bf2f(a1.y >> 16);
                    v[j] = v[j] + gv * y; }
            }
            float ss = 0.f;
#pragma unroll
            for (int j = 0; j < 4; ++j) ss += (v[j].x * v[j].x + v[j].y * v[j].y) + (v[j].z * v[j].z + v[j].w * v[j].w);
            const float rstd = rsqrtf(wave_sum(ss) * (1.0f / DM) + EPS);
            const f32x4* gp = (const f32x4*)a.g + lane;
            if (MODE == 2) {
                f32x4* o = (f32x4*)(a.out + (size_t)row * DM) + lane;
#if defined(PROBE_T) || defined(PROBE_A)
                { const unsigned long long* tp = (const unsigned long long*)(a.ecnt - CW_ECNT); const float code_ = (float)((tp[151] / (tp[152] ? tp[152] : 1ull)) / 250ull) * 10.0f;
#pragma unroll
                  for (int j = 0; j < 4; ++j) v[j] = v[j] * (1.0f + 0.001f * code_); }
#endif
#pragma unroll
                for (int j = 0; j < 4; ++j) o[64 * j] = v[j] * rstd * gp[64 * j];
            } else {
                const f32x4* sh = (const f32x4*)(a.shift + (size_t)b * 6144) + lane; const f32x4* sc = (const f32x4*)(a.scale + (size_t)b * 6144) + lane;
#pragma unroll
                for (int j = 0; j < 4; ++j) v[j] = v[j] * rstd * gp[64 * j] * (sc[64 * j] + 1.0f) + sh[64 * j];
                if (a.act8) { unsigned* o = (unsigned*)(a.act8 + (size_t)row * DM) + lane;
#pragma unroll
                    for (int j = 0; j < 4; ++j) o[64 * j] = pg8::pk4_fp8(v[j].x, v[j].y, v[j].z, v[j].w); }
                if (a.act) { u32x2* o = (u32x2*)(a.act + (size_t)row * DM) + lane;
#pragma unroll
                    for (int j = 0; j < 4; ++j) { u32x2 w; w.x = pk2(v[j].x, v[j].y); w.y = pk2(v[j].z, v[j].w); o[64 * j] = w; } }
                if (MODE == 1) {
                    float lg[8];
#pragma unroll
                    for (int e = 0; e < 8; ++e) lg[e] = 0.f;
#pragma unroll
                    for (int j = 0; j < 4; ++j) { const float hv[4] = {v[j].x, v[j].y, v[j].z, v[j].w};
#pragma unroll
                        for (int q = 0; q < 4; ++q) { const f32x4* wr = (const f32x4*)(a.w_router + (size_t)(256 * j + 4 * lane + q) * 8); const f32x4 w0 = wr[0], w1 = wr[1];
                            lg[0] += hv[q] * w0.x; lg[1] += hv[q] * w0.y; lg[2] += hv[q] * w0.z; lg[3] += hv[q] * w0.w; lg[4] += hv[q] * w1.x; lg[5] += hv[q] * w1.y; lg[6] += hv[q] * w1.z; lg[7] += hv[q] * w1.w; } }
#pragma unroll
                    for (int e = 0; e < 8; ++e) lg[e] = wave_sum(lg[e]);
                    int e0 = 0; float v0 = lg[0];
#pragma unroll
                    for (int e = 1; e < 8; ++e) if (lg[e] > v0) { v0 = lg[e]; e0 = e; }
                    int e1 = -1; float v1 = -INFINITY;
#pragma unroll
                    for (int e = 0; e < 8; ++e) if (e != e0 && lg[e] > v1) { v1 = lg[e]; e1 = e; }
                    const float g0 = 1.0f / (1.0f + __expf(v1 - v0)), g1 = 1.0f - g0;
                    if (lane == 0) { const unsigned q0 = __hip_atomic_fetch_add(&lcnt[e0], 1u, __ATOMIC_RELAXED, __HIP_MEMORY_SCOPE_WORKGROUP), q1 = __hip_atomic_fetch_add(&lcnt[e1], 1u, __ATOMIC_RELAXED, __HIP_MEMORY_SCOPE_WORKGROUP);
                        linfo[lr][0] = e0; linfo[lr][1] = e1; linfo[lr][2] = (int)q0; linfo[lr][3] = (int)q1; linfo[lr][4] = __float_as_int(g0); linfo[lr][5] = __float_as_int(g1); }
                }
            }
        }
      }
        if (MODE == 1) {
            __syncthreads();
            if (tid < 8) { lbase[tid] = atomicAdd(&a.ecnt[tid], lcnt[tid]); }
            __syncthreads();
            if (tid < 128) { int* ti = a.tok + (size_t)(blk * 128 + tid) * 8; const int e0 = linfo[tid][0], e1 = linfo[tid][1];
                const int p0_ = linfo[tid][2] + (int)lbase[e0], p1_ = linfo[tid][3] + (int)lbase[e1];
                ti[0] = e0; ti[1] = e1; ti[2] = p0_; ti[3] = p1_; ti[4] = linfo[tid][4]; ti[5] = linfo[tid][5]; ti[6] = 0; ti[7] = 0;
                if (a.elist) { a.elist[e0 * T + p0_] = blk * 128 + tid; a.elist[e1 * T + p1_] = blk * 128 + tid; } }
            __syncthreads();
            if (tid < 8) lcnt[tid] = 0u;
            __syncthreads();
        }
    }
}
__device__ __forceinline__ void ph_gather(const unsigned char* act8, const int* tok, const unsigned* ecnt, unsigned char* xs8, int bid, int nblk) {
    const int lane = otid() & 63, gw = bid * 8 + (otid() >> 6), ngw = nblk * 8;
    const MoeTiles mt = moe_tiles(ecnt);
    for (int t = gw; t < T; t += 4 * ngw) {
        int e0[4], e1[4], p0[4], p1[4]; u32x4 a0[4];
#pragma unroll
        for (int q = 0; q < 4; ++q) { const int* ti = tok + (size_t)(t + q * ngw) * 8; e0[q] = ti[0]; e1[q] = ti[1]; p0[q] = ti[2]; p1[q] = ti[3];
            a0[q] = ((const u32x4*)(act8 + (size_t)(t + q * ngw) * DM))[lane]; }
#pragma unroll
        for (int q = 0; q < 4; ++q) { const size_t s0 = (size_t)moe_tile_start(mt, e0[q]) * 256 + p0[q], s1 = (size_t)moe_tile_start(mt, e1[q]) * 256 + p1[q];
            ((u32x4*)(xs8 + s0 * DM))[lane] = a0[q]; ((u32x4*)(xs8 + s1 * DM))[lane] = a0[q]; }
    }
    for (int i = gw; i < 8 * 256; i += ngw) { const int e = i >> 8, r = i & 255; const int cnt = (int)__hip_atomic_load(ecnt + e, __ATOMIC_RELAXED, __HIP_MEMORY_SCOPE_AGENT); const int padded = ((cnt + 255) >> 8) << 8;
        if (cnt + r < padded) { unsigned z0 = 0u; asm volatile("" : "+v"(z0)); const u32x4 z = {z0, z0, z0, z0};
            ((u32x4*)(xs8 + ((size_t)moe_tile_start(mt, e) * 256 + cnt + r) * DM))[lane] = z; } }
}

__device__ __forceinline__ void ld16(const bf16* p, float (&f)[16]) { ld8(p, &f[0]); ld8(p + 8, &f[8]); }
__device__ __forceinline__ float dot16x4(const float (&q)[16], const bf16* p) {
    float f[16]; ld16(p, f); float s0 = 0.f, s1 = 0.f;
#pragma unroll
    for (int i = 0; i < 16; i += 2) { s0 += q[i] * f[i]; s1 += q[i + 1] * f[i + 1]; }
    float s = s0 + s1; s += __shfl_xor(s, 1); s += __shfl_xor(s, 2); return s;
}
__device__ __forceinline__ void axpy16(float (&o)[16], float w, const bf16* p) {
    float f[16]; ld16(p, f);
#pragma unroll
    for (int i = 0; i < 16; ++i) o[i] += w * f[i];
}
__device__ __forceinline__ void head_norm_store16(float (&o)[16], const float* gh, bf16* dst) {
    float ss = 0.f;
#pragma unroll
    for (int i = 0; i < 16; ++i) ss += o[i] * o[i];
    ss += __shfl_xor(ss, 1); ss += __shfl_xor(ss, 2);
    const float r = rsqrtf(ss * (1.0f / 64.0f) + EPS);
#pragma unroll
    for (int i = 0; i < 2; ++i) { u32x4 w; const float* q = &o[8 * i]; const float* g = gh + 8 * i;
        w.x = pk2(q[0] * r * g[0], q[1] * r * g[1]); w.y = pk2(q[2] * r * g[2], q[3] * r * g[3]); w.z = pk2(q[4] * r * g[4], q[5] * r * g[5]); w.w = pk2(q[6] * r * g[6], q[7] * r * g[7]);
        *(u32x4*)(dst + 8 * i) = w; }
}
#define OSM_STEP(s, vrow) do { if ((s) > m) { const float a_ = __expf(m - (s)); l *= a_; _Pragma("unroll") for (int d_ = 0; d_ < 16; ++d_) o[d_] *= a_; m = (s); } \
    const float p_ = __expf((s) - m); l += p_; axpy16(o, p_, (vrow)); } while (0)
#define NAIVE_IDX() const int part = gidx & 3, idx = gidx >> 2; const int t = idx & (SEQ - 1), h = (idx >> 12) & 3, b = idx >> 14; const int po = 16 * part

__device__ __forceinline__ void sb_naive_one(const bf16* P, const float* gh, bf16* act, int gidx) {
    NAIVE_IDX();
    const bf16* Pb = P + (size_t)b * SEQ * PW + po;
    float q[16], o[16];
    ld16(Pb + (size_t)t * PW + h * 64, q);
#pragma unroll
    for (int i = 0; i < 16; ++i) o[i] = 0.f;
    float carry = 1.0f;
    for (int s = t - 1; s >= 0; --s) {
        float z = dot16x4(q, Pb + (size_t)s * PW + 256 + h * 64); z = fminf(fmaxf(z, -80.f), 80.f);
        const float e = __expf(z), om = 1.0f / (1.0f + e), beta = e * om, aw = beta * carry;
        axpy16(o, aw, Pb + (size_t)s * PW + 512 + h * 64);
        carry *= om;
        if (carry < 1e-30f) break;
    }
    head_norm_store16(o, gh + h * 64 + po, act + (size_t)(b * SEQ + t) * DM + h * 64 + po);
}
__device__ __forceinline__ void dil_naive_one(const bf16* P, const float* gh, bf16* act, int gidx) {
    NAIVE_IDX();
    const bf16* Pb = P + (size_t)b * SEQ * PW + 1536 + po;
    const float slope = alibi_slope(1, h);
    float q[16], o[16];
    ld16(Pb + (size_t)t * PW + h * 64, q);
#pragma unroll
    for (int i = 0; i < 16; ++i) o[i] = 0.f;
    float m = -INFINITY, l = 0.f;
    for (int br = 0; br < 3; ++br) { const int dil = br == 0 ? 1 : (br == 1 ? 4 : 16);
        for (int j = 0; j <= 128; ++j) { const int dist = j * dil, kp = t - dist; if (kp < 0) break;
            const float s = dot16x4(q, Pb + (size_t)kp * PW + 256 + h * 64) - slope * (float)dist;
            OSM_STEP(s, Pb + (size_t)kp * PW + 512 + h * 64); } }
    const float rl = 1.0f / l;
#pragma unroll
    for (int i = 0; i < 16; ++i) o[i] *= rl;
    head_norm_store16(o, gh + (8 + h) * 64 + po, act + (size_t)(b * SEQ + t) * DM + (8 + h) * 64 + po);
}
__device__ __forceinline__ unsigned moba_sel_one(const float (&q)[16], const float* kmean, int b, int t, int h, int po) {
    const int own = t >> 8; unsigned sel = 0u;
    if (own <= 3) sel = (1u << own) - 1u;
    else {
        float g[16];
#pragma unroll
        for (int blk = 0; blk < 16; ++blk) { float s = -INFINITY;
            if (blk < own) { const float* km = kmean + ((size_t)b * 16 + blk) * 256 + h * 64 + po; s = 0.f;
#pragma unroll
                for (int d = 0; d < 16; ++d) s += q[d] * km[d];
                s += __shfl_xor(s, 1); s += __shfl_xor(s, 2); }
            g[blk] = s; }
#pragma unroll
        for (int r = 0; r < 3; ++r) { int bi = 0; float bv = -INFINITY;
#pragma unroll
            for (int blk = 0; blk < 16; ++blk) { const bool free_ = !((sel >> blk) & 1u); if (free_ && g[blk] > bv) { bv = g[blk]; bi = blk; } }
            sel |= 1u << bi; }
    }
    return sel;
}
template <int MODE> __device__ __forceinline__ void masked_naive_one(const bf16* P, const unsigned long long* mask, const float* kmean, const float* gh, bf16* act, int gidx) {
    NAIVE_IDX();
    const int cb = MODE == 0 ? 768 : 2304, hb = MODE == 0 ? 4 : 12;
    const bf16* Pb = P + (size_t)b * SEQ * PW + cb + po;
    const float slope = alibi_slope(MODE == 0 ? 0 : 2, h);
    float q[16], o[16];
    ld16(Pb + (size_t)t * PW + h * 64, q);
#pragma unroll
    for (int i = 0; i < 16; ++i) o[i] = 0.f;
    float m = -INFINITY, l = 0.f;
    if (MODE == 0) {
        const unsigned long long* mr = mask + (size_t)(b * SEQ + t) * 64;
        for (int w = 0; w <= (t >> 6); ++w) { unsigned long long bits = mr[w];
            while (bits) { const int j = __builtin_ctzll(bits); bits &= bits - 1; const int kp = w * 64 + j;
                const float s = dot16x4(q, Pb + (size_t)kp * PW + 256 + h * 64) - slope * (float)(t - kp);
                OSM_STEP(s, Pb + (size_t)kp * PW + 512 + h * 64); } }
    } else {
        const int own = t >> 8; const unsigned sel = moba_sel_one(q, kmean, b, t, h, po);
        for (int blk = 0; blk <= own; ++blk) { if (blk < own && !((sel >> blk) & 1u)) continue;
            const int kend = blk == own ? t : blk * 256 + 255;
            for (int kp = blk * 256; kp <= kend; ++kp) {
                const float s = dot16x4(q, Pb + (size_t)kp * PW + 256 + h * 64) - slope * (float)(t - kp);
                OSM_STEP(s, Pb + (size_t)kp * PW + 512 + h * 64); } }
    }
    const float rl = 1.0f / l;
#pragma unroll
    for (int i = 0; i < 16; ++i) o[i] *= rl;
    head_norm_store16(o, gh + (hb + h) * 64 + po, act + (size_t)(b * SEQ + t) * DM + (hb + h) * 64 + po);
}
__device__ __forceinline__ void kmean_unit(const bf16* P, float* kmean, unsigned* knmax, int unit, LAS unsigned char* lds) {
    const int tid = otid();
    const int b = unit >> 4, blk = unit & 15;
    { const int g = tid >> 5, c8 = tid & 31;
      const bf16* p = P + ((size_t)b * SEQ + blk * 256 + g * 16) * PW + 2304 + 256 + c8 * 8;
      float s[8];
#pragma unroll
      for (int i = 0; i < 8; ++i) s[i] = 0.f;
#pragma unroll
      for (int r = 0; r < 16; ++r) { float f[8]; ld8(p + (size_t)r * PW, f);
#pragma unroll
          for (int i = 0; i < 8; ++i) s[i] += f[i]; }
      LAS float* part = (LAS float*)lds;
#pragma unroll
      for (int i = 0; i < 8; ++i) part[g * 256 + c8 * 8 + i] = s[i];
      __syncthreads();
      if (tid < 256) { float t = 0.f;
#pragma unroll
          for (int g2 = 0; g2 < 16; ++g2) t += part[g2 * 256 + tid];
          kmean[(size_t)unit * 256 + tid] = t * (1.0f / 256.0f); } }
    { const int key = tid >> 1, mx = tid & 1; const bf16* kr = P + ((size_t)b * SEQ + blk * 256 + key) * PW + (mx ? 2304 : 768) + 256;
#pragma unroll
      for (int h = 0; h < 4; ++h) { float ss = 0.f;
#pragma unroll
          for (int c8 = 0; c8 < 8; ++c8) { float f[8]; ld8(kr + h * 64 + 8 * c8, f);
#pragma unroll
              for (int i = 0; i < 8; ++i) ss += f[i] * f[i]; }
          float nm = sqrtf(ss);
#pragma unroll
          for (int o_ = 2; o_ < 64; o_ <<= 1) nm = fmaxf(nm, __shfl_xor(nm, o_));
          if ((tid & 63) < 2) atomicMax(&knmax[(b * 2 + mx) * 4 + h], __float_as_uint(nm)); } }
    __syncthreads();
}
constexpr int DSA_LDS = 8 * 4096 * 4;
#define DSA_COUNT_GE(trial, out) do { int cl0_ = 0, cl1_ = 0; const unsigned t_ = (unsigned)__builtin_amdgcn_readfirstlane((int)(trial)); \
    _Pragma("unroll") for (int g_ = 0; g_ < 8; ++g_) if (g_ * 8 < nreg) { \
        asm volatile("v_cmp_le_u32_e32 vcc, %10, %2\n\tv_addc_co_u32_e32 %0, vcc, 0, %0, vcc\n\tv_cmp_le_u32_e32 vcc, %10, %3\n\tv_addc_co_u32_e32 %1, vcc, 0, %1, vcc\n\t" \
                     "v_cmp_le_u32_e32 vcc, %10, %4\n\tv_addc_co_u32_e32 %0, vcc, 0, %0, vcc\n\tv_cmp_le_u32_e32 vcc, %10, %5\n\tv_addc_co_u32_e32 %1, vcc, 0, %1, vcc\n\t" \
                     "v_cmp_le_u32_e32 vcc, %10, %6\n\tv_addc_co_u32_e32 %0, vcc, 0, %0, vcc\n\tv_cmp_le_u32_e32 vcc, %10, %7\n\tv_addc_co_u32_e32 %1, vcc, 0, %1, vcc\n\t" \
                     "v_cmp_le_u32_e32 vcc, %10, %8\n\tv_addc_co_u32_e32 %0, vcc, 0, %0, vcc\n\tv_cmp_le_u32_e32 vcc, %10, %9\n\tv_addc_co_u32_e32 %1, vcc, 0, %1, vcc" \
                     : "+v"(cl0_), "+v"(cl1_) : "v"(K[g_ * 8 + 0]), "v"(K[g_ * 8 + 1]), "v"(K[g_ * 8 + 2]), "v"(K[g_ * 8 + 3]), "v"(K[g_ * 8 + 4]), "v"(K[g_ * 8 + 5]), "v"(K[g_ * 8 + 6]), "v"(K[g_ * 8 + 7]), "s"(t_) : "vcc"); } \
    const int cl_ = cl0_ + cl1_; int c_ = 0; \
    _Pragma("unroll") for (int b_ = 0; b_ < 7; ++b_) c_ += __builtin_popcountll(__ballot((cl_ >> b_) & 1)) << b_; \
    (out) = c_; } while (0)
typedef float f32x2_t __attribute__((ext_vector_type(2)));
#ifdef DSA_BITSLICE
#define DSA_SLOT(key) ((((key) & 63) << 6) + ((((key) >> 6) ^ (key)) & 63))
__device__ __forceinline__ int dsa_scan(int v) {
    v += __builtin_amdgcn_update_dpp(0, v, 0x111, 0xf, 0xf, false);
    v += __builtin_amdgcn_update_dpp(0, v, 0x112, 0xf, 0xf, false);
    v += __builtin_amdgcn_update_dpp(0, v, 0x114, 0xf, 0xe, false);
    v += __builtin_amdgcn_update_dpp(0, v, 0x118, 0xf, 0xc, false);
    v += __builtin_amdgcn_update_dpp(0, v, 0x142, 0xa, 0xf, false);
    v += __builtin_amdgcn_update_dpp(0, v, 0x143, 0xc, 0xf, false);
    return v; }
#else
#define DSA_SLOT(key) (key)
#endif
__device__ __forceinline__ void dsa_select_unit(const bf16* P, unsigned long long* mask, int unit, LAS unsigned* sc) {
#ifdef PROBE_T
    long long tacc = 0;
#define TSTAMP(beg_of, end_of) do { asm volatile("s_waitcnt lgkmcnt(0)" ::: "memory"); const long long c_ = clock64(); if (PROBE_T == (beg_of) || (PROBE_T == 5 && (beg_of) == 1)) tacc -= c_; if (PROBE_T == (end_of) || (PROBE_T == 5 && (end_of) == 4)) tacc += c_; } while (0)
#else
#define TSTAMP(a, b) do {} while (0)
#endif
    const int tid = otid(), lane = tid & 63, wid = tid >> 6, r32 = lane & 31, hi = lane >> 5;
    const int b = unit >> 9, t0 = (unit & 511) * 8;
    const bf16* Pb = P + (size_t)b * SEQ * PW;
    const int hrow = (r32 & 3) + 4 * ((r32 >> 3) & 1), qrow = 2 * ((r32 >> 2) & 1) + ((r32 >> 4) & 1);
    bf16x8 af[2][4];
#pragma unroll
    for (int qg = 0; qg < 2; ++qg)
#pragma unroll
        for (int s = 0; s < 4; ++s) af[qg][s] = *(const bf16x8*)(Pb + (size_t)(t0 + 4 * qg + qrow) * PW + COL_QI + hrow * 64 + 16 * s + 8 * hi);
    float wv[2][2][8];
#pragma unroll
    for (int qg = 0; qg < 2; ++qg)
#pragma unroll
        for (int qq = 0; qq < 2; ++qq) ld8(Pb + (size_t)(t0 + 4 * qg + 2 * hi + qq) * PW + COL_WI, wv[qg][qq]);
    const int ntile = (t0 + 8 + 31) >> 5;
    {
        bf16x8 fa[4], fb[4], fc[4];
#define DSA_LOAD(F, kt_) do { if ((kt_) < ntile) { _Pragma("unroll") for (int s = 0; s < 4; ++s) F[s] = *(const bf16x8*)(Pb + (size_t)((kt_) * 32 + r32) * PW + COL_KI + 16 * s + 8 * hi); } } while (0)
#define DSA_SCORE(F, kt_) do { if ((kt_) < ntile) { const int key = (kt_) * 32 + r32; \
            _Pragma("unroll") for (int qg = 0; qg < 2; ++qg) { \
                f32x16 acc = {0.f, 0.f, 0.f, 0.f, 0.f, 0.f, 0.f, 0.f, 0.f, 0.f, 0.f, 0.f, 0.f, 0.f, 0.f, 0.f}; \
                _Pragma("unroll") for (int s = 0; s < 4; ++s) acc = __builtin_amdgcn_mfma_f32_32x32x16_bf16(af[qg][s], F[s], acc, 0, 0, 0); \
                _Pragma("unroll") for (int qq = 0; qq < 2; ++qq) { float sA_ = 0.f, sB_ = 0.f; \
                    _Pragma("unroll") for (int h = 0; h < 8; h += 2) { sA_ = __builtin_fmaf(__builtin_amdgcn_fmed3f(acc[8 * qq + h], 0.f, 3.0e38f), wv[qg][qq][h], sA_); \
                        asm("" : "+v"(sA_));       \
                        sB_ = __builtin_fmaf(__builtin_amdgcn_fmed3f(acc[8 * qq + h + 1], 0.f, 3.0e38f), wv[qg][qq][h + 1], sB_); } \
                    const float s = sA_ + sB_;        \
                    const int ql = 4 * qg + 2 * hi + qq; \
                    const unsigned u = __float_as_uint(s); const unsigned sk = (u & 0x80000000u) ? ~u : (u | 0x80000000u); \
                    sc[ql * 4096 + DSA_SLOT(key)] = (key <= t0 + ql) ? sk : 0u; } } } } while (0)
#if defined(PROBE_SUB) && PROBE_SUB == 7
        for (int rep_ = 0; rep_ < 2; ++rep_) {
#endif
        int kt = wid;
        DSA_LOAD(fa, kt); DSA_LOAD(fb, kt + 8);
        while (kt < ntile) {
            DSA_LOAD(fc, kt + 16); DSA_SCORE(fa, kt);
            DSA_LOAD(fa, kt + 24); DSA_SCORE(fb, kt + 8);
            DSA_LOAD(fb, kt + 32); DSA_SCORE(fc, kt + 16);
            kt += 24;
        }
#if defined(PROBE_SUB) && PROBE_SUB == 7
        }
#endif
#undef DSA_LOAD
#undef DSA_SCORE
    }
    __syncthreads();
#if defined(PROBE_SUB) && PROBE_SUB == 8
    unsigned long long first_word = 0ull;
    for (int rep_ = 0; rep_ < 2; ++rep_)
#endif
    {
        const int t = t0 + wid, nvalid = t + 1, nk = ntile * 32, nreg = (nk + 63) >> 6;
        unsigned long long myword = 0ull;
        if (nvalid <= 256) {
            const int lo = lane * 64; myword = (nvalid >= lo + 64) ? ~0ull : (nvalid > lo ? ((1ull << (nvalid - lo)) - 1ull) : 0ull);
        } else {
#ifdef DSA_BITSLICE
            LAS unsigned* row = sc + wid * 4096;
            unsigned A[64];
#pragma unroll
            for (int r = 0; r < 64; ++r) A[r] = row[r * 64 + ((lane ^ r) & 63)];
#pragma unroll
            for (int blk = 0; blk < 64; blk += 32) {
#pragma unroll
                for (int js = 0; js < 5; ++js) { const int j = 16 >> js; const unsigned m = js == 0 ? 0x0000FFFFu : (js == 1 ? 0x00FF00FFu : (js == 2 ? 0x0F0F0F0Fu : (js == 3 ? 0x33333333u : 0x55555555u)));
#pragma unroll
                    for (int k = 0; k < 32; ++k) if ((k & j) == 0) { const unsigned a_ = A[blk + k], b_ = A[blk + k + j];
                        A[blk + k] = (a_ & ~(m << j)) | ((b_ << j) & (m << j)); A[blk + k + j] = (b_ & ~m) | ((a_ >> j) & m); } } }
            const int lim_ = nk - 64 * lane; const unsigned long long vm = lim_ >= 64 ? ~0ull : (lim_ <= 0 ? 0ull : ((1ull << lim_) - 1ull));
            unsigned c_lo = (unsigned)vm, c_hi = (unsigned)(vm >> 32), g_lo = 0u, g_hi = 0u; int need = 256, ncand = nk;
#pragma unroll
            for (int bb = 31; bb >= 0; --bb) {
                if (ncand != need) {
                const unsigned x_lo = c_lo & A[bb], x_hi = c_hi & A[32 + bb];
                const int cnt = __builtin_amdgcn_readlane(dsa_scan(__builtin_popcount(x_lo) + __builtin_popcount(x_hi)), 63);
                const bool up = cnt >= need;
                const unsigned fl = up ? 0u : ~0u;
                c_lo &= (A[bb] ^ fl); c_hi &= (A[32 + bb] ^ fl);
                g_lo |= x_lo & fl; g_hi |= x_hi & fl;
                need -= up ? 0 : cnt; ncand = up ? cnt : ncand - cnt; }
            }
            { const int mine = __builtin_popcount(c_lo) + __builtin_popcount(c_hi); const int incl = dsa_scan(mine); const int tot = __builtin_amdgcn_readlane(incl, 63);
              unsigned long long eq = ((unsigned long long)c_hi << 32) | c_lo;
              if (tot != need) { int k_ = need - (incl - mine); k_ = k_ < 0 ? 0 : (k_ > mine ? mine : k_);
                  while (__builtin_popcountll(eq) > k_) eq &= ~(1ull << (63 - __builtin_clzll(eq))); }
              myword = (((unsigned long long)g_hi << 32) | g_lo) | eq; }
#else
            LAS unsigned* row = sc + wid * 4096;
            unsigned K[64];
            TSTAMP(1, 0);
#pragma unroll
            for (int r = 0; r < 64; ++r) K[r] = (r * 64 + lane < nk) ? row[r * 64 + lane] : 0u;
            TSTAMP(2, 1);
            unsigned prefix = 0u; int cnt_prefix = 4096, c_above = 0, bit = 32;
            { int ca, cb; DSA_COUNT_GE(0xBC000000u, ca);
              if (ca >= 256) { DSA_COUNT_GE(0xC0000000u, cb);
                  if (cb < 256) { int cm; DSA_COUNT_GE(0xBE000000u, cm);
                      if (cm >= 256) { prefix = 0xBE000000u; cnt_prefix = cm; c_above = cb; } else { prefix = 0xBC000000u; cnt_prefix = ca; c_above = cm; }
                      bit = 25; } } }
            while (bit > 0 && cnt_prefix - c_above > 128) { --bit; const unsigned trial = prefix | (1u << bit); int cnt; DSA_COUNT_GE(trial, cnt);
                if (cnt >= 256) { prefix = trial; cnt_prefix = cnt; } else c_above = cnt; }
            TSTAMP(3, 2);
            if (bit > 0) {
                const unsigned himask = ~((1u << bit) - 1u); const unsigned long long below = (1ull << lane) - 1ull; int base = 0;
#pragma unroll
                for (int g = 0; g < 8; ++g) if (g * 8 < nreg) {
#pragma unroll
                    for (int r = 0; r < 8; ++r) { const unsigned k = K[g * 8 + r]; const bool in = (k & himask) == prefix; const unsigned long long mk = __ballot(in);
                        if (in) row[base + __builtin_popcountll(mk & below)] = k; base += __builtin_popcountll(mk); } }
                const unsigned C0 = (lane < base) ? row[lane] : 0u, C1 = (64 + lane < base) ? row[64 + lane] : 0u;
                while (bit > 1) { bit -= 2; const unsigned t1 = prefix | (1u << bit), t2 = prefix | (2u << bit), t3 = prefix | (3u << bit);
                    const int n1 = c_above + __builtin_popcountll(__ballot(C0 >= t1)) + __builtin_popcountll(__ballot(C1 >= t1));
                    const int n2 = c_above + __builtin_popcountll(__ballot(C0 >= t2)) + __builtin_popcountll(__ballot(C1 >= t2));
                    const int n3 = c_above + __builtin_popcountll(__ballot(C0 >= t3)) + __builtin_popcountll(__ballot(C1 >= t3));
                    if (n3 >= 256) { prefix = t3; cnt_prefix = n3; } else if (n2 >= 256) { prefix = t2; cnt_prefix = n2; } else if (n1 >= 256) { prefix = t1; cnt_prefix = n1; } }
                if (bit > 0) { --bit; const unsigned trial = prefix | (1u << bit);
                    const int cnt = c_above + __builtin_popcountll(__ballot(C0 >= trial)) + __builtin_popcountll(__ballot(C1 >= trial));
                    if (cnt >= 256) { prefix = trial; cnt_prefix = cnt; } }
            }
            TSTAMP(4, 3);
            if (cnt_prefix == 256) {
#pragma unroll
                for (int g = 0; g < 8; ++g) if (g * 8 < nreg) {
#pragma unroll
                    for (int r = 0; r < 8; ++r) { const unsigned long long word = __ballot(K[g * 8 + r] >= prefix); if (lane == g * 8 + r) myword = word; } }
            } else {
                int cgt; DSA_COUNT_GE(prefix + 1u, cgt);
                int need = 256 - cgt;
                const unsigned long long below = (1ull << lane) - 1ull;
#pragma unroll
                for (int g = 0; g < 8; ++g) if (g * 8 < nreg) {
#pragma unroll
                    for (int r = 0; r < 8; ++r) { const unsigned k = K[g * 8 + r];
                        const unsigned long long gt = __ballot(k > prefix), eq = __ballot(k == prefix);
                        const int c = __builtin_popcountll(eq); unsigned long long take;
                        if (c <= need) { take = eq; need -= c; }
                        else { const bool mine = ((eq >> lane) & 1ull) && (__builtin_popcountll(eq & below) < need); take = __ballot(mine); need = 0; }
                        const unsigned long long word = gt | take;
                        if (lane == g * 8 + r) myword = word; } }
            }
#endif
        }
#if defined(PROBE_SUB) && PROBE_SUB == 8
        if (rep_ == 0) first_word = myword; myword = first_word;
#endif
        if (nvalid > 256) TSTAMP(0, 4);
#ifdef PROBE_T
        if (blockIdx.x == 0 && tid == 0 && nvalid > 256) { unsigned long long* tp = (unsigned long long*)((unsigned char*)mask - WS_MASK); atomicAdd(&tp[151], (unsigned long long)tacc); atomicAdd(&tp[152], 1ull); }
#endif
        mask[(size_t)(b * SEQ + t) * 64 + lane] = myword;
    }
    __syncthreads();
}

#define MFMA32(a, b, c) __builtin_amdgcn_mfma_f32_32x32x16_bf16(a, b, c, 0, 0, 0)
__device__ __forceinline__ int crow(int r, int hi) { return (r & 3) + 8 * (r >> 2) + 4 * hi; }
__device__ __forceinline__ float xh_max(float v) { const auto r = __builtin_amdgcn_permlane32_swap(__float_as_uint(v), __float_as_uint(v), false, false); return fmaxf(__uint_as_float(r[0]), __uint_as_float(r[1])); }
__device__ __forceinline__ float xh_sum(float v) { const auto r = __builtin_amdgcn_permlane32_swap(__float_as_uint(v), __float_as_uint(v), false, false); return __uint_as_float(r[0]) + __uint_as_float(r[1]); }
__device__ __forceinline__ float xh_other(float v, int hi) { const auto r = __builtin_amdgcn_permlane32_swap(__float_as_uint(v), __float_as_uint(v), false, false); return __uint_as_float(hi ? r[0] : r[1]); }
constexpr int AT_KROW = 144, AT_VROW = 136;
constexpr int AT_KBUF = 64 * AT_KROW, AT_VBUF = 64 * AT_VROW;
constexpr int AT_KOFF = 0, AT_VOFF = 2 * AT_KBUF, AT_KMOFF = AT_VOFF + 2 * AT_VBUF, AT_MISC = AT_KMOFF + 4096;
typedef short s16x4 __attribute__((ext_vector_type(4)));

__device__ __forceinline__ void at_load(const bf16* Pb, int k0, int kcol, int vcol, int tid, u32x4& kr, u32x4& vr) {
    const bf16* row = Pb + (size_t)(k0 + (tid >> 3)) * PW + (tid & 7) * 8;
    kr = *(const u32x4*)(row + kcol); vr = *(const u32x4*)(row + vcol);
}
__device__ __forceinline__ void at_store(LAS unsigned char* lds, int buf, int tid, const u32x4& kr, const u32x4& vr) {
    const int key = tid >> 3, c = tid & 7;
    *(LAS u32x4*)(lds + AT_KOFF + buf * AT_KBUF + key * AT_KROW + c * 16) = kr;
#ifdef AT_TR
    *(LAS u32x4*)(lds + AT_VOFF + buf * AT_VBUF + 1024 * (key >> 3) + 512 * (c >> 2) + 64 * (key & 7) + 16 * ((c & 3) ^ ((key >> 2) & 3))) = vr;
}
#else
    LAS unsigned short* vt = (LAS unsigned short*)(lds + AT_VOFF + buf * AT_VBUF + (8 * c) * AT_VROW + key * 2);
    vt[0 * (AT_VROW / 2)] = (unsigned short)(vr.x & 0xffffu); vt[1 * (AT_VROW / 2)] = (unsigned short)(vr.x >> 16);
    vt[2 * (AT_VROW / 2)] = (unsigned short)(vr.y & 0xffffu); vt[3 * (AT_VROW / 2)] = (unsigned short)(vr.y >> 16);
    vt[4 * (AT_VROW / 2)] = (unsigned short)(vr.z & 0xffffu); vt[5 * (AT_VROW / 2)] = (unsigned short)(vr.z >> 16);
    vt[6 * (AT_VROW / 2)] = (unsigned short)(vr.w & 0xffffu); vt[7 * (AT_VROW / 2)] = (unsigned short)(vr.w >> 16);
}
#endif
__device__ __forceinline__ f32x16 at_scores(LAS unsigned char* lds, int buf, int a, int r32, int hi, const bf16x8 (&qf)[4], const f32x16 sinit = (f32x16){0.f, 0.f, 0.f, 0.f, 0.f, 0.f, 0.f, 0.f, 0.f, 0.f, 0.f, 0.f, 0.f, 0.f, 0.f, 0.f}) {
    f32x16 s = sinit;
    const LAS unsigned char* kp = lds + AT_KOFF + buf * AT_KBUF + (32 * a + r32) * AT_KROW + hi * 16;
#pragma unroll
    for (int sp = 0; sp < 4; ++sp) { const bf16x8 kf = *(const LAS bf16x8*)(kp + sp * 32); s = MFMA32(kf, qf[sp], s); }
    return s;
}
__device__ __forceinline__ void at_pv(LAS unsigned char* lds, int buf, int a, int r32, int hi, const f32x16& p, f32x16 (&o)[2]) {
#ifdef AT_TR
    s16x4 vtr[2][2][2];
    { const unsigned q4 = (unsigned)(r32 & 15) >> 2, p4 = (unsigned)r32 & 3u, g16 = ((unsigned)r32 >> 4) & 1u;
      const unsigned vb = (unsigned)(size_t)(lds + AT_VOFF) + (unsigned)(buf * AT_VBUF) + 4096u * (unsigned)a + 64u * (4u * (unsigned)hi + q4) + 8u * (p4 & 1u);
      const unsigned a0 = vb + 16u * ((2u * g16 + (p4 >> 1)) ^ ((unsigned)hi & 3u)), a1 = vb + 16u * ((2u * g16 + (p4 >> 1)) ^ (((unsigned)hi + 2u) & 3u));
      asm volatile("ds_read_b64_tr_b16 %0, %8\n\tds_read_b64_tr_b16 %1, %9 offset:1024\n\tds_read_b64_tr_b16 %2, %8 offset:512\n\tds_read_b64_tr_b16 %3, %9 offset:1536\n\t"
                   "ds_read_b64_tr_b16 %4, %8 offset:2048\n\tds_read_b64_tr_b16 %5, %9 offset:3072\n\tds_read_b64_tr_b16 %6, %8 offset:2560\n\tds_read_b64_tr_b16 %7, %9 offset:3584\n\ts_waitcnt lgkmcnt(0)"
                   : "=&v"(vtr[0][0][0]), "=&v"(vtr[0][0][1]), "=&v"(vtr[0][1][0]), "=&v"(vtr[0][1][1]), "=&v"(vtr[1][0][0]), "=&v"(vtr[1][0][1]), "=&v"(vtr[1][1][0]), "=&v"(vtr[1][1][1])
                   : "v"(a0), "v"(a1) : "memory"); }
#pragma unroll
    for (int s = 0; s < 2; ++s) {
        u32x4 w; w.x = cvt_pk_bf16(p[8 * s + 0], p[8 * s + 1]); w.y = cvt_pk_bf16(p[8 * s + 2], p[8 * s + 3]); w.z = cvt_pk_bf16(p[8 * s + 4], p[8 * s + 5]); w.w = cvt_pk_bf16(p[8 * s + 6], p[8 * s + 7]);
        const bf16x8 pf = __builtin_bit_cast(bf16x8, w);
#pragma unroll
        for (int dh = 0; dh < 2; ++dh) { const bf16x8 vf = {vtr[s][dh][0][0], vtr[s][dh][0][1], vtr[s][dh][0][2], vtr[s][dh][0][3], vtr[s][dh][1][0], vtr[s][dh][1][1], vtr[s][dh][1][2], vtr[s][dh][1][3]};
            o[dh] = MFMA32(vf, pf, o[dh]); }
    }
    return;
#endif
#pragma unroll
    for (int s = 0; s < 2; ++s) {
        u32x4 w; w.x = cvt_pk_bf16(p[8 * s + 0], p[8 * s + 1]); w.y = cvt_pk_bf16(p[8 * s + 2], p[8 * s + 3]); w.z = cvt_pk_bf16(p[8 * s + 4], p[8 * s + 5]); w.w = cvt_pk_bf16(p[8 * s + 6], p[8 * s + 7]);
        const bf16x8 pf = __builtin_bit_cast(bf16x8, w);
#pragma unroll
        for (int dh = 0; dh < 2; ++dh) {
            const LAS unsigned char* vp = lds + AT_VOFF + buf * AT_VBUF + (32 * dh + r32) * AT_VROW + (32 * a + 16 * s + 4 * hi) * 2;
            const s16x4 v0 = *(const LAS s16x4*)vp, v1 = *(const LAS s16x4*)(vp + 16);
            const bf16x8 vf = {v0[0], v0[1], v0[2], v0[3], v1[0], v1[1], v1[2], v1[3]};
            o[dh] = MFMA32(vf, pf, o[dh]);
        }
    }
}
#ifdef WOUT_FP8
typedef unsigned char acto_t;
#else
typedef bf16 acto_t;
#endif
__device__ __forceinline__ void at_finish(f32x16 (&o)[2], float inv_l, int hi, const float* gh, acto_t* dst) {
    float ss = 0.f;
#pragma unroll
    for (int dh = 0; dh < 2; ++dh)
#pragma unroll
        for (int r = 0; r < 16; ++r) { o[dh][r] *= inv_l; ss += o[dh][r] * o[dh][r]; }
    ss = xh_sum(ss);
    const float rn = rsqrtf(ss * (1.0f / 64.0f) + EPS);
#pragma unroll
    for (int dh = 0; dh < 2; ++dh)
#pragma unroll
        for (int g = 0; g < 4; ++g) { const int d = 32 * dh + 8 * g + 4 * hi; const f32x4 gv = *(const f32x4*)(gh + d);
#ifdef WOUT_FP8
            *(unsigned*)(dst + d) = pg8::pk4_fp8(o[dh][4 * g + 0] * rn * gv.x, o[dh][4 * g + 1] * rn * gv.y, o[dh][4 * g + 2] * rn * gv.z, o[dh][4 * g + 3] * rn * gv.w); }
#else
            u32x2 w; w.x = cvt_pk_bf16(o[dh][4 * g + 0] * rn * gv.x, o[dh][4 * g + 1] * rn * gv.y); w.y = cvt_pk_bf16(o[dh][4 * g + 2] * rn * gv.z, o[dh][4 * g + 3] * rn * gv.w);
            *(u32x2*)(dst + d) = w; }
#endif
}

constexpr float LOG2E = 1.4426950408889634f;
template <int MODE> __device__ __forceinline__ void attn_masked_unit(const bf16* P, const unsigned long long* mask, const float* kmean, const unsigned* knmax, const float* gh16, acto_t* act, int b, int h, int qb, LAS unsigned char* lds) {
    const int tid = otid(), lane = tid & 63, wid = tid >> 6, r32 = lane & 31, hi = lane >> 5;
    const int cb = MODE == 0 ? 768 : 2304, hb = MODE == 0 ? 4 : 12;
    const bf16* Pb = P + (size_t)b * SEQ * PW + cb;
    const int kcol = 256 + h * 64, vcol = 512 + h * 64;
    const int q0 = qb * 256, tq = q0 + 32 * wid + r32, qmax = q0 + 32 * wid + 31;
    const float slope2 = alibi_slope(MODE == 0 ? 0 : 2, h) * LOG2E;
    bf16x8 qf[4];
#pragma unroll
    for (int sp = 0; sp < 4; ++sp) qf[sp] = *(const bf16x8*)(Pb + (size_t)tq * PW + h * 64 + 16 * sp + 8 * hi);
    float qn2 = 0.f;
#pragma unroll
    for (int sp = 0; sp < 4; ++sp)
#pragma unroll
        for (int i = 0; i < 8; ++i) { const float v = bf2f((unsigned)(unsigned short)qf[sp][i]); qn2 += v * v; }
    qn2 = xh_sum(qn2);
    const float bound0 = sqrtf(qn2) * __uint_as_float(knmax[(b * 2 + MODE) * 4 + h]) * 1.01f + 1e-3f;
    LAS unsigned* misc = (LAS unsigned*)(lds + AT_MISC);
    unsigned sel = 0u, wgsel = 0xffffu;
    if (tid < 8) misc[tid] = 0u;
    if (MODE == 1) {
        LAS float* km = (LAS float*)(lds + AT_KMOFF);
        for (int i = tid; i < 16 * 64; i += 512) km[i] = kmean[((size_t)b * 16 + (i >> 6)) * 256 + h * 64 + (i & 63)];
        __syncthreads();
        if (qb <= 3) sel = (1u << qb) - 1u;
        else {
            u32x4 qraw[8];
#pragma unroll
            for (int c = 0; c < 8; ++c) qraw[c] = *(const u32x4*)(Pb + (size_t)tq * PW + h * 64 + 8 * c);
            float v1 = -INFINITY, v2 = -INFINITY, v3 = -INFINITY; int i1 = 0, i2 = 0, i3 = 0;
            for (int blk = 0; blk < qb; ++blk) {
                const LAS f32x4* kb = (const LAS f32x4*)(km + blk * 64); float g0 = 0.f, g1 = 0.f;
#pragma unroll
                for (int c = 0; c < 8; ++c) { const u32x4 u = qraw[c]; const f32x4 ka = kb[2 * c], kc = kb[2 * c + 1];
                    g0 += __uint_as_float(u.x << 16) * ka.x; g1 += __uint_as_float(u.x & 0xffff0000u) * ka.y;
                    g0 += __uint_as_float(u.y << 16) * ka.z; g1 += __uint_as_float(u.y & 0xffff0000u) * ka.w;
                    g0 += __uint_as_float(u.z << 16) * kc.x; g1 += __uint_as_float(u.z & 0xffff0000u) * kc.y;
                    g0 += __uint_as_float(u.w << 16) * kc.z; g1 += __uint_as_float(u.w & 0xffff0000u) * kc.w; }
                const float g = g0 + g1;
                if (g > v1) { v3 = v2; i3 = i2; v2 = v1; i2 = i1; v1 = g; i1 = blk; }
                else if (g > v2) { v3 = v2; i3 = i2; v2 = g; i2 = blk; }
                else if (g > v3) { v3 = g; i3 = blk; }
            }
            sel = (1u << i1) | (1u << i2) | (1u << i3);
        }
        unsigned ws_ = sel;
#pragma unroll
        for (int o_ = 1; o_ < 64; o_ <<= 1) ws_ |= (unsigned)__shfl_xor((int)ws_, o_);
        if (lane == 0) __hip_atomic_fetch_or(&misc[0], ws_, __ATOMIC_RELAXED, __HIP_MEMORY_SCOPE_WORKGROUP);
        __syncthreads();
        wgsel = misc[0] | (1u << qb);
    }
    f32x16 cr;
#pragma unroll
    for (int r = 0; r < 16; ++r) cr[r] = slope2 * (float)((r & 3) + 8 * (r >> 2));
    f32x16 o[2];
#pragma unroll
    for (int r = 0; r < 16; ++r) { o[0][r] = 0.f; o[1][r] = 0.f; }
    float m = -INFINITY, l = 0.f; bool done = false;
    const unsigned long long* mrow = mask + (size_t)(b * SEQ + tq) * 64;
#define AT_NEXT(x, y) do { (y) = (x) - 1; if (MODE == 1) { while ((y) >= 0 && !((wgsel >> ((y) >> 2)) & 1u)) (y) -= 4; } } while (0)
    int t = 4 * qb + 3, tn, tn2;
    u32x4 kr, vr, kr2, vr2;
    at_load(Pb, t * 64, kcol, vcol, tid, kr, vr);
    unsigned long long mw = (MODE == 0) ? mrow[t] : 0ull, mwn = 0ull, mwn2 = 0ull;
    at_store(lds, 0, tid, kr, vr);
    AT_NEXT(t, tn);
    if (tn >= 0) { at_load(Pb, tn * 64, kcol, vcol, tid, kr, vr); if (MODE == 0) mwn = mrow[tn]; }
    __syncthreads();
    int buf = 0, it = 0;
#ifdef PROBE_A
    long long tacc = 0; int tcnt = 0;
#define ASTAMP(beg_of, end_of) do { const long long c_ = clock64(); if (PROBE_A == (beg_of) || (PROBE_A == 5 && (beg_of) == 1)) tacc -= c_; if (PROBE_A == (end_of) || (PROBE_A == 5 && (end_of) == 4)) tacc += c_; } while (0)
#else
#define ASTAMP(a, b) do {} while (0)
#endif
#define AT_STEP(KA, VA, MA, KB, VB, MB) { \
        ASTAMP(1, 0); \
        tn2 = -1; if (tn >= 0) AT_NEXT(tn, tn2); \
        if (tn2 >= 0) { at_load(Pb, tn2 * 64, kcol, vcol, tid, KB, VB); if (MODE == 0) MB = mrow[tn2]; } \
        ASTAMP(2, 1); \
        at_compute(); \
        ASTAMP(3, 2); \
        if (lane == 0 && (done || tn < 0)) __hip_atomic_fetch_add(&misc[4 + it % 3], 1u, __ATOMIC_RELAXED, __HIP_MEMORY_SCOPE_WORKGROUP); \
        if (tid == 0) misc[4 + (it + 1) % 3] = 0u; \
        if (tn >= 0) at_store(lds, buf ^ 1, tid, KA, VA); \
        ASTAMP(4, 3); \
        __syncthreads(); \
        ASTAMP(0, 4); \
        nd = misc[4 + it % 3]; \
        buf ^= 1; t = tn; tn = tn2; mw = MA; ++it; }
    auto at_compute = [&]() __attribute__((always_inline)) {
        const int k0 = t * 64; const bool own = t >= 4 * qb;
        if (!done && k0 <= qmax) {
            const float ub = bound0 + slope2 * (float)(k0 + 63 - tq);
#if defined(PROBE_SUB) && PROBE_SUB == 6
            if (!own && __all(ub - m < -1e30f)) done = true;
#else
            if (!own && __all(ub - m < -151.0f)) done = true;
#endif
            else if (MODE == 0 || own || __any((sel >> (t >> 2)) & 1u)) {
                f32x16 s0 = cr, s1 = cr;
                { const LAS unsigned char* kp0_ = lds + AT_KOFF + buf * AT_KBUF + r32 * AT_KROW + hi * 16; const LAS unsigned char* kp1_ = kp0_ + 32 * AT_KROW;
                  bf16x8 ka_[4], kb_[4];
#pragma unroll
                  for (int sp = 0; sp < 4; ++sp) { ka_[sp] = *(const LAS bf16x8*)(kp0_ + sp * 32); kb_[sp] = *(const LAS bf16x8*)(kp1_ + sp * 32); }
                  asm volatile("" : "+v"(ka_[0]), "+v"(ka_[1]), "+v"(ka_[2]), "+v"(ka_[3]), "+v"(kb_[0]), "+v"(kb_[1]), "+v"(kb_[2]), "+v"(kb_[3]));
#pragma unroll
                  for (int sp = 0; sp < 4; ++sp) { s0 = MFMA32(ka_[sp], qf[sp], s0); s1 = MFMA32(kb_[sp], qf[sp], s1); } }
                if (MODE == 0) asm volatile("s_nop 11" : "+v"(s0), "+v"(s1));
                float tb0 = slope2 * (float)(k0 + 4 * hi - tq);
                if (MODE == 1 && !own && !((sel >> (t >> 2)) & 1u)) tb0 = -INFINITY;
                const float tb1 = tb0 + 32.0f * slope2;
                float mx0 = -INFINITY, mx1 = -INFINITY;
                const unsigned wlo = (unsigned)(mw >> (4 * hi)), whi = (unsigned)(mw >> (32 + 4 * hi));
                const int lim = tq - k0 - 4 * hi;
                if (MODE == 1 && k0 + 63 > q0 + 32 * wid) {
#pragma unroll
                    for (int r = 0; r < 16; ++r) { const int kk = (r & 3) + 8 * (r >> 2); s0[r] = (kk <= lim) ? s0[r] : -INFINITY; s1[r] = (kk + 32 <= lim) ? s1[r] : -INFINITY; } }
#pragma unroll
                for (int r = 0; r < 16; ++r) { const int kk = (r & 3) + 8 * (r >> 2);
                    float x0 = s0[r], x1 = s1[r];
#ifdef AT_BFI
                    if (MODE == 0) { unsigned y0_, y1_;
                        const int b0_ = __builtin_amdgcn_sbfe((int)wlo, kk, 1), b1_ = __builtin_amdgcn_sbfe((int)whi, kk, 1);
                        asm("v_bfi_b32 %0, %1, %2, %3" : "=v"(y0_) : "v"(b0_), "v"(x0), "v"(0xff800000u)); asm("v_bfi_b32 %0, %1, %2, %3" : "=v"(y1_) : "v"(b1_), "v"(x1), "v"(0xff800000u));
                        x0 = __uint_as_float(y0_); x1 = __uint_as_float(y1_); }
#else
                    if (MODE == 0) { x0 = (wlo & (1u << kk)) ? x0 : -INFINITY; x1 = (whi & (1u << kk)) ? x1 : -INFINITY; }
#endif
                    s0[r] = x0; s1[r] = x1; mx0 = fmaxf(mx0, x0); mx1 = fmaxf(mx1, x1); }
                float mx = fmaxf(mx0 + tb0, mx1 + tb1);
                mx = xh_max(mx);
                if (__any(mx - m > 8.0f)) {
                    const float mn = fmaxf(m, mx), alpha = (mn == -INFINITY) ? 1.0f : exp2f(m - mn);
                    l *= alpha; m = mn;
#pragma unroll
                    for (int r = 0; r < 16; ++r) { o[0][r] *= alpha; o[1][r] *= alpha; } }
                const float mt0 = (m == -INFINITY) ? INFINITY : m - tb0, mt1 = (m == -INFINITY) ? INFINITY : m - tb1;
                float ps = 0.f;
                float ps1 = 0.f;
#pragma unroll
                for (int r = 0; r < 16; ++r) { s0[r] = __builtin_amdgcn_exp2f(s0[r] - mt0); s1[r] = __builtin_amdgcn_exp2f(s1[r] - mt1); ps += s0[r]; asm("" : "+v"(ps)); ps1 += s1[r]; }
                ps += ps1;
                l += ps;
                at_pv(lds, buf, 0, r32, hi, s0, o);
                at_pv(lds, buf, 1, r32, hi, s1, o);
            }
        }
    };
    unsigned nd = 0u;
    while (t >= 0) {
        AT_STEP(kr, vr, mwn, kr2, vr2, mwn2);
        if (nd == 8u || t < 0) break;
        AT_STEP(kr2, vr2, mwn2, kr, vr, mwn);
        if (nd == 8u) break;
    }
#undef AT_STEP
#ifdef PROBE_A
    if (MODE == 0 && blockIdx.x == 0 && tid == 64 * 5) { unsigned long long* tp = (unsigned long long*)((unsigned char*)mask - WS_MASK); atomicAdd(&tp[151], (unsigned long long)tacc); atomicAdd(&tp[152], (unsigned long long)it); }
#endif
#undef AT_NEXT
    l = xh_sum(l);
    at_finish(o, 1.0f / l, hi, gh16 + (hb + h) * 64, act + (size_t)(b * SEQ + tq) * DM + (hb + h) * 64);
    __syncthreads();
}

template <int DUMMY> __device__ __forceinline__ void attn_sb_unit(const bf16* P, const float* gh16, acto_t* act, int b, int h, int qb, LAS unsigned char* lds) {
    const int tid = otid(), lane = tid & 63, wid = tid >> 6, r32 = lane & 31, hi = lane >> 5;
    const bf16* Pb = P + (size_t)b * SEQ * PW;
    const int kcol = 256 + h * 64, vcol = 512 + h * 64;
    const int q0 = qb * 256, tq = q0 + 32 * wid + r32, qmax = q0 + 32 * wid + 31;
    bf16x8 qf[4];
#pragma unroll
    for (int sp = 0; sp < 4; ++sp) qf[sp] = *(const bf16x8*)(Pb + (size_t)tq * PW + h * 64 + 16 * sp + 8 * hi);
    LAS unsigned* vote = (LAS unsigned*)(lds + AT_MISC);
    if (tid < 3) vote[tid] = 0u;
    f32x16 o[2];
#pragma unroll
    for (int r = 0; r < 16; ++r) { o[0][r] = 0.f; o[1][r] = 0.f; }
    float carry = 1.0f; bool done = false;
    int t = 4 * qb + 3;
    u32x4 kr, vr;
    at_load(Pb, t * 64, kcol, vcol, tid, kr, vr);
    at_store(lds, 0, tid, kr, vr);
    __syncthreads();
    int buf = 0, it = 0;
    while (t >= 0) {
        const int tn = t - 1;
        if (tn >= 0) at_load(Pb, tn * 64, kcol, vcol, tid, kr, vr);
        const int k0 = t * 64;
        if (!done && k0 < qmax) {
#pragma unroll
            for (int ai = 0; ai < 2; ++ai) { const int a = 1 - ai, ks = k0 + 32 * a;
                if (ks < qmax) {
                    f32x16 s = at_scores(lds, buf, a, r32, hi, qf);
                    float G[4];
#pragma unroll
                    for (int g = 0; g < 4; ++g) { float gp = 1.0f;
#pragma unroll
                        for (int i = 0; i < 4; ++i) { const int r = 4 * g + i; const int kp = ks + 8 * g + 4 * hi + i; const bool valid = kp < tq;
                            const float z = fminf(fmaxf(s[r], -80.f), 80.f); const float e = __expf(z); float om = __builtin_amdgcn_rcpf(1.0f + e); float beta = e * om;
                            om = valid ? om : 1.0f; beta = valid ? beta : 0.0f;
                            s[r] = beta; gp *= om; }
                        G[g] = gp; }
                    float Gp[4];
#pragma unroll
                    for (int g = 0; g < 4; ++g) Gp[g] = xh_other(G[g], hi);
                    float SP[4]; SP[3] = 1.0f;
#pragma unroll
                    for (int g = 2; g >= 0; --g) SP[g] = SP[g + 1] * (G[g + 1] * Gp[g + 1]);
                    const float tot = SP[0] * (G[0] * Gp[0]);
#pragma unroll
                    for (int g = 0; g < 4; ++g) { float suf = carry * SP[g] * (hi ? 1.0f : Gp[g]);
#pragma unroll
                        for (int i = 3; i >= 0; --i) { const int r = 4 * g + i; const float beta = s[r]; s[r] = beta * suf; suf *= (1.0f - beta); } }
                    carry *= tot;
                    at_pv(lds, buf, a, r32, hi, s, o);
                }
            }
            done = __all(carry < 1e-30f);
        }
        if (lane == 0 && (done || k0 == 0)) __hip_atomic_fetch_add(&vote[it % 3], 1u, __ATOMIC_RELAXED, __HIP_MEMORY_SCOPE_WORKGROUP);
        if (tid == 0) vote[(it + 1) % 3] = 0u;
        if (tn >= 0) at_store(lds, buf ^ 1, tid, kr, vr);
        __syncthreads();
        const unsigned nd = vote[it % 3];
        buf ^= 1; t = tn; ++it;
        if (nd == 8u) break;
    }
    at_finish(o, 1.0f, hi, gh16 + h * 64, act + (size_t)(b * SEQ + tq) * DM + h * 64);
    __syncthreads();
}

template <int DUMMY> __device__ __forceinline__ void attn_sb_wave(const bf16* P, const float* gh16, acto_t* act, int b, int h, int qb, LAS unsigned char* lds) {
    const int tid = otid(), lane = tid & 63, wid = tid >> 6, r32 = lane & 31, hi = lane >> 5;
    const bf16* Pb = P + (size_t)b * SEQ * PW;
    const int kcol = 256 + h * 64;
    const int q0 = qb * 256, tq = q0 + 32 * wid + r32;
    bf16x8 qf[4];
#pragma unroll
    for (int sp = 0; sp < 4; ++sp) qf[sp] = *(const bf16x8*)(Pb + (size_t)tq * PW + h * 64 + 16 * sp + 8 * hi);
    LAS unsigned char* vt = lds + wid * 4608;
    f32x16 o[2];
#pragma unroll
    for (int r = 0; r < 16; ++r) { o[0][r] = 0.f; o[1][r] = 0.f; }
    float carry = 1.0f;
    const int lrow = lane >> 3, lch = lane & 7;
    LAS unsigned char* st_base = vt + 512 * (lch >> 2) + 64 * lrow;
    const unsigned q4 = (unsigned)(r32 & 15) >> 2, p4 = (unsigned)r32 & 3u, g16 = ((unsigned)r32 >> 4) & 1u;
    const unsigned vb = (unsigned)(size_t)vt + 64u * (4u * (unsigned)hi + q4) + 8u * (p4 & 1u);
    const unsigned tra0 = vb + 16u * ((2u * g16 + (p4 >> 1)) ^ ((unsigned)hi & 3u)), tra1 = vb + 16u * ((2u * g16 + (p4 >> 1)) ^ (((unsigned)hi + 2u) & 3u));
    u32x4 ksA[4], vvA[4], ksB[4], vvB[4];
    auto gld = [&](int ks_, u32x4 (&ks)[4], u32x4 (&vv)[4]) __attribute__((always_inline)) {
#pragma unroll
        for (int i = 0; i < 4; ++i) { const bf16* cp_ = Pb + (size_t)(ks_ + 8 * i + lrow) * PW + kcol + 8 * lch; ks[i] = *(const u32x4*)cp_; vv[i] = *(const u32x4*)(cp_ + 256); } };
    bool done = false;
    auto step = [&](int ks_, u32x4 (&ks)[4], u32x4 (&vv)[4]) __attribute__((always_inline)) {
#pragma unroll
        for (int i = 0; i < 4; ++i) *(LAS u32x4*)(st_base + 1024 * i + 16 * ((lch & 3) ^ ((2 * i + (lrow >> 2)) & 3))) = ks[i];
        bf16x8 kf[4];
#pragma unroll
        for (int sp = 0; sp < 4; ++sp) { const int ch_ = 2 * sp + hi; kf[sp] = *(const LAS bf16x8*)(vt + 1024 * (r32 >> 3) + 512 * (ch_ >> 2) + 64 * (r32 & 7) + 16 * ((ch_ & 3) ^ ((r32 >> 2) & 3))); }
        asm volatile("s_waitcnt lgkmcnt(0)" ::: "memory");
#pragma unroll
        for (int i = 0; i < 4; ++i) *(LAS u32x4*)(st_base + 1024 * i + 16 * ((lch & 3) ^ ((2 * i + (lrow >> 2)) & 3))) = vv[i];
        if (ks_ >= 64) gld(ks_ - 64, ks, vv);
        f32x16 s = {0.f, 0.f, 0.f, 0.f, 0.f, 0.f, 0.f, 0.f, 0.f, 0.f, 0.f, 0.f, 0.f, 0.f, 0.f, 0.f};
#pragma unroll
        for (int sp = 0; sp < 4; ++sp) s = MFMA32(kf[sp], qf[sp], s);
        float G[4];
#pragma unroll
        for (int g = 0; g < 4; ++g) { float gp = 1.0f;
#pragma unroll
            for (int i = 0; i < 4; ++i) { const int r = 4 * g + i; const int kp = ks_ + 8 * g + 4 * hi + i; const bool valid = kp < tq;
                const float z = __builtin_amdgcn_fmed3f(s[r], -115.41560327111707f, 115.41560327111707f); const float e = __builtin_amdgcn_exp2f(z); float om = __builtin_amdgcn_rcpf(1.0f + e); float beta = e * om;
                om = valid ? om : 1.0f; beta = valid ? beta : 0.0f;
                s[r] = beta; gp *= om; }
            G[g] = gp; }
        float Gp[4];
#pragma unroll
        for (int g = 0; g < 4; ++g) Gp[g] = xh_other(G[g], hi);
        float SP[4]; SP[3] = 1.0f;
#pragma unroll
        for (int g = 2; g >= 0; --g) SP[g] = SP[g + 1] * (G[g + 1] * Gp[g + 1]);
        const float tot = SP[0] * (G[0] * Gp[0]);
#pragma unroll
        for (int g = 0; g < 4; ++g) { float suf = carry * SP[g] * (hi ? 1.0f : Gp[g]);
#pragma unroll
            for (int i = 3; i >= 0; --i) { const int r = 4 * g + i; const float beta = s[r]; s[r] = beta * suf; suf *= (1.0f - beta); } }
        carry *= tot;
        s16x4 vtr[2][2][2];
        asm volatile("ds_read_b64_tr_b16 %0, %8\n\tds_read_b64_tr_b16 %1, %9 offset:1024\n\tds_read_b64_tr_b16 %2, %8 offset:512\n\tds_read_b64_tr_b16 %3, %9 offset:1536\n\t"
                     "ds_read_b64_tr_b16 %4, %8 offset:2048\n\tds_read_b64_tr_b16 %5, %9 offset:3072\n\tds_read_b64_tr_b16 %6, %8 offset:2560\n\tds_read_b64_tr_b16 %7, %9 offset:3584\n\ts_waitcnt lgkmcnt(0)"
                     : "=&v"(vtr[0][0][0]), "=&v"(vtr[0][0][1]), "=&v"(vtr[0][1][0]), "=&v"(vtr[0][1][1]), "=&v"(vtr[1][0][0]), "=&v"(vtr[1][0][1]), "=&v"(vtr[1][1][0]), "=&v"(vtr[1][1][1])
                     : "v"(tra0), "v"(tra1) : "memory");
#pragma unroll
        for (int sk = 0; sk < 2; ++sk) {
            u32x4 w; w.x = cvt_pk_bf16(s[8 * sk + 0], s[8 * sk + 1]); w.y = cvt_pk_bf16(s[8 * sk + 2], s[8 * sk + 3]); w.z = cvt_pk_bf16(s[8 * sk + 4], s[8 * sk + 5]); w.w = cvt_pk_bf16(s[8 * sk + 6], s[8 * sk + 7]);
            const bf16x8 pf = __builtin_bit_cast(bf16x8, w);
#pragma unroll
            for (int dh = 0; dh < 2; ++dh) { const bf16x8 vf = {vtr[sk][dh][0][0], vtr[sk][dh][0][1], vtr[sk][dh][0][2], vtr[sk][dh][0][3], vtr[sk][dh][1][0], vtr[sk][dh][1][1], vtr[sk][dh][1][2], vtr[sk][dh][1][3]};
                o[dh] = MFMA32(vf, pf, o[dh]); } }
        done = __all(carry < 1e-30f);
    };
    int ks0 = q0 + 32 * wid;
    gld(ks0, ksA, vvA); if (ks0 >= 32) gld(ks0 - 32, ksB, vvB);
    for (; ks0 >= 0; ks0 -= 64) { step(ks0, ksA, vvA); if (done || ks0 < 32) break; step(ks0 - 32, ksB, vvB); if (done) break; }
    at_finish(o, 1.0f, hi, gh16 + h * 64, act + (size_t)(b * SEQ + tq) * DM + h * 64);
}

constexpr int DL_VROW = 72, DL_VT = 0, DL_VTW = 64 * DL_VROW, DL_CB = 8 * DL_VTW, DL_CBROW = 65, DL_ML = DL_CB + 256 * DL_CBROW * 4;
template <int BR> __device__ __forceinline__ int dl_kpos(int rho, int j, int q0, int wid) {
    if (BR == 0) return q0 + 32 * wid - 128 + 32 * j + rho;
    if (BR == 1) return q0 + (wid & 3) + 4 * (32 * (wid >> 2) - 128 + 32 * j + rho);
    return q0 + 2 * wid + (rho >> 4) + 16 * (-128 + 16 * j + (rho & 15));
}
template <int BR> __device__ __forceinline__ void dilated_branch(const bf16* Pb, int h, int q0, float slope, LAS unsigned char* lds, int wid, int r32, int hi, const float* ghh, acto_t* actb) {
    constexpr int R = BR == 0 ? 1 : (BR == 1 ? 4 : 16), W = 128 * R, NSUB = BR == 2 ? 9 : 5;
    const int qpos = BR == 0 ? q0 + 32 * wid + r32 : (BR == 1 ? q0 + (wid & 3) + 4 * (32 * (wid >> 2) + r32) : q0 + 2 * wid + (r32 >> 4) + 16 * (r32 & 15));
    bf16x8 qf[4];
#pragma unroll
    for (int sp = 0; sp < 4; ++sp) qf[sp] = *(const bf16x8*)(Pb + (size_t)qpos * PW + h * 64 + 16 * sp + 8 * hi);
    LAS unsigned char* vt = lds + DL_VT + wid * DL_VTW;
    f32x16 o[2];
#pragma unroll
    for (int r = 0; r < 16; ++r) { o[0][r] = 0.f; o[1][r] = 0.f; }
    float m = -INFINITY, l = 0.f;
    const int lane_ = r32 + 32 * hi, lrow = lane_ >> 3, lch = lane_ & 7;
    LAS unsigned char* st_base = vt + 512 * (lch >> 2) + 64 * lrow;
    const unsigned q4 = (unsigned)(r32 & 15) >> 2, p4 = (unsigned)r32 & 3u, g16 = ((unsigned)r32 >> 4) & 1u;
    const unsigned vb = (unsigned)(size_t)vt + 64u * (4u * (unsigned)hi + q4) + 8u * (p4 & 1u);
    const unsigned tra0 = vb + 16u * ((2u * g16 + (p4 >> 1)) ^ ((unsigned)hi & 3u)), tra1 = vb + 16u * ((2u * g16 + (p4 >> 1)) ^ (((unsigned)hi + 2u) & 3u));
    u32x4 ksA[4], vvA[4], ksB[4], vvB[4];
    const float sR = slope * (float)R; f32x16 sinit;
#pragma unroll
    for (int r = 0; r < 16; ++r) sinit[r] = sR * (float)((BR == 2 ? 8 * ((r >> 2) & 1) : 8 * (r >> 2)) + (r & 3));
    const unsigned ubp1 = (unsigned)min(128, qpos / R) + 1u;
    const unsigned ubp1_lo = (BR == 2 && r32 >= 16) ? 0u : ubp1, ubp1_hi = (BR == 2 && r32 < 16) ? 0u : ubp1;
    auto gld = [&](int jj, u32x4 (&ks)[4], u32x4 (&vv)[4]) __attribute__((always_inline)) {
#pragma unroll
        for (int i = 0; i < 4; ++i) { const int kp_ = dl_kpos<BR>(8 * i + lrow, jj, q0, wid); const bf16* cp_ = Pb + (size_t)(kp_ < 0 ? 0 : kp_) * PW + 256 + h * 64 + 8 * lch;
            ks[i] = *(const u32x4*)cp_; vv[i] = *(const u32x4*)(cp_ + 256); } };
    auto step = [&](int j, u32x4 (&ks)[4], u32x4 (&vv)[4]) __attribute__((always_inline)) {
#pragma unroll
        for (int i = 0; i < 4; ++i) *(LAS u32x4*)(st_base + 1024 * i + 16 * ((lch & 3) ^ ((2 * i + (lrow >> 2)) & 3))) = ks[i];
        bf16x8 kf[4];
#pragma unroll
        for (int sp = 0; sp < 4; ++sp) { const int ch_ = 2 * sp + hi; kf[sp] = *(const LAS bf16x8*)(vt + 1024 * (r32 >> 3) + 512 * (ch_ >> 2) + 64 * (r32 & 7) + 16 * ((ch_ & 3) ^ ((r32 >> 2) & 3))); }
        asm volatile("s_waitcnt lgkmcnt(0)" ::: "memory");
#pragma unroll
        for (int i = 0; i < 4; ++i) *(LAS u32x4*)(st_base + 1024 * i + 16 * ((lch & 3) ^ ((2 * i + (lrow >> 2)) & 3))) = vv[i];
        if (j + 2 < NSUB) gld(j + 2, ks, vv);
        f32x16 s = sinit;
#pragma unroll
        for (int sp = 0; sp < 4; ++sp) s = MFMA32(kf[sp], qf[sp], s);
        const int T0 = (BR == 2 ? (r32 & 15) + 128 - 16 * j : r32 + 128 - 32 * j) - 4 * hi; const float b0 = -sR * (float)T0;
        const int hiB = T0 < 31 ? T0 : 31, loB = (T0 - (int)ubp1 + 1) > 0 ? (T0 - (int)ubp1 + 1) : 0;
        const unsigned bandm = (T0 >= 0 && hiB >= loB) ? (((2u << hiB) - 1u) & ~((1u << loB) - 1u)) : 0u;
        const unsigned bm_lo = ubp1_lo ? bandm : 0u, bm_hi = ubp1_hi ? bandm : 0u;
        float mx = -INFINITY;
#pragma unroll
        for (int r = 0; r < 16; ++r) { const int c_r = (BR == 2 ? 8 * ((r >> 2) & 1) : 8 * (r >> 2)) + (r & 3);
            const int vb_ = __builtin_amdgcn_sbfe((int)((BR == 2 && r >= 8) ? bm_hi : bm_lo), c_r, 1); const float x_ = s[r] + b0; unsigned y_;
            asm("v_bfi_b32 %0, %1, %2, %3" : "=v"(y_) : "v"(vb_), "v"(x_), "v"(0xff800000u));
            s[r] = __uint_as_float(y_); mx = fmaxf(mx, s[r]); }
        mx = xh_max(mx);
        if (__any(mx - m > 8.0f)) {
            const float mn = fmaxf(m, mx), alpha = (mn == -INFINITY) ? 1.0f : exp2f(m - mn);
            l *= alpha; m = mn;
#pragma unroll
            for (int r = 0; r < 16; ++r) { o[0][r] *= alpha; o[1][r] *= alpha; } }
        const float mu = (m == -INFINITY) ? INFINITY : m;
        float ps = 0.f;
#pragma unroll
        for (int r = 0; r < 16; ++r) { s[r] = __builtin_amdgcn_exp2f(s[r] - mu); ps += s[r]; }
        l += ps;
        s16x4 vtr[2][2][2];
        asm volatile("ds_read_b64_tr_b16 %0, %8\n\tds_read_b64_tr_b16 %1, %9 offset:1024\n\tds_read_b64_tr_b16 %2, %8 offset:512\n\tds_read_b64_tr_b16 %3, %9 offset:1536\n\t"
                     "ds_read_b64_tr_b16 %4, %8 offset:2048\n\tds_read_b64_tr_b16 %5, %9 offset:3072\n\tds_read_b64_tr_b16 %6, %8 offset:2560\n\tds_read_b64_tr_b16 %7, %9 offset:3584\n\ts_waitcnt lgkmcnt(0)"
                     : "=&v"(vtr[0][0][0]), "=&v"(vtr[0][0][1]), "=&v"(vtr[0][1][0]), "=&v"(vtr[0][1][1]), "=&v"(vtr[1][0][0]), "=&v"(vtr[1][0][1]), "=&v"(vtr[1][1][0]), "=&v"(vtr[1][1][1])
                     : "v"(tra0), "v"(tra1) : "memory");
#pragma unroll
        for (int sk = 0; sk < 2; ++sk) {
            u32x4 w; w.x = cvt_pk_bf16(s[8 * sk + 0], s[8 * sk + 1]); w.y = cvt_pk_bf16(s[8 * sk + 2], s[8 * sk + 3]); w.z = cvt_pk_bf16(s[8 * sk + 4], s[8 * sk + 5]); w.w = cvt_pk_bf16(s[8 * sk + 6], s[8 * sk + 7]);
            const bf16x8 pf = __builtin_bit_cast(bf16x8, w);
#pragma unroll
            for (int dh = 0; dh < 2; ++dh) { const bf16x8 vf = {vtr[sk][dh][0][0], vtr[sk][dh][0][1], vtr[sk][dh][0][2], vtr[sk][dh][0][3], vtr[sk][dh][1][0], vtr[sk][dh][1][1], vtr[sk][dh][1][2], vtr[sk][dh][1][3]};
                o[dh] = MFMA32(vf, pf, o[dh]); } }
    };
    gld(0, ksA, vvA); if (NSUB > 1) gld(1, ksB, vvB);
    for (int j = 0; j < NSUB; j += 2) { step(j, ksA, vvA); if (j + 1 < NSUB) step(j + 1, ksB, vvB); }
    l = xh_sum(l);
    const int qi = qpos - q0;
    LAS float* cb = (LAS float*)(lds + DL_CB) + qi * DL_CBROW; LAS float* ml = (LAS float*)(lds + DL_ML);
    if (BR > 0) {
        const float M0 = ml[qi], L0 = ml[256 + qi];
        const float mn = fmaxf(M0, m), a0 = __builtin_amdgcn_exp2f(M0 - mn), a1 = __builtin_amdgcn_exp2f(m - mn);
#pragma unroll
        for (int dh = 0; dh < 2; ++dh)
#pragma unroll
            for (int r = 0; r < 16; ++r) o[dh][r] = o[dh][r] * a1 + cb[32 * dh + crow(r, hi)] * a0;
        l = l * a1 + L0 * a0; m = mn;
    }
    if (BR < 2) {
        __syncthreads();
#pragma unroll
        for (int dh = 0; dh < 2; ++dh)
#pragma unroll
            for (int r = 0; r < 16; ++r) cb[32 * dh + crow(r, hi)] = o[dh][r];
        if (hi == 0) { ml[qi] = m; ml[256 + qi] = l; }
        __syncthreads();
    } else {
        at_finish(o, 1.0f / l, hi, ghh, actb + (size_t)qpos * DM);
    }
}
__device__ __forceinline__ void attn_dilated_unit(const bf16* P, const float* gh16, acto_t* act, int b, int h, int qb, LAS unsigned char* lds) {
    const int tid = otid(), lane = tid & 63, wid = tid >> 6, r32 = lane & 31, hi = lane >> 5;
    const bf16* Pb = P + (size_t)b * SEQ * PW + 1536;
    const float slope = alibi_slope(1, h) * LOG2E;
    const float* ghh = gh16 + (8 + h) * 64; acto_t* actb = act + (size_t)b * SEQ * DM + (8 + h) * 64;
    dilated_branch<0>(Pb, h, qb * 256, slope, lds, wid, r32, hi, ghh, actb);
    dilated_branch<1>(Pb, h, qb * 256, slope, lds, wid, r32, hi, ghh, actb);
    dilated_branch<2>(Pb, h, qb * 256, slope, lds, wid, r32, hi, ghh, actb);
    __syncthreads();
}

#ifndef MK_SPLIT
#define MK_SPLIT 0
#endif
constexpr int MISC_OFF = 131072, ROWTAB_OFF = MISC_OFF + 1024, LDS_BYTES = 131072 + 2048 + 64;
constexpr int N_PHASES = 19;
struct MegaArgs { const float* in[17]; float* out; unsigned char* ws; int ph_lo, ph_hi, li, pad; };

__global__ void __launch_bounds__(512, 2) mega_fwd(MegaArgs a) {
    extern __shared__ __attribute__((aligned(16))) unsigned char lds_raw[];
    LAS unsigned char* lds = (LAS unsigned char*)lds_raw;
    volatile LAS unsigned* MISC = (volatile LAS unsigned*)(lds + MISC_OFF);
    const int tid = threadIdx.x, bid = blockIdx.x, nblk = gridDim.x;
    for (int u = tid; u < (LDS_BYTES - MISC_OFF) / 4; u += 512) MISC[u] = 0u;
    __syncthreads();
    if (tid < 17) { const unsigned long long p = (unsigned long long)a.in[tid]; MISC[64 + 2 * tid] = (unsigned)p; MISC[65 + 2 * tid] = (unsigned)(p >> 32); }
    __syncthreads();
#define INP(i) ((const float*)(((unsigned long long)(unsigned)__builtin_amdgcn_readfirstlane((int)MISC[65 + 2 * (i)]) << 32) | (unsigned long long)(unsigned)__builtin_amdgcn_readfirstlane((int)MISC[64 + 2 * (i)])))
    unsigned char* ws = a.ws;
    unsigned* ctl = (unsigned*)(ws + WS_CTL);
    XcdBarrier bar; bar.bar = ctl + CW_BAR + a.li * XCD_BAR_WORDS; bar.x = 0; bar.st = nullptr;
    if (!MK_SPLIT) bar = xcd_barrier_post(ctl + CW_BAR + a.li * XCD_BAR_WORDS, MISC + 8);
    const int lo = a.ph_lo, hi = a.ph_hi;
#define RUN(k) (lo <= (k) && (k) < hi)
#define SEAM(k) do { if (RUN(k) && RUN((k) + 1)) { if (!MK_SPLIT) xcd_barrier(bar); } } while (0)
    float* out = a.out;
    float* mod = (float*)(ws + WS_MOD); float* kmean = (float*)(ws + WS_KMEAN); const float* gv = (const float*)(ws + WS_GV);
    int* tok = (int*)(ws + WS_TOK); bf16* act = (bf16*)(ws + WS_ACT); bf16* P = (bf16*)(ws + WS_P); bf16* hid = (bf16*)(ws + WS_HID); unsigned char* xs = ws + WS_XS; bf16* ys = (bf16*)(ws + WS_YS);
    unsigned long long* mask = (unsigned long long*)(ws + WS_MASK); unsigned* ecnt = ctl + CW_ECNT;

    if (RUN(0)) {
        PrepArgs pa{INP(5), INP(7), INP(9), INP(10), INP(11), INP(13), INP(14), INP(15), ws};
        ph_prep(pa, lds, bid, nblk);
        __syncthreads();
        ph_mod(INP(1), INP(2), INP(3), mod, lds, bid, nblk);
        { float* gvw = (float*)(ws + WS_GV); const float* s4 = INP(4); const float* s6 = INP(6); const float* s8 = INP(8); const float* s16 = INP(16);
          for (int i = bid * 512 + otid(); i < 7168; i += nblk * 512) gvw[i] = i < 2048 ? s4[i] : (i < 4096 ? s6[i - 2048] : (i < 6144 ? s8[i - 4096] : s16[i - 6144])); }
    }
    SEAM(0);
#if defined(PROBE_SUB) && PROBE_SUB == 9
    for (int rep_ = 0; rep_ < 20; ++rep_) xcd_barrier(bar);
#endif
    for (int l = 0; l < NLAYER; ++l) {
        const int pb = 1 + 8 * l;
        const float* ml = mod + (size_t)l * 8 * 6144; bf16* xb = (bf16*)(ws + WS_XB); const float* gh = gv + 2048 + l * 1024;
#ifdef WIN_FP8
        if (RUN(pb)) { NormArgs na{}; if (l == 0) na.xin = INP(0); else na.xin16 = xb; na.g = gv + l * DM; na.shift = ml; na.scale = ml + 1024; na.act = act; na.act8 = ws + WS_ACT8W; ph_norm<0>(na, lds, bid, nblk); }
#else
        if (RUN(pb)) { NormArgs na{}; if (l == 0) na.xin = INP(0); else na.xin16 = xb; na.g = gv + l * DM; na.shift = ml; na.scale = ml + 1024; na.act = act; ph_norm<0>(na, lds, bid, nblk); }
#endif
        SEAM(pb);
#ifdef WIN_FP8
        if (RUN(pb + 1)) { pg8::EpiBf16 E{P, PW, 0};
            { pg8::Gemm g{act, (const bf16*)(ws + WS_WIN) + (size_t)l * PW * DM, T, PW, DM}; pg8::SubOrder S; S.init(T, WIN_NB16, WIN_LIST16, nblk, bid, 1 << 30, 0);
              pg8::gemm_phase<pg8::EpiBf16, pg8::SubOrder, true, true>(lds, g, S, E); }
            __syncthreads();
            { pg8::Gemm g{(const bf16*)(ws + WS_ACT8W), (const bf16*)(ws + WS_WIN8 + (size_t)l * PW * DM), T, PW, DM}; pg8::SubOrder S; S.init(T, 15 - WIN_NB16, WIN_LIST8, nblk, bid, WIN_FULL8, nblk / 2);
              pg8::gemm_phase<pg8::EpiBf16, pg8::SubOrder, true, true, true, 0x7A7A7A7A>(lds, g, S, E); } }
#else
        if (RUN(pb + 1)) { pg8::Gemm g{act, (const bf16*)(ws + WS_WIN) + (size_t)l * PW * DM, T, PW, DM}; pg8::StaticOrder S; S.init(T, PW, nblk, bid);
            pg8::EpiBf16 E{P, PW, 0}; pg8::gemm_phase<pg8::EpiBf16, pg8::StaticOrder, true, true>(lds, g, S, E); }
#endif
        SEAM(pb + 1);
        if (RUN(pb + 2)) {
            for (int u = bid, r = 0; u < NB * 512; u += nblk, ++r) { const int unit = (r & 1) ? (r * nblk + nblk - 1 - bid) : u; if (unit < NB * 512) dsa_select_unit(P, mask, unit, (LAS unsigned*)lds); }
            for (int unit = bid; unit < NB * 16; unit += nblk) kmean_unit(P, kmean, ctl + CW_KNMAX + l * 64, unit, lds);
#if defined(PROBE_SUB) && PROBE_SUB == 1
            if (l == 1) for (int u = bid, r = 0; u < NB * 512; u += nblk, ++r) { const int unit = (r & 1) ? (r * nblk + nblk - 1 - bid) : u; if (unit < NB * 512) dsa_select_unit(P, mask, unit, (LAS unsigned*)lds); }
#endif
#if defined(PROBE_SUB) && PROBE_SUB == 2
            if (l == 1) for (int u = bid; u < 512; u += nblk) attn_sb_unit<0>(P, gh, (acto_t*)act, u & 7, (u >> 3) & 3, u >> 5, lds);
#endif
#if defined(PROBE_SUB) && PROBE_SUB == 3
            if (l == 1) for (int u = bid; u < 512; u += nblk) attn_dilated_unit(P, gh, (acto_t*)act, u & 7, (u >> 3) & 3, u >> 5, lds);
#endif
#ifndef NO_SB
#ifdef SB_WAVE
            __syncthreads();
#ifdef HEAD_PASS
            for (int u = bid; u < 512; u += nblk) attn_sb_wave<0>(P, gh, (acto_t*)act, u & 7, 2 * ((u >> 8) & 1) + ((u >> 3) & 1), (u >> 4) & 15, lds);
#else
            for (int u = bid; u < 512; u += nblk) attn_sb_wave<0>(P, gh, (acto_t*)act, u & 7, (u >> 3) & 3, u >> 5, lds);
#endif
            __syncthreads();
#else
            for (int u = bid; u < 512; u += nblk) attn_sb_unit<0>(P, gh, (acto_t*)act, u & 7, (u >> 3) & 3, u >> 5, lds);
#endif
#endif
#ifndef NO_DIL
#ifdef HEAD_PASS
            for (int u = bid; u < 512; u += nblk) attn_dilated_unit(P, gh, (acto_t*)act, u & 7, 2 * ((u >> 8) & 1) + ((u >> 3) & 1), (u >> 4) & 15, lds);
#else
            for (int u = bid; u < 512; u += nblk) attn_dilated_unit(P, gh, (acto_t*)act, u & 7, (u >> 3) & 3, u >> 5, lds);
#endif
#endif
#ifdef PREP_LAZY
            { PrepArgs pa{INP(5), INP(7), INP(9), INP(10), INP(11), INP(13), INP(14), INP(15), ws}; prep_lazy(pa, ctl, CW_PDONE + 2 * l, nblk, lds); }
#endif
        }
        SEAM(pb + 2);
        if (RUN(pb + 3)) {
            LAS unsigned* qslot = (LAS unsigned*)(lds + AT_MISC + 64);
            for (;;) { if (otid() == 0) qslot[0] = atomicAdd(&ctl[CW_QUEUE + 2 * l], 1u);
                __syncthreads(); const unsigned u = qslot[0]; __syncthreads();
                if (u >= 512u) break;
                attn_masked_unit<0>(P, mask, kmean, ctl + CW_KNMAX + l * 64, gh, (acto_t*)act, (int)(u & 7u), 3 - (int)((u >> 3) & 3u), 15 - (int)(u >> 5), lds); }
#if defined(PROBE_SUB) && PROBE_SUB == 4
            if (l == 1) for (;;) { if (otid() == 0) qslot[0] = atomicAdd(&ctl[CW_QUEUE + 8], 1u);
                __syncthreads(); const unsigned u = qslot[0]; __syncthreads();
                if (u >= 512u) break;
                attn_masked_unit<0>(P, mask, kmean, ctl + CW_KNMAX + l * 64, gh, (acto_t*)act, (int)(u & 7u), 3 - (int)((u >> 3) & 3u), 15 - (int)(u >> 5), lds); }
#endif
#if defined(PROBE_SUB) && PROBE_SUB == 5
            if (l == 1) for (;;) { if (otid() == 0) qslot[0] = atomicAdd(&ctl[CW_QUEUE + 8], 1u);
                __syncthreads(); const unsigned u = qslot[0]; __syncthreads();
                if (u >= 512u) break;
                attn_masked_unit<1>(P, mask, kmean, ctl + CW_KNMAX + l * 64, gh, (acto_t*)act, (int)(u & 7u), 3 - (int)((u >> 3) & 3u), 15 - (int)(u >> 5), lds); }
#endif
            for (;;) { if (otid() == 0) qslot[0] = atomicAdd(&ctl[CW_QUEUE + 2 * l + 1], 1u);
                __syncthreads(); const unsigned u = qslot[0]; __syncthreads();
                if (u >= 512u) break;
                attn_masked_unit<1>(P, mask, kmean, ctl + CW_KNMAX + l * 64, gh, (acto_t*)act, (int)(u & 7u), 3 - (int)((u >> 3) & 3u), 15 - (int)(u >> 5), lds); }
#ifdef PREP_LAZY
            { PrepArgs pa{INP(5), INP(7), INP(9), INP(10), INP(11), INP(13), INP(14), INP(15), ws}; prep_lazy(pa, ctl, CW_PDONE + 2 * l + 1, nblk, lds); }
#endif
        }
        SEAM(pb + 3);
#ifdef WOUT_FP8
        if (RUN(pb + 4)) { pg8::Gemm g{act, (const bf16*)(ws + WS_WOUT + (size_t)l * DM * DM), T, DM, DM}; pg8::StaticOrder S; S.init(T, DM, nblk, bid);
            pg8::EpiRes E{l == 0 ? INP(0) : nullptr, xb, xb, ml + 2048}; pg8::gemm_phase<pg8::EpiRes, pg8::StaticOrder, true, true, true, 0x79797979>(lds, g, S, E); }
#else
        if (RUN(pb + 4)) { pg8::Gemm g{act, (const bf16*)(ws + WS_WOUT) + (size_t)l * DM * DM, T, DM, DM}; pg8::StaticOrder S; S.init(T, DM, nblk, bid);
            pg8::EpiRes E{l == 0 ? INP(0) : nullptr, xb, xb, ml + 2048}; pg8::gemm_phase<pg8::EpiRes, pg8::StaticOrder, true, true>(lds, g, S, E); }
#endif
        SEAM(pb + 4);
        if (l == 0) {
            if (RUN(6)) { NormArgs na{}; na.xin16 = xb; na.g = gv + 4096; na.shift = ml + 3072; na.scale = ml + 4096; na.act8 = (unsigned char*)act; ph_norm<0>(na, lds, bid, nblk); }
            SEAM(6);
#ifndef NO_FF
            if (RUN(7)) { pg8::Gemm g{act, (const bf16*)(ws + WS_WFU), T, 2 * DFF, DM}; pg8::StaticOrder S; S.init(T, 2 * DFF, nblk, bid);
                pg8::EpiSwiGLU8 E{(unsigned char*)hid, DFF, 0}; pg8::gemm_phase<pg8::EpiSwiGLU8, pg8::StaticOrder, true, true, true, 0x7A7A7A7A>(lds, g, S, E); }
            SEAM(7);
            if (RUN(8)) { pg8::Gemm g{hid, (const bf16*)(ws + WS_WFD), T, DM, DFF}; pg8::StaticOrder S; S.init(T, DM, nblk, bid);
                pg8::EpiRes E{nullptr, xb, xb, ml + 5120}; pg8::gemm_phase<pg8::EpiRes, pg8::StaticOrder, true, true, true, 0x79797979>(lds, g, S, E); }
            SEAM(8);
#endif
        } else {
            if (RUN(14)) { NormArgs na{}; na.xin16 = xb; na.g = gv + 4096 + DM; na.shift = ml + 3072; na.scale = ml + 4096; na.act8 = (unsigned char*)act; na.w_router = INP(12); na.tok = tok; na.ecnt = ecnt; na.elist = (int*)(ws + WS_ELIST);
                ph_norm<1>(na, lds, bid, nblk);
#ifdef PREP_LAZY
                { PrepArgs pa{INP(5), INP(7), INP(9), INP(10), INP(11), INP(13), INP(14), INP(15), ws}; prep_lazy(pa, ctl, -1, nblk, lds); }
#endif
            }
            SEAM(14);
#ifndef MOE_GATHER_A
            if (RUN(15)) ph_gather((const unsigned char*)act, tok, ecnt, xs, bid, nblk);
            SEAM(15);
#endif
            if (RUN(16) || RUN(17)) {
                LAS unsigned char* etab = lds + MISC_OFF + 512;
                int ntot;
                { const MoeTiles mt = moe_tiles(ecnt); ntot = moe_tile_start(mt, 7) + mt.p7;
                  const int t_ = otid(); if (t_ < XS_TILES) { int e_ = 0;
#pragma unroll
                      for (int k = 1; k < 8; ++k) e_ += (t_ >= moe_tile_start(mt, k)) ? 1 : 0;
                      etab[t_] = (unsigned char)e_; }
                  __syncthreads(); }
                pg8::MoeOrder S; S.nrt = ntot; S.G = nblk; S.c = bid; S.etab = etab;
#ifdef MOE_GATHER_A
                if (RUN(16)) { S.nN = 28; S.mode = 2; S.estride = (size_t)7168 * DM;
                    LAS unsigned* rowtab = (LAS unsigned*)(lds + ROWTAB_OFF); LAS int* einfo = (LAS int*)(lds + ROWTAB_OFF + 1024); S.rowtab = rowtab;
                    { const MoeTiles mt = moe_tiles(ecnt); const int t_ = otid(); if (t_ < 8) { einfo[t_] = moe_tile_start(mt, t_); einfo[8 + t_] = (int)__hip_atomic_load(ecnt + t_, __ATOMIC_RELAXED, __HIP_MEMORY_SCOPE_AGENT); } }
                    const int full = ntot / nblk, rem = ntot - full * nblk; const int* elist = (const int*)(ws + WS_ELIST);
                    pg8::Gemm g{act, (const bf16*)(ws + WS_WEU), 0, 0, DM}; pg8::EpiSwiGLU8 E{(unsigned char*)hid, DFE, 0};
                    for (int seg = 0;; ++seg) {
                        if (seg < full) { S.pm0 = seg * nblk + bid; S.pn0 = 0; S.cnt = 28; }
                        else { const int L = (seg - full) * nblk + bid; if (rem <= 0 || L >= rem * 28) break; S.pm0 = full * nblk + L % rem; S.pn0 = L / rem; S.cnt = 1; }
                        __syncthreads();
                        { const int t_ = otid(); if (t_ < 256) { const int e_ = (int)etab[S.pm0]; const int pos_ = (S.pm0 - einfo[e_]) * 256 + t_; const int tk_ = pos_ < einfo[8 + e_] ? elist[e_ * T + pos_] : 0; rowtab[t_] = (unsigned)tk_ * (unsigned)DM; } }
                        __syncthreads();
                        pg8::gemm_phase<pg8::EpiSwiGLU8, pg8::MoeOrder, true, true, true, 0x7A7A7A7A, 0x7F7F7F7F, true>(lds, g, S, E);
                    } }
#else
                if (RUN(16)) { S.nN = 28; S.mode = 0; S.estride = (size_t)7168 * DM;
                    pg8::Gemm g{(const bf16*)xs, (const bf16*)(ws + WS_WEU), 0, 0, DM};
                    pg8::EpiSwiGLU8 E{(unsigned char*)hid, DFE, 0}; pg8::gemm_phase<pg8::EpiSwiGLU8, pg8::MoeOrder, true, true, true, 0x7A7A7A7A>(lds, g, S, E); }
#endif
                SEAM(16);
                if (RUN(17)) { S.nN = 4; S.mode = 1; S.estride = (size_t)DM * DFE;
                    pg8::Gemm g{hid, (const bf16*)(ws + WS_WED), 0, 0, DFE};
                    pg8::EpiBf16 E{ys, DM, 0}; pg8::gemm_phase<pg8::EpiBf16, pg8::MoeOrder, true, true, true, 0x79797979>(lds, g, S, E); }
                SEAM(17);
            }
            if (RUN(18)) { NormArgs na{}; na.xin16 = xb; na.g = gv + 6144; na.tok = tok; na.ecnt = ecnt; na.ys = ys; na.gate = ml + 5120; na.out = out; ph_norm<2>(na, lds, bid, nblk); }
        }
    }
#undef RUN
#undef SEAM
}

extern "C" void kernel_launch(void* const* d_in, const int* in_sizes, int n_in, void* d_out, int out_size, void* d_ws, size_t ws_size, hipStream_t stream) {
    static int grid = 0;
    if (grid == 0) {
        if (n_in != 17 || out_size != T * DM || ws_size < WS_END) { fprintf(stderr, "kernel_launch: unexpected problem (n_in %d out %d ws %zu)\n", n_in, out_size, ws_size); grid = -1; return; }
        int dev = 0, cus = 0, per_cu = 0;
        if (hipGetDevice(&dev) != hipSuccess || hipDeviceGetAttribute(&cus, hipDeviceAttributeMultiprocessorCount, dev) != hipSuccess) { grid = -1; return; }
        if (hipFuncSetAttribute((const void*)mega_fwd, hipFuncAttributeMaxDynamicSharedMemorySize, LDS_BYTES) != hipSuccess) { fprintf(stderr, "kernel_launch: hipFuncSetAttribute failed\n"); grid = -1; return; }
        if (hipOccupancyMaxActiveBlocksPerMultiprocessor(&per_cu, (const void*)mega_fwd, 512, LDS_BYTES) != hipSuccess || per_cu < 1) fprintf(stderr, "kernel_launch: occupancy query says %d\n", per_cu);
        (void)hipGetLastError();
        grid = cus;
    }
    if (grid < 0) return;
    if (hipMemsetAsync((unsigned char*)d_ws + WS_CTL, 0, CTL_BYTES, stream) != hipSuccess) return;
    MegaArgs a{};
    for (int i = 0; i < 17; ++i) a.in[i] = (const float*)d_in[i];
    a.out = (float*)d_out; a.ws = (unsigned char*)d_ws;
#if MK_SPLIT
    for (int p = 0; p < N_PHASES; ++p) { a.ph_lo = p; a.ph_hi = p + 1; hipLaunchKernelGGL(mega_fwd, dim3(grid), dim3(512), LDS_BYTES, stream, a); }
#elif defined(PROBE_PHASE)
    a.li = 0; a.ph_lo = 0; a.ph_hi = PROBE_PHASE + 1; hipLaunchKernelGGL(mega_fwd, dim3(grid), dim3(512), LDS_BYTES, stream, a);
    a.li = 1; a.ph_lo = PROBE_PHASE; a.ph_hi = PROBE_PHASE + 1; hipLaunchKernelGGL(mega_fwd, dim3(grid), dim3(512), LDS_BYTES, stream, a);
    a.li = 2; a.ph_lo = PROBE_PHASE + 1; a.ph_hi = N_PHASES; hipLaunchKernelGGL(mega_fwd, dim3(grid), dim3(512), LDS_BYTES, stream, a);
#else
    a.ph_lo = 0; a.ph_hi = N_PHASES;
    hipLaunchKernelGGL(mega_fwd, dim3(grid), dim3(512), LDS_BYTES, stream, a);
#endif
}
```

```cpp
#define WIN_FP8 1
#define WOUT_FP8 1
#define MOE_GATHER_A 1
#define PREP_LAZY 1
#define DL_TR 1
#define AT_TR 1
#define SWIGLU_PK 1
#define AT_BFI 1
#define WIN_VARIANT_C 1
#define SB_WAVE 1
#define HEAD_PASS 1
#define DSA_BITSLICE 1
#define FIN_WIDE 1
#define Q_FIRST 1
#include <hip/hip_runtime.h>
#include <cstdio>
#include <cstdint>

#define LAS __attribute__((address_space(3)))
#define GAS __attribute__((address_space(1)))
typedef unsigned short bf16;
typedef short bf16x8 __attribute__((ext_vector_type(8)));
typedef float f32x4 __attribute__((ext_vector_type(4)));
typedef float f32x16 __attribute__((ext_vector_type(16)));
typedef unsigned u32x4 __attribute__((ext_vector_type(4)));
typedef unsigned u32x2 __attribute__((ext_vector_type(2)));

constexpr int NB = 8, SEQ = 4096, T = NB * SEQ, DM = 1024, NLAYER = 2;
constexpr int PW = 3840;
constexpr int NIN = 3656;
constexpr int COL_QI = 3072, COL_KI = 3584, COL_WI = 3648;
constexpr int DFF = 2816, DFE = 3584, NEXP = 8;
constexpr float EPS = 1e-6f;
constexpr int XS_TILES = 264;

constexpr size_t MiB = 1u << 20;
constexpr size_t WS_CTL = 0, CTL_BYTES = 1 * MiB;
constexpr size_t WS_MOD = 1 * MiB;
constexpr size_t WS_GV = 1 * MiB + 400 * 1024;
constexpr size_t WS_KMEAN = 1 * MiB + 512 * 1024;
constexpr size_t WS_MOBASEL = 1 * MiB + 768 * 1024;
constexpr size_t WS_TOK = 2 * MiB;
constexpr size_t WS_WIN = 4 * MiB;
constexpr size_t WS_WIN8 = 458 * MiB;
#if defined(WIN_VARIANT_C)
constexpr unsigned WIN_BF16_TILES = 0x7000u; constexpr int WIN_NB16 = 3, WIN_FULL8 = 5; constexpr unsigned long long WIN_LIST16 = 0xEDCull, WIN_LIST8 = 0xBA9876543210ull;
#elif defined(WIN_VARIANT_B)
constexpr unsigned WIN_BF16_TILES = 0x4600u; constexpr int WIN_NB16 = 3, WIN_FULL8 = 5; constexpr unsigned long long WIN_LIST16 = 0xEA9ull, WIN_LIST8 = 0xDCB876543210ull;
#else
constexpr unsigned WIN_BF16_TILES = 0x7600u;
constexpr int WIN_NB16 = 5, WIN_FULL8 = 4; constexpr unsigned long long WIN_LIST16 = 0xEDCA9ull, WIN_LIST8 = 0xB876543210ull;
#endif
constexpr size_t WS_ACT8W = 360 * MiB;
constexpr size_t WS_WOUT = 19 * MiB;
constexpr size_t WS_WFU = 23 * MiB;
constexpr size_t WS_WFD = 34 * MiB;
constexpr size_t WS_ELIST = 37 * MiB;
constexpr size_t WS_ACT = 40 * MiB;
constexpr size_t WS_P = 104 * MiB;
constexpr size_t WS_HID = 104 * MiB;
constexpr size_t WS_XS = 336 * MiB;
constexpr size_t WS_YS = 336 * MiB;
constexpr size_t WS_MASK = 344 * MiB;
constexpr size_t WS_WEU = 402 * MiB;
constexpr size_t WS_WED = 468 * MiB;
constexpr size_t WS_XB = 496 * MiB;
constexpr size_t WS_END = 560 * MiB;
constexpr int CW_ECNT = 64;
constexpr int CW_KNMAX = 128;
constexpr int CW_QUEUE = 256;
constexpr int CW_PREPQ = 352, CW_PDONE = 353;
constexpr int CW_BAR = 4096;

__device__ __forceinline__ float bf2f(unsigned v) { return __uint_as_float(v << 16); }
__device__ __forceinline__ unsigned f2bf(float f) { unsigned u = __float_as_uint(f); return (u + 0x7fffu + ((u >> 16) & 1u)) >> 16; }
__device__ __forceinline__ unsigned pk2(float lo, float hi) { return f2bf(lo) | (f2bf(hi) << 16); }
__device__ __forceinline__ unsigned cvt_pk_bf16(float lo, float hi) { unsigned r; asm volatile("v_cvt_pk_bf16_f32 %0, %1, %2" : "=v"(r) : "v"(lo), "v"(hi)); return r; }
__device__ __forceinline__ float wave_sum(float v) {
#pragma unroll
    for (int o = 1; o < 64; o <<= 1) v += __shfl_xor(v, o);
    return v;
}
__device__ __forceinline__ void ld8(const bf16* p, float* f) {
    const u32x4 u = *(const u32x4*)p;
    f[0] = __uint_as_float(u.x << 16); f[1] = __uint_as_float(u.x & 0xffff0000u);
    f[2] = __uint_as_float(u.y << 16); f[3] = __uint_as_float(u.y & 0xffff0000u);
    f[4] = __uint_as_float(u.z << 16); f[5] = __uint_as_float(u.z & 0xffff0000u);
    f[6] = __uint_as_float(u.w << 16); f[7] = __uint_as_float(u.w & 0xffff0000u);
}
__device__ __forceinline__ float alibi_slope(int mixer_pos, int h) { return exp2f(-8.0f * (float)(3 * h + mixer_pos + 1) / 12.0f); }
__device__ __forceinline__ float silu_f(float x) { return x * __builtin_amdgcn_rcpf(1.0f + __expf(-x)); }
__device__ __forceinline__ int otid() { int t = threadIdx.x; asm volatile("" : "+v"(t)); return t; }
#define XB_TMO      128
#define XB_XCNT(j)  (256  + 64 * (j))
#define XB_XSUB(j)  (1280 + 64 * (j))
#define XB_XGEN(j)  (2304 + 64 * (j))
#define XB_TOP      3328
#define XB_TOPGEN   3392
#define XCD_BAR_WORDS 3456
#define XB_SPIN_CAP (1u << 18)

__device__ __forceinline__ unsigned xb_ld(unsigned* p)              { return __hip_atomic_load(p, __ATOMIC_RELAXED, __HIP_MEMORY_SCOPE_AGENT); }
__device__ __forceinline__ unsigned xb_add(unsigned* p, unsigned v) { return __hip_atomic_fetch_add(p, v, __ATOMIC_RELAXED, __HIP_MEMORY_SCOPE_AGENT); }
__device__ __forceinline__ unsigned xb_xcc_id() { return (unsigned)__builtin_amdgcn_s_getreg((3 << 11) | 20) & 0xFu; }
#define XB_SPIN(cond, bar) do { unsigned _sp = 0; while (cond) { __builtin_amdgcn_s_sleep(1); \
    if ((++_sp & 255u) == 0u) { if (xb_ld(&(bar)[XB_TMO])) break; if (_sp > XB_SPIN_CAP) { atomicAdd(&(bar)[XB_TMO], 1u); break; } } } } while (0)

struct XcdBarrier {
    unsigned* bar; unsigned x;
    volatile LAS unsigned* st;
};

__device__ __forceinline__ XcdBarrier xcd_barrier_post(unsigned* bar, volatile LAS unsigned* st) {
    XcdBarrier b; b.bar = bar; b.x = xb_xcc_id(); b.st = st;
    if (threadIdx.x == 0) (void)xb_add(&bar[XB_XCNT(b.x)], 1u);
    return b;
}
__device__ __forceinline__ void xcd_barrier_complete(unsigned* bar, unsigned x, unsigned& nloc, unsigned& nx) {
    const unsigned G = gridDim.x * gridDim.y * gridDim.z;
    unsigned sum, cnt, mine, sp = 0u;
    for (;;) {
        asm volatile("" : "+s"(bar), "+s"(x));
        sum = 0u; cnt = 0u; mine = 0u;
#pragma unroll
        for (unsigned j = 0; j < 16; ++j) { const unsigned c = xb_ld(&bar[XB_XCNT(j)]); sum += c; cnt += (c > 0u) ? 1u : 0u; mine = (j == x) ? c : mine; }
        if (sum == G) break;
        __builtin_amdgcn_s_sleep(1);
        if ((++sp & 255u) == 0u) { if (xb_ld(&bar[XB_TMO])) break; if (sp > XB_SPIN_CAP) { atomicAdd(&bar[XB_TMO], 1u); break; } }
    }
    nloc = mine > 0u ? mine : 1u; nx = cnt > 0u ? cnt : 1u;
}

__device__ __forceinline__ void xcd_barrier(const XcdBarrier& b) {
    asm volatile("s_waitcnt vmcnt(0)" ::: "memory");
    __syncthreads();
    if (threadIdx.x == 0) {
        unsigned* bar = b.bar; unsigned bx = b.x; asm volatile("" : "+s"(bx));
        __builtin_amdgcn_s_waitcnt(0);
        unsigned nloc = b.st[0], nx = b.st[1];
        if (nloc == 0u) { xcd_barrier_complete(bar, bx, nloc, nx); b.st[0] = nloc; b.st[1] = nx; }
        const unsigned old = xb_add(&bar[XB_XSUB(bx)], 1u);
        const unsigned gen = old / nloc;
        if (old + 1u == (gen + 1u) * nloc) {
            __builtin_amdgcn_fence(__ATOMIC_RELEASE, "agent");
            asm volatile("s_waitcnt vmcnt(0)" ::: "memory");
            const unsigned og = xb_add(&bar[XB_TOP], 1u);
            const unsigned tg = og / nx;
            if (og + 1u == (tg + 1u) * nx) xb_add(&bar[XB_TOPGEN], 1u);
            else XB_SPIN(xb_ld(&bar[XB_TOPGEN]) == tg, bar);
            __builtin_amdgcn_fence(__ATOMIC_ACQUIRE, "agent");
            xb_add(&bar[XB_XGEN(bx)], 1u);
            asm volatile("s_waitcnt vmcnt(0)" ::: "memory");
        } else {
            XB_SPIN(xb_ld(&bar[XB_XGEN(bx)]) == gen, bar);
            __builtin_amdgcn_fence(__ATOMIC_ACQUIRE, "agent");
            asm volatile("s_waitcnt vmcnt(0)" ::: "memory");
        }
    }
    __syncthreads();
}
namespace pg8 {
#define PG8_LAS __attribute__((address_space(3)))
typedef unsigned short bf16_t;
typedef short bf16x8 __attribute__((ext_vector_type(8)));
typedef float f32x4 __attribute__((ext_vector_type(4)));
typedef unsigned u32x4 __attribute__((ext_vector_type(4)));
constexpr int BM = 256, BK = 64, HALF = 128, HTB = HALF * BK * 2  , STAGE_BYTES = 8 * HTB, NXCD = 8, WGM = 8;

__host__ __device__ __forceinline__ int lds_byte(int r, int c) { const int st = (r >> 4) * 2 + (c >> 5), rr = r & 15, cc = c & 31, ob = rr * 64 + cc * 2; return st * 1024 + (ob ^ (((ob >> 9) & 1) << 5)); }
__host__ __device__ __forceinline__ void stage_rc(int b, int& R, int& C) { const int st = b / 1024, sb = b % 1024, swz = sb ^ (((sb >> 9) & 1) << 5); R = (st >> 1) * 16 + swz / 64; C = (st & 1) * 32 + (swz % 64) / 2; }
__host__ __device__ __forceinline__ int perm32(int rho) { const int n = rho >> 4, i = rho & 15; return 8 * (i >> 2) + 4 * n + (i & 3); }

struct Unit { int pm, pn; };
struct Gemm { const bf16_t* A; const bf16_t* Bt; int M, N, K; };

struct StaticOrder {
    int nM, nN, nwg, G, c;
    __host__ __device__ void init(int M, int N, int G_, int c_) { nM = M / BM; nN = N / BM; nwg = nM * nN; G = G_; c = c_; }
    __host__ __device__ bool next(int i, Unit& u) const {
        const long L = (long)i * G + c; if (L >= nwg) return false;
        int wgid = (int)L; { const int q = nwg / NXCD, r = nwg % NXCD, xcd = wgid % NXCD, off = wgid / NXCD; wgid = (xcd < r ? xcd * (q + 1) : r * (q + 1) + (xcd - r) * q) + off; }
        const int nig = WGM * nN, gid = wgid / nig, fm = gid * WGM, gsz = (nM - fm) < WGM ? (nM - fm) : WGM;
        u.pm = fm + ((wgid % nig) % gsz); u.pn = (wgid % nig) / gsz; return true;
    }
    __device__ __forceinline__ void a_ready(const Unit&) const {}
    __device__ __forceinline__ void done(const Unit&) const {}
    __device__ __forceinline__ const char* a_base(const Gemm& g, const Unit& u, size_t tstep) const { return (const char*)g.A + (size_t)u.pm * tstep; }
    __device__ __forceinline__ const char* b_base(const Gemm& g, const Unit& u, size_t tstep) const { return (const char*)g.Bt + (size_t)u.pn * tstep; }
};


typedef int v4i_t __attribute__((ext_vector_type(4)));
typedef int v8i_t __attribute__((ext_vector_type(8)));
__device__ __forceinline__ v8i_t cat8(bf16x8 lo, bf16x8 hi) { const v4i_t a = __builtin_bit_cast(v4i_t, lo), b = __builtin_bit_cast(v4i_t, hi); return __builtin_shufflevector(a, b, 0, 1, 2, 3, 4, 5, 6, 7); }
__device__ __forceinline__ unsigned pk4_fp8(float a, float b, float c, float d) {
    a = fminf(fmaxf(a, -448.f), 448.f); b = fminf(fmaxf(b, -448.f), 448.f); c = fminf(fmaxf(c, -448.f), 448.f); d = fminf(fmaxf(d, -448.f), 448.f);
    int w = 0; w = __builtin_amdgcn_cvt_pk_fp8_f32(a, b, w, false); w = __builtin_amdgcn_cvt_pk_fp8_f32(c, d, w, true); return (unsigned)w; }

struct EpiBf16 {
    static constexpr bool PERM = true, AFTER_DRAIN = false;
    bf16_t* O; int ldc; int row_shift;
    __device__ __forceinline__ void operator()(const f32x4 (&acc)[2][2][4][2], const Unit& u, int wr, int wc, int fr, int fq) const {
        const int row0 = u.pm * BM + row_shift + wr * 64 + fr, col0 = u.pn * BM + wc * 32 + 8 * fq;
#pragma unroll
        for (int ai = 0; ai < 2; ++ai)
#pragma unroll
            for (int m = 0; m < 4; ++m) { bf16_t* rowp = O + (size_t)(row0 + ai * HALF + m * 16) * ldc + col0;
#pragma unroll
                for (int bj = 0; bj < 2; ++bj) { const f32x4 v0 = acc[ai][bj][m][0], v1 = acc[ai][bj][m][1];
                    u32x4 w; w.x = cvt_pk_bf16(v0[0], v0[1]); w.y = cvt_pk_bf16(v0[2], v0[3]); w.z = cvt_pk_bf16(v1[0], v1[1]); w.w = cvt_pk_bf16(v1[2], v1[3]);
                    *(u32x4*)(rowp + bj * HALF) = w; } }
    }
};
struct EpiSwiGLU {
    static constexpr bool PERM = true, AFTER_DRAIN = false;
    bf16_t* H; int ldh; int row_shift;
    __device__ __forceinline__ void operator()(const f32x4 (&acc)[2][2][4][2], const Unit& u, int wr, int wc, int fr, int fq) const {
        const int row0 = u.pm * BM + row_shift + wr * 64 + fr, col0 = u.pn * HALF + wc * 32 + 8 * fq;
#pragma unroll
        for (int ai = 0; ai < 2; ++ai)
#pragma unroll
            for (int m = 0; m < 4; ++m) { bf16_t* rowp = H + (size_t)(row0 + ai * HALF + m * 16) * ldh + col0;
                const f32x4 g0 = acc[ai][0][m][0], g1 = acc[ai][0][m][1], u0 = acc[ai][1][m][0], u1 = acc[ai][1][m][1];
                float h[8];
#pragma unroll
                for (int i = 0; i < 4; ++i) { h[i] = silu_f(g0[i]) * u0[i]; h[4 + i] = silu_f(g1[i]) * u1[i]; }
                u32x4 w; w.x = cvt_pk_bf16(h[0], h[1]); w.y = cvt_pk_bf16(h[2], h[3]); w.z = cvt_pk_bf16(h[4], h[5]); w.w = cvt_pk_bf16(h[6], h[7]);
                *(u32x4*)rowp = w; }
    }
};
struct EpiSwiGLU8 {
    static constexpr bool PERM = true, AFTER_DRAIN = false;
    unsigned char* H; int ldh; int row_shift;
    __device__ __forceinline__ void operator()(const f32x4 (&acc)[2][2][4][2], const Unit& u, int wr, int wc, int fr, int fq) const {
        const int row0 = u.pm * BM + row_shift + wr * 64 + fr, col0 = u.pn * HALF + wc * 32 + 8 * fq;
#pragma unroll
        for (int ai = 0; ai < 2; ++ai)
#pragma unroll
            for (int m = 0; m < 4; ++m) { unsigned char* rowp = H + (size_t)(row0 + ai * HALF + m * 16) * ldh + col0;
                const f32x4 g0 = acc[ai][0][m][0], g1 = acc[ai][0][m][1], u0 = acc[ai][1][m][0], u1 = acc[ai][1][m][1];
                float h[8];
#ifdef SWIGLU_PK
                typedef float f32x2_t __attribute__((ext_vector_type(2)));
#pragma unroll
                for (int i = 0; i < 4; i += 2) {
                    const f32x2_t ga = {g0[i], g0[i + 1]}, gb = {g1[i], g1[i + 1]}, ua = {u0[i], u0[i + 1]}, ub = {u1[i], u1[i + 1]};
                    f32x2_t ea = {__builtin_amdgcn_exp2f(-ga.x), __builtin_amdgcn_exp2f(-ga.y)}, eb = {__builtin_amdgcn_exp2f(-gb.x), __builtin_amdgcn_exp2f(-gb.y)};
                    ea = ea + 1.0f; eb = eb + 1.0f;
                    const f32x2_t ra = {__builtin_amdgcn_rcpf(ea.x), __builtin_amdgcn_rcpf(ea.y)}, rb = {__builtin_amdgcn_rcpf(eb.x), __builtin_amdgcn_rcpf(eb.y)};
                    const f32x2_t ha = (ga * ua) * ra, hb = (gb * ub) * rb;
                    h[i] = ha.x; h[i + 1] = ha.y; h[4 + i] = hb.x; h[4 + i + 1] = hb.y; }
#else
#pragma unroll
                for (int i = 0; i < 4; ++i) { h[i] = silu_f(g0[i]) * u0[i]; h[4 + i] = silu_f(g1[i]) * u1[i]; }
#endif
                typedef unsigned u32x2_t __attribute__((ext_vector_type(2)));
                u32x2_t w; w.x = pk4_fp8(h[0], h[1], h[2], h[3]); w.y = pk4_fp8(h[4], h[5], h[6], h[7]);
                *(u32x2_t*)rowp = w;
                asm volatile("" ::: "memory"); }
    }
};
struct EpiRes {
    static constexpr bool PERM = true, AFTER_DRAIN = false;
    const float* xin32; const bf16_t* xin16; bf16_t* xout; const float* gate;
    __device__ __forceinline__ void operator()(const f32x4 (&acc)[2][2][4][2], const Unit& u, int wr, int wc, int fr, int fq) const {
        const int row0 = u.pm * BM + wr * 64 + fr, col0 = u.pn * BM + wc * 32 + 8 * fq;
        const float* gb = gate + (size_t)((u.pm * BM) / SEQ) * 6144;
        f32x4 gv[2][2];
#pragma unroll
        for (int bj = 0; bj < 2; ++bj)
#pragma unroll
            for (int n = 0; n < 2; ++n) gv[bj][n] = *(const f32x4*)(gb + col0 + bj * HALF + n * 4);
#pragma unroll
        for (int ai = 0; ai < 2; ++ai)
#pragma unroll
            for (int m = 0; m < 4; ++m) { const size_t off = (size_t)(row0 + ai * HALF + m * 16) * DM + col0;
#pragma unroll
                for (int bj = 0; bj < 2; ++bj) { f32x4 x0, x1;
                    if (xin32) { x0 = *(const f32x4*)(xin32 + off + bj * HALF); x1 = *(const f32x4*)(xin32 + off + bj * HALF + 4); }
                    else { const u32x4 w = *(const u32x4*)(xin16 + off + bj * HALF);
                        x0 = (f32x4){__uint_as_float(w.x << 16), __uint_as_float(w.x & 0xffff0000u), __uint_as_float(w.y << 16), __uint_as_float(w.y & 0xffff0000u)};
                        x1 = (f32x4){__uint_as_float(w.z << 16), __uint_as_float(w.z & 0xffff0000u), __uint_as_float(w.w << 16), __uint_as_float(w.w & 0xffff0000u)}; }
                    x0 = x0 + gv[bj][0] * acc[ai][bj][m][0]; x1 = x1 + gv[bj][1] * acc[ai][bj][m][1];
                    u32x4 o; o.x = cvt_pk_bf16(x0[0], x0[1]); o.y = cvt_pk_bf16(x0[2], x0[3]); o.z = cvt_pk_bf16(x1[0], x1[1]); o.w = cvt_pk_bf16(x1[2], x1[3]);
                    *(u32x4*)(xout + off + bj * HALF) = o; } }
    }
};
struct SubOrder {
    int nM, nN, nwg, G, c, full, skip; unsigned long long list;
    __host__ __device__ void init(int M, int ncol, unsigned long long list_, int G_, int c_, int full_, int skip_) { nM = M / BM; nN = ncol; nwg = nM * nN; G = G_; c = c_; full = full_; skip = skip_; list = list_; }
    __host__ __device__ bool next(int i, Unit& u) const {
        long L;
        if (i >= full) { if (c < skip) return false; L = (long)full * G + (long)(i - full) * (G - skip) + (c - skip); } else L = (long)i * G + c;
        if (L >= nwg) return false;
        int wgid = (int)L; { const int q = nwg / NXCD, r = nwg % NXCD, xcd = wgid % NXCD, off = wgid / NXCD; wgid = (xcd < r ? xcd * (q + 1) : r * (q + 1) + (xcd - r) * q) + off; }
        const int nig = WGM * nN, gid = wgid / nig, fm = gid * WGM, gsz = (nM - fm) < WGM ? (nM - fm) : WGM;
        u.pm = fm + ((wgid % nig) % gsz); u.pn = (int)((list >> (4 * ((wgid % nig) / gsz))) & 15ull); return true;
    }
    __device__ __forceinline__ void a_ready(const Unit&) const {}
    __device__ __forceinline__ void done(const Unit&) const {}
    __device__ __forceinline__ const char* a_base(const Gemm& g, const Unit& u, size_t tstep) const { return (const char*)g.A + (size_t)u.pm * tstep; }
    __device__ __forceinline__ const char* b_base(const Gemm& g, const Unit& u, size_t tstep) const { return (const char*)g.Bt + (size_t)u.pn * tstep; }
};
struct MoeOrder {
    int nrt, nN, G, c, mode; const PG8_LAS unsigned char* etab; size_t estride; int pm0, pn0, cnt; const PG8_LAS unsigned* rowtab;
    __device__ __forceinline__ bool next(int i, Unit& u) const {
        if (nrt <= 0) return false;
        if (mode == 2) { if (i >= cnt) return false; u.pm = pm0; u.pn = pn0 + i; return true; }
        if (mode == 0) {
            const int full = nrt / G, rem = nrt - full * G;
            if (i < full * nN) { u.pm = (i / nN) * G + c; u.pn = i % nN; return true; }
            const int L = (i - full * nN) * G + c; if (rem <= 0 || L >= rem * nN) return false;
            u.pm = full * G + L % rem; u.pn = L / rem; return true;
        }
        if ((G & 31) == 0) { const int x = c & 7, y = c >> 3, ppr = G / nN;
            const int pm = i * ppr + x + 8 * (y >> 2); if (pm >= nrt) return false; u.pm = pm; u.pn = y & 3; return true; }
        const int L = i * G + c; if (L >= nrt * nN) return false; u.pm = L / nN; u.pn = L % nN; return true;
    }
    __device__ __forceinline__ void a_ready(const Unit&) const {}
    __device__ __forceinline__ void done(const Unit&) const {}
    __device__ __forceinline__ const char* a_base(const Gemm& g, const Unit& u, size_t tstep) const { return mode == 2 ? (const char*)g.A : (const char*)g.A + (size_t)u.pm * tstep; }
    __device__ __forceinline__ const char* b_base(const Gemm& g, const Unit& u, size_t tstep) const {
        const int e = __builtin_amdgcn_readfirstlane((int)etab[u.pm]);
        return (const char*)g.Bt + (size_t)e * estride + (size_t)u.pn * tstep;
    }
};
template <class Epi, class Sched, bool ALIGN_EPI = false, bool SP2 = false, bool FP8 = false, int sc_w = 0x7F7F7F7F, int sc_a = 0x7F7F7F7F, bool GA = false>
__device__ __forceinline__ void gemm_phase(PG8_LAS unsigned char* lds, const Gemm g, const Sched& S, const Epi& E) {
    int tid_ = threadIdx.x; asm volatile("" : "+v"(tid_));
    const int tid = tid_, wid = __builtin_amdgcn_readfirstlane(tid >> 6), lane = tid & 63, wr = wid >> 2, wc = wid & 3, fr = lane & 15, fq = lane >> 4;
    constexpr int ES = FP8 ? 1 : 2;
    int K_ = g.K; asm volatile("" : "+s"(K_));
    const int K = K_, nt = K * ES / (BK * 2);
    unsigned voffA[2], voffA1[2], voffB[2];
#pragma unroll
    for (int i = 0; i < 2; ++i) { int R, C; stage_rc(tid * 16 + i * 8192, R, C); const int Rb = Epi::PERM ? ((R & ~31) + perm32(R & 31)) : R;
        voffB[i] = (unsigned)(Rb * K * ES + C * 2);
        if constexpr (GA) { voffA[i] = S.rowtab[R] + (unsigned)(C * 2); voffA1[i] = S.rowtab[R + HALF] + (unsigned)(C * 2); }
        else { voffA[i] = (unsigned)(R * K * ES + C * 2); voffA1[i] = voffA[i]; } }
    const size_t kstep = (size_t)(BK * 2);
    const size_t hstep = (size_t)HALF * K * ES;
    const size_t hstepA = GA ? (size_t)0 : hstep;
    const size_t tstep = 2 * hstep;
    const unsigned ldsw = (unsigned)wid * 1024u;
    const int aoff = lds_byte(wr * 64 + fr, fq * 8), boff = lds_byte(wc * 32 + fr, fq * 8);
#define PG8_SA(b, h) (((b) * 2 + (h)) * HTB)
#define PG8_SB(b, h) ((4 + (b) * 2 + (h)) * HTB)
#define PG8_STAGE(bufoff, gbase, voff) do { _Pragma("unroll") for (int _i = 0; _i < 2; ++_i) \
        __builtin_amdgcn_global_load_lds((const unsigned*)((const char*)(gbase) + (voff)[_i]), (PG8_LAS unsigned*)(lds + (bufoff) + ldsw + _i * 8192), 16, 0, 0); } while (0)
#define PG8_LDA(dst, b, h) do { _Pragma("unroll") for (int m = 0; m < 4; ++m) { \
        if constexpr (FP8) { const v4i_t l_ = *(const PG8_LAS v4i_t*)(lds + PG8_SA(b, h) + aoff + m * 2048), h_ = *(const PG8_LAS v4i_t*)(lds + PG8_SA(b, h) + aoff + m * 2048 + 1024); dst##F[m] = __builtin_shufflevector(l_, h_, 0, 1, 2, 3, 4, 5, 6, 7); } \
        else { _Pragma("unroll") for (int k = 0; k < 2; ++k) dst[m][k] = *(const PG8_LAS bf16x8*)(lds + PG8_SA(b, h) + aoff + m * 2048 + k * 1024); } } } while (0)
#define PG8_LDB(dst, b, h) do { _Pragma("unroll") for (int n = 0; n < 2; ++n) { \
        if constexpr (FP8) { const v4i_t l_ = *(const PG8_LAS v4i_t*)(lds + PG8_SB(b, h) + boff + n * 2048), h_ = *(const PG8_LAS v4i_t*)(lds + PG8_SB(b, h) + boff + n * 2048 + 1024); dst##F[n] = __builtin_shufflevector(l_, h_, 0, 1, 2, 3, 4, 5, 6, 7); } \
        else { _Pragma("unroll") for (int k = 0; k < 2; ++k) dst[n][k] = *(const PG8_LAS bf16x8*)(lds + PG8_SB(b, h) + boff + n * 2048 + k * 1024); } } } while (0)
#define PG8_MMA(ai, bj, At, Bt) do { __builtin_amdgcn_s_setprio(1); _Pragma("unroll") for (int m = 0; m < 4; ++m) _Pragma("unroll") for (int n = 0; n < 2; ++n) { \
        if constexpr (FP8) asm volatile("v_mfma_scale_f32_16x16x128_f8f6f4 %0, %1, %2, %0, %3, %4 op_sel_hi:[0,0,0]" : "+v"(acc[ai][bj][m][n]) : "v"(Bt##F[n]), "v"(At##F[m]), "v"(sc_w), "v"(sc_a)); \
        else { _Pragma("unroll") for (int k = 0; k < 2; ++k) acc[ai][bj][m][n] = __builtin_amdgcn_mfma_f32_16x16x32_bf16(Bt[n][k], At[m][k], acc[ai][bj][m][n], 0, 0, 0); } } \
        __builtin_amdgcn_s_setprio(0); } while (0)
#define PG8_WAIT_V(n) asm volatile("s_waitcnt vmcnt(" #n ")" ::: "memory")
#define PG8_WAIT_L(n) asm volatile("s_waitcnt lgkmcnt(" #n ")" ::: "memory")
#define PG8_BAR __builtin_amdgcn_s_barrier()
#define PG8_SCHED __builtin_amdgcn_sched_barrier(0)
    Unit cur, nxt; int ui = 0;
    if (!S.next(0, cur)) return;
    f32x4 acc[2][2][4][2];
#pragma unroll
    for (int a = 0; a < 2; ++a)
#pragma unroll
        for (int b = 0; b < 2; ++b)
#pragma unroll
            for (int m = 0; m < 4; ++m)
#pragma unroll
                for (int n = 0; n < 2; ++n) acc[a][b][m][n] = (f32x4){0.f, 0.f, 0.f, 0.f};
    bf16x8 At[4][2], B0[2][2], B1[2][2];
    v8i_t AtF[4], B0F[2], B1F[2];
    const char* cA = S.a_base(g, cur, tstep); const char* cB = S.b_base(g, cur, tstep);
    S.a_ready(cur);
    if constexpr (SP2) {
        PG8_STAGE(PG8_SB(0, 0), cB, voffB); PG8_STAGE(PG8_SB(0, 1), cB + hstep, voffB); PG8_STAGE(PG8_SA(0, 0), cA, voffA); PG8_STAGE(PG8_SA(0, 1), cA + hstepA, voffA1);
        if (wr == 1) PG8_BAR;
        PG8_WAIT_V(2); PG8_BAR;
        PG8_STAGE(PG8_SB(1, 0), cB + kstep, voffB); PG8_STAGE(PG8_SA(1, 0), cA + kstep, voffA); PG8_STAGE(PG8_SB(1, 1), cB + hstep + kstep, voffB);
        PG8_WAIT_V(6); PG8_BAR;
    } else {
        PG8_STAGE(PG8_SB(0, 0), cB, voffB); PG8_STAGE(PG8_SA(0, 0), cA, voffA); PG8_STAGE(PG8_SB(0, 1), cB + hstep, voffB); PG8_STAGE(PG8_SA(0, 1), cA + hstepA, voffA1);
        if (wr == 1) PG8_BAR;
        PG8_WAIT_V(4); PG8_BAR;
        PG8_STAGE(PG8_SB(1, 0), cB + kstep, voffB); PG8_STAGE(PG8_SA(1, 0), cA + kstep, voffA); PG8_STAGE(PG8_SB(1, 1), cB + hstep + kstep, voffB);
        PG8_WAIT_V(6); PG8_BAR;
    }
    for (;;) {
        const bool has_next = S.next(ui + 1, nxt);
        const char* nA = has_next ? S.a_base(g, nxt, tstep) : cA; const char* nB = has_next ? S.b_base(g, nxt, tstep) : cB;
        for (int t = 0; t < nt; t += 2) {
            const bool last = (t == nt - 2);
            const char* a1 = cA + (size_t)(t + 1) * kstep;
            const char* a2 = last ? nA : cA + (size_t)(t + 2) * kstep; const char* b2 = last ? nB : cB + (size_t)(t + 2) * kstep;
            const char* a3 = a2 + kstep; const char* b3 = b2 + kstep;
            if (last && has_next) S.a_ready(nxt);
            if constexpr (SP2) {
            PG8_LDB(B0, 0, 0); PG8_LDB(B1, 0, 1); PG8_SCHED; PG8_LDA(At, 0, 0); PG8_STAGE(PG8_SA(1, 1), a1 + hstepA, voffA1);
            PG8_WAIT_V(8); PG8_WAIT_L(0); PG8_BAR; PG8_MMA(0, 0, At, B0); PG8_MMA(0, 1, At, B1); PG8_BAR; PG8_SCHED;
            PG8_LDA(At, 0, 1); PG8_STAGE(PG8_SB(0, 0), b2, voffB); PG8_STAGE(PG8_SB(0, 1), b2 + hstep, voffB); PG8_STAGE(PG8_SA(0, 0), a2, voffA);
            PG8_WAIT_V(8); PG8_WAIT_L(0); PG8_BAR; PG8_MMA(1, 0, At, B0); PG8_MMA(1, 1, At, B1); PG8_BAR; PG8_SCHED;
            PG8_LDB(B0, 1, 0); PG8_LDB(B1, 1, 1); PG8_SCHED; PG8_LDA(At, 1, 0); PG8_STAGE(PG8_SA(0, 1), a2 + hstepA, voffA1);
            PG8_WAIT_V(8); PG8_WAIT_L(0); PG8_BAR; PG8_MMA(0, 0, At, B0); PG8_MMA(0, 1, At, B1); PG8_BAR; PG8_SCHED;
            PG8_LDA(At, 1, 1); PG8_STAGE(PG8_SB(1, 0), b3, voffB); PG8_STAGE(PG8_SB(1, 1), b3 + hstep, voffB); PG8_STAGE(PG8_SA(1, 0), a3, voffA);
            PG8_WAIT_V(8); PG8_WAIT_L(0); PG8_BAR; PG8_MMA(1, 0, At, B0); PG8_MMA(1, 1, At, B1); PG8_BAR; PG8_SCHED;
            } else {
            PG8_LDB(B0, 0, 0); PG8_SCHED; PG8_LDA(At, 0, 0); PG8_STAGE(PG8_SA(1, 1), a1 + hstepA, voffA1);
            PG8_WAIT_L(8); PG8_BAR; PG8_WAIT_L(0); PG8_MMA(0, 0, At, B0); PG8_BAR; PG8_SCHED;
            PG8_LDB(B1, 0, 1); PG8_STAGE(PG8_SB(0, 0), b2, voffB);
            PG8_BAR; PG8_WAIT_L(0); PG8_MMA(0, 1, At, B1); PG8_BAR;
            PG8_LDA(At, 0, 1); PG8_STAGE(PG8_SA(0, 0), a2, voffA);
            PG8_BAR; PG8_WAIT_L(0); PG8_MMA(1, 0, At, B0); PG8_BAR; PG8_SCHED;
            PG8_STAGE(PG8_SB(0, 1), b2 + hstep, voffB);
            PG8_WAIT_V(6); PG8_BAR; PG8_MMA(1, 1, At, B1); PG8_BAR;
            PG8_LDB(B0, 1, 0); PG8_SCHED; PG8_LDA(At, 1, 0); PG8_STAGE(PG8_SA(0, 1), a2 + hstepA, voffA1);
            PG8_WAIT_L(8); PG8_BAR; PG8_WAIT_L(0); PG8_MMA(0, 0, At, B0); PG8_BAR; PG8_SCHED;
            PG8_LDB(B1, 1, 1); PG8_STAGE(PG8_SB(1, 0), b3, voffB);
            PG8_BAR; PG8_WAIT_L(0); PG8_MMA(0, 1, At, B1); PG8_BAR;
            PG8_LDA(At, 1, 1); PG8_STAGE(PG8_SA(1, 0), a3, voffA);
            PG8_BAR; PG8_WAIT_L(0); PG8_MMA(1, 0, At, B0); PG8_BAR; PG8_SCHED;
            PG8_STAGE(PG8_SB(1, 1), b3 + hstep, voffB);
            PG8_WAIT_V(6); PG8_BAR; PG8_MMA(1, 1, At, B1); PG8_BAR;
            }
        }
        if constexpr (ALIGN_EPI) { if (wr == 0) PG8_BAR; }
        asm volatile("s_nop 15\n\ts_nop 15\n\ts_nop 15" ::: "memory");
        if constexpr (!Epi::AFTER_DRAIN) { E(acc, cur, wr, wc, fr, fq); S.done(cur); }
        if (!has_next) break;
#pragma unroll
        for (int a = 0; a < 2; ++a)
#pragma unroll
            for (int b = 0; b < 2; ++b)
#pragma unroll
                for (int m = 0; m < 4; ++m)
#pragma unroll
                    for (int n = 0; n < 2; ++n) acc[a][b][m][n] = (f32x4){0.f, 0.f, 0.f, 0.f};
        cur = nxt; cA = nA; cB = nB; ++ui;
        if constexpr (ALIGN_EPI) { if (wr == 1) PG8_BAR; }
    }
    PG8_WAIT_V(0);
    if constexpr (!ALIGN_EPI) { if (wr == 0) PG8_BAR; }
    PG8_BAR;
    if constexpr (Epi::AFTER_DRAIN) { E.fused(acc, cur, wr, wc, fr, fq, lds, wid, lane); S.done(cur); }
#undef PG8_SA
#undef PG8_SB
#undef PG8_STAGE
#undef PG8_LDA
#undef PG8_LDB
#undef PG8_MMA
#undef PG8_WAIT_V
#undef PG8_WAIT_L
#undef PG8_BAR
#undef PG8_SCHED
}
}

#define LDS_WAIT() asm volatile("s_waitcnt lgkmcnt(0)" ::: "memory")
#define VM_WAIT() asm volatile("s_waitcnt vmcnt(0)" ::: "memory")

template <bool F8 = false> __device__ __forceinline__ void transpose_item(const float* W, int ldw, int scol0, int ncol_valid, float scale, bf16* WT, int K, int drow0, int k0, LAS float* scr, int lane) {
    const int n4 = lane & 7, kr = lane >> 3; const bool ok = (scol0 + 4 * n4) < ncol_valid;
    f32x4 v[8];
    const float* wp = W + (size_t)(k0 + kr) * ldw + scol0 + 4 * n4;
#pragma unroll
    for (int i = 0; i < 8; ++i) v[i] = ok ? *(const f32x4*)(wp + (size_t)(8 * i) * ldw) : (f32x4){0.f, 0.f, 0.f, 0.f};
#pragma unroll
    for (int i = 0; i < 8; ++i) { LAS float* d = scr + (8 * i + kr) * 33 + 4 * n4; d[0] = v[i].x * scale; d[1] = v[i].y * scale; d[2] = v[i].z * scale; d[3] = v[i].w * scale; }
    LDS_WAIT(); asm volatile("" ::: "memory");
    const int c = lane & 7;
#pragma unroll
    for (int j = 0; j < 4; ++j) { const int nn = (lane >> 3) + 8 * j; const LAS float* s = scr + (8 * c) * 33 + nn;
        if (F8) { u32x2 o; o.x = pg8::pk4_fp8(s[0 * 33], s[1 * 33], s[2 * 33], s[3 * 33]); o.y = pg8::pk4_fp8(s[4 * 33], s[5 * 33], s[6 * 33], s[7 * 33]);
            *(u32x2*)((unsigned char*)WT + (size_t)(drow0 + nn) * K + k0 + 8 * c) = o; }
        else { u32x4 o; o.x = pk2(s[0 * 33], s[1 * 33]); o.y = pk2(s[2 * 33], s[3 * 33]); o.z = pk2(s[4 * 33], s[5 * 33]); o.w = pk2(s[6 * 33], s[7 * 33]);
            *(u32x4*)(WT + (size_t)(drow0 + nn) * K + k0 + 8 * c) = o; } }
    LDS_WAIT(); asm volatile("" ::: "memory");
}
#ifdef SWIGLU_PK
constexpr float SC_GATE = 32.f * 1.4426950408889634f, SC_UP = 32.f / 1.4426950408889634f;
#else
constexpr float SC_GATE = 32.f, SC_UP = 32.f;
#endif
struct PrepArgs { const float *w_in, *w_out, *wfg, *wfu, *wfd, *weg, *weu, *wed; unsigned char* ws; };
constexpr int PI_WIN = 2 * 16 * 120, PI_WOUT = 2 * 16 * 32, PI_FU = 16 * 176, PI_FD = 44 * 32, PI_EU = 8 * 16 * 224, PI_ED = 8 * 56 * 32;
constexpr int PREP_ITEMS = PI_WIN + PI_WOUT + PI_FU + PI_FD + PI_EU + PI_ED;
constexpr int PI_STATIC = PI_WIN + PI_WOUT + PI_FU + PI_FD, LAZY_BATCHES = (PI_EU + PI_ED) / 8, LAZY_NB = 4;
__device__ __forceinline__ void prep_item(const PrepArgs& a, int it, LAS float* scr, int lane) {
    int r = it;
    if (r < PI_WIN) { const int l = r / 1920; r %= 1920; const int kb = r / 120, nb = r % 120, n0 = nb * 32;
        float sc = 1.f; if (n0 >= COL_QI && n0 < COL_KI) sc = 0.125f; else if (n0 < 3072 && (n0 % 768) < 256) sc = 0.125f * 1.4426950408889634f; else if (n0 == COL_WI) sc = 0.35355339059327373f;
#ifdef WIN_FP8
        if (!((WIN_BF16_TILES >> (n0 >> 8)) & 1)) { transpose_item<true>(a.w_in + (size_t)l * DM * NIN, NIN, n0, NIN, sc * 32.f, (bf16*)(a.ws + WS_WIN8 + (size_t)l * PW * DM), DM, n0, kb * 64, scr, lane); return; }
        transpose_item(a.w_in + (size_t)l * DM * NIN, NIN, n0, NIN, sc, (bf16*)(a.ws + WS_WIN) + (size_t)l * PW * DM, DM, n0, kb * 64, scr, lane); return; }
#else
        transpose_item(a.w_in + (size_t)l * DM * NIN, NIN, n0, NIN, sc, (bf16*)(a.ws + WS_WIN) + (size_t)l * PW * DM, DM, n0, kb * 64, scr, lane); return; }
#endif
    r -= PI_WIN;
    if (r < PI_WOUT) { const int l = r / 512; r %= 512; const int kb = r / 32, nb = r % 32;
#ifdef WOUT_FP8
        transpose_item<true>(a.w_out + (size_t)l * DM * DM, DM, nb * 32, DM, 64.f, (bf16*)(a.ws + WS_WOUT + (size_t)l * DM * DM), DM, nb * 32, kb * 64, scr, lane); return; }
#else
        transpose_item(a.w_out + (size_t)l * DM * DM, DM, nb * 32, DM, 1.f, (bf16*)(a.ws + WS_WOUT) + (size_t)l * DM * DM, DM, nb * 32, kb * 64, scr, lane); return; }
#endif
    r -= PI_WOUT;
    if (r < PI_FU) { const int kb = r / 176, nb = r % 176, r0 = nb * 32, blk = r0 >> 8, w = r0 & 255;
        transpose_item<true>(w < 128 ? a.wfg : a.wfu, DFF, blk * 128 + (w & 127), DFF, w < 128 ? SC_GATE : SC_UP, (bf16*)(a.ws + WS_WFU), DM, r0, kb * 64, scr, lane); return; }
    r -= PI_FU;
    if (r < PI_FD) { const int kb = r / 32, nb = r % 32;
        transpose_item<true>(a.wfd, DM, nb * 32, DM, 64.f, (bf16*)(a.ws + WS_WFD), DFF, nb * 32, kb * 64, scr, lane); return; }
    r -= PI_FD;
    if (r < PI_EU) { const int e = r / 3584; r %= 3584; const int kb = r / 224, nb = r % 224, r0 = nb * 32, blk = r0 >> 8, w = r0 & 255;
        transpose_item<true>((w < 128 ? a.weg : a.weu) + (size_t)e * DM * DFE, DFE, blk * 128 + (w & 127), DFE, w < 128 ? SC_GATE : SC_UP, (bf16*)(a.ws + WS_WEU + (size_t)e * 7168 * DM), DM, r0, kb * 64, scr, lane); return; }
    r -= PI_EU;
    { const int e = r / 1792; r %= 1792; const int kb = r / 32, nb = r % 32;
        transpose_item<true>(a.wed + (size_t)e * DFE * DM, DM, nb * 32, DM, 64.f, (bf16*)(a.ws + WS_WED + (size_t)e * DM * DFE), DFE, nb * 32, kb * 64, scr, lane); }
}
__device__ __forceinline__ void ph_prep(const PrepArgs& a, LAS unsigned char* lds, int bid, int nblk) {
    const int lane = otid() & 63, wave = otid() >> 6;
    LAS float* scr = (LAS float*)lds + wave * 64 * 33;
    const int gw = bid * 8 + wave, ngw = nblk * 8;
#ifdef PREP_LAZY
    for (int it = gw; it < PI_STATIC; it += ngw) prep_item(a, it, scr, lane);
#else
    for (int it = gw; it < PREP_ITEMS; it += ngw) prep_item(a, it, scr, lane);
#endif
}
__device__ __forceinline__ void prep_lazy(const PrepArgs& a, unsigned* ctl, int done_word, int nblk, LAS unsigned char* lds) {
    const int tid = otid(), lane = tid & 63, wave = tid >> 6;
    LAS float* scr = (LAS float*)lds + wave * 64 * 33; LAS unsigned* slot = (LAS unsigned*)(lds + 71680);
    __syncthreads();
    if (tid == 0 && done_word >= 0) __hip_atomic_fetch_add(ctl + done_word, 1u, __ATOMIC_RELAXED, __HIP_MEMORY_SCOPE_AGENT);
#ifdef LAZY_WAVE
    { unsigned vn = 0xffffffffu, dn = 0u;
      if (lane == 0) vn = __hip_atomic_fetch_add(ctl + CW_PREPQ, 1u, __ATOMIC_RELAXED, __HIP_MEMORY_SCOPE_AGENT);
      if (done_word >= 0) dn = __hip_atomic_load(ctl + done_word, __ATOMIC_RELAXED, __HIP_MEMORY_SCOPE_AGENT);
      for (;;) {
          const unsigned cur = (unsigned)__builtin_amdgcn_readfirstlane((int)vn), d = (unsigned)__builtin_amdgcn_readfirstlane((int)dn);
          if (cur >= (unsigned)(PI_EU + PI_ED)) break;
          vn = 0xffffffffu;
          if (done_word < 0 || d < (unsigned)nblk) {
              if (lane == 0) vn = __hip_atomic_fetch_add(ctl + CW_PREPQ, 1u, __ATOMIC_RELAXED, __HIP_MEMORY_SCOPE_AGENT);
              if (done_word >= 0) dn = __hip_atomic_load(ctl + done_word, __ATOMIC_RELAXED, __HIP_MEMORY_SCOPE_AGENT); }
          prep_item(a, PI_STATIC + (int)cur, scr, lane);
      } }
    __syncthreads();
    return;
#endif
    for (;;) {
        if (tid == 0) { unsigned b = 0xffffffffu;
            if (done_word < 0 || __hip_atomic_load(ctl + done_word, __ATOMIC_RELAXED, __HIP_MEMORY_SCOPE_AGENT) < (unsigned)nblk) b = __hip_atomic_fetch_add(ctl + CW_PREPQ, 1u, __ATOMIC_RELAXED, __HIP_MEMORY_SCOPE_AGENT);
            slot[0] = b; }
        __syncthreads(); const unsigned b = slot[0]; __syncthreads();
        if (b >= (unsigned)(LAZY_BATCHES / LAZY_NB)) break;
#pragma unroll 1
        for (int k = 0; k < LAZY_NB; ++k) prep_item(a, PI_STATIC + ((int)b * LAZY_NB + k) * 8 + wave, scr, lane);
    }
    __syncthreads();
}
__device__ __forceinline__ void ph_mod(const float* c, const float* w_ada, const float* b_ada, float* mod, LAS unsigned char* lds, int bid, int nblk) {
    LAS float* sc = (LAS float*)lds; LAS float* part = (LAS float*)(lds + 32768);
    const int tid = otid();
    if (bid >= 192) return;
    for (int i = tid; i < 8 * 1024; i += 512) { const float v = c[i]; sc[i] = v / (1.0f + __expf(-v)); }
    __syncthreads();
    for (int item = bid; item < 192; item += nblk) {
        const int l = item / 96, j0 = (item % 96) * 64, jj = tid & 63, kq = tid >> 6;
        float acc[8];
#pragma unroll
        for (int b = 0; b < 8; ++b) acc[b] = 0.f;
        const float* w = w_ada + (size_t)l * DM * 6144 + j0 + jj;
#pragma unroll 16
        for (int k = kq * 128; k < kq * 128 + 128; ++k) { const float wv = w[(size_t)k * 6144];
#pragma unroll
            for (int b = 0; b < 8; ++b) acc[b] += sc[b * 1024 + k] * wv; }
#pragma unroll
        for (int b = 0; b < 8; ++b) part[(kq * 8 + b) * 64 + jj] = acc[b];
        __syncthreads();
        { const int b = tid >> 6, j = tid & 63; float sum = 0.f;
#pragma unroll
          for (int q = 0; q < 8; ++q) sum += part[(q * 8 + b) * 64 + j];
          mod[(size_t)l * 8 * 6144 + (size_t)b * 6144 + j0 + j] = sum + b_ada[l * 6144 + j0 + j]; }
        __syncthreads();
    }
}

struct MoeTiles { int p0, p1, p2, p3, p4, p5, p6, p7; };
__device__ __forceinline__ MoeTiles moe_tiles(const unsigned* ecnt) {
#define ECNT_LD(i) ((int)((__hip_atomic_load(ecnt + (i), __ATOMIC_RELAXED, __HIP_MEMORY_SCOPE_AGENT) + 255u) >> 8))
    MoeTiles m; m.p0 = ECNT_LD(0); m.p1 = ECNT_LD(1); m.p2 = ECNT_LD(2); m.p3 = ECNT_LD(3); m.p4 = ECNT_LD(4); m.p5 = ECNT_LD(5); m.p6 = ECNT_LD(6); m.p7 = ECNT_LD(7); return m;
#undef ECNT_LD
}
__device__ __forceinline__ int moe_tile_start(const MoeTiles& m, int e) {
    int s = 0; s += (e > 0) ? m.p0 : 0; s += (e > 1) ? m.p1 : 0; s += (e > 2) ? m.p2 : 0; s += (e > 3) ? m.p3 : 0; s += (e > 4) ? m.p4 : 0; s += (e > 5) ? m.p5 : 0; s += (e > 6) ? m.p6 : 0; return s;
}
struct NormArgs {
    const float* xin; const bf16* xin16; const float* g; const float* shift; const float* scale;
    bf16* act; unsigned char* act8;
    const float* w_router; int* tok; unsigned* ecnt; int* elist;
    const bf16* ys; const float* gate; float* out;
};
template <int MODE> __device__ __forceinline__ void ph_norm(const NormArgs& a, LAS unsigned char* lds, int bid, int nblk) {
    LAS unsigned* lcnt = (LAS unsigned*)lds; LAS unsigned* lbase = lcnt + 8; typedef int info6[6]; LAS info6* linfo = (LAS info6*)(lds + 64);
    const int tid = otid(), lane = tid & 63, wave = tid >> 6;
    if (MODE == 1) { if (tid < 8) lcnt[tid] = 0u; __syncthreads(); }
    MoeTiles mt; if (MODE == 2) mt = moe_tiles(a.ecnt);
    for (int blk = bid; blk < T / 128; blk += nblk) {
      for (int i4 = 0; i4 < 16; i4 += 4) {
        f32x4 vq[4][4]; u32x2 yq0[4][4], yq1[4][4]; float gq0[4], gq1[4];
#pragma unroll
        for (int q = 0; q < 4; ++q) { const int row_ = blk * 128 + wave + 8 * (i4 + q);
            if (a.xin) { const f32x4* xr = (const f32x4*)(a.xin + (size_t)row_ * DM) + lane;
#pragma unroll
                for (int j = 0; j < 4; ++j) vq[q][j] = xr[64 * j]; }
            else { const u32x2* xr = (const u32x2*)(a.xin16 + (size_t)row_ * DM) + lane;
#pragma unroll
                for (int j = 0; j < 4; ++j) { const u32x2 w = xr[64 * j];
                    vq[q][j] = (f32x4){__uint_as_float(w.x << 16), __uint_as_float(w.x & 0xffff0000u), __uint_as_float(w.y << 16), __uint_as_float(w.y & 0xffff0000u)}; } }
            if (MODE == 2) {
                const int* ti = a.tok + (size_t)row_ * 8; const int e0 = ti[0], e1 = ti[1], p0 = ti[2], p1 = ti[3]; gq0[q] = __int_as_float(ti[4]); gq1[q] = __int_as_float(ti[5]);
                const size_t s0 = (size_t)moe_tile_start(mt, e0) * 256 + p0, s1 = (size_t)moe_tile_start(mt, e1) * 256 + p1;
                const u32x2* y0 = (const u32x2*)(a.ys + s0 * DM) + lane; const u32x2* y1 = (const u32x2*)(a.ys + s1 * DM) + lane;
#pragma unroll
                for (int j = 0; j < 4; ++j) { yq0[q][j] = y0[64 * j]; yq1[q][j] = y1[64 * j]; } } }
#pragma unroll
        for (int q = 0; q < 4; ++q) {
            const int i = i4 + q;
            const int lr = wave + 8 * i, row = blk * 128 + lr, b = row / SEQ;
            f32x4 v[4];
#pragma unroll
            for (int j = 0; j < 4; ++j) v[j] = vq[q][j];
            if (MODE == 2) {
                const float g0 = gq0[q], g1 = gq1[q];
                const f32x4* gt = (const f32x4*)(a.gate + (size_t)b * 6144) + lane;
#pragma unroll
                for (int j = 0; j < 4; ++j) { const u32x2 a0 = yq0[q][j], a1 = yq1[q][j]; const f32x4 gv = gt[64 * j];
                    f32x4 y; y.x = g0 * bf2f(a0.x & 0xffffu) + g1 * bf2f(a1.x & 0xffffu); y.y = g0 * bf2f(a0.x >> 16) + g1 * bf2f(a1.x >> 16);
                    y.z = g0 * bf2f(a0.y & 0xffffu) + g1 * bf2f(a1.y & 0xffffu); y.w = g0 * bf2f(a0.y >> 16) + g1 * bf2f(a1.y >> 16);
                    v[j] = v[j] + gv * y; }
            }
            float ss = 0.f;
#pragma unroll
            for (int j = 0; j < 4; ++j) ss += (v[j].x * v[j].x + v[j].y * v[j].y) + (v[j].z * v[j].z + v[j].w * v[j].w);
            const float rstd = rsqrtf(wave_sum(ss) * (1.0f / DM) + EPS);
            const f32x4* gp = (const f32x4*)a.g + lane;
            if (MODE == 2) {
                f32x4* o = (f32x4*)(a.out + (size_t)row * DM) + lane;
#if defined(PROBE_T) || defined(PROBE_A)
                { const unsigned long long* tp = (const unsigned long long*)(a.ecnt - CW_ECNT); const float code_ = (float)((tp[151] / (tp[152] ? tp[152] : 1ull)) / 250ull) * 10.0f;
#pragma unroll
                  for (int j = 0; j < 4; ++j) v[j] = v[j] * (1.0f + 0.001f * code_); }
#endif
#pragma unroll
                for (int j = 0; j < 4; ++j) o[64 * j] = v[j] * rstd * gp[64 * j];
            } else {
                const f32x4* sh = (const f32x4*)(a.shift + (size_t)b * 6144) + lane; const f32x4* sc = (const f32x4*)(a.scale + (size_t)b * 6144) + lane;
#pragma unroll
                for (int j = 0; j < 4; ++j) v[j] = v[j] * rstd * gp[64 * j] * (sc[64 * j] + 1.0f) + sh[64 * j];
                if (a.act8) { unsigned* o = (unsigned*)(a.act8 + (size_t)row * DM) + lane;
#pragma unroll
                    for (int j = 0; j < 4; ++j) o[64 * j] = pg8::pk4_fp8(v[j].x, v[j].y, v[j].z, v[j].w); }
                if (a.act) { u32x2* o = (u32x2*)(a.act + (size_t)row * DM) + lane;
#pragma unroll
                    for (int j = 0; j < 4; ++j) { u32x2 w; w.x = pk2(v[j].x, v[j].y); w.y = pk2(v[j].z, v[j].w); o[64 * j] = w; } }
                if (MODE == 1) {
                    float lg[8];
#pragma unroll
                    for (int e = 0; e < 8; ++e) lg[e] = 0.f;
#pragma unroll
                    for (int j = 0; j < 4; ++j) { const float hv[4] = {v[j].x, v[j].y, v[j].z, v[j].w};
#pragma unroll
                        for (int q = 0; q < 4; ++q) { const f32x4* wr = (const f32x4*)(a.w_router + (size_t)(256 * j + 4 * lane + q) * 8); const f32x4 w0 = wr[0], w1 = wr[1];
                            lg[0] += hv[q] * w0.x; lg[1] += hv[q] * w0.y; lg[2] += hv[q] * w0.z; lg[3] += hv[q] * w0.w; lg[4] += hv[q] * w1.x; lg[5] += hv[q] * w1.y; lg[6] += hv[q] * w1.z; lg[7] += hv[q] * w1.w; } }
#pragma unroll
                    for (int e = 0; e < 8; ++e) lg[e] = wave_sum(lg[e]);
                    int e0 = 0; float v0 = lg[0];
#pragma unroll
                    for (int e = 1; e < 8; ++e) if (lg[e] > v0) { v0 = lg[e]; e0 = e; }
                    int e1 = -1; float v1 = -INFINITY;
#pragma unroll
                    for (int e = 0; e < 8; ++e) if (e != e0 && lg[e] > v1) { v1 = lg[e]; e1 = e; }
                    const float g0 = 1.0f / (1.0f + __expf(v1 - v0)), g1 = 1.0f - g0;
                    if (lane == 0) { const unsigned q0 = __hip_atomic_fetch_add(&lcnt[e0], 1u, __ATOMIC_RELAXED, __HIP_MEMORY_SCOPE_WORKGROUP), q1 = __hip_atomic_fetch_add(&lcnt[e1], 1u, __ATOMIC_RELAXED, __HIP_MEMORY_SCOPE_WORKGROUP);
                        linfo[lr][0] = e0; linfo[lr][1] = e1; linfo[lr][2] = (int)q0; linfo[lr][3] = (int)q1; linfo[lr][4] = __float_as_int(g0); linfo[lr][5] = __float_as_int(g1); }
                }
            }
        }
      }
        if (MODE == 1) {
            __syncthreads();
            if (tid < 8) { lbase[tid] = atomicAdd(&a.ecnt[tid], lcnt[tid]); }
            __syncthreads();
            if (tid < 128) { int* ti = a.tok + (size_t)(blk * 128 + tid) * 8; const int e0 = linfo[tid][0], e1 = linfo[tid][1];
                const int p0_ = linfo[tid][2] + (int)lbase[e0], p1_ = linfo[tid][3] + (int)lbase[e1];
                ti[0] = e0; ti[1] = e1; ti[2] = p0_; ti[3] = p1_; ti[4] = linfo[tid][4]; ti[5] = linfo[tid][5]; ti[6] = 0; ti[7] = 0;
                if (a.elist) { a.elist[e0 * T + p0_] = blk * 128 + tid; a.elist[e1 * T + p1_] = blk * 128 + tid; } }
            __syncthreads();
            if (tid < 8) lcnt[tid] = 0u;
            __syncthreads();
        }
    }
}
__device__ __forceinline__ void ph_gather(const unsigned char* act8, const int* tok, const unsigned* ecnt, unsigned char* xs8, int bid, int nblk) {
    const int lane = otid() & 63, gw = bid * 8 + (otid() >> 6), ngw = nblk * 8;
    const MoeTiles mt = moe_tiles(ecnt);
    for (int t = gw; t < T; t += 4 * ngw) {
        int e0[4], e1[4], p0[4], p1[4]; u32x4 a0[4];
#pragma unroll
        for (int q = 0; q < 4; ++q) { const int* ti = tok + (size_t)(t + q * ngw) * 8; e0[q] = ti[0]; e1[q] = ti[1]; p0[q] = ti[2]; p1[q] = ti[3];
            a0[q] = ((const u32x4*)(act8 + (size_t)(t + q * ngw) * DM))[lane]; }
#pragma unroll
        for (int q = 0; q < 4; ++q) { const size_t s0 = (size_t)moe_tile_start(mt, e0[q]) * 256 + p0[q], s1 = (size_t)moe_tile_start(mt, e1[q]) * 256 + p1[q];
            ((u32x4*)(xs8 + s0 * DM))[lane] = a0[q]; ((u32x4*)(xs8 + s1 * DM))[lane] = a0[q]; }
    }
    for (int i = gw; i < 8 * 256; i += ngw) { const int e = i >> 8, r = i & 255; const int cnt = (int)__hip_atomic_load(ecnt + e, __ATOMIC_RELAXED, __HIP_MEMORY_SCOPE_AGENT); const int padded = ((cnt + 255) >> 8) << 8;
        if (cnt + r < padded) { unsigned z0 = 0u; asm volatile("" : "+v"(z0)); const u32x4 z = {z0, z0, z0, z0};
            ((u32x4*)(xs8 + ((size_t)moe_tile_start(mt, e) * 256 + cnt + r) * DM))[lane] = z; } }
}

__device__ __forceinline__ void ld16(const bf16* p, float (&f)[16]) { ld8(p, &f[0]); ld8(p + 8, &f[8]); }
__device__ __forceinline__ float dot16x4(const float (&q)[16], const bf16* p) {
    float f[16]; ld16(p, f); float s0 = 0.f, s1 = 0.f;
#pragma unroll
    for (int i = 0; i < 16; i += 2) { s0 += q[i] * f[i]; s1 += q[i + 1] * f[i + 1]; }
    float s = s0 + s1; s += __shfl_xor(s, 1); s += __shfl_xor(s, 2); return s;
}
__device__ __forceinline__ void axpy16(float (&o)[16], float w, const bf16* p) {
    float f[16]; ld16(p, f);
#pragma unroll
    for (int i = 0; i < 16; ++i) o[i] += w * f[i];
}
__device__ __forceinline__ void head_norm_store16(float (&o)[16], const float* gh, bf16* dst) {
    float ss = 0.f;
#pragma unroll
    for (int i = 0; i < 16; ++i) ss += o[i] * o[i];
    ss += __shfl_xor(ss, 1); ss += __shfl_xor(ss, 2);
    const float r = rsqrtf(ss * (1.0f / 64.0f) + EPS);
#pragma unroll
    for (int i = 0; i < 2; ++i) { u32x4 w; const float* q = &o[8 * i]; const float* g = gh + 8 * i;
        w.x = pk2(q[0] * r * g[0], q[1] * r * g[1]); w.y = pk2(q[2] * r * g[2], q[3] * r * g[3]); w.z = pk2(q[4] * r * g[4], q[5] * r * g[5]); w.w = pk2(q[6] * r * g[6], q[7] * r * g[7]);
        *(u32x4*)(dst + 8 * i) = w; }
}
#define OSM_STEP(s, vrow) do { if ((s) > m) { const float a_ = __expf(m - (s)); l *= a_; _Pragma("unroll") for (int d_ = 0; d_ < 16; ++d_) o[d_] *= a_; m = (s); } \
    const float p_ = __expf((s) - m); l += p_; axpy16(o, p_, (vrow)); } while (0)
#define NAIVE_IDX() const int part = gidx & 3, idx = gidx >> 2; const int t = idx & (SEQ - 1), h = (idx >> 12) & 3, b = idx >> 14; const int po = 16 * part

__device__ __forceinline__ void sb_naive_one(const bf16* P, const float* gh, bf16* act, int gidx) {
    NAIVE_IDX();
    const bf16* Pb = P + (size_t)b * SEQ * PW + po;
    float q[16], o[16];
    ld16(Pb + (size_t)t * PW + h * 64, q);
#pragma unroll
    for (int i = 0; i < 16; ++i) o[i] = 0.f;
    float carry = 1.0f;
    for (int s = t - 1; s >= 0; --s) {
        float z = dot16x4(q, Pb + (size_t)s * PW + 256 + h * 64); z = fminf(fmaxf(z, -80.f), 80.f);
        const float e = __expf(z), om = 1.0f / (1.0f + e), beta = e * om, aw = beta * carry;
        axpy16(o, aw, Pb + (size_t)s * PW + 512 + h * 64);
        carry *= om;
        if (carry < 1e-30f) break;
    }
    head_norm_store16(o, gh + h * 64 + po, act + (size_t)(b * SEQ + t) * DM + h * 64 + po);
}
__device__ __forceinline__ void dil_naive_one(const bf16* P, const float* gh, bf16* act, int gidx) {
    NAIVE_IDX();
    const bf16* Pb = P + (size_t)b * SEQ * PW + 1536 + po;
    const float slope = alibi_slope(1, h);
    float q[16], o[16];
    ld16(Pb + (size_t)t * PW + h * 64, q);
#pragma unroll
    for (int i = 0; i < 16; ++i) o[i] = 0.f;
    float m = -INFINITY, l = 0.f;
    for (int br = 0; br < 3; ++br) { const int dil = br == 0 ? 1 : (br == 1 ? 4 : 16);
        for (int j = 0; j <= 128; ++j) { const int dist = j * dil, kp = t - dist; if (kp < 0) break;
            const float s = dot16x4(q, Pb + (size_t)kp * PW + 256 + h * 64) - slope * (float)dist;
            OSM_STEP(s, Pb + (size_t)kp * PW + 512 + h * 64); } }
    const float rl = 1.0f / l;
#pragma unroll
    for (int i = 0; i < 16; ++i) o[i] *= rl;
    head_norm_store16(o, gh + (8 + h) * 64 + po, act + (size_t)(b * SEQ + t) * DM + (8 + h) * 64 + po);
}
__device__ __forceinline__ unsigned moba_sel_one(const float (&q)[16], const float* kmean, int b, int t, int h, int po) {
    const int own = t >> 8; unsigned sel = 0u;
    if (own <= 3) sel = (1u << own) - 1u;
    else {
        float g[16];
#pragma unroll
        for (int blk = 0; blk < 16; ++blk) { float s = -INFINITY;
            if (blk < own) { const float* km = kmean + ((size_t)b * 16 + blk) * 256 + h * 64 + po; s = 0.f;
#pragma unroll
                for (int d = 0; d < 16; ++d) s += q[d] * km[d];
                s += __shfl_xor(s, 1); s += __shfl_xor(s, 2); }
            g[blk] = s; }
#pragma unroll
        for (int r = 0; r < 3; ++r) { int bi = 0; float bv = -INFINITY;
#pragma unroll
            for (int blk = 0; blk < 16; ++blk) { const bool free_ = !((sel >> blk) & 1u); if (free_ && g[blk] > bv) { bv = g[blk]; bi = blk; } }
            sel |= 1u << bi; }
    }
    return sel;
}
template <int MODE> __device__ __forceinline__ void masked_naive_one(const bf16* P, const unsigned long long* mask, const float* kmean, const float* gh, bf16* act, int gidx) {
    NAIVE_IDX();
    const int cb = MODE == 0 ? 768 : 2304, hb = MODE == 0 ? 4 : 12;
    const bf16* Pb = P + (size_t)b * SEQ * PW + cb + po;
    const float slope = alibi_slope(MODE == 0 ? 0 : 2, h);
    float q[16], o[16];
    ld16(Pb + (size_t)t * PW + h * 64, q);
#pragma unroll
    for (int i = 0; i < 16; ++i) o[i] = 0.f;
    float m = -INFINITY, l = 0.f;
    if (MODE == 0) {
        const unsigned long long* mr = mask + (size_t)(b * SEQ + t) * 64;
        for (int w = 0; w <= (t >> 6); ++w) { unsigned long long bits = mr[w];
            while (bits) { const int j = __builtin_ctzll(bits); bits &= bits - 1; const int kp = w * 64 + j;
                const float s = dot16x4(q, Pb + (size_t)kp * PW + 256 + h * 64) - slope * (float)(t - kp);
                OSM_STEP(s, Pb + (size_t)kp * PW + 512 + h * 64); } }
    } else {
        const int own = t >> 8; const unsigned sel = moba_sel_one(q, kmean, b, t, h, po);
        for (int blk = 0; blk <= own; ++blk) { if (blk < own && !((sel >> blk) & 1u)) continue;
            const int kend = blk == own ? t : blk * 256 + 255;
            for (int kp = blk * 256; kp <= kend; ++kp) {
                const float s = dot16x4(q, Pb + (size_t)kp * PW + 256 + h * 64) - slope * (float)(t - kp);
                OSM_STEP(s, Pb + (size_t)kp * PW + 512 + h * 64); } }
    }
    const float rl = 1.0f / l;
#pragma unroll
    for (int i = 0; i < 16; ++i) o[i] *= rl;
    head_norm_store16(o, gh + (hb + h) * 64 + po, act + (size_t)(b * SEQ + t) * DM + (hb + h) * 64 + po);
}
__device__ __forceinline__ void kmean_unit(const bf16* P, float* kmean, unsigned* knmax, int unit, LAS unsigned char* lds) {
    const int tid = otid();
    const int b = unit >> 4, blk = unit & 15;
    { const int g = tid >> 5, c8 = tid & 31;
      const bf16* p = P + ((size_t)b * SEQ + blk * 256 + g * 16) * PW + 2304 + 256 + c8 * 8;
      float s[8];
#pragma unroll
      for (int i = 0; i < 8; ++i) s[i] = 0.f;
#pragma unroll
      for (int r = 0; r < 16; ++r) { float f[8]; ld8(p + (size_t)r * PW, f);
#pragma unroll
          for (int i = 0; i < 8; ++i) s[i] += f[i]; }
      LAS float* part = (LAS float*)lds;
#pragma unroll
      for (int i = 0; i < 8; ++i) part[g * 256 + c8 * 8 + i] = s[i];
      __syncthreads();
      if (tid < 256) { float t = 0.f;
#pragma unroll
          for (int g2 = 0; g2 < 16; ++g2) t += part[g2 * 256 + tid];
          kmean[(size_t)unit * 256 + tid] = t * (1.0f / 256.0f); } }
    { const int key = tid >> 1, mx = tid & 1; const bf16* kr = P + ((size_t)b * SEQ + blk * 256 + key) * PW + (mx ? 2304 : 768) + 256;
#pragma unroll
      for (int h = 0; h < 4; ++h) { float ss = 0.f;
#pragma unroll
          for (int c8 = 0; c8 < 8; ++c8) { float f[8]; ld8(kr + h * 64 + 8 * c8, f);
#pragma unroll
              for (int i = 0; i < 8; ++i) ss += f[i] * f[i]; }
          float nm = sqrtf(ss);
#pragma unroll
          for (int o_ = 2; o_ < 64; o_ <<= 1) nm = fmaxf(nm, __shfl_xor(nm, o_));
          if ((tid & 63) < 2) atomicMax(&knmax[(b * 2 + mx) * 4 + h], __float_as_uint(nm)); } }
    __syncthreads();
}
constexpr int DSA_LDS = 8 * 4096 * 4;
#define DSA_COUNT_GE(trial, out) do { int cl0_ = 0, cl1_ = 0; const unsigned t_ = (unsigned)__builtin_amdgcn_readfirstlane((int)(trial)); \
    _Pragma("unroll") for (int g_ = 0; g_ < 8; ++g_) if (g_ * 8 < nreg) { \
        asm volatile("v_cmp_le_u32_e32 vcc, %10, %2\n\tv_addc_co_u32_e32 %0, vcc, 0, %0, vcc\n\tv_cmp_le_u32_e32 vcc, %10, %3\n\tv_addc_co_u32_e32 %1, vcc, 0, %1, vcc\n\t" \
                     "v_cmp_le_u32_e32 vcc, %10, %4\n\tv_addc_co_u32_e32 %0, vcc, 0, %0, vcc\n\tv_cmp_le_u32_e32 vcc, %10, %5\n\tv_addc_co_u32_e32 %1, vcc, 0, %1, vcc\n\t" \
                     "v_cmp_le_u32_e32 vcc, %10, %6\n\tv_addc_co_u32_e32 %0, vcc, 0, %0, vcc\n\tv_cmp_le_u32_e32 vcc, %10, %7\n\tv_addc_co_u32_e32 %1, vcc, 0, %1, vcc\n\t" \
                     "v_cmp_le_u32_e32 vcc, %10, %8\n\tv_addc_co_u32_e32 %0, vcc, 0, %0, vcc\n\tv_cmp_le_u32_e32 vcc, %10, %9\n\tv_addc_co_u32_e32 %1, vcc, 0, %1, vcc" \
                     : "+v"(cl0_), "+v"(cl1_) : "v"(K[g_ * 8 + 0]), "v"(K[g_ * 8 + 1]), "v"(K[g_ * 8 + 2]), "v"(K[g_ * 8 + 3]), "v"(K[g_ * 8 + 4]), "v"(K[g_ * 8 + 5]), "v"(K[g_ * 8 + 6]), "v"(K[g_ * 8 + 7]), "s"(t_) : "vcc"); } \
    const int cl_ = cl0_ + cl1_; int c_ = 0; \
    _Pragma("unroll") for (int b_ = 0; b_ < 7; ++b_) c_ += __builtin_popcountll(__ballot((cl_ >> b_) & 1)) << b_; \
    (out) = c_; } while (0)
typedef float f32x2_t __attribute__((ext_vector_type(2)));
#ifdef DSA_BITSLICE
#define DSA_SLOT(key) ((((key) & 63) << 6) + ((((key) >> 6) ^ (key)) & 63))
__device__ __forceinline__ int dsa_scan(int v) {
    v += __builtin_amdgcn_update_dpp(0, v, 0x111, 0xf, 0xf, false);
    v += __builtin_amdgcn_update_dpp(0, v, 0x112, 0xf, 0xf, false);
    v += __builtin_amdgcn_update_dpp(0, v, 0x114, 0xf, 0xe, false);
    v += __builtin_amdgcn_update_dpp(0, v, 0x118, 0xf, 0xc, false);
    v += __builtin_amdgcn_update_dpp(0, v, 0x142, 0xa, 0xf, false);
    v += __builtin_amdgcn_update_dpp(0, v, 0x143, 0xc, 0xf, false);
    return v; }
#else
#define DSA_SLOT(key) (key)
#endif
__device__ __forceinline__ void dsa_select_unit(const bf16* P, unsigned long long* mask, int unit, LAS unsigned* sc) {
#ifdef PROBE_T
    long long tacc = 0;
#define TSTAMP(beg_of, end_of) do { asm volatile("s_waitcnt lgkmcnt(0)" ::: "memory"); const long long c_ = clock64(); if (PROBE_T == (beg_of) || (PROBE_T == 5 && (beg_of) == 1)) tacc -= c_; if (PROBE_T == (end_of) || (PROBE_T == 5 && (end_of) == 4)) tacc += c_; } while (0)
#else
#define TSTAMP(a, b) do {} while (0)
#endif
    const int tid = otid(), lane = tid & 63, wid = tid >> 6, r32 = lane & 31, hi = lane >> 5;
    const int b = unit >> 9, t0 = (unit & 511) * 8;
    const bf16* Pb = P + (size_t)b * SEQ * PW;
    const int hrow = (r32 & 3) + 4 * ((r32 >> 3) & 1), qrow = 2 * ((r32 >> 2) & 1) + ((r32 >> 4) & 1);
    bf16x8 af[2][4];
#pragma unroll
    for (int qg = 0; qg < 2; ++qg)
#pragma unroll
        for (int s = 0; s < 4; ++s) af[qg][s] = *(const bf16x8*)(Pb + (size_t)(t0 + 4 * qg + qrow) * PW + COL_QI + hrow * 64 + 16 * s + 8 * hi);
    float wv[2][2][8];
#pragma unroll
    for (int qg = 0; qg < 2; ++qg)
#pragma unroll
        for (int qq = 0; qq < 2; ++qq) ld8(Pb + (size_t)(t0 + 4 * qg + 2 * hi + qq) * PW + COL_WI, wv[qg][qq]);
    const int ntile = (t0 + 8 + 31) >> 5;
    {
        bf16x8 fa[4], fb[4], fc[4];
#define DSA_LOAD(F, kt_) do { if ((kt_) < ntile) { _Pragma("unroll") for (int s = 0; s < 4; ++s) F[s] = *(const bf16x8*)(Pb + (size_t)((kt_) * 32 + r32) * PW + COL_KI + 16 * s + 8 * hi); } } while (0)
#define DSA_SCORE(F, kt_) do { if ((kt_) < ntile) { const int key = (kt_) * 32 + r32; \
            _Pragma("unroll") for (int qg = 0; qg < 2; ++qg) { \
                f32x16 acc = {0.f, 0.f, 0.f, 0.f, 0.f, 0.f, 0.f, 0.f, 0.f, 0.f, 0.f, 0.f, 0.f, 0.f, 0.f, 0.f}; \
                _Pragma("unroll") for (int s = 0; s < 4; ++s) acc = __builtin_amdgcn_mfma_f32_32x32x16_bf16(af[qg][s], F[s], acc, 0, 0, 0); \
                _Pragma("unroll") for (int qq = 0; qq < 2; ++qq) { float sA_ = 0.f, sB_ = 0.f; \
                    _Pragma("unroll") for (int h = 0; h < 8; h += 2) { sA_ = __builtin_fmaf(__builtin_amdgcn_fmed3f(acc[8 * qq + h], 0.f, 3.0e38f), wv[qg][qq][h], sA_); \
                        asm("" : "+v"(sA_));       \
                        sB_ = __builtin_fmaf(__builtin_amdgcn_fmed3f(acc[8 * qq + h + 1], 0.f, 3.0e38f), wv[qg][qq][h + 1], sB_); } \
                    const float s = sA_ + sB_;        \
                    const int ql = 4 * qg + 2 * hi + qq; \
                    const unsigned u = __float_as_uint(s); const unsigned sk = (u & 0x80000000u) ? ~u : (u | 0x80000000u); \
                    sc[ql * 4096 + DSA_SLOT(key)] = (key <= t0 + ql) ? sk : 0u; } } } } while (0)
#if defined(PROBE_SUB) && PROBE_SUB == 7
        for (int rep_ = 0; rep_ < 2; ++rep_) {
#endif
        int kt = wid;
        DSA_LOAD(fa, kt); DSA_LOAD(fb, kt + 8);
        while (kt < ntile) {
            DSA_LOAD(fc, kt + 16); DSA_SCORE(fa, kt);
            DSA_LOAD(fa, kt + 24); DSA_SCORE(fb, kt + 8);
            DSA_LOAD(fb, kt + 32); DSA_SCORE(fc, kt + 16);
            kt += 24;
        }
#if defined(PROBE_SUB) && PROBE_SUB == 7
        }
#endif
#undef DSA_LOAD
#undef DSA_SCORE
    }
    __syncthreads();
#if defined(PROBE_SUB) && PROBE_SUB == 8
    unsigned long long first_word = 0ull;
    for (int rep_ = 0; rep_ < 2; ++rep_)
#endif
    {
        const int t = t0 + wid, nvalid = t + 1, nk = ntile * 32, nreg = (nk + 63) >> 6;
        unsigned long long myword = 0ull;
        if (nvalid <= 256) {
            const int lo = lane * 64; myword = (nvalid >= lo + 64) ? ~0ull : (nvalid > lo ? ((1ull << (nvalid - lo)) - 1ull) : 0ull);
        } else {
#ifdef DSA_BITSLICE
            LAS unsigned* row = sc + wid * 4096;
            unsigned A[64];
#pragma unroll
            for (int r = 0; r < 64; ++r) A[r] = row[r * 64 + ((lane ^ r) & 63)];
#pragma unroll
            for (int blk = 0; blk < 64; blk += 32) {
#pragma unroll
                for (int js = 0; js < 5; ++js) { const int j = 16 >> js; const unsigned m = js == 0 ? 0x0000FFFFu : (js == 1 ? 0x00FF00FFu : (js == 2 ? 0x0F0F0F0Fu : (js == 3 ? 0x33333333u : 0x55555555u)));
#pragma unroll
                    for (int k = 0; k < 32; ++k) if ((k & j) == 0) { const unsigned a_ = A[blk + k], b_ = A[blk + k + j];
                        A[blk + k] = (a_ & ~(m << j)) | ((b_ << j) & (m << j)); A[blk + k + j] = (b_ & ~m) | ((a_ >> j) & m); } } }
            const int lim_ = nk - 64 * lane; const unsigned long long vm = lim_ >= 64 ? ~0ull : (lim_ <= 0 ? 0ull : ((1ull << lim_) - 1ull));
            unsigned c_lo = (unsigned)vm, c_hi = (unsigned)(vm >> 32), g_lo = 0u, g_hi = 0u; int need = 256, ncand = nk;
#pragma unroll
            for (int bb = 31; bb >= 0; --bb) {
                if (ncand != need) {
                const unsigned x_lo = c_lo & A[bb], x_hi = c_hi & A[32 + bb];
                const int cnt = __builtin_amdgcn_readlane(dsa_scan(__builtin_popcount(x_lo) + __builtin_popcount(x_hi)), 63);
                const bool up = cnt >= need;
                const unsigned fl = up ? 0u : ~0u;
                c_lo &= (A[bb] ^ fl); c_hi &= (A[32 + bb] ^ fl);
                g_lo |= x_lo & fl; g_hi |= x_hi & fl;
                need -= up ? 0 : cnt; ncand = up ? cnt : ncand - cnt; }
            }
            { const int mine = __builtin_popcount(c_lo) + __builtin_popcount(c_hi); const int incl = dsa_scan(mine); const int tot = __builtin_amdgcn_readlane(incl, 63);
              unsigned long long eq = ((unsigned long long)c_hi << 32) | c_lo;
              if (tot != need) { int k_ = need - (incl - mine); k_ = k_ < 0 ? 0 : (k_ > mine ? mine : k_);
                  while (__builtin_popcountll(eq) > k_) eq &= ~(1ull << (63 - __builtin_clzll(eq))); }
              myword = (((unsigned long long)g_hi << 32) | g_lo) | eq; }
#else
            LAS unsigned* row = sc + wid * 4096;
            unsigned K[64];
            TSTAMP(1, 0);
#pragma unroll
            for (int r = 0; r < 64; ++r) K[r] = (r * 64 + lane < nk) ? row[r * 64 + lane] : 0u;
            TSTAMP(2, 1);
            unsigned prefix = 0u; int cnt_prefix = 4096, c_above = 0, bit = 32;
            { int ca, cb; DSA_COUNT_GE(0xBC000000u, ca);
              if (ca >= 256) { DSA_COUNT_GE(0xC0000000u, cb);
                  if (cb < 256) { int cm; DSA_COUNT_GE(0xBE000000u, cm);
                      if (cm >= 256) { prefix = 0xBE000000u; cnt_prefix = cm; c_above = cb; } else { prefix = 0xBC000000u; cnt_prefix = ca; c_above = cm; }
                      bit = 25; } } }
            while (bit > 0 && cnt_prefix - c_above > 128) { --bit; const unsigned trial = prefix | (1u << bit); int cnt; DSA_COUNT_GE(trial, cnt);
                if (cnt >= 256) { prefix = trial; cnt_prefix = cnt; } else c_above = cnt; }
            TSTAMP(3, 2);
            if (bit > 0) {
                const unsigned himask = ~((1u << bit) - 1u); const unsigned long long below = (1ull << lane) - 1ull; int base = 0;
#pragma unroll
                for (int g = 0; g < 8; ++g) if (g * 8 < nreg) {
#pragma unroll
                    for (int r = 0; r < 8; ++r) { const unsigned k = K[g * 8 + r]; const bool in = (k & himask) == prefix; const unsigned long long mk = __ballot(in);
                        if (in) row[base + __builtin_popcountll(mk & below)] = k; base += __builtin_popcountll(mk); } }
                const unsigned C0 = (lane < base) ? row[lane] : 0u, C1 = (64 + lane < base) ? row[64 + lane] : 0u;
                while (bit > 1) { bit -= 2; const unsigned t1 = prefix | (1u << bit), t2 = prefix | (2u << bit), t3 = prefix | (3u << bit);
                    const int n1 = c_above + __builtin_popcountll(__ballot(C0 >= t1)) + __builtin_popcountll(__ballot(C1 >= t1));
                    const int n2 = c_above + __builtin_popcountll(__ballot(C0 >= t2)) + __builtin_popcountll(__ballot(C1 >= t2));
                    const int n3 = c_above + __builtin_popcountll(__ballot(C0 >= t3)) + __builtin_popcountll(__ballot(C1 >= t3));
                    if (n3 >= 256) { prefix = t3; cnt_prefix = n3; } else if (n2 >= 256) { prefix = t2; cnt_prefix = n2; } else if (n1 >= 256) { prefix = t1; cnt_prefix = n1; } }
                if (bit > 0) { --bit; const unsigned trial = prefix | (1u << bit);
                    const int cnt = c_above + __builtin_popcountll(__ballot(C0 >= trial)) + __builtin_popcountll(__ballot(C1 >= trial));
                    if (cnt >= 256) { prefix = trial; cnt_prefix = cnt; } }
            }
            TSTAMP(4, 3);
            if (cnt_prefix == 256) {
#pragma unroll
                for (int g = 0; g < 8; ++g) if (g * 8 < nreg) {
#pragma unroll
                    for (int r = 0; r < 8; ++r) { const unsigned long long word = __ballot(K[g * 8 + r] >= prefix); if (lane == g * 8 + r) myword = word; } }
            } else {
                int cgt; DSA_COUNT_GE(prefix + 1u, cgt);
                int need = 256 - cgt;
                const unsigned long long below = (1ull << lane) - 1ull;
#pragma unroll
                for (int g = 0; g < 8; ++g) if (g * 8 < nreg) {
#pragma unroll
                    for (int r = 0; r < 8; ++r) { const unsigned k = K[g * 8 + r];
                        const unsigned long long gt = __ballot(k > prefix), eq = __ballot(k == prefix);
                        const int c = __builtin_popcountll(eq); unsigned long long take;
                        if (c <= need) { take = eq; need -= c; }
                        else { const bool mine = ((eq >> lane) & 1ull) && (__builtin_popcountll(eq & below) < need); take = __ballot(mine); need = 0; }
                        const unsigned long long word = gt | take;
                        if (lane == g * 8 + r) myword = word; } }
            }
#endif
        }
#if defined(PROBE_SUB) && PROBE_SUB == 8
        if (rep_ == 0) first_word = myword; myword = first_word;
#endif
        if (nvalid > 256) TSTAMP(0, 4);
#ifdef PROBE_T
        if (blockIdx.x == 0 && tid == 0 && nvalid > 256) { unsigned long long* tp = (unsigned long long*)((unsigned char*)mask - WS_MASK); atomicAdd(&tp[151], (unsigned long long)tacc); atomicAdd(&tp[152], 1ull); }
#endif
        mask[(size_t)(b * SEQ + t) * 64 + lane] = myword;
    }
    __syncthreads();
}

#define MFMA32(a, b, c) __builtin_amdgcn_mfma_f32_32x32x16_bf16(a, b, c, 0, 0, 0)
__device__ __forceinline__ int crow(int r, int hi) { return (r & 3) + 8 * (r >> 2) + 4 * hi; }
__device__ __forceinline__ float xh_max(float v) { const auto r = __builtin_amdgcn_permlane32_swap(__float_as_uint(v), __float_as_uint(v), false, false); return fmaxf(__uint_as_float(r[0]), __uint_as_float(r[1])); }
__device__ __forceinline__ float xh_sum(float v) { const auto r = __builtin_amdgcn_permlane32_swap(__float_as_uint(v), __float_as_uint(v), false, false); return __uint_as_float(r[0]) + __uint_as_float(r[1]); }
__device__ __forceinline__ float xh_other(float v, int hi) { const auto r = __builtin_amdgcn_permlane32_swap(__float_as_uint(v), __float_as_uint(v), false, false); return __uint_as_float(hi ? r[0] : r[1]); }
constexpr int AT_KROW = 144, AT_VROW = 136;
constexpr int AT_KBUF = 64 * AT_KROW, AT_VBUF = 64 * AT_VROW;
constexpr int AT_KOFF = 0, AT_VOFF = 2 * AT_KBUF, AT_KMOFF = AT_VOFF + 2 * AT_VBUF, AT_MISC = AT_KMOFF + 4096;
typedef short s16x4 __attribute__((ext_vector_type(4)));

__device__ __forceinline__ void at_load(const bf16* Pb, int k0, int kcol, int vcol, int tid, u32x4& kr, u32x4& vr) {
    const bf16* row = Pb + (size_t)(k0 + (tid >> 3)) * PW + (tid & 7) * 8;
    kr = *(const u32x4*)(row + kcol); vr = *(const u32x4*)(row + vcol);
}
__device__ __forceinline__ void at_store(LAS unsigned char* lds, int buf, int tid, const u32x4& kr, const u32x4& vr) {
    const int key = tid >> 3, c = tid & 7;
    *(LAS u32x4*)(lds + AT_KOFF + buf * AT_KBUF + key * AT_KROW + c * 16) = kr;
#ifdef AT_TR
    *(LAS u32x4*)(lds + AT_VOFF + buf * AT_VBUF + 1024 * (key >> 3) + 512 * (c >> 2) + 64 * (key & 7) + 16 * ((c & 3) ^ ((key >> 2) & 3))) = vr;
}
#else
    LAS unsigned short* vt = (LAS unsigned short*)(lds + AT_VOFF + buf * AT_VBUF + (8 * c) * AT_VROW + key * 2);
    vt[0 * (AT_VROW / 2)] = (unsigned short)(vr.x & 0xffffu); vt[1 * (AT_VROW / 2)] = (unsigned short)(vr.x >> 16);
    vt[2 * (AT_VROW / 2)] = (unsigned short)(vr.y & 0xffffu); vt[3 * (AT_VROW / 2)] = (unsigned short)(vr.y >> 16);
    vt[4 * (AT_VROW / 2)] = (unsigned short)(vr.z & 0xffffu); vt[5 * (AT_VROW / 2)] = (unsigned short)(vr.z >> 16);
    vt[6 * (AT_VROW / 2)] = (unsigned short)(vr.w & 0xffffu); vt[7 * (AT_VROW / 2)] = (unsigned short)(vr.w >> 16);
}
#endif
__device__ __forceinline__ f32x16 at_scores(LAS unsigned char* lds, int buf, int a, int r32, int hi, const bf16x8 (&qf)[4], const f32x16 sinit = (f32x16){0.f, 0.f, 0.f, 0.f, 0.f, 0.f, 0.f, 0.f, 0.f, 0.f, 0.f, 0.f, 0.f, 0.f, 0.f, 0.f}) {
    f32x16 s = sinit;
    const LAS unsigned char* kp = lds + AT_KOFF + buf * AT_KBUF + (32 * a + r32) * AT_KROW + hi * 16;
#pragma unroll
    for (int sp = 0; sp < 4; ++sp) { const bf16x8 kf = *(const LAS bf16x8*)(kp + sp * 32); s = MFMA32(kf, qf[sp], s); }
    return s;
}
__device__ __forceinline__ void at_pv(LAS unsigned char* lds, int buf, int a, int r32, int hi, const f32x16& p, f32x16 (&o)[2]) {
#ifdef AT_TR
    s16x4 vtr[2][2][2];
    { const unsigned q4 = (unsigned)(r32 & 15) >> 2, p4 = (unsigned)r32 & 3u, g16 = ((unsigned)r32 >> 4) & 1u;
      const unsigned vb = (unsigned)(size_t)(lds + AT_VOFF) + (unsigned)(buf * AT_VBUF) + 4096u * (unsigned)a + 64u * (4u * (unsigned)hi + q4) + 8u * (p4 & 1u);
      const unsigned a0 = vb + 16u * ((2u * g16 + (p4 >> 1)) ^ ((unsigned)hi & 3u)), a1 = vb + 16u * ((2u * g16 + (p4 >> 1)) ^ (((unsigned)hi + 2u) & 3u));
      asm volatile("ds_read_b64_tr_b16 %0, %8\n\tds_read_b64_tr_b16 %1, %9 offset:1024\n\tds_read_b64_tr_b16 %2, %8 offset:512\n\tds_read_b64_tr_b16 %3, %9 offset:1536\n\t"
                   "ds_read_b64_tr_b16 %4, %8 offset:2048\n\tds_read_b64_tr_b16 %5, %9 offset:3072\n\tds_read_b64_tr_b16 %6, %8 offset:2560\n\tds_read_b64_tr_b16 %7, %9 offset:3584\n\ts_waitcnt lgkmcnt(0)"
                   : "=&v"(vtr[0][0][0]), "=&v"(vtr[0][0][1]), "=&v"(vtr[0][1][0]), "=&v"(vtr[0][1][1]), "=&v"(vtr[1][0][0]), "=&v"(vtr[1][0][1]), "=&v"(vtr[1][1][0]), "=&v"(vtr[1][1][1])
                   : "v"(a0), "v"(a1) : "memory"); }
#pragma unroll
    for (int s = 0; s < 2; ++s) {
        u32x4 w; w.x = cvt_pk_bf16(p[8 * s + 0], p[8 * s + 1]); w.y = cvt_pk_bf16(p[8 * s + 2], p[8 * s + 3]); w.z = cvt_pk_bf16(p[8 * s + 4], p[8 * s + 5]); w.w = cvt_pk_bf16(p[8 * s + 6], p[8 * s + 7]);
        const bf16x8 pf = __builtin_bit_cast(bf16x8, w);
#pragma unroll
        for (int dh = 0; dh < 2; ++dh) { const bf16x8 vf = {vtr[s][dh][0][0], vtr[s][dh][0][1], vtr[s][dh][0][2], vtr[s][dh][0][3], vtr[s][dh][1][0], vtr[s][dh][1][1], vtr[s][dh][1][2], vtr[s][dh][1][3]};
            o[dh] = MFMA32(vf, pf, o[dh]); }
    }
    return;
#endif
#pragma unroll
    for (int s = 0; s < 2; ++s) {
        u32x4 w; w.x = cvt_pk_bf16(p[8 * s + 0], p[8 * s + 1]); w.y = cvt_pk_bf16(p[8 * s + 2], p[8 * s + 3]); w.z = cvt_pk_bf16(p[8 * s + 4], p[8 * s + 5]); w.w = cvt_pk_bf16(p[8 * s + 6], p[8 * s + 7]);
        const bf16x8 pf = __builtin_bit_cast(bf16x8, w);
#pragma unroll
        for (int dh = 0; dh < 2; ++dh) {
            const LAS unsigned char* vp = lds + AT_VOFF + buf * AT_VBUF + (32 * dh + r32) * AT_VROW + (32 * a + 16 * s + 4 * hi) * 2;
            const s16x4 v0 = *(const LAS s16x4*)vp, v1 = *(const LAS s16x4*)(vp + 16);
            const bf16x8 vf = {v0[0], v0[1], v0[2], v0[3], v1[0], v1[1], v1[2], v1[3]};
            o[dh] = MFMA32(vf, pf, o[dh]);
        }
    }
}
#ifdef WOUT_FP8
typedef unsigned char acto_t;
#else
typedef bf16 acto_t;
#endif
__device__ __forceinline__ void at_finish(f32x16 (&o)[2], float inv_l, int hi, const float* gh, acto_t* dst) {
    float ss = 0.f;
#pragma unroll
    for (int dh = 0; dh < 2; ++dh)
#pragma unroll
        for (int r = 0; r < 16; ++r) { o[dh][r] *= inv_l; ss += o[dh][r] * o[dh][r]; }
    ss = xh_sum(ss);
    const float rn = rsqrtf(ss * (1.0f / 64.0f) + EPS);
#if defined(WOUT_FP8) && defined(FIN_WIDE)
    { unsigned w_[2][4];
#pragma unroll
      for (int dh = 0; dh < 2; ++dh)
#pragma unroll
          for (int g = 0; g < 4; ++g) { const int d = 32 * dh + 8 * g + 4 * hi; const f32x4 gv = *(const f32x4*)(gh + d);
              w_[dh][g] = pg8::pk4_fp8(o[dh][4 * g + 0] * rn * gv.x, o[dh][4 * g + 1] * rn * gv.y, o[dh][4 * g + 2] * rn * gv.z, o[dh][4 * g + 3] * rn * gv.w); }
      unsigned x_[4], y_[4];
#pragma unroll
      for (int g = 0; g < 4; ++g) { const auto r_ = __builtin_amdgcn_permlane32_swap(w_[0][g], w_[1][g], false, false); x_[g] = r_[0]; y_[g] = r_[1]; }
      u32x4 s0_, s1_; s0_.x = x_[0]; s0_.y = y_[0]; s0_.z = x_[1]; s0_.w = y_[1]; s1_.x = x_[2]; s1_.y = y_[2]; s1_.z = x_[3]; s1_.w = y_[3];
      *(u32x4*)(dst + 32 * hi) = s0_; *(u32x4*)(dst + 32 * hi + 16) = s1_; }
    return;
#endif
#pragma unroll
    for (int dh = 0; dh < 2; ++dh)
#pragma unroll
        for (int g = 0; g < 4; ++g) { const int d = 32 * dh + 8 * g + 4 * hi; const f32x4 gv = *(const f32x4*)(gh + d);
#ifdef WOUT_FP8
            *(unsigned*)(dst + d) = pg8::pk4_fp8(o[dh][4 * g + 0] * rn * gv.x, o[dh][4 * g + 1] * rn * gv.y, o[dh][4 * g + 2] * rn * gv.z, o[dh][4 * g + 3] * rn * gv.w); }
#else
            u32x2 w; w.x = cvt_pk_bf16(o[dh][4 * g + 0] * rn * gv.x, o[dh][4 * g + 1] * rn * gv.y); w.y = cvt_pk_bf16(o[dh][4 * g + 2] * rn * gv.z, o[dh][4 * g + 3] * rn * gv.w);
            *(u32x2*)(dst + d) = w; }
#endif
}

constexpr float LOG2E = 1.4426950408889634f;
template <int MODE> __device__ __forceinline__ void attn_masked_unit(const bf16* P, const unsigned long long* mask, const float* kmean, const unsigned* knmax, const float* gh16, acto_t* act, int b, int h, int qb, LAS unsigned char* lds) {
    const int tid = otid(), lane = tid & 63, wid = tid >> 6, r32 = lane & 31, hi = lane >> 5;
    const int cb = MODE == 0 ? 768 : 2304, hb = MODE == 0 ? 4 : 12;
    const bf16* Pb = P + (size_t)b * SEQ * PW + cb;
    const int kcol = 256 + h * 64, vcol = 512 + h * 64;
    const int q0 = qb * 256, tq = q0 + 32 * wid + r32, qmax = q0 + 32 * wid + 31;
    const float slope2 = alibi_slope(MODE == 0 ? 0 : 2, h) * LOG2E;
    bf16x8 qf[4];
#pragma unroll
    for (int sp = 0; sp < 4; ++sp) qf[sp] = *(const bf16x8*)(Pb + (size_t)tq * PW + h * 64 + 16 * sp + 8 * hi);
    int t = 4 * qb + 3, tn, tn2;
    u32x4 kr, vr, kr2, vr2;
    at_load(Pb, t * 64, kcol, vcol, tid, kr, vr);
    const unsigned long long* mrow = mask + (size_t)(b * SEQ + tq) * 64;
    unsigned long long mw = (MODE == 0) ? mrow[t] : 0ull, mwn = 0ull, mwn2 = 0ull;
    float kmv0 = 0.f, kmv1 = 0.f;
    if (MODE == 1) { kmv0 = kmean[((size_t)b * 16 + (tid >> 6)) * 256 + h * 64 + (tid & 63)]; kmv1 = kmean[((size_t)b * 16 + 8 + (tid >> 6)) * 256 + h * 64 + (tid & 63)]; }
    float qn2 = 0.f;
#pragma unroll
    for (int sp = 0; sp < 4; ++sp)
#pragma unroll
        for (int i = 0; i < 8; ++i) { const float v = bf2f((unsigned)(unsigned short)qf[sp][i]); qn2 += v * v; }
    qn2 = xh_sum(qn2);
    const float bound0 = sqrtf(qn2) * __uint_as_float(knmax[(b * 2 + MODE) * 4 + h]) * 1.01f + 1e-3f;
    LAS unsigned* misc = (LAS unsigned*)(lds + AT_MISC);
    unsigned sel = 0u, wgsel = 0xffffu;
    if (tid < 8) misc[tid] = 0u;
    if (MODE == 1) {
        LAS float* km = (LAS float*)(lds + AT_KMOFF);
        km[tid] = kmv0; km[512 + tid] = kmv1;
        __syncthreads();
        if (qb <= 3) sel = (1u << qb) - 1u;
        else {
            float q32[32];
#pragma unroll
            for (int sp = 0; sp < 4; ++sp) { const u32x4 u = __builtin_bit_cast(u32x4, qf[sp]);
                q32[8 * sp + 0] = __uint_as_float(u.x << 16); q32[8 * sp + 1] = __uint_as_float(u.x & 0xffff0000u); q32[8 * sp + 2] = __uint_as_float(u.y << 16); q32[8 * sp + 3] = __uint_as_float(u.y & 0xffff0000u);
                q32[8 * sp + 4] = __uint_as_float(u.z << 16); q32[8 * sp + 5] = __uint_as_float(u.z & 0xffff0000u); q32[8 * sp + 6] = __uint_as_float(u.w << 16); q32[8 * sp + 7] = __uint_as_float(u.w & 0xffff0000u); }
            float v1 = -INFINITY, v2 = -INFINITY, v3 = -INFINITY; int i1 = 0, i2 = 0, i3 = 0;
            for (int blk = 0; blk < qb; ++blk) {
                const LAS f32x4* kb = (const LAS f32x4*)(km + blk * 64 + 8 * hi); float g0 = 0.f, g1 = 0.f;
#pragma unroll
                for (int sp = 0; sp < 4; ++sp) { const f32x4 ka = kb[4 * sp], kc = kb[4 * sp + 1];
                    g0 += q32[8 * sp + 0] * ka.x; g1 += q32[8 * sp + 1] * ka.y; g0 += q32[8 * sp + 2] * ka.z; g1 += q32[8 * sp + 3] * ka.w;
                    g0 += q32[8 * sp + 4] * kc.x; g1 += q32[8 * sp + 5] * kc.y; g0 += q32[8 * sp + 6] * kc.z; g1 += q32[8 * sp + 7] * kc.w; }
                const float g = xh_sum(g0 + g1);
                if (g > v1) { v3 = v2; i3 = i2; v2 = v1; i2 = i1; v1 = g; i1 = blk; }
                else if (g > v2) { v3 = v2; i3 = i2; v2 = g; i2 = blk; }
                else if (g > v3) { v3 = g; i3 = blk; }
            }
            sel = (1u << i1) | (1u << i2) | (1u << i3);
        }
        unsigned ws_ = sel;
#define WOR_DPP(ctrl, rm, bm) ws_ |= (unsigned)__builtin_amdgcn_update_dpp(0, (int)ws_, ctrl, rm, bm, false)
        WOR_DPP(0x111, 0xf, 0xf); WOR_DPP(0x112, 0xf, 0xf); WOR_DPP(0x114, 0xf, 0xe); WOR_DPP(0x118, 0xf, 0xc); WOR_DPP(0x142, 0xa, 0xf); WOR_DPP(0x143, 0xc, 0xf);
#undef WOR_DPP
        if (lane == 63) __hip_atomic_fetch_or(&misc[0], ws_, __ATOMIC_RELAXED, __HIP_MEMORY_SCOPE_WORKGROUP);
        __syncthreads();
        wgsel = misc[0] | (1u << qb);
    }
    f32x16 cr;
#pragma unroll
    for (int r = 0; r < 16; ++r) cr[r] = slope2 * (float)((r & 3) + 8 * (r >> 2));
    f32x16 o[2];
#pragma unroll
    for (int r = 0; r < 16; ++r) { o[0][r] = 0.f; o[1][r] = 0.f; }
    float m = -INFINITY, l = 0.f; bool done = false;
#define AT_NEXT(x, y) do { (y) = (x) - 1; if (MODE == 1) { while ((y) >= 0 && !((wgsel >> ((y) >> 2)) & 1u)) (y) -= 4; } } while (0)
    at_store(lds, 0, tid, kr, vr);
    AT_NEXT(t, tn);
    if (tn >= 0) { at_load(Pb, tn * 64, kcol, vcol, tid, kr, vr); if (MODE == 0) mwn = mrow[tn]; }
    __syncthreads();
    int buf = 0, it = 0;
#ifdef PROBE_A
    long long tacc = 0; int tcnt = 0;
#define ASTAMP(beg_of, end_of) do { const long long c_ = clock64(); if (PROBE_A == (beg_of) || (PROBE_A == 5 && (beg_of) == 1)) tacc -= c_; if (PROBE_A == (end_of) || (PROBE_A == 5 && (end_of) == 4)) tacc += c_; } while (0)
#else
#define ASTAMP(a, b) do {} while (0)
#endif
#define AT_STEP(KA, VA, MA, KB, VB, MB) { \
        ASTAMP(1, 0); \
        tn2 = -1; if (tn >= 0) AT_NEXT(tn, tn2); \
        if (tn2 >= 0) { at_load(Pb, tn2 * 64, kcol, vcol, tid, KB, VB); if (MODE == 0) MB = mrow[tn2]; } \
        ASTAMP(2, 1); \
        at_compute(); \
        ASTAMP(3, 2); \
        if (lane == 0 && (done || tn < 0)) __hip_atomic_fetch_add(&misc[4 + it % 3], 1u, __ATOMIC_RELAXED, __HIP_MEMORY_SCOPE_WORKGROUP); \
        if (tid == 0) misc[4 + (it + 1) % 3] = 0u; \
        if (tn >= 0) at_store(lds, buf ^ 1, tid, KA, VA); \
        ASTAMP(4, 3); \
        __syncthreads(); \
        ASTAMP(0, 4); \
        nd = misc[4 + it % 3]; \
        buf ^= 1; t = tn; tn = tn2; mw = MA; ++it; }
    auto at_compute = [&]() __attribute__((always_inline)) {
        const int k0 = t * 64; const bool own = t >= 4 * qb;
        if (!done && k0 <= qmax) {
            const float ub = bound0 + slope2 * (float)(k0 + 63 - tq);
#if defined(PROBE_SUB) && PROBE_SUB == 6
            if (!own && __all(ub - m < -1e30f)) done = true;
#else
            if (!own && __all(ub - m < -151.0f)) done = true;
#endif
            else if (MODE == 0 || own || __any((sel >> (t >> 2)) & 1u)) {
                f32x16 s0 = cr, s1 = cr;
                { const LAS unsigned char* kp0_ = lds + AT_KOFF + buf * AT_KBUF + r32 * AT_KROW + hi * 16; const LAS unsigned char* kp1_ = kp0_ + 32 * AT_KROW;
                  bf16x8 ka_[4], kb_[4];
#pragma unroll
                  for (int sp = 0; sp < 4; ++sp) { ka_[sp] = *(const LAS bf16x8*)(kp0_ + sp * 32); kb_[sp] = *(const LAS bf16x8*)(kp1_ + sp * 32); }
                  asm volatile("" : "+v"(ka_[0]), "+v"(ka_[1]), "+v"(ka_[2]), "+v"(ka_[3]), "+v"(kb_[0]), "+v"(kb_[1]), "+v"(kb_[2]), "+v"(kb_[3]));
#pragma unroll
                  for (int sp = 0; sp < 4; ++sp) { s0 = MFMA32(ka_[sp], qf[sp], s0); s1 = MFMA32(kb_[sp], qf[sp], s1); } }
                if (MODE == 0) asm volatile("s_nop 11" : "+v"(s0), "+v"(s1));
                float tb0 = slope2 * (float)(k0 + 4 * hi - tq);
                if (MODE == 1 && !own && !((sel >> (t >> 2)) & 1u)) tb0 = -INFINITY;
                const float tb1 = tb0 + 32.0f * slope2;
                float mx0 = -INFINITY, mx1 = -INFINITY;
                const unsigned wlo = (unsigned)(mw >> (4 * hi)), whi = (unsigned)(mw >> (32 + 4 * hi));
                const int lim = tq - k0 - 4 * hi;
                if (MODE == 1 && k0 + 63 > q0 + 32 * wid) {
#pragma unroll
                    for (int r = 0; r < 16; ++r) { const int kk = (r & 3) + 8 * (r >> 2); s0[r] = (kk <= lim) ? s0[r] : -INFINITY; s1[r] = (kk + 32 <= lim) ? s1[r] : -INFINITY; } }
#pragma unroll
                for (int r = 0; r < 16; ++r) { const int kk = (r & 3) + 8 * (r >> 2);
                    float x0 = s0[r], x1 = s1[r];
#ifdef AT_BFI
                    if (MODE == 0) { unsigned y0_, y1_;
                        const int b0_ = __builtin_amdgcn_sbfe((int)wlo, kk, 1), b1_ = __builtin_amdgcn_sbfe((int)whi, kk, 1);
                        asm("v_bfi_b32 %0, %1, %2, %3" : "=v"(y0_) : "v"(b0_), "v"(x0), "v"(0xff800000u)); asm("v_bfi_b32 %0, %1, %2, %3" : "=v"(y1_) : "v"(b1_), "v"(x1), "v"(0xff800000u));
                        x0 = __uint_as_float(y0_); x1 = __uint_as_float(y1_); }
#else
                    if (MODE == 0) { x0 = (wlo & (1u << kk)) ? x0 : -INFINITY; x1 = (whi & (1u << kk)) ? x1 : -INFINITY; }
#endif
                    s0[r] = x0; s1[r] = x1; mx0 = fmaxf(mx0, x0); mx1 = fmaxf(mx1, x1); }
                float mx = fmaxf(mx0 + tb0, mx1 + tb1);
                mx = xh_max(mx);
                if (__any(mx - m > 8.0f)) {
                    const float mn = fmaxf(m, mx), alpha = (mn == -INFINITY) ? 1.0f : exp2f(m - mn);
                    l *= alpha; m = mn;
#pragma unroll
                    for (int r = 0; r < 16; ++r) { o[0][r] *= alpha; o[1][r] *= alpha; } }
                const float mt0 = (m == -INFINITY) ? INFINITY : m - tb0, mt1 = (m == -INFINITY) ? INFINITY : m - tb1;
                float ps = 0.f;
                float ps1 = 0.f;
#pragma unroll
                for (int r = 0; r < 16; ++r) { s0[r] = __builtin_amdgcn_exp2f(s0[r] - mt0); s1[r] = __builtin_amdgcn_exp2f(s1[r] - mt1); ps += s0[r]; asm("" : "+v"(ps)); ps1 += s1[r]; }
                ps += ps1;
                l += ps;
                at_pv(lds, buf, 0, r32, hi, s0, o);
                at_pv(lds, buf, 1, r32, hi, s1, o);
            }
        }
    };
    unsigned nd = 0u;
    while (t >= 0) {
        AT_STEP(kr, vr, mwn, kr2, vr2, mwn2);
        if (nd == 8u || t < 0) break;
        AT_STEP(kr2, vr2, mwn2, kr, vr, mwn);
        if (nd == 8u) break;
    }
#undef AT_STEP
#ifdef PROBE_A
    if (MODE == 0 && blockIdx.x == 0 && tid == 64 * 5) { unsigned long long* tp = (unsigned long long*)((unsigned char*)mask - WS_MASK); atomicAdd(&tp[151], (unsigned long long)tacc); atomicAdd(&tp[152], (unsigned long long)it); }
#endif
#undef AT_NEXT
    l = xh_sum(l);
    at_finish(o, 1.0f / l, hi, gh16 + (hb + h) * 64, act + (size_t)(b * SEQ + tq) * DM + (hb + h) * 64);
    __syncthreads();
}

template <int DUMMY> __device__ __forceinline__ void attn_sb_unit(const bf16* P, const float* gh16, acto_t* act, int b, int h, int qb, LAS unsigned char* lds) {
    const int tid = otid(), lane = tid & 63, wid = tid >> 6, r32 = lane & 31, hi = lane >> 5;
    const bf16* Pb = P + (size_t)b * SEQ * PW;
    const int kcol = 256 + h * 64, vcol = 512 + h * 64;
    const int q0 = qb * 256, tq = q0 + 32 * wid + r32, qmax = q0 + 32 * wid + 31;
    bf16x8 qf[4];
#pragma unroll
    for (int sp = 0; sp < 4; ++sp) qf[sp] = *(const bf16x8*)(Pb + (size_t)tq * PW + h * 64 + 16 * sp + 8 * hi);
    LAS unsigned* vote = (LAS unsigned*)(lds + AT_MISC);
    if (tid < 3) vote[tid] = 0u;
    f32x16 o[2];
#pragma unroll
    for (int r = 0; r < 16; ++r) { o[0][r] = 0.f; o[1][r] = 0.f; }
    float carry = 1.0f; bool done = false;
    int t = 4 * qb + 3;
    u32x4 kr, vr;
    at_load(Pb, t * 64, kcol, vcol, tid, kr, vr);
    at_store(lds, 0, tid, kr, vr);
    __syncthreads();
    int buf = 0, it = 0;
    while (t >= 0) {
        const int tn = t - 1;
        if (tn >= 0) at_load(Pb, tn * 64, kcol, vcol, tid, kr, vr);
        const int k0 = t * 64;
        if (!done && k0 < qmax) {
#pragma unroll
            for (int ai = 0; ai < 2; ++ai) { const int a = 1 - ai, ks = k0 + 32 * a;
                if (ks < qmax) {
                    f32x16 s = at_scores(lds, buf, a, r32, hi, qf);
                    float G[4];
#pragma unroll
                    for (int g = 0; g < 4; ++g) { float gp = 1.0f;
#pragma unroll
                        for (int i = 0; i < 4; ++i) { const int r = 4 * g + i; const int kp = ks + 8 * g + 4 * hi + i; const bool valid = kp < tq;
                            const float z = fminf(fmaxf(s[r], -80.f), 80.f); const float e = __expf(z); float om = __builtin_amdgcn_rcpf(1.0f + e); float beta = e * om;
                            om = valid ? om : 1.0f; beta = valid ? beta : 0.0f;
                            s[r] = beta; gp *= om; }
                        G[g] = gp; }
                    float Gp[4];
#pragma unroll
                    for (int g = 0; g < 4; ++g) Gp[g] = xh_other(G[g], hi);
                    float SP[4]; SP[3] = 1.0f;
#pragma unroll
                    for (int g = 2; g >= 0; --g) SP[g] = SP[g + 1] * (G[g + 1] * Gp[g + 1]);
                    const float tot = SP[0] * (G[0] * Gp[0]);
#pragma unroll
                    for (int g = 0; g < 4; ++g) { float suf = carry * SP[g] * (hi ? 1.0f : Gp[g]);
#pragma unroll
                        for (int i = 3; i >= 0; --i) { const int r = 4 * g + i; const float beta = s[r]; s[r] = beta * suf; suf *= (1.0f - beta); } }
                    carry *= tot;
                    at_pv(lds, buf, a, r32, hi, s, o);
                }
            }
            done = __all(carry < 1e-30f);
        }
        if (lane == 0 && (done || k0 == 0)) __hip_atomic_fetch_add(&vote[it % 3], 1u, __ATOMIC_RELAXED, __HIP_MEMORY_SCOPE_WORKGROUP);
        if (tid == 0) vote[(it + 1) % 3] = 0u;
        if (tn >= 0) at_store(lds, buf ^ 1, tid, kr, vr);
        __syncthreads();
        const unsigned nd = vote[it % 3];
        buf ^= 1; t = tn; ++it;
        if (nd == 8u) break;
    }
    at_finish(o, 1.0f, hi, gh16 + h * 64, act + (size_t)(b * SEQ + tq) * DM + h * 64);
    __syncthreads();
}

template <int DUMMY> __device__ __forceinline__ void attn_sb_wave(const bf16* P, const float* gh16, acto_t* act, int b, int h, int qb, LAS unsigned char* lds) {
    const int tid = otid(), lane = tid & 63, wid = tid >> 6, r32 = lane & 31, hi = lane >> 5;
    const bf16* Pb = P + (size_t)b * SEQ * PW;
    const int kcol = 256 + h * 64;
    const int q0 = qb * 256, tq = q0 + 32 * wid + r32;
    bf16x8 qf[4];
#pragma unroll
    for (int sp = 0; sp < 4; ++sp) qf[sp] = *(const bf16x8*)(Pb + (size_t)tq * PW + h * 64 + 16 * sp + 8 * hi);
    LAS unsigned char* vt = lds + wid * 4608;
    f32x16 o[2];
#pragma unroll
    for (int r = 0; r < 16; ++r) { o[0][r] = 0.f; o[1][r] = 0.f; }
    float carry = 1.0f;
    const int lrow = lane >> 3, lch = lane & 7;
    LAS unsigned char* st_base = vt + 512 * (lch >> 2) + 64 * lrow;
    const unsigned q4 = (unsigned)(r32 & 15) >> 2, p4 = (unsigned)r32 & 3u, g16 = ((unsigned)r32 >> 4) & 1u;
    const unsigned vb = (unsigned)(size_t)vt + 64u * (4u * (unsigned)hi + q4) + 8u * (p4 & 1u);
    const unsigned tra0 = vb + 16u * ((2u * g16 + (p4 >> 1)) ^ ((unsigned)hi & 3u)), tra1 = vb + 16u * ((2u * g16 + (p4 >> 1)) ^ (((unsigned)hi + 2u) & 3u));
    u32x4 ksA[4], vvA[4], ksB[4], vvB[4];
    auto gld = [&](int ks_, u32x4 (&ks)[4], u32x4 (&vv)[4]) __attribute__((always_inline)) {
#pragma unroll
        for (int i = 0; i < 4; ++i) { const bf16* cp_ = Pb + (size_t)(ks_ + 8 * i + lrow) * PW + kcol + 8 * lch; ks[i] = *(const u32x4*)cp_; vv[i] = *(const u32x4*)(cp_ + 256); } };
    bool done = false;
    auto step = [&](int ks_, u32x4 (&ks)[4], u32x4 (&vv)[4]) __attribute__((always_inline)) {
#pragma unroll
        for (int i = 0; i < 4; ++i) *(LAS u32x4*)(st_base + 1024 * i + 16 * ((lch & 3) ^ ((2 * i + (lrow >> 2)) & 3))) = ks[i];
        bf16x8 kf[4];
#pragma unroll
        for (int sp = 0; sp < 4; ++sp) { const int ch_ = 2 * sp + hi; kf[sp] = *(const LAS bf16x8*)(vt + 1024 * (r32 >> 3) + 512 * (ch_ >> 2) + 64 * (r32 & 7) + 16 * ((ch_ & 3) ^ ((r32 >> 2) & 3))); }
        asm volatile("s_waitcnt lgkmcnt(0)" ::: "memory");
#pragma unroll
        for (int i = 0; i < 4; ++i) *(LAS u32x4*)(st_base + 1024 * i + 16 * ((lch & 3) ^ ((2 * i + (lrow >> 2)) & 3))) = vv[i];
        if (ks_ >= 64) gld(ks_ - 64, ks, vv);
        f32x16 s = {0.f, 0.f, 0.f, 0.f, 0.f, 0.f, 0.f, 0.f, 0.f, 0.f, 0.f, 0.f, 0.f, 0.f, 0.f, 0.f};
#pragma unroll
        for (int sp = 0; sp < 4; ++sp) s = MFMA32(kf[sp], qf[sp], s);
        float G[4];
#pragma unroll
        for (int g = 0; g < 4; ++g) { float gp = 1.0f;
#pragma unroll
            for (int i = 0; i < 4; ++i) { const int r = 4 * g + i; const int kp = ks_ + 8 * g + 4 * hi + i; const bool valid = kp < tq;
                const float z = __builtin_amdgcn_fmed3f(s[r], -115.41560327111707f, 115.41560327111707f); const float e = __builtin_amdgcn_exp2f(z); float om = __builtin_amdgcn_rcpf(1.0f + e); float beta = e * om;
                om = valid ? om : 1.0f; beta = valid ? beta : 0.0f;
                s[r] = beta; gp *= om; }
            G[g] = gp; }
        float Gp[4];
#pragma unroll
        for (int g = 0; g < 4; ++g) Gp[g] = xh_other(G[g], hi);
        float SP[4]; SP[3] = 1.0f;
#pragma unroll
        for (int g = 2; g >= 0; --g) SP[g] = SP[g + 1] * (G[g + 1] * Gp[g + 1]);
        const float tot = SP[0] * (G[0] * Gp[0]);
#pragma unroll
        for (int g = 0; g < 4; ++g) { float suf = carry * SP[g] * (hi ? 1.0f : Gp[g]);
#pragma unroll
            for (int i = 3; i >= 0; --i) { const int r = 4 * g + i; const float beta = s[r]; s[r] = beta * suf; suf *= (1.0f - beta); } }
        carry *= tot;
        s16x4 vtr[2][2][2];
        asm volatile("ds_read_b64_tr_b16 %0, %8\n\tds_read_b64_tr_b16 %1, %9 offset:1024\n\tds_read_b64_tr_b16 %2, %8 offset:512\n\tds_read_b64_tr_b16 %3, %9 offset:1536\n\t"
                     "ds_read_b64_tr_b16 %4, %8 offset:2048\n\tds_read_b64_tr_b16 %5, %9 offset:3072\n\tds_read_b64_tr_b16 %6, %8 offset:2560\n\tds_read_b64_tr_b16 %7, %9 offset:3584\n\ts_waitcnt lgkmcnt(0)"
                     : "=&v"(vtr[0][0][0]), "=&v"(vtr[0][0][1]), "=&v"(vtr[0][1][0]), "=&v"(vtr[0][1][1]), "=&v"(vtr[1][0][0]), "=&v"(vtr[1][0][1]), "=&v"(vtr[1][1][0]), "=&v"(vtr[1][1][1])
                     : "v"(tra0), "v"(tra1) : "memory");
#pragma unroll
        for (int sk = 0; sk < 2; ++sk) {
            u32x4 w; w.x = cvt_pk_bf16(s[8 * sk + 0], s[8 * sk + 1]); w.y = cvt_pk_bf16(s[8 * sk + 2], s[8 * sk + 3]); w.z = cvt_pk_bf16(s[8 * sk + 4], s[8 * sk + 5]); w.w = cvt_pk_bf16(s[8 * sk + 6], s[8 * sk + 7]);
            const bf16x8 pf = __builtin_bit_cast(bf16x8, w);
#pragma unroll
            for (int dh = 0; dh < 2; ++dh) { const bf16x8 vf = {vtr[sk][dh][0][0], vtr[sk][dh][0][1], vtr[sk][dh][0][2], vtr[sk][dh][0][3], vtr[sk][dh][1][0], vtr[sk][dh][1][1], vtr[sk][dh][1][2], vtr[sk][dh][1][3]};
                o[dh] = MFMA32(vf, pf, o[dh]); } }
        done = __all(carry < 1e-30f);
    };
    int ks0 = q0 + 32 * wid;
    gld(ks0, ksA, vvA); if (ks0 >= 32) gld(ks0 - 32, ksB, vvB);
    for (; ks0 >= 0; ks0 -= 64) { step(ks0, ksA, vvA); if (done || ks0 < 32) break; step(ks0 - 32, ksB, vvB); if (done) break; }
    at_finish(o, 1.0f, hi, gh16 + h * 64, act + (size_t)(b * SEQ + tq) * DM + h * 64);
}

constexpr int DL_VROW = 72, DL_VT = 0, DL_VTW = 64 * DL_VROW, DL_CB = 8 * DL_VTW, DL_CBROW = 65, DL_ML = DL_CB + 256 * DL_CBROW * 4;
template <int BR> __device__ __forceinline__ int dl_kpos(int rho, int j, int q0, int wid) {
    if (BR == 0) return q0 + 32 * wid - 128 + 32 * j + rho;
    if (BR == 1) return q0 + (wid & 3) + 4 * (32 * (wid >> 2) - 128 + 32 * j + rho);
    return q0 + 2 * wid + (rho >> 4) + 16 * (-128 + 16 * j + (rho & 15));
}
template <int BR> __device__ __forceinline__ void dilated_branch(const bf16* Pb, int h, int q0, float slope, LAS unsigned char* lds, int wid, int r32, int hi, const float* ghh, acto_t* actb) {
    constexpr int R = BR == 0 ? 1 : (BR == 1 ? 4 : 16), W = 128 * R, NSUB = BR == 2 ? 9 : 5;
    const int qpos = BR == 0 ? q0 + 32 * wid + r32 : (BR == 1 ? q0 + (wid & 3) + 4 * (32 * (wid >> 2) + r32) : q0 + 2 * wid + (r32 >> 4) + 16 * (r32 & 15));
    bf16x8 qf[4];
#pragma unroll
    for (int sp = 0; sp < 4; ++sp) qf[sp] = *(const bf16x8*)(Pb + (size_t)qpos * PW + h * 64 + 16 * sp + 8 * hi);
    LAS unsigned char* vt = lds + DL_VT + wid * DL_VTW;
    f32x16 o[2];
#pragma unroll
    for (int r = 0; r < 16; ++r) { o[0][r] = 0.f; o[1][r] = 0.f; }
    float m = -INFINITY, l = 0.f;
    const int lane_ = r32 + 32 * hi, lrow = lane_ >> 3, lch = lane_ & 7;
    LAS unsigned char* st_base = vt + 512 * (lch >> 2) + 64 * lrow;
    const unsigned q4 = (unsigned)(r32 & 15) >> 2, p4 = (unsigned)r32 & 3u, g16 = ((unsigned)r32 >> 4) & 1u;
    const unsigned vb = (unsigned)(size_t)vt + 64u * (4u * (unsigned)hi + q4) + 8u * (p4 & 1u);
    const unsigned tra0 = vb + 16u * ((2u * g16 + (p4 >> 1)) ^ ((unsigned)hi & 3u)), tra1 = vb + 16u * ((2u * g16 + (p4 >> 1)) ^ (((unsigned)hi + 2u) & 3u));
    u32x4 ksA[4], vvA[4], ksB[4], vvB[4];
    const float sR = slope * (float)R; f32x16 sinit;
#pragma unroll
    for (int r = 0; r < 16; ++r) sinit[r] = sR * (float)((BR == 2 ? 8 * ((r >> 2) & 1) : 8 * (r >> 2)) + (r & 3));
    const unsigned ubp1 = (unsigned)min(128, qpos / R) + 1u;
    const unsigned ubp1_lo = (BR == 2 && r32 >= 16) ? 0u : ubp1, ubp1_hi = (BR == 2 && r32 < 16) ? 0u : ubp1;
    auto gld = [&](int jj, u32x4 (&ks)[4], u32x4 (&vv)[4]) __attribute__((always_inline)) {
#pragma unroll
        for (int i = 0; i < 4; ++i) { const int kp_ = dl_kpos<BR>(8 * i + lrow, jj, q0, wid); const bf16* cp_ = Pb + (size_t)(kp_ < 0 ? 0 : kp_) * PW + 256 + h * 64 + 8 * lch;
            ks[i] = *(const u32x4*)cp_; vv[i] = *(const u32x4*)(cp_ + 256); } };
    auto step = [&](int j, u32x4 (&ks)[4], u32x4 (&vv)[4]) __attribute__((always_inline)) {
#pragma unroll
        for (int i = 0; i < 4; ++i) *(LAS u32x4*)(st_base + 1024 * i + 16 * ((lch & 3) ^ ((2 * i + (lrow >> 2)) & 3))) = ks[i];
        bf16x8 kf[4];
#pragma unroll
        for (int sp = 0; sp < 4; ++sp) { const int ch_ = 2 * sp + hi; kf[sp] = *(const LAS bf16x8*)(vt + 1024 * (r32 >> 3) + 512 * (ch_ >> 2) + 64 * (r32 & 7) + 16 * ((ch_ & 3) ^ ((r32 >> 2) & 3))); }
        asm volatile("s_waitcnt lgkmcnt(0)" ::: "memory");
#pragma unroll
        for (int i = 0; i < 4; ++i) *(LAS u32x4*)(st_base + 1024 * i + 16 * ((lch & 3) ^ ((2 * i + (lrow >> 2)) & 3))) = vv[i];
        if (j + 2 < NSUB) gld(j + 2, ks, vv);
        f32x16 s = sinit;
#pragma unroll
        for (int sp = 0; sp < 4; ++sp) s = MFMA32(kf[sp], qf[sp], s);
        const int T0 = (BR == 2 ? (r32 & 15) + 128 - 16 * j : r32 + 128 - 32 * j) - 4 * hi; const float b0 = -sR * (float)T0;
        const int hiB = T0 < 31 ? T0 : 31, loB = (T0 - (int)ubp1 + 1) > 0 ? (T0 - (int)ubp1 + 1) : 0;
        const unsigned bandm = (T0 >= 0 && hiB >= loB) ? (((2u << hiB) - 1u) & ~((1u << loB) - 1u)) : 0u;
        const unsigned bm_lo = ubp1_lo ? bandm : 0u, bm_hi = ubp1_hi ? bandm : 0u;
        float mx = -INFINITY;
#pragma unroll
        for (int r = 0; r < 16; ++r) { const int c_r = (BR == 2 ? 8 * ((r >> 2) & 1) : 8 * (r >> 2)) + (r & 3);
            const int vb_ = __builtin_amdgcn_sbfe((int)((BR == 2 && r >= 8) ? bm_hi : bm_lo), c_r, 1); const float x_ = s[r] + b0; unsigned y_;
            asm("v_bfi_b32 %0, %1, %2, %3" : "=v"(y_) : "v"(vb_), "v"(x_), "v"(0xff800000u));
            s[r] = __uint_as_float(y_); mx = fmaxf(mx, s[r]); }
        mx = xh_max(mx);
        if (__any(mx - m > 8.0f)) {
            const float mn = fmaxf(m, mx), alpha = (mn == -INFINITY) ? 1.0f : exp2f(m - mn);
            l *= alpha; m = mn;
#pragma unroll
            for (int r = 0; r < 16; ++r) { o[0][r] *= alpha; o[1][r] *= alpha; } }
        const float mu = (m == -INFINITY) ? INFINITY : m;
        float ps = 0.f;
#pragma unroll
        for (int r = 0; r < 16; ++r) { s[r] = __builtin_amdgcn_exp2f(s[r] - mu); ps += s[r]; }
        l += ps;
        s16x4 vtr[2][2][2];
        asm volatile("ds_read_b64_tr_b16 %0, %8\n\tds_read_b64_tr_b16 %1, %9 offset:1024\n\tds_read_b64_tr_b16 %2, %8 offset:512\n\tds_read_b64_tr_b16 %3, %9 offset:1536\n\t"
                     "ds_read_b64_tr_b16 %4, %8 offset:2048\n\tds_read_b64_tr_b16 %5, %9 offset:3072\n\tds_read_b64_tr_b16 %6, %8 offset:2560\n\tds_read_b64_tr_b16 %7, %9 offset:3584\n\ts_waitcnt lgkmcnt(0)"
                     : "=&v"(vtr[0][0][0]), "=&v"(vtr[0][0][1]), "=&v"(vtr[0][1][0]), "=&v"(vtr[0][1][1]), "=&v"(vtr[1][0][0]), "=&v"(vtr[1][0][1]), "=&v"(vtr[1][1][0]), "=&v"(vtr[1][1][1])
                     : "v"(tra0), "v"(tra1) : "memory");
#pragma unroll
        for (int sk = 0; sk < 2; ++sk) {
            u32x4 w; w.x = cvt_pk_bf16(s[8 * sk + 0], s[8 * sk + 1]); w.y = cvt_pk_bf16(s[8 * sk + 2], s[8 * sk + 3]); w.z = cvt_pk_bf16(s[8 * sk + 4], s[8 * sk + 5]); w.w = cvt_pk_bf16(s[8 * sk + 6], s[8 * sk + 7]);
            const bf16x8 pf = __builtin_bit_cast(bf16x8, w);
#pragma unroll
            for (int dh = 0; dh < 2; ++dh) { const bf16x8 vf = {vtr[sk][dh][0][0], vtr[sk][dh][0][1], vtr[sk][dh][0][2], vtr[sk][dh][0][3], vtr[sk][dh][1][0], vtr[sk][dh][1][1], vtr[sk][dh][1][2], vtr[sk][dh][1][3]};
                o[dh] = MFMA32(vf, pf, o[dh]); } }
    };
    gld(0, ksA, vvA); if (NSUB > 1) gld(1, ksB, vvB);
    for (int j = 0; j < NSUB; j += 2) { step(j, ksA, vvA); if (j + 1 < NSUB) step(j + 1, ksB, vvB); }
    l = xh_sum(l);
    const int qi = qpos - q0;
    LAS float* cb = (LAS float*)(lds + DL_CB) + qi * DL_CBROW; LAS float* ml = (LAS float*)(lds + DL_ML);
    if (BR > 0) {
        const float M0 = ml[qi], L0 = ml[256 + qi];
        const float mn = fmaxf(M0, m), a0 = __builtin_amdgcn_exp2f(M0 - mn), a1 = __builtin_amdgcn_exp2f(m - mn);
#pragma unroll
        for (int dh = 0; dh < 2; ++dh)
#pragma unroll
            for (int r = 0; r < 16; ++r) o[dh][r] = o[dh][r] * a1 + cb[32 * dh + crow(r, hi)] * a0;
        l = l * a1 + L0 * a0; m = mn;
    }
    if (BR < 2) {
        __syncthreads();
#pragma unroll
        for (int dh = 0; dh < 2; ++dh)
#pragma unroll
            for (int r = 0; r < 16; ++r) cb[32 * dh + crow(r, hi)] = o[dh][r];
        if (hi == 0) { ml[qi] = m; ml[256 + qi] = l; }
        __syncthreads();
    } else {
        at_finish(o, 1.0f / l, hi, ghh, actb + (size_t)qpos * DM);
    }
}
__device__ __forceinline__ void attn_dilated_unit(const bf16* P, const float* gh16, acto_t* act, int b, int h, int qb, LAS unsigned char* lds) {
    const int tid = otid(), lane = tid & 63, wid = tid >> 6, r32 = lane & 31, hi = lane >> 5;
    const bf16* Pb = P + (size_t)b * SEQ * PW + 1536;
    const float slope = alibi_slope(1, h) * LOG2E;
    const float* ghh = gh16 + (8 + h) * 64; acto_t* actb = act + (size_t)b * SEQ * DM + (8 + h) * 64;
    dilated_branch<0>(Pb, h, qb * 256, slope, lds, wid, r32, hi, ghh, actb);
    dilated_branch<1>(Pb, h, qb * 256, slope, lds, wid, r32, hi, ghh, actb);
    dilated_branch<2>(Pb, h, qb * 256, slope, lds, wid, r32, hi, ghh, actb);
    __syncthreads();
}

#ifndef MK_SPLIT
#define MK_SPLIT 0
#endif
constexpr int MISC_OFF = 131072, ROWTAB_OFF = MISC_OFF + 1024, LDS_BYTES = 131072 + 2048 + 64;
constexpr int N_PHASES = 19;
struct MegaArgs { const float* in[17]; float* out; unsigned char* ws; int ph_lo, ph_hi, li, pad; };

__global__ void __launch_bounds__(512, 2) mega_fwd(MegaArgs a) {
    extern __shared__ __attribute__((aligned(16))) unsigned char lds_raw[];
    LAS unsigned char* lds = (LAS unsigned char*)lds_raw;
    volatile LAS unsigned* MISC = (volatile LAS unsigned*)(lds + MISC_OFF);
    const int tid = threadIdx.x, bid = blockIdx.x, nblk = gridDim.x;
    for (int u = tid; u < (LDS_BYTES - MISC_OFF) / 4; u += 512) MISC[u] = 0u;
    __syncthreads();
    if (tid < 17) { const unsigned long long p = (unsigned long long)a.in[tid]; MISC[64 + 2 * tid] = (unsigned)p; MISC[65 + 2 * tid] = (unsigned)(p >> 32); }
    __syncthreads();
#define INP(i) ((const float*)(((unsigned long long)(unsigned)__builtin_amdgcn_readfirstlane((int)MISC[65 + 2 * (i)]) << 32) | (unsigned long long)(unsigned)__builtin_amdgcn_readfirstlane((int)MISC[64 + 2 * (i)])))
    unsigned char* ws = a.ws;
    unsigned* ctl = (unsigned*)(ws + WS_CTL);
    XcdBarrier bar; bar.bar = ctl + CW_BAR + a.li * XCD_BAR_WORDS; bar.x = 0; bar.st = nullptr;
    if (!MK_SPLIT) bar = xcd_barrier_post(ctl + CW_BAR + a.li * XCD_BAR_WORDS, MISC + 8);
    const int lo = a.ph_lo, hi = a.ph_hi;
#define RUN(k) (lo <= (k) && (k) < hi)
#define SEAM(k) do { if (RUN(k) && RUN((k) + 1)) { if (!MK_SPLIT) xcd_barrier(bar); } } while (0)
    float* out = a.out;
    float* mod = (float*)(ws + WS_MOD); float* kmean = (float*)(ws + WS_KMEAN); const float* gv = (const float*)(ws + WS_GV);
    int* tok = (int*)(ws + WS_TOK); bf16* act = (bf16*)(ws + WS_ACT); bf16* P = (bf16*)(ws + WS_P); bf16* hid = (bf16*)(ws + WS_HID); unsigned char* xs = ws + WS_XS; bf16* ys = (bf16*)(ws + WS_YS);
    unsigned long long* mask = (unsigned long long*)(ws + WS_MASK); unsigned* ecnt = ctl + CW_ECNT;

    if (RUN(0)) {
        PrepArgs pa{INP(5), INP(7), INP(9), INP(10), INP(11), INP(13), INP(14), INP(15), ws};
        ph_prep(pa, lds, bid, nblk);
        __syncthreads();
        ph_mod(INP(1), INP(2), INP(3), mod, lds, bid, nblk);
        { float* gvw = (float*)(ws + WS_GV); const float* s4 = INP(4); const float* s6 = INP(6); const float* s8 = INP(8); const float* s16 = INP(16);
          for (int i = bid * 512 + otid(); i < 7168; i += nblk * 512) gvw[i] = i < 2048 ? s4[i] : (i < 4096 ? s6[i - 2048] : (i < 6144 ? s8[i - 4096] : s16[i - 6144])); }
    }
    SEAM(0);
#if defined(PROBE_SUB) && PROBE_SUB == 9
    for (int rep_ = 0; rep_ < 20; ++rep_) xcd_barrier(bar);
#endif
    for (int l = 0; l < NLAYER; ++l) {
        const int pb = 1 + 8 * l;
        const float* ml = mod + (size_t)l * 8 * 6144; bf16* xb = (bf16*)(ws + WS_XB); const float* gh = gv + 2048 + l * 1024;
#ifdef WIN_FP8
        if (RUN(pb)) { NormArgs na{}; if (l == 0) na.xin = INP(0); else na.xin16 = xb; na.g = gv + l * DM; na.shift = ml; na.scale = ml + 1024; na.act = act; na.act8 = ws + WS_ACT8W; ph_norm<0>(na, lds, bid, nblk); }
#else
        if (RUN(pb)) { NormArgs na{}; if (l == 0) na.xin = INP(0); else na.xin16 = xb; na.g = gv + l * DM; na.shift = ml; na.scale = ml + 1024; na.act = act; ph_norm<0>(na, lds, bid, nblk); }
#endif
        SEAM(pb);
#ifdef WIN_FP8
        if (RUN(pb + 1)) { pg8::EpiBf16 E{P, PW, 0};
            { pg8::Gemm g{act, (const bf16*)(ws + WS_WIN) + (size_t)l * PW * DM, T, PW, DM}; pg8::SubOrder S; S.init(T, WIN_NB16, WIN_LIST16, nblk, bid, 1 << 30, 0);
              pg8::gemm_phase<pg8::EpiBf16, pg8::SubOrder, true, true>(lds, g, S, E); }
            __syncthreads();
            { pg8::Gemm g{(const bf16*)(ws + WS_ACT8W), (const bf16*)(ws + WS_WIN8 + (size_t)l * PW * DM), T, PW, DM}; pg8::SubOrder S; S.init(T, 15 - WIN_NB16, WIN_LIST8, nblk, bid, WIN_FULL8, nblk / 2);
              pg8::gemm_phase<pg8::EpiBf16, pg8::SubOrder, true, true, true, 0x7A7A7A7A>(lds, g, S, E); } }
#else
        if (RUN(pb + 1)) { pg8::Gemm g{act, (const bf16*)(ws + WS_WIN) + (size_t)l * PW * DM, T, PW, DM}; pg8::StaticOrder S; S.init(T, PW, nblk, bid);
            pg8::EpiBf16 E{P, PW, 0}; pg8::gemm_phase<pg8::EpiBf16, pg8::StaticOrder, true, true>(lds, g, S, E); }
#endif
        SEAM(pb + 1);
        if (RUN(pb + 2)) {
            for (int u = bid, r = 0; u < NB * 512; u += nblk, ++r) { const int unit = (r & 1) ? (r * nblk + nblk - 1 - bid) : u; if (unit < NB * 512) dsa_select_unit(P, mask, unit, (LAS unsigned*)lds); }
            for (int unit = bid; unit < NB * 16; unit += nblk) kmean_unit(P, kmean, ctl + CW_KNMAX + l * 64, unit, lds);
#if defined(PROBE_SUB) && PROBE_SUB == 1
            if (l == 1) for (int u = bid, r = 0; u < NB * 512; u += nblk, ++r) { const int unit = (r & 1) ? (r * nblk + nblk - 1 - bid) : u; if (unit < NB * 512) dsa_select_unit(P, mask, unit, (LAS unsigned*)lds); }
#endif
#if defined(PROBE_SUB) && PROBE_SUB == 2
            if (l == 1) for (int u = bid; u < 512; u += nblk) attn_sb_unit<0>(P, gh, (acto_t*)act, u & 7, (u >> 3) & 3, u >> 5, lds);
#endif
#if defined(PROBE_SUB) && PROBE_SUB == 3
            if (l == 1) for (int u = bid; u < 512; u += nblk) attn_dilated_unit(P, gh, (acto_t*)act, u & 7, (u >> 3) & 3, u >> 5, lds);
#endif
#ifndef NO_SB
#ifdef SB_WAVE
            __syncthreads();
#ifdef HEAD_PASS
            for (int u = bid; u < 512; u += nblk) attn_sb_wave<0>(P, gh, (acto_t*)act, u & 7, 2 * ((u >> 8) & 1) + ((u >> 3) & 1), (u >> 4) & 15, lds);
#else
            for (int u = bid; u < 512; u += nblk) attn_sb_wave<0>(P, gh, (acto_t*)act, u & 7, (u >> 3) & 3, u >> 5, lds);
#endif
            __syncthreads();
#else
            for (int u = bid; u < 512; u += nblk) attn_sb_unit<0>(P, gh, (acto_t*)act, u & 7, (u >> 3) & 3, u >> 5, lds);
#endif
#endif
#ifndef NO_DIL
#ifdef HEAD_PASS
            for (int u = bid; u < 512; u += nblk) attn_dilated_unit(P, gh, (acto_t*)act, u & 7, 2 * ((u >> 8) & 1) + ((u >> 3) & 1), (u >> 4) & 15, lds);
#else
            for (int u = bid; u < 512; u += nblk) attn_dilated_unit(P, gh, (acto_t*)act, u & 7, (u >> 3) & 3, u >> 5, lds);
#endif
#endif
#ifdef PREP_LAZY
            { PrepArgs pa{INP(5), INP(7), INP(9), INP(10), INP(11), INP(13), INP(14), INP(15), ws}; prep_lazy(pa, ctl, CW_PDONE + 2 * l, nblk, lds); }
#endif
        }
        SEAM(pb + 2);
        if (RUN(pb + 3)) {
            LAS unsigned* qslot = (LAS unsigned*)(lds + AT_MISC + 64);
#ifdef Q_FIRST
            for (bool first_ = true;; first_ = false) { if (otid() == 0) qslot[0] = first_ ? (unsigned)bid : atomicAdd(&ctl[CW_QUEUE + 2 * l], 1u) + (unsigned)nblk;
#else
            for (;;) { if (otid() == 0) qslot[0] = atomicAdd(&ctl[CW_QUEUE + 2 * l], 1u);
#endif
                __syncthreads(); const unsigned u = qslot[0]; __syncthreads();
                if (u >= 512u) break;
                attn_masked_unit<0>(P, mask, kmean, ctl + CW_KNMAX + l * 64, gh, (acto_t*)act, (int)(u & 7u), 3 - (int)((u >> 3) & 3u), 15 - (int)(u >> 5), lds); }
#if defined(PROBE_SUB) && PROBE_SUB == 4
            if (l == 1) for (;;) { if (otid() == 0) qslot[0] = atomicAdd(&ctl[CW_QUEUE + 8], 1u);
                __syncthreads(); const unsigned u = qslot[0]; __syncthreads();
                if (u >= 512u) break;
                attn_masked_unit<0>(P, mask, kmean, ctl + CW_KNMAX + l * 64, gh, (acto_t*)act, (int)(u & 7u), 3 - (int)((u >> 3) & 3u), 15 - (int)(u >> 5), lds); }
#endif
#if defined(PROBE_SUB) && PROBE_SUB == 5
            if (l == 1) for (;;) { if (otid() == 0) qslot[0] = atomicAdd(&ctl[CW_QUEUE + 8], 1u);
                __syncthreads(); const unsigned u = qslot[0]; __syncthreads();
                if (u >= 512u) break;
                attn_masked_unit<1>(P, mask, kmean, ctl + CW_KNMAX + l * 64, gh, (acto_t*)act, (int)(u & 7u), 3 - (int)((u >> 3) & 3u), 15 - (int)(u >> 5), lds); }
#endif
            for (;;) { if (otid() == 0) qslot[0] = atomicAdd(&ctl[CW_QUEUE + 2 * l + 1], 1u);
                __syncthreads(); const unsigned u = qslot[0]; __syncthreads();
                if (u >= 512u) break;
                attn_masked_unit<1>(P, mask, kmean, ctl + CW_KNMAX + l * 64, gh, (acto_t*)act, (int)(u & 7u), 3 - (int)((u >> 3) & 3u), 15 - (int)(u >> 5), lds); }
#ifdef PREP_LAZY
            { PrepArgs pa{INP(5), INP(7), INP(9), INP(10), INP(11), INP(13), INP(14), INP(15), ws}; prep_lazy(pa, ctl, CW_PDONE + 2 * l + 1, nblk, lds); }
#endif
        }
        SEAM(pb + 3);
#ifdef WOUT_FP8
        if (RUN(pb + 4)) { pg8::Gemm g{act, (const bf16*)(ws + WS_WOUT + (size_t)l * DM * DM), T, DM, DM}; pg8::StaticOrder S; S.init(T, DM, nblk, bid);
            pg8::EpiRes E{l == 0 ? INP(0) : nullptr, xb, xb, ml + 2048}; pg8::gemm_phase<pg8::EpiRes, pg8::StaticOrder, true, true, true, 0x79797979>(lds, g, S, E); }
#else
        if (RUN(pb + 4)) { pg8::Gemm g{act, (const bf16*)(ws + WS_WOUT) + (size_t)l * DM * DM, T, DM, DM}; pg8::StaticOrder S; S.init(T, DM, nblk, bid);
            pg8::EpiRes E{l == 0 ? INP(0) : nullptr, xb, xb, ml + 2048}; pg8::gemm_phase<pg8::EpiRes, pg8::StaticOrder, true, true>(lds, g, S, E); }
#endif
        SEAM(pb + 4);
        if (l == 0) {
            if (RUN(6)) { NormArgs na{}; na.xin16 = xb; na.g = gv + 4096; na.shift = ml + 3072; na.scale = ml + 4096; na.act8 = (unsigned char*)act; ph_norm<0>(na, lds, bid, nblk); }
            SEAM(6);
#ifndef NO_FF
            if (RUN(7)) { pg8::Gemm g{act, (const bf16*)(ws + WS_WFU), T, 2 * DFF, DM}; pg8::StaticOrder S; S.init(T, 2 * DFF, nblk, bid);
                pg8::EpiSwiGLU8 E{(unsigned char*)hid, DFF, 0}; pg8::gemm_phase<pg8::EpiSwiGLU8, pg8::StaticOrder, true, true, true, 0x7A7A7A7A>(lds, g, S, E); }
            SEAM(7);
            if (RUN(8)) { pg8::Gemm g{hid, (const bf16*)(ws + WS_WFD), T, DM, DFF}; pg8::StaticOrder S; S.init(T, DM, nblk, bid);
                pg8::EpiRes E{nullptr, xb, xb, ml + 5120}; pg8::gemm_phase<pg8::EpiRes, pg8::StaticOrder, true, true, true, 0x79797979>(lds, g, S, E); }
            SEAM(8);
#endif
        } else {
            if (RUN(14)) { NormArgs na{}; na.xin16 = xb; na.g = gv + 4096 + DM; na.shift = ml + 3072; na.scale = ml + 4096; na.act8 = (unsigned char*)act; na.w_router = INP(12); na.tok = tok; na.ecnt = ecnt; na.elist = (int*)(ws + WS_ELIST);
                ph_norm<1>(na, lds, bid, nblk);
#ifdef PREP_LAZY
                { PrepArgs pa{INP(5), INP(7), INP(9), INP(10), INP(11), INP(13), INP(14), INP(15), ws}; prep_lazy(pa, ctl, -1, nblk, lds); }
#endif
            }
            SEAM(14);
#ifndef MOE_GATHER_A
            if (RUN(15)) ph_gather((const unsigned char*)act, tok, ecnt, xs, bid, nblk);
            SEAM(15);
#endif
            if (RUN(16) || RUN(17)) {
                LAS unsigned char* etab = lds + MISC_OFF + 512;
                int ntot;
                { const MoeTiles mt = moe_tiles(ecnt); ntot = moe_tile_start(mt, 7) + mt.p7;
                  const int t_ = otid(); if (t_ < XS_TILES) { int e_ = 0;
#pragma unroll
                      for (int k = 1; k < 8; ++k) e_ += (t_ >= moe_tile_start(mt, k)) ? 1 : 0;
                      etab[t_] = (unsigned char)e_; }
                  __syncthreads(); }
                pg8::MoeOrder S; S.nrt = ntot; S.G = nblk; S.c = bid; S.etab = etab;
#ifdef MOE_GATHER_A
                if (RUN(16)) { S.nN = 28; S.mode = 2; S.estride = (size_t)7168 * DM;
                    LAS unsigned* rowtab = (LAS unsigned*)(lds + ROWTAB_OFF); LAS int* einfo = (LAS int*)(lds + ROWTAB_OFF + 1024); S.rowtab = rowtab;
                    { const MoeTiles mt = moe_tiles(ecnt); const int t_ = otid(); if (t_ < 8) { einfo[t_] = moe_tile_start(mt, t_); einfo[8 + t_] = (int)__hip_atomic_load(ecnt + t_, __ATOMIC_RELAXED, __HIP_MEMORY_SCOPE_AGENT); } }
                    const int full = ntot / nblk, rem = ntot - full * nblk; const int* elist = (const int*)(ws + WS_ELIST);
                    pg8::Gemm g{act, (const bf16*)(ws + WS_WEU), 0, 0, DM}; pg8::EpiSwiGLU8 E{(unsigned char*)hid, DFE, 0};
                    for (int seg = 0;; ++seg) {
                        if (seg < full) { S.pm0 = seg * nblk + bid; S.pn0 = 0; S.cnt = 28; }
                        else { const int L = (seg - full) * nblk + bid; if (rem <= 0 || L >= rem * 28) break; S.pm0 = full * nblk + L % rem; S.pn0 = L / rem; S.cnt = 1; }
                        __syncthreads();
                        { const int t_ = otid(); if (t_ < 256) { const int e_ = (int)etab[S.pm0]; const int pos_ = (S.pm0 - einfo[e_]) * 256 + t_; const int tk_ = pos_ < einfo[8 + e_] ? elist[e_ * T + pos_] : 0; rowtab[t_] = (unsigned)tk_ * (unsigned)DM; } }
                        __syncthreads();
                        pg8::gemm_phase<pg8::EpiSwiGLU8, pg8::MoeOrder, true, true, true, 0x7A7A7A7A, 0x7F7F7F7F, true>(lds, g, S, E);
                    } }
#else
                if (RUN(16)) { S.nN = 28; S.mode = 0; S.estride = (size_t)7168 * DM;
                    pg8::Gemm g{(const bf16*)xs, (const bf16*)(ws + WS_WEU), 0, 0, DM};
                    pg8::EpiSwiGLU8 E{(unsigned char*)hid, DFE, 0}; pg8::gemm_phase<pg8::EpiSwiGLU8, pg8::MoeOrder, true, true, true, 0x7A7A7A7A>(lds, g, S, E); }
#endif
                SEAM(16);
                if (RUN(17)) { S.nN = 4; S.mode = 1; S.estride = (size_t)DM * DFE;
                    pg8::Gemm g{hid, (const bf16*)(ws + WS_WED), 0, 0, DFE};
                    pg8::EpiBf16 E{ys, DM, 0}; pg8::gemm_phase<pg8::EpiBf16, pg8::MoeOrder, true, true, true, 0x79797979>(lds, g, S, E); }
                SEAM(17);
            }
            if (RUN(18)) { NormArgs na{}; na.xin16 = xb; na.g = gv + 6144; na.tok = tok; na.ecnt = ecnt; na.ys = ys; na.gate = ml + 5120; na.out = out; ph_norm<2>(na, lds, bid, nblk); }
        }
    }
#undef RUN
#undef SEAM
}

extern "C" void kernel_launch(void* const* d_in, const int* in_sizes, int n_in, void* d_out, int out_size, void* d_ws, size_t ws_size, hipStream_t stream) {
    static int grid = 0;
    if (grid == 0) {
        if (n_in != 17 || out_size != T * DM || ws_size < WS_END) { fprintf(stderr, "kernel_launch: unexpected problem (n_in %d out %d ws %zu)\n", n_in, out_size, ws_size); grid = -1; return; }
        int dev = 0, cus = 0, per_cu = 0;
        if (hipGetDevice(&dev) != hipSuccess || hipDeviceGetAttribute(&cus, hipDeviceAttributeMultiprocessorCount, dev) != hipSuccess) { grid = -1; return; }
        if (hipFuncSetAttribute((const void*)mega_fwd, hipFuncAttributeMaxDynamicSharedMemorySize, LDS_BYTES) != hipSuccess) { fprintf(stderr, "kernel_launch: hipFuncSetAttribute failed\n"); grid = -1; return; }
        if (hipOccupancyMaxActiveBlocksPerMultiprocessor(&per_cu, (const void*)mega_fwd, 512, LDS_BYTES) != hipSuccess || per_cu < 1) fprintf(stderr, "kernel_launch: occupancy query says %d\n", per_cu);
        (void)hipGetLastError();
        grid = cus;
    }
    if (grid < 0) return;
    if (hipMemsetAsync((unsigned char*)d_ws + WS_CTL, 0, CTL_BYTES, stream) != hipSuccess) return;
    MegaArgs a{};
    for (int i = 0; i < 17; ++i) a.in[i] = (const float*)d_in[i];
    a.out = (float*)d_out; a.ws = (unsigned char*)d_ws;
#if MK_SPLIT
    for (int p = 0; p < N_PHASES; ++p) { a.ph_lo = p; a.ph_hi = p + 1; hipLaunchKernelGGL(mega_fwd, dim3(grid), dim3(512), LDS_BYTES, stream, a); }
#elif defined(PROBE_PHASE)
    a.li = 0; a.ph_lo = 0; a.ph_hi = PROBE_PHASE + 1; hipLaunchKernelGGL(mega_fwd, dim3(grid), dim3(512), LDS_BYTES, stream, a);
    a.li = 1; a.ph_lo = PROBE_PHASE; a.ph_hi = PROBE_PHASE + 1; hipLaunchKernelGGL(mega_fwd, dim3(grid), dim3(512), LDS_BYTES, stream, a);
    a.li = 2; a.ph_lo = PROBE_PHASE + 1; a.ph_hi = N_PHASES; hipLaunchKernelGGL(mega_fwd, dim3(grid), dim3(512), LDS_BYTES, stream, a);
#else
    a.ph_lo = 0; a.ph_hi = N_PHASES;
    hipLaunchKernelGGL(mega_fwd, dim3(grid), dim3(512), LDS_BYTES, stream, a);
#endif
}
```
